# Optimizing an MI355X kernel written in HIP

```python
import jax, jax.numpy as jnp
from jax import lax
import numpy as np

D_MODEL = 1024
BATCH = 2
SEQ = 16384
DEPTH = 1

A_GROUPS = 4
A_GROUP_DIM = 128
A_WIDTH = A_GROUPS * A_GROUP_DIM
CHUNK = 128
N_HEADS = 4
HEAD_DIM = 128
B_WIDTH = N_HEADS * HEAD_DIM
KV_LATENT = 256
ROT_DIM = HEAD_DIM // 4
IDX_HEADS = 4
IDX_DIM = 64
IDX_ROT = IDX_DIM // 4
TOPK_MAX = 256
Q_BLOCK = 128
ROPE_THETA = 500000.0
N_BRANCHES = 2
PEER_HEADS = 8
PEER_KEY_DIM = 256
PEER_HALF = PEER_KEY_DIM // 2
N_KEYS = 128
N_EXPERTS = N_KEYS * N_KEYS
PEER_TOPK = 16
PEER_BLOCK = 128
EPS = 1e-6

SPLITS = (A_WIDTH, A_WIDTH, B_WIDTH, KV_LATENT, IDX_HEADS * IDX_DIM, IDX_DIM, IDX_HEADS, N_BRANCHES * D_MODEL)
IN_WIDTH = sum(SPLITS)
SPLIT_OFFSETS = tuple(int(o) for o in np.cumsum(SPLITS)[:-1])

kernel_name = "hybrid_gmlp_dsa_peer_block"


def rms_norm(x, g):
    xf = x.astype(jnp.float32)
    y = xf * lax.rsqrt(jnp.mean(xf * xf, axis=-1, keepdims=True) + EPS)
    return (y * g.astype(jnp.float32)).astype(x.dtype)


def layer_norm(x, g, b):
    xf = x.astype(jnp.float32)
    mu = jnp.mean(xf, axis=-1, keepdims=True)
    xc = xf - mu
    y = xc * lax.rsqrt(jnp.mean(xc * xc, axis=-1, keepdims=True) + EPS)
    return (y * g.astype(jnp.float32) + b.astype(jnp.float32)).astype(x.dtype)


def partial_rope(x, pos, rot_dim):
    half = rot_dim // 2
    inv = jnp.power(jnp.float32(ROPE_THETA), -jnp.arange(half, dtype=jnp.float32) * 2.0 / rot_dim)
    ang = pos.astype(jnp.float32)[..., None] * inv
    cos = jnp.cos(ang)[:, :, None, :]
    sin = jnp.sin(ang)[:, :, None, :]
    xr = x[..., :rot_dim].astype(jnp.float32)
    x1, x2 = xr[..., :half], xr[..., half:]
    rot = jnp.concatenate([x1 * cos - x2 * sin, x2 * cos + x1 * sin], axis=-1)
    return jnp.concatenate([rot.astype(x.dtype), x[..., rot_dim:]], axis=-1)


def chunked_spatial_gating(u, v, v_g, v_b, w_s, b_s):
    bsz, s, _ = u.shape
    u = jax.nn.gelu(u)
    v = layer_norm(jax.nn.gelu(v), v_g, v_b)
    v = v.reshape(bsz, s // CHUNK, CHUNK, A_GROUPS, A_GROUP_DIM)
    causal = jnp.tril(jnp.ones((CHUNK, CHUNK), dtype=bool))
    w = jnp.where(causal[None], w_s, jnp.zeros_like(w_s))
    z = jnp.einsum('gts,bcsgd->bctgd', w, v) + b_s.T[None, None, :, :, None]
    return u * z.reshape(bsz, s, A_WIDTH)


def dsa_attention(q, k, v, q_idx, k_idx, w_idx):
    bsz, s = q.shape[:2]
    n_sel = min(TOPK_MAX, s // 4)
    nblk = s // Q_BLOCK
    key_pos = jnp.arange(s)

    def to_blocks(a):
        return a.reshape(bsz, nblk, Q_BLOCK, *a.shape[2:]).swapaxes(0, 1)

    def gather_rows(table, idx):
        return table[idx]

    def block_fn(args):
        blk, qb, qib, wib = args
        q_pos = blk * Q_BLOCK + jnp.arange(Q_BLOCK)
        causal = key_pos[None, :] <= q_pos[:, None]
        logits = jnp.einsum('bqhd,bsd->bqhs', qib, k_idx, preferred_element_type=jnp.float32) * (IDX_DIM ** -0.5)
        scores = jnp.einsum('bqh,bqhs->bqs', wib.astype(jnp.float32), jax.nn.relu(logits))
        scores = jnp.where(causal[None], scores, -jnp.inf)
        _, idx = lax.top_k(scores, n_sel)
        valid = idx <= q_pos[None, :, None]
        k_sel = jax.vmap(gather_rows)(k, idx)
        v_sel = jax.vmap(gather_rows)(v, idx)
        att = jnp.einsum('bqhd,bqnd->bqhn', qb, k_sel, preferred_element_type=jnp.float32) * (HEAD_DIM ** -0.5)
        att = jnp.where(valid[:, :, None, :], att, jnp.float32(-1e30))
        p = jax.nn.softmax(att, axis=-1).astype(v.dtype)
        return jnp.einsum('bqhn,bqnd->bqhd', p, v_sel)

    out = lax.map(block_fn, (jnp.arange(nblk), to_blocks(q), to_blocks(q_idx), to_blocks(w_idx)))
    return out.swapaxes(0, 1).reshape(bsz, s, B_WIDTH)


def peer(xn, wq, subkeys, u_tab, v_tab):
    bsz, s, d = xn.shape
    q = (xn @ wq).reshape(bsz, s, PEER_HEADS, 2, PEER_HALF)
    sub = jnp.einsum('bshpd,hpnd->bshpn', q, subkeys, preferred_element_type=jnp.float32)
    s_top, i_top = lax.top_k(sub, PEER_TOPK)
    cand = (s_top[..., 0, :, None] + s_top[..., 1, None, :]).reshape(bsz, s, PEER_HEADS, PEER_TOPK * PEER_TOPK)
    cand_idx = (i_top[..., 0, :, None] * N_KEYS + i_top[..., 1, None, :]).reshape(bsz, s, PEER_HEADS, PEER_TOPK * PEER_TOPK)
    best, pos = lax.top_k(cand, PEER_TOPK)
    expert = jnp.take_along_axis(cand_idx, pos, axis=-1)
    gate = jax.nn.softmax(best, axis=-1)
    nb = (bsz * s) // PEER_BLOCK
    hk = PEER_HEADS * PEER_TOPK
    xt = xn.reshape(nb, PEER_BLOCK, d)
    et = expert.reshape(nb, PEER_BLOCK, hk)
    gt = gate.reshape(nb, PEER_BLOCK, hk)

    def blk(args):
        xb, eb, gb = args
        ub = u_tab[eb]
        vb = v_tab[eb]
        a = jax.nn.gelu(jnp.einsum('td,ted->te', xb, ub, preferred_element_type=jnp.float32))
        return jnp.einsum('te,ted->td', (gb * a).astype(vb.dtype), vb)

    y = lax.map(blk, (xt, et, gt))
    return y.reshape(bsz, s, d)


def setup_inputs(seed: int = 0) -> dict:
    key = jax.random.key(seed)
    ks = jax.random.split(key, 24)
    f32 = jnp.float32
    L = DEPTH
    nrm = lambda k, shape, scale: jax.random.normal(k, shape, f32) * scale
    x = jax.random.normal(ks[0], (BATCH, SEQ, D_MODEL), f32)
    positions = jnp.broadcast_to(jnp.arange(SEQ, dtype=jnp.int32)[None, :], (BATCH, SEQ))
    return {
        "x": x,
        "positions": positions,
        "norm1_g": 1.0 + nrm(ks[1], (L, D_MODEL), 0.02),
        "w_in": nrm(ks[2], (L, D_MODEL, IN_WIDTH), D_MODEL ** -0.5),
        "v_norm_g": 1.0 + nrm(ks[3], (L, A_WIDTH), 0.02),
        "v_norm_b": nrm(ks[4], (L, A_WIDTH), 0.02),
        "spatial_w": nrm(ks[5], (L, A_GROUPS, CHUNK, CHUNK), CHUNK ** -0.5),
        "spatial_b": 1.0 + nrm(ks[6], (L, A_GROUPS, CHUNK), 0.1),
        "kv_norm_g": 1.0 + nrm(ks[7], (L, KV_LATENT), 0.02),
        "w_uk": nrm(ks[8], (L, KV_LATENT, HEAD_DIM), KV_LATENT ** -0.5),
        "w_uv": nrm(ks[9], (L, KV_LATENT, HEAD_DIM), KV_LATENT ** -0.5),
        "q_norm_g": 1.0 + nrm(ks[10], (L, HEAD_DIM), 0.02),
        "k_norm_g": 1.0 + nrm(ks[11], (L, HEAD_DIM), 0.02),
        "w_a_out": nrm(ks[12], (L, A_WIDTH, D_MODEL), A_WIDTH ** -0.5),
        "w_b_out": nrm(ks[13], (L, B_WIDTH, D_MODEL), B_WIDTH ** -0.5),
        "w_o": nrm(ks[14], (L, D_MODEL, D_MODEL), D_MODEL ** -0.5),
        "norm2_g": 1.0 + nrm(ks[15], (L, D_MODEL), 0.02),
        "peer_wq": nrm(ks[16], (L, D_MODEL, PEER_HEADS * PEER_KEY_DIM), D_MODEL ** -0.5),
        "peer_subkeys": nrm(ks[17], (L, PEER_HEADS, 2, N_KEYS, PEER_HALF), PEER_HALF ** -0.5),
        "peer_u": nrm(ks[18], (L, N_EXPERTS, D_MODEL), D_MODEL ** -0.5),
        "peer_v": nrm(ks[19], (L, N_EXPERTS, D_MODEL), 0.5 * PEER_HEADS ** -0.5),
    }


def reference(x, positions, norm1_g, w_in, v_norm_g, v_norm_b, spatial_w, spatial_b, kv_norm_g, w_uk, w_uv,
              q_norm_g, k_norm_g, w_a_out, w_b_out, w_o, norm2_g, peer_wq, peer_subkeys, peer_u, peer_v):
    bsz, s, d = x.shape
    h = x
    for l in range(DEPTH):
        xn = rms_norm(h, norm1_g[l])
        proj = xn @ w_in[l]
        u, v, q, c_kv, q_idx, k_idx, w_idx, gates = jnp.split(proj, SPLIT_OFFSETS, axis=-1)

        y_a = chunked_spatial_gating(u, v, v_norm_g[l], v_norm_b[l], spatial_w[l], spatial_b[l])

        c_n = rms_norm(c_kv, kv_norm_g[l])
        k = rms_norm(c_n @ w_uk[l], k_norm_g[l])
        vv = c_n @ w_uv[l]
        qh = rms_norm(q.reshape(bsz, s, N_HEADS, HEAD_DIM), q_norm_g[l])
        qh = partial_rope(qh, positions, ROT_DIM)
        k = partial_rope(k[:, :, None, :], positions, ROT_DIM)[:, :, 0, :]
        qi = partial_rope(q_idx.reshape(bsz, s, IDX_HEADS, IDX_DIM), positions, IDX_ROT)
        ki = partial_rope(k_idx[:, :, None, :], positions, IDX_ROT)[:, :, 0, :]
        wi = w_idx * (IDX_HEADS ** -0.5)
        y_b = dsa_attention(qh, k, vv, qi, ki, wi)

        g = jax.nn.sigmoid(gates.reshape(bsz, s, N_BRANCHES, d))
        merged = g[:, :, 0, :] * (y_a @ w_a_out[l]) + g[:, :, 1, :] * (y_b @ w_b_out[l])
        h = h + merged @ w_o[l]

        hn = rms_norm(h, norm2_g[l])
        h = h + peer(hn, peer_wq[l], peer_subkeys[l], peer_u[l], peer_v[l])
    return h
```

```cpp
#include <hip/hip_runtime.h>
#include <hip/hip_cooperative_groups.h>
#include <stdint.h>
#include <cstdio>
namespace cg = cooperative_groups;

#ifndef MULTI_LAUNCH
#define MULTI_LAUNCH 1
#endif

typedef unsigned short u16;
typedef unsigned int u32;
typedef unsigned char u8;
using bf16x8 = __attribute__((ext_vector_type(8))) short;
using f32x4 = __attribute__((ext_vector_type(4))) float;
using f32x16 = __attribute__((ext_vector_type(16))) float;
typedef __bf16 bf16x2_t __attribute__((ext_vector_type(2)));
typedef float float2_t __attribute__((ext_vector_type(2)));

constexpr int BATCH = 2, SEQ = 16384, DM = 1024, T = BATCH * SEQ;
constexpr int NWIN = 4224;
constexpr int NTHREADS = 256;
constexpr float EPS = 1e-6f;
constexpr int ABUF = 128 * 144;
constexpr int CS_LD = 132;
constexpr int SMEM_BYTES = 77824;
constexpr int EXTRA_OFF = 4 * ABUF;
constexpr int CAP = 768;

__constant__ float INV32[16] = {1.000000000e+00f, 4.403665960e-01f, 1.939227432e-01f, 8.539710194e-02f, 3.760603070e-02f, 1.656043902e-02f, 7.292664610e-03f, 3.211445874e-03f, 1.414213562e-03f, 6.227723788e-04f, 2.742481884e-04f, 1.207697351e-04f, 5.318296098e-05f, 2.341999971e-05f, 1.031338616e-05f, 4.541670478e-06f};
__constant__ float INV16[8] = {1.000000000e+00f, 1.939227432e-01f, 3.760603070e-02f, 7.292664610e-03f, 1.414213562e-03f, 2.742481884e-04f, 5.318296098e-05f, 1.031338616e-05f};
__constant__ u8 PAIR_TAB[56] = {
  0x00,0x01,0x02,0x03,0x04,0x05,0x06,0x07,0x08,0x09,0x0a,0x0b,0x0c,0x0d,0x0e,0x0f,
  0x10,0x11,0x12,0x13,0x14,0x15,0x16,0x17,
  0x20,0x21,0x22,0x23,0x24,
  0x30,0x31,0x32,0x33,
  0x40,0x41,0x42,
  0x50,0x51,
  0x60,0x61,
  0x70,0x71,
  0x80,0x90,0xa0,0xb0,0xc0,0xd0,0xe0,0xf0,
  0xff,0xff,0xff,0xff,0xff,0xff};

struct Params {
  const float* x; const int* pos;
  const float *norm1_g, *w_in, *v_norm_g, *v_norm_b, *spatial_w, *spatial_b, *kv_norm_g, *w_uk, *w_uv,
      *q_norm_g, *k_norm_g, *w_a_out, *w_b_out, *w_o, *norm2_g, *peer_wq, *peer_subkeys, *peer_u, *peer_v;
  float* out;
  u16 *xn, *WinT, *WaT, *WbT, *WoT, *WqT, *WkvT, *SubK, *Wtril, *Ub, *Vb;
  u16 *gu, *gv, *qh, *ckv, *qi, *ki, *sg, *kk, *vv, *ya, *yb, *merged, *h1b, *sel;
  float *wi, *ssq, *stv;
  u8* sti;
};

__device__ __forceinline__ u32 pack_bf16(float a, float b) {
  float2_t v = {a, b};
  bf16x2_t r = __builtin_convertvector(v, bf16x2_t);
  return __builtin_bit_cast(u32, r);
}
__device__ __forceinline__ u16 f2bf(float a) { return (u16)(pack_bf16(a, 0.f) & 0xffffu); }
__device__ __forceinline__ float bf_lo(u32 u) { return __uint_as_float(u << 16); }
__device__ __forceinline__ float bf_hi(u32 u) { return __uint_as_float(u & 0xffff0000u); }
__device__ __forceinline__ float bf2f(u16 h) { return __uint_as_float(((u32)h) << 16); }
__device__ __forceinline__ float wave_sum(float v) {
#pragma unroll
  for (int m = 32; m >= 1; m >>= 1) v += __shfl_xor(v, m);
  return v;
}
__device__ __forceinline__ float gelu_f(float x) {
  float z = 1.5957691216057308f * (x + 0.044715f * x * x * x);
  return x / (1.f + __expf(-z));
}
__device__ __forceinline__ float sigmoid_f(float x) { return 1.f / (1.f + __expf(-x)); }
__device__ __forceinline__ u32 sortable(u32 b) { return b ^ ((u32)((int)b >> 31) | 0x80000000u); }
__device__ __forceinline__ u32 unsortable(u32 k) { return k ^ ((k & 0x80000000u) ? 0x80000000u : 0xffffffffu); }
__device__ __forceinline__ int mbcnt64(unsigned long long m) {
  return __builtin_amdgcn_mbcnt_hi((u32)(m >> 32), __builtin_amdgcn_mbcnt_lo((u32)m, 0));
}

typedef u32 u32x4 __attribute__((ext_vector_type(4)));
struct Tile4 { u32x4 v0, v1, v2, v3; };
__device__ __forceinline__ void gemm_load_tile(const u16* __restrict__ g, int ld, int k0, Tile4& r) {
  const int tid = threadIdx.x;
  const int row = tid >> 3, kc = tid & 7;
  const u16* base = g + (size_t)row * ld + k0 + kc * 8;
  r.v0 = *reinterpret_cast<const u32x4*>(base);
  r.v1 = *reinterpret_cast<const u32x4*>(base + (size_t)32 * ld);
  r.v2 = *reinterpret_cast<const u32x4*>(base + (size_t)64 * ld);
  r.v3 = *reinterpret_cast<const u32x4*>(base + (size_t)96 * ld);
}
__device__ __forceinline__ void gemm_store_tile(char* buf, const Tile4& r) {
  const int tid = threadIdx.x;
  const int row = tid >> 3, kc = tid & 7;
  char* base = buf + row * 144 + kc * 16;
  *reinterpret_cast<u32x4*>(base) = r.v0;
  *reinterpret_cast<u32x4*>(base + 32 * 144) = r.v1;
  *reinterpret_cast<u32x4*>(base + 64 * 144) = r.v2;
  *reinterpret_cast<u32x4*>(base + 96 * 144) = r.v3;
}
__device__ __forceinline__ void mma_ktile(const char* sa, const char* sb, f32x16 (&acc)[2][2]) {
  const int lane = threadIdx.x & 63, wid = threadIdx.x >> 6;
  const int wr = wid >> 1, wc = wid & 1;
  const int r32 = lane & 31, hf = lane >> 5;
#pragma unroll
  for (int s = 0; s < 4; ++s) {
    bf16x8 a[2], b[2];
#pragma unroll
    for (int i = 0; i < 2; ++i) {
      a[i] = *reinterpret_cast<const bf16x8*>(sa + (wr * 64 + i * 32 + r32) * 144 + s * 32 + hf * 16);
      b[i] = *reinterpret_cast<const bf16x8*>(sb + (wc * 64 + i * 32 + r32) * 144 + s * 32 + hf * 16);
    }
#pragma unroll
    for (int i = 0; i < 2; ++i)
#pragma unroll
      for (int j = 0; j < 2; ++j)
        acc[i][j] = __builtin_amdgcn_mfma_f32_32x32x16_bf16(a[i], b[j], acc[i][j], 0, 0, 0);
  }
}
__device__ __forceinline__ void gemm_mainloop(const u16* __restrict__ A, int lda, const u16* __restrict__ B, int ldb,
                                              int K, f32x16 (&acc)[2][2], char* smem) {
  Tile4 ra, rb;
  const int nk = K >> 6;
  gemm_load_tile(A, lda, 0, ra);
  gemm_load_tile(B, ldb, 0, rb);
  __syncthreads();
  gemm_store_tile(smem, ra);
  gemm_store_tile(smem + 2 * ABUF, rb);
  __syncthreads();
#pragma unroll 1
  for (int kt = 0; kt < nk; ++kt) {
    const int cur = kt & 1;
    if (kt + 1 < nk) {
      gemm_load_tile(A, lda, (kt + 1) << 6, ra);
      gemm_load_tile(B, ldb, (kt + 1) << 6, rb);
    }
    mma_ktile(smem + cur * ABUF, smem + (2 + cur) * ABUF, acc);
    if (kt + 1 < nk) {
      gemm_store_tile(smem + (cur ^ 1) * ABUF, ra);
      gemm_store_tile(smem + (2 + (cur ^ 1)) * ABUF, rb);
    }
    __syncthreads();
  }
}
__device__ __forceinline__ void zero_acc(f32x16 (&acc)[2][2]) {
#pragma unroll
  for (int i = 0; i < 2; ++i)
#pragma unroll
    for (int j = 0; j < 2; ++j)
#pragma unroll
      for (int r = 0; r < 16; ++r) acc[i][j][r] = 0.f;
}
__device__ __forceinline__ void stage_acc(const f32x16 (&acc)[2][2], float* cs) {
  const int lane = threadIdx.x & 63, wid = threadIdx.x >> 6;
  const int wr = wid >> 1, wc = wid & 1;
#pragma unroll
  for (int i = 0; i < 2; ++i)
#pragma unroll
    for (int j = 0; j < 2; ++j)
#pragma unroll
      for (int r = 0; r < 16; ++r) {
        int row = wr * 64 + i * 32 + (r & 3) + 8 * (r >> 2) + 4 * (lane >> 5);
        int col = wc * 64 + j * 32 + (lane & 31);
        cs[row * CS_LD + col] = acc[i][j][r];
      }
}

__device__ __forceinline__ int win_srccol(int n) {
  if (n < 2116) return n;
  if (n < 2176) return -1;
  return n - 60;
}
__device__ void phase_prep(const Params& p, char* smem) {
  const int tid = threadIdx.x, lane = tid & 63, wid = tid >> 6;
  for (int rb = blockIdx.x; rb < T / 4; rb += gridDim.x) {
    int row = rb * 4 + wid;
    const float* xr = p.x + (size_t)row * DM;
    float4 v[4];
    float ss = 0.f;
#pragma unroll
    for (int i = 0; i < 4; ++i) {
      v[i] = *reinterpret_cast<const float4*>(xr + lane * 4 + 256 * i);
      ss += v[i].x * v[i].x + v[i].y * v[i].y + v[i].z * v[i].z + v[i].w * v[i].w;
    }
    ss = wave_sum(ss);
    float r = rsqrtf(ss * (1.f / DM) + EPS);
#pragma unroll
    for (int i = 0; i < 4; ++i) {
      float4 g = *reinterpret_cast<const float4*>(p.norm1_g + lane * 4 + 256 * i);
      uint2 o;
      o.x = pack_bf16(v[i].x * r * g.x, v[i].y * r * g.y);
      o.y = pack_bf16(v[i].z * r * g.z, v[i].w * r * g.w);
      *reinterpret_cast<uint2*>(p.xn + (size_t)row * DM + lane * 4 + 256 * i) = o;
    }
  }
  float* tile = reinterpret_cast<float*>(smem);
  constexpr int NT_TOTAL = 1056 + 128 + 128 + 256 + 512 + 8 + 8;
  for (int ti = blockIdx.x; ti < NT_TOTAL; ti += gridDim.x) {
    const float* src; const float* scale = nullptr; u16* dst; int ldsrc, K, nn, mode = 0; int t = ti;
    if (t < 1056) { src = p.w_in; ldsrc = 4164; K = 1024; nn = 66; dst = p.WinT; mode = 1; }
    else if ((t -= 1056) < 128) { src = p.w_a_out; ldsrc = 1024; K = 512; nn = 16; dst = p.WaT; }
    else if ((t -= 128) < 128) { src = p.w_b_out; ldsrc = 1024; K = 512; nn = 16; dst = p.WbT; }
    else if ((t -= 128) < 256) { src = p.w_o; ldsrc = 1024; K = 1024; nn = 16; dst = p.WoT; }
    else if ((t -= 256) < 512) { src = p.peer_wq; ldsrc = 2048; K = 1024; nn = 32; dst = p.WqT; scale = p.norm2_g; }
    else if ((t -= 512) < 8) { src = p.w_uk; ldsrc = 128; K = 256; nn = 2; dst = p.WkvT; scale = p.kv_norm_g; }
    else { t -= 8; src = p.w_uv; ldsrc = 128; K = 256; nn = 2; dst = p.WkvT + 128 * 256; scale = p.kv_norm_g; }
    int n0 = (t % nn) * 64, k0 = (t / nn) * 64;
    __syncthreads();
    {
      int n = tid & 63;
      int sc = (mode == 1) ? win_srccol(n0 + n) : (n0 + n);
      for (int kk = tid >> 6; kk < 64; kk += 4) {
        float v = 0.f;
        if (sc >= 0) v = src[(size_t)(k0 + kk) * ldsrc + sc];
        if (scale) v *= scale[k0 + kk];
        tile[kk * 65 + n] = v;
      }
    }
    __syncthreads();
    {
      int k = (tid & 31) * 2;
      for (int n = tid >> 5; n < 64; n += 8) {
        u32 o = pack_bf16(tile[k * 65 + n], tile[(k + 1) * 65 + n]);
        *reinterpret_cast<u32*>(dst + (size_t)(n0 + n) * K + k0 + k) = o;
      }
    }
  }
  constexpr int G_SUB = 262144 / 4, G_SW = 65536 / 4, G_U = 16384 * 1024 / 4;
  constexpr int G_TOTAL = G_SUB + G_SW + 2 * G_U;
  for (int gi = blockIdx.x * NTHREADS + tid; gi < G_TOTAL; gi += gridDim.x * NTHREADS) {
    int g = gi;
    if (g < G_SUB) {
      float4 v = *reinterpret_cast<const float4*>(p.peer_subkeys + (size_t)g * 4);
      uint2 o = {pack_bf16(v.x, v.y), pack_bf16(v.z, v.w)};
      *reinterpret_cast<uint2*>(p.SubK + (size_t)g * 4) = o;
    } else if ((g -= G_SUB) < G_SW) {
      float4 v = *reinterpret_cast<const float4*>(p.spatial_w + (size_t)g * 4);
      int e = g * 4; int s = e & 127, tt = (e >> 7) & 127;
      if (s > tt) v.x = 0.f;
      if (s + 1 > tt) v.y = 0.f;
      if (s + 2 > tt) v.z = 0.f;
      if (s + 3 > tt) v.w = 0.f;
      uint2 o = {pack_bf16(v.x, v.y), pack_bf16(v.z, v.w)};
      *reinterpret_cast<uint2*>(p.Wtril + (size_t)g * 4) = o;
    } else if ((g -= G_SW) < G_U) {
      float4 v = *reinterpret_cast<const float4*>(p.peer_u + (size_t)g * 4);
      float4 s = *reinterpret_cast<const float4*>(p.norm2_g + ((g * 4) & 1023));
      uint2 o = {pack_bf16(v.x * s.x, v.y * s.y), pack_bf16(v.z * s.z, v.w * s.w)};
      *reinterpret_cast<uint2*>(p.Ub + (size_t)g * 4) = o;
    } else {
      g -= G_U;
      float4 v = *reinterpret_cast<const float4*>(p.peer_v + (size_t)g * 4);
      uint2 o = {pack_bf16(v.x, v.y), pack_bf16(v.z, v.w)};
      *reinterpret_cast<uint2*>(p.Vb + (size_t)g * 4) = o;
    }
  }
}

__device__ __forceinline__ void rope_pair(float& y0, float& y1, int lc, int half, int xm, float posf, const float* inv) {
  float p0 = __shfl_xor(y0, xm), p1 = __shfl_xor(y1, xm);
  if (lc < 2 * half) {
    int j = lc & (half - 1);
    float a0 = posf * inv[j], a1 = posf * inv[j + 1];
    float s0, c0, s1, c1;
    sincosf(a0, &s0, &c0);
    sincosf(a1, &s1, &c1);
    if (lc < half) { y0 = y0 * c0 - p0 * s0; y1 = y1 * c1 - p1 * s1; }
    else { y0 = y0 * c0 + p0 * s0; y1 = y1 * c1 + p1 * s1; }
  }
}

__device__ void phase_gemm1(const Params& p, char* smem) {
  const int tid = threadIdx.x, lane = tid & 63, wid = tid >> 6;
  float* cs = reinterpret_cast<float*>(smem);
  constexpr int NTN = NWIN / 128;
  constexpr int NTILES = (T / 128) * NTN;
  for (int ti = blockIdx.x; ti < NTILES; ti += gridDim.x) {
    int mt = ti / NTN, nt = ti % NTN;
    int m0 = mt * 128;
    f32x16 acc[2][2];
    zero_acc(acc);
    gemm_mainloop(p.xn + (size_t)m0 * DM, DM, p.WinT + (size_t)nt * 128 * DM, DM, DM, acc, smem);
    stage_acc(acc, cs);
    __syncthreads();
    const int c0 = 2 * lane;
    for (int rr = 0; rr < 32; ++rr) {
      int row = wid * 32 + rr;
      int t = m0 + row;
      float2 v = *reinterpret_cast<const float2*>(cs + row * CS_LD + c0);
      float v0 = v.x, v1 = v.y;
      if (nt < 4) {
        *reinterpret_cast<u32*>(p.gu + (size_t)t * 512 + nt * 128 + c0) = pack_bf16(gelu_f(v0), gelu_f(v1));
      } else if (nt < 8) {
        *reinterpret_cast<u32*>(p.gv + (size_t)t * 512 + (nt - 4) * 128 + c0) = pack_bf16(gelu_f(v0), gelu_f(v1));
      } else if (nt < 12) {
        float ss = wave_sum(v0 * v0 + v1 * v1);
        float r = rsqrtf(ss * (1.f / 128.f) + EPS);
        float y0 = v0 * r * p.q_norm_g[c0], y1 = v1 * r * p.q_norm_g[c0 + 1];
        float posf = (float)p.pos[t];
        rope_pair(y0, y1, c0, 16, 8, posf, INV32);
        *reinterpret_cast<u32*>(p.qh + (size_t)t * 512 + (nt - 8) * 128 + c0) = pack_bf16(y0, y1);
      } else if (nt < 14) {
        *reinterpret_cast<u32*>(p.ckv + (size_t)t * 256 + (nt - 12) * 128 + c0) = pack_bf16(v0, v1);
      } else if (nt < 16) {
        float posf = (float)p.pos[t];
        float y0 = v0, y1 = v1;
        rope_pair(y0, y1, c0 & 63, 8, 4, posf, INV16);
        *reinterpret_cast<u32*>(p.qi + (size_t)t * 256 + (nt - 14) * 128 + c0) = pack_bf16(y0, y1);
      } else if (nt == 16) {
        float posf = (float)p.pos[t];
        float y0 = v0, y1 = v1;
        rope_pair(y0, y1, c0 < 64 ? c0 : 64, 8, 4, posf, INV16);
        if (c0 < 64) *reinterpret_cast<u32*>(p.ki + (size_t)t * 64 + c0) = pack_bf16(y0, y1);
        else if (c0 < 68) { p.wi[(size_t)t * 4 + (c0 - 64)] = v0 * 0.0625f; p.wi[(size_t)t * 4 + (c0 - 63)] = v1 * 0.0625f; }
      } else {
        *reinterpret_cast<u32*>(p.sg + (size_t)t * 2048 + (nt - 17) * 128 + c0) = pack_bf16(sigmoid_f(v0), sigmoid_f(v1));
      }
    }
    __syncthreads();
  }
}

__device__ void unit_kv(const Params& p, char* smem, int mt) {
  const int tid = threadIdx.x, lane = tid & 63, wid = tid >> 6;
  float* cs = reinterpret_cast<float*>(smem);
  float* rr_s = reinterpret_cast<float*>(smem + EXTRA_OFF);
  const int m0 = mt * 128;
  __syncthreads();
  {
    int row = tid >> 1, half = tid & 1;
    const u16* src = p.ckv + (size_t)(m0 + row) * 256 + half * 128;
    float ss = 0.f;
#pragma unroll 4
    for (int i = 0; i < 16; ++i) {
      uint4 q = *reinterpret_cast<const uint4*>(src + i * 8);
      u32 w[4] = {q.x, q.y, q.z, q.w};
#pragma unroll
      for (int j = 0; j < 4; ++j) { float a = bf_lo(w[j]), b = bf_hi(w[j]); ss += a * a + b * b; }
    }
    ss += __shfl_xor(ss, 1);
    if (half == 0) rr_s[row] = rsqrtf(ss * (1.f / 256.f) + EPS);
  }
#pragma unroll 1
  for (int nt = 0; nt < 2; ++nt) {
    f32x16 acc[2][2];
    zero_acc(acc);
    gemm_mainloop(p.ckv + (size_t)m0 * 256, 256, p.WkvT + (size_t)nt * 128 * 256, 256, 256, acc, smem);
    stage_acc(acc, cs);
    __syncthreads();
    const int c0 = 2 * lane;
#pragma unroll 1
    for (int rr = 0; rr < 32; ++rr) {
      int row = wid * 32 + rr;
      int t = m0 + row;
      float2 v = *reinterpret_cast<const float2*>(cs + row * CS_LD + c0);
      float rs = rr_s[row];
      float v0 = v.x * rs, v1 = v.y * rs;
      if (nt == 0) {
        float ss = wave_sum(v0 * v0 + v1 * v1);
        float r = rsqrtf(ss * (1.f / 128.f) + EPS);
        float y0 = v0 * r * p.k_norm_g[c0], y1 = v1 * r * p.k_norm_g[c0 + 1];
        float posf = (float)p.pos[t];
        rope_pair(y0, y1, c0, 16, 8, posf, INV32);
        *reinterpret_cast<u32*>(p.kk + (size_t)t * 128 + c0) = pack_bf16(y0, y1);
      } else {
        *reinterpret_cast<u32*>(p.vv + (size_t)t * 128 + c0) = pack_bf16(v0, v1);
      }
    }
    __syncthreads();
  }
}

__device__ void unit_spatial(const Params& p, char* smem, int unit) {
  const int tid = threadIdx.x, lane = tid & 63, wid = tid >> 6;
  const int chunk = unit >> 2, g = unit & 3;
  const int t0 = chunk * 128;
  float* cs = reinterpret_cast<float*>(smem);
  float* mu_s = reinterpret_cast<float*>(smem + EXTRA_OFF);
  float* rs_s = mu_s + 128;
  __syncthreads();
  {
    int row = tid >> 1, half = tid & 1;
    const u16* src = p.gv + (size_t)(t0 + row) * 512 + half * 256;
    float s = 0.f, ss = 0.f;
#pragma unroll 4
    for (int i = 0; i < 32; ++i) {
      uint4 q = *reinterpret_cast<const uint4*>(src + i * 8);
      u32 w[4] = {q.x, q.y, q.z, q.w};
#pragma unroll
      for (int j = 0; j < 4; ++j) { float a = bf_lo(w[j]), b = bf_hi(w[j]); s += a + b; ss += a * a + b * b; }
    }
    s += __shfl_xor(s, 1);
    ss += __shfl_xor(ss, 1);
    float mean = s * (1.f / 512.f);
    float var = fmaxf(ss * (1.f / 512.f) - mean * mean, 0.f);
    if (half == 0) { mu_s[row] = mean; rs_s[row] = rsqrtf(var + EPS); }
  }
  {
    const u16* wsrc = p.Wtril + (size_t)g * 128 * 128;
#pragma unroll
    for (int i = 0; i < 8; ++i) {
      int c = tid + 256 * i;
      int row = c >> 4, kc = c & 15;
      uint4 q = *reinterpret_cast<const uint4*>(wsrc + row * 128 + kc * 8);
      *reinterpret_cast<uint4*>(smem + (kc >> 3) * ABUF + row * 144 + (kc & 7) * 16) = q;
    }
  }
  __syncthreads();
  {
    int s = tid & 127;
    float mu = mu_s[s], rs = rs_s[s];
    const u16* src = p.gv + (size_t)(t0 + s) * 512 + g * 128;
    char* bbase = smem + (2 + (s >> 6)) * ABUF + (s & 63) * 2;
#pragma unroll
    for (int i = 0; i < 8; ++i) {
      int d0 = ((tid >> 7) + 2 * i) * 8;
      uint4 q = *reinterpret_cast<const uint4*>(src + d0);
      u32 w[4] = {q.x, q.y, q.z, q.w};
#pragma unroll
      for (int j = 0; j < 4; ++j) {
        int d = d0 + 2 * j;
        float a = (bf_lo(w[j]) - mu) * rs * p.v_norm_g[g * 128 + d] + p.v_norm_b[g * 128 + d];
        float b = (bf_hi(w[j]) - mu) * rs * p.v_norm_g[g * 128 + d + 1] + p.v_norm_b[g * 128 + d + 1];
        *reinterpret_cast<u16*>(bbase + d * 144) = f2bf(a);
        *reinterpret_cast<u16*>(bbase + (d + 1) * 144) = f2bf(b);
      }
    }
  }
  __syncthreads();
  f32x16 acc[2][2];
  zero_acc(acc);
  mma_ktile(smem, smem + 2 * ABUF, acc);
  mma_ktile(smem + ABUF, smem + 3 * ABUF, acc);
  __syncthreads();
  stage_acc(acc, cs);
  __syncthreads();
  const int c0 = 2 * lane;
  for (int rr = 0; rr < 32; ++rr) {
    int row = wid * 32 + rr;
    int t = t0 + row;
    float2 v = *reinterpret_cast<const float2*>(cs + row * CS_LD + c0);
    float b = p.spatial_b[g * 128 + row];
    u32 uu = *reinterpret_cast<const u32*>(p.gu + (size_t)t * 512 + g * 128 + c0);
    *reinterpret_cast<u32*>(p.ya + (size_t)t * 512 + g * 128 + c0) = pack_bf16(bf_lo(uu) * (v.x + b), bf_hi(uu) * (v.y + b));
  }
}

__device__ __forceinline__ void radix_select(const u32 (&key)[12], int rank, u32& Tout, int& krem_out) {
  u32 prefix = 0;
  int krem = rank;
  for (int b = 31; b >= 0; --b) {
    u32 cand = prefix | (1u << b);
    u32 himask = ~((1u << b) - 1u);
    int c = 0;
#pragma unroll
    for (int k = 0; k < 12; ++k) c += __popcll(__ballot((key[k] & himask) == cand));
    if (c >= krem) prefix = cand; else krem -= c;
  }
  Tout = prefix;
  krem_out = krem;
}

__device__ void unit_indexer(const Params& p, char* smem, int unit) {
  const int tid = threadIdx.x, lane = tid & 63, wid = tid >> 6;
  const int b = unit >> 10, grp = unit & 1023;
  const int tb = b * SEQ, i0 = grp * 16;
  u32* cval = reinterpret_cast<u32*>(smem);
  u16* cidx = reinterpret_cast<u16*>(smem + 16 * CAP * 4);
  volatile int* cnt = reinterpret_cast<volatile int*>(smem + EXTRA_OFF);
  __syncthreads();
  if (tid < 16) cnt[tid] = 0;
  __syncthreads();
  const int qsub = lane >> 4;
  const int ql = wid * 4 + qsub;
  const int iq = i0 + ql;
  const int kcol = lane & 15;
  bf16x8 afr[2];
  {
    const u16* qa = p.qi + ((size_t)(tb + i0 + wid * 4 + (kcol >> 2)) * 4 + (kcol & 3)) * 64 + 8 * (lane >> 4);
    afr[0] = *reinterpret_cast<const bf16x8*>(qa);
    afr[1] = *reinterpret_cast<const bf16x8*>(qa + 32);
  }
  const float4 w4 = *reinterpret_cast<const float4*>(p.wi + (size_t)(tb + iq) * 4);
  float thr = -INFINITY;
  u32* myval = cval + ql * CAP;
  u16* myidx = cidx + ql * CAP;
  const int nchunks = (grp + 1 + 3) >> 2;
  for (int ch = 0; ch < nchunks; ++ch) {
    const int jc = ch * 64;
    bf16x8 bfr[4][2];
#pragma unroll
    for (int u = 0; u < 4; ++u) {
      const u16* kb = p.ki + (size_t)(tb + jc + 16 * u + kcol) * 64 + 8 * (lane >> 4);
      bfr[u][0] = *reinterpret_cast<const bf16x8*>(kb);
      bfr[u][1] = *reinterpret_cast<const bf16x8*>(kb + 32);
    }
    bool anyp = false;
    float sc[4]; bool ps[4];
#pragma unroll
    for (int u = 0; u < 4; ++u) {
      f32x4 acc = {0.f, 0.f, 0.f, 0.f};
      acc = __builtin_amdgcn_mfma_f32_16x16x32_bf16(afr[0], bfr[u][0], acc, 0, 0, 0);
      acc = __builtin_amdgcn_mfma_f32_16x16x32_bf16(afr[1], bfr[u][1], acc, 0, 0, 0);
      float s = 0.0f;
      s += w4.x * fmaxf(acc[0], 0.f);
      s += w4.y * fmaxf(acc[1], 0.f);
      s += w4.z * fmaxf(acc[2], 0.f);
      s += w4.w * fmaxf(acc[3], 0.f);
      s += 0.0f;
      int j = jc + 16 * u + kcol;
      sc[u] = s;
      ps[u] = (j <= iq) && (s >= thr);
      anyp |= ps[u];
    }
    if (__any(anyp)) {
#pragma unroll
      for (int u = 0; u < 4; ++u) {
        if (ps[u]) {
          int slot = atomicAdd((int*)&cnt[ql], 1);
          if (slot < CAP) { myval[slot] = __float_as_uint(sc[u]); myidx[slot] = (u16)(jc + 16 * u + kcol); }
        }
      }
      __builtin_amdgcn_wave_barrier();
      int c = cnt[ql];
      unsigned long long need = __ballot(c > CAP - 64);
      while (need) {
        int l = __ffsll((long long)need) - 1;
        int qc = l >> 4;
        need &= ~(0xFFFFull << (qc * 16));
        int qlc = wid * 4 + qc;
        int n = __builtin_amdgcn_readfirstlane(cnt[qlc]);
        if (n > CAP) n = CAP;
        u32* cv = cval + qlc * CAP; u16* ci = cidx + qlc * CAP;
        u32 key[12]; u16 idx[12];
#pragma unroll
        for (int k = 0; k < 12; ++k) {
          int e = lane + 64 * k;
          bool in = e < n;
          key[k] = in ? sortable(cv[e]) : 0u;
          idx[k] = in ? ci[e] : (u16)0;
        }
        u32 Tk; int krem;
        radix_select(key, 256, Tk, krem);
        int base = 0;
#pragma unroll
        for (int k = 0; k < 12; ++k) {
          bool keep = key[k] >= Tk && key[k] != 0u;
          unsigned long long m = __ballot(keep);
          int pos = base + mbcnt64(m);
          if (keep) { cv[pos] = unsortable(key[k]); ci[pos] = idx[k]; }
          base += __popcll(m);
        }
        __builtin_amdgcn_wave_barrier();
        if (lane == 0) cnt[qlc] = base;
        if (qsub == qc) thr = __uint_as_float(unsortable(Tk));
        __builtin_amdgcn_wave_barrier();
      }
    }
  }
  __builtin_amdgcn_wave_barrier();
  for (int qc = 0; qc < 4; ++qc) {
    int qlc = wid * 4 + qc;
    int n = __builtin_amdgcn_readfirstlane(cnt[qlc]);
    if (n > CAP) n = CAP;
    u32* cv = cval + qlc * CAP; u16* ci = cidx + qlc * CAP;
    u16* out = p.sel + (size_t)(tb + i0 + qlc) * 256;
    if (n <= 256) {
#pragma unroll
      for (int k = 0; k < 4; ++k) {
        int e = lane + 64 * k;
        out[e] = (e < n) ? ci[e] : (u16)0xFFFF;
      }
    } else {
      u32 key[12]; u16 idx[12];
#pragma unroll
      for (int k = 0; k < 12; ++k) {
        int e = lane + 64 * k;
        bool in = e < n;
        key[k] = in ? sortable(cv[e]) : 0u;
        idx[k] = in ? ci[e] : (u16)0;
      }
      u32 Tk; int krem;
      radix_select(key, 256, Tk, krem);
      u32 ik[12];
      int neq = 0;
#pragma unroll
      for (int k = 0; k < 12; ++k) {
        bool eq = key[k] == Tk;
        ik[k] = eq ? (0x10000u - (u32)idx[k]) : 0u;
        neq += __popcll(__ballot(eq));
      }
      u32 Jk = 0;
      if (krem < neq) { int kr2; radix_select(ik, krem, Jk, kr2); }
      int base = 0;
#pragma unroll
      for (int k = 0; k < 12; ++k) {
        bool keep = (key[k] > Tk) || (key[k] == Tk && ik[k] >= Jk);
        unsigned long long m = __ballot(keep);
        int pos = base + mbcnt64(m);
        if (keep && pos < 256) out[pos] = idx[k];
        base += __popcll(m);
      }
    }
  }
}

__device__ void phase_attn(const Params& p, char* smem) {
  const int tid = threadIdx.x, lane = tid & 63, wid = tid >> 6;
  u16* lidx = reinterpret_cast<u16*>(smem + wid * 4608);
  float* P = reinterpret_cast<float*>(smem + wid * 4608 + 512);
  const float scale = 0.08838834764831845f;
  for (int tq = blockIdx.x * 4 + wid; tq < T; tq += gridDim.x * 4) {
    const int b = tq / SEQ, i = tq - b * SEQ;
    const size_t tb = (size_t)b * SEQ;
    __builtin_amdgcn_wave_barrier();
    {
      uint2 v = *reinterpret_cast<const uint2*>(p.sel + (size_t)tq * 256 + lane * 4);
      *reinterpret_cast<uint2*>(lidx + lane * 4) = v;
    }
    __builtin_amdgcn_wave_barrier();
    bf16x8 qf[4];
    {
      int h = lane & 15;
#pragma unroll
      for (int s = 0; s < 4; ++s) {
        if (h < 4) qf[s] = *reinterpret_cast<const bf16x8*>(p.qh + (size_t)tq * 512 + h * 128 + 8 * (lane >> 4) + 32 * s);
        else qf[s] = (bf16x8){0, 0, 0, 0, 0, 0, 0, 0};
      }
    }
    float sv[16][4];
#pragma unroll
    for (int u = 0; u < 16; ++u) {
      int id = lidx[16 * u + (lane & 15)];
      bool valid = id <= i;
      int idc = valid ? id : 0;
      const u16* kr = p.kk + (tb + idc) * 128 + 8 * (lane >> 4);
      f32x4 acc = {0.f, 0.f, 0.f, 0.f};
#pragma unroll
      for (int s = 0; s < 4; ++s) {
        bf16x8 kf = *reinterpret_cast<const bf16x8*>(kr + 32 * s);
        acc = __builtin_amdgcn_mfma_f32_16x16x32_bf16(qf[s], kf, acc, 0, 0, 0);
      }
#pragma unroll
      for (int h = 0; h < 4; ++h) sv[u][h] = valid ? acc[h] * scale : -1e30f;
    }
    float mx[4], sm[4];
#pragma unroll
    for (int h = 0; h < 4; ++h) {
      float m = sv[0][h];
#pragma unroll
      for (int u = 1; u < 16; ++u) m = fmaxf(m, sv[u][h]);
#pragma unroll
      for (int d = 8; d >= 1; d >>= 1) m = fmaxf(m, __shfl_xor(m, d));
      mx[h] = m;
      float s = 0.f;
#pragma unroll
      for (int u = 0; u < 16; ++u) { sv[u][h] = __expf(sv[u][h] - m); s += sv[u][h]; }
#pragma unroll
      for (int d = 8; d >= 1; d >>= 1) s += __shfl_xor(s, d);
      sm[h] = 1.f / s;
    }
    if (lane < 16) {
#pragma unroll
      for (int u = 0; u < 16; ++u) {
        float4 o = {sv[u][0] * sm[0], sv[u][1] * sm[1], sv[u][2] * sm[2], sv[u][3] * sm[3]};
        *reinterpret_cast<float4*>(P + (16 * u + lane) * 4) = o;
      }
    }
    __builtin_amdgcn_wave_barrier();
    const int kg = lane >> 4, dc = lane & 15;
    float o[4][8];
#pragma unroll
    for (int h = 0; h < 4; ++h)
#pragma unroll
      for (int j = 0; j < 8; ++j) o[h][j] = 0.f;
#pragma unroll 4
    for (int it = 0; it < 64; ++it) {
      int n = it * 4 + kg;
      int id = lidx[n];
      int idc = (id <= i) ? id : 0;
      uint4 q = *reinterpret_cast<const uint4*>(p.vv + (tb + idc) * 128 + dc * 8);
      float4 pw = *reinterpret_cast<const float4*>(P + n * 4);
      float v[8] = {bf_lo(q.x), bf_hi(q.x), bf_lo(q.y), bf_hi(q.y), bf_lo(q.z), bf_hi(q.z), bf_lo(q.w), bf_hi(q.w)};
      float pv[4] = {pw.x, pw.y, pw.z, pw.w};
#pragma unroll
      for (int h = 0; h < 4; ++h)
#pragma unroll
        for (int j = 0; j < 8; ++j) o[h][j] += pv[h] * v[j];
    }
#pragma unroll
    for (int h = 0; h < 4; ++h)
#pragma unroll
      for (int j = 0; j < 8; ++j) {
        float x = o[h][j];
        x += __shfl_xor(x, 16);
        x += __shfl_xor(x, 32);
        o[h][j] = x;
      }
    if (kg == 0) {
#pragma unroll
      for (int h = 0; h < 4; ++h) {
        uint4 w = {pack_bf16(o[h][0], o[h][1]), pack_bf16(o[h][2], o[h][3]), pack_bf16(o[h][4], o[h][5]), pack_bf16(o[h][6], o[h][7])};
        *reinterpret_cast<uint4*>(p.yb + (size_t)tq * 512 + h * 128 + dc * 8) = w;
      }
    }
  }
}

__device__ void phase_merge(const Params& p, char* smem) {
  const int tid = threadIdx.x, lane = tid & 63, wid = tid >> 6;
  float* cs = reinterpret_cast<float*>(smem);
  constexpr int NTILES = (T / 128) * 8;
  for (int ti = blockIdx.x; ti < NTILES; ti += gridDim.x) {
    int mt = ti >> 3, nt = ti & 7;
    int m0 = mt * 128, n0 = nt * 128;
    f32x16 acc[2][2];
    zero_acc(acc);
    gemm_mainloop(p.ya + (size_t)m0 * 512, 512, p.WaT + (size_t)n0 * 512, 512, 512, acc, smem);
    stage_acc(acc, cs);
    __syncthreads();
#pragma unroll 4
    for (int rr = 0; rr < 32; ++rr) {
      int row = wid * 32 + rr;
      float2 v = *reinterpret_cast<const float2*>(cs + row * CS_LD + 2 * lane);
      u32 g = *reinterpret_cast<const u32*>(p.sg + (size_t)(m0 + row) * 2048 + n0 + 2 * lane);
      *reinterpret_cast<u32*>(p.merged + (size_t)(m0 + row) * 1024 + n0 + 2 * lane) = pack_bf16(v.x * bf_lo(g), v.y * bf_hi(g));
    }
    __syncthreads();
    zero_acc(acc);
    gemm_mainloop(p.yb + (size_t)m0 * 512, 512, p.WbT + (size_t)n0 * 512, 512, 512, acc, smem);
    stage_acc(acc, cs);
    __syncthreads();
#pragma unroll 4
    for (int rr = 0; rr < 32; ++rr) {
      int row = wid * 32 + rr;
      float2 v = *reinterpret_cast<const float2*>(cs + row * CS_LD + 2 * lane);
      u32 g = *reinterpret_cast<const u32*>(p.sg + (size_t)(m0 + row) * 2048 + 1024 + n0 + 2 * lane);
      u32* mp = reinterpret_cast<u32*>(p.merged + (size_t)(m0 + row) * 1024 + n0 + 2 * lane);
      u32 pa = *mp;
      *mp = pack_bf16(bf_lo(pa) + v.x * bf_lo(g), bf_hi(pa) + v.y * bf_hi(g));
    }
    __syncthreads();
  }
}

__device__ void phase_wo(const Params& p, char* smem) {
  const int tid = threadIdx.x, lane = tid & 63, wid = tid >> 6;
  float* cs = reinterpret_cast<float*>(smem);
  constexpr int NTILES = (T / 128) * 8;
  for (int ti = blockIdx.x; ti < NTILES; ti += gridDim.x) {
    int mt = ti >> 3, nt = ti & 7;
    int m0 = mt * 128, n0 = nt * 128;
    f32x16 acc[2][2];
    zero_acc(acc);
    gemm_mainloop(p.merged + (size_t)m0 * 1024, 1024, p.WoT + (size_t)n0 * 1024, 1024, 1024, acc, smem);
    stage_acc(acc, cs);
    __syncthreads();
    for (int rr = 0; rr < 32; ++rr) {
      int row = wid * 32 + rr;
      size_t t = m0 + row;
      float2 v = *reinterpret_cast<const float2*>(cs + row * CS_LD + 2 * lane);
      float2 xv = *reinterpret_cast<const float2*>(p.x + t * 1024 + n0 + 2 * lane);
      float h0 = xv.x + v.x, h1 = xv.y + v.y;
      *reinterpret_cast<float2*>(p.out + t * 1024 + n0 + 2 * lane) = make_float2(h0, h1);
      *reinterpret_cast<u32*>(p.h1b + t * 1024 + n0 + 2 * lane) = pack_bf16(h0, h1);
      float ss = wave_sum(h0 * h0 + h1 * h1);
      if (lane == 0) p.ssq[t * 8 + nt] = ss;
    }
    __syncthreads();
  }
}

__device__ __forceinline__ void ins16(float (&l)[16], float v) {
#pragma unroll
  for (int q = 15; q >= 1; --q) l[q] = __builtin_amdgcn_fmed3f(v, l[q - 1], l[q]);
  l[0] = fmaxf(l[0], v);
}
__device__ void phase_peerq(const Params& p, char* smem) {
  const int tid = threadIdx.x, lane = tid & 63, wid = tid >> 6;
  const int wr = wid >> 1, wc = wid & 1;
  float* cs = reinterpret_cast<float*>(smem);
  constexpr int NTILES = (T / 128) * 16;
  for (int ti = blockIdx.x; ti < NTILES; ti += gridDim.x) {
    int mt = ti >> 4, hp = ti & 15;
    int m0 = mt * 128;
    f32x16 acc[2][2];
    zero_acc(acc);
    gemm_mainloop(p.h1b + (size_t)m0 * 1024, 1024, p.WqT + (size_t)hp * 128 * 1024, 1024, 1024, acc, smem);
#pragma unroll
    for (int i = 0; i < 2; ++i)
#pragma unroll
      for (int j = 0; j < 2; ++j)
#pragma unroll
        for (int r = 0; r < 16; ++r) {
          int row = wr * 64 + i * 32 + (r & 3) + 8 * (r >> 2) + 4 * (lane >> 5);
          int col = wc * 64 + j * 32 + (lane & 31);
          *reinterpret_cast<u16*>(smem + (col >> 6) * ABUF + row * 144 + (col & 63) * 2) = f2bf(acc[i][j][r]);
        }
    {
      const u16* sk = p.SubK + (size_t)hp * 128 * 128;
#pragma unroll
      for (int i = 0; i < 8; ++i) {
        int c = tid + 256 * i;
        int row = c >> 4, kc = c & 15;
        uint4 q = *reinterpret_cast<const uint4*>(sk + row * 128 + kc * 8);
        *reinterpret_cast<uint4*>(smem + (2 + (kc >> 3)) * ABUF + row * 144 + (kc & 7) * 16) = q;
      }
    }
    __syncthreads();
    zero_acc(acc);
    mma_ktile(smem, smem + 2 * ABUF, acc);
    mma_ktile(smem + ABUF, smem + 3 * ABUF, acc);
    __syncthreads();
    stage_acc(acc, cs);
    __syncthreads();
    {
      int row = tid >> 1, half = tid & 1;
      float* rp = cs + row * CS_LD + half * 64;
      float l[16];
#pragma unroll
      for (int q = 0; q < 16; ++q) l[q] = -INFINITY;
      for (int c = 0; c < 64; c += 4) {
        float4 v4 = *reinterpret_cast<const float4*>(rp + c);
        float vv[4] = {v4.x, v4.y, v4.z, v4.w};
#pragma unroll
        for (int e = 0; e < 4; ++e) {
          u32 bits = __float_as_uint(vv[e]);
          u32 n = (u32)(half * 64 + c + e);
          bits = (bits & ~127u) | ((bits >> 31) ? n : (127u - n));
          ins16(l, __uint_as_float(bits));
        }
      }
#pragma unroll
      for (int q = 0; q < 16; ++q) rp[q] = l[q];
    }
    __syncthreads();
    if (tid < 128) {
      int row = tid;
      size_t t = (size_t)m0 + row;
      const float* la = cs + row * CS_LD;
      const float* lb = la + 64;
      float ssum = 0.f;
#pragma unroll
      for (int q = 0; q < 8; ++q) ssum += p.ssq[t * 8 + q];
      float rt = rsqrtf(ssum * (1.f / 1024.f) + EPS);
      int ia = 0, ib = 0;
      float* ov = p.stv + (t * 16 + hp) * 16;
      u8* oi = p.sti + (t * 16 + hp) * 16;
      for (int q = 0; q < 16; ++q) {
        float va = la[ia], vb = lb[ib];
        bool ta = va >= vb;
        float v = ta ? va : vb;
        ia += ta ? 1 : 0;
        ib += ta ? 0 : 1;
        u32 bits = __float_as_uint(v);
        u32 low = bits & 127u;
        u32 n = (bits >> 31) ? low : (127u - low);
        ov[q] = __uint_as_float(bits & ~127u) * rt;
        oi[q] = (u8)n;
      }
    }
    __syncthreads();
  }
}

__device__ void phase_peer(const Params& p, char* smem) {
  const int tid = threadIdx.x, lane = tid & 63, wid = tid >> 6;
  int* pe_e = reinterpret_cast<int*>(smem + wid * 1024);
  float* pe_g = reinterpret_cast<float*>(smem + wid * 1024 + 512);
  for (int tq = blockIdx.x * 4 + wid; tq < T; tq += gridDim.x * 4) {
    const size_t t = tq;
    const int h = lane >> 3, g = lane & 7;
    const float* s1 = p.stv + (t * 16 + 2 * h) * 16;
    const float* s2 = s1 + 16;
    float l[16];
#pragma unroll
    for (int q = 0; q < 16; ++q) l[q] = -INFINITY;
#pragma unroll
    for (int c = 0; c < 7; ++c) {
      u32 pr = PAIR_TAB[g * 7 + c];
      float v = -INFINITY;
      if (pr != 0xffu) {
        float a = s1[pr >> 4] + s2[pr & 15];
        u32 bits = __float_as_uint(a);
        bits = (bits & ~255u) | ((bits >> 31) ? pr : (255u - pr));
        v = __uint_as_float(bits);
      }
      ins16(l, v);
    }
#pragma unroll
    for (int msk = 1; msk <= 4; msk <<= 1) {
      float c[16];
#pragma unroll
      for (int q = 0; q < 16; ++q) c[q] = __shfl_xor(l[15 - q], msk);
#pragma unroll
      for (int q = 0; q < 16; ++q) c[q] = fmaxf(l[q], c[q]);
#pragma unroll
      for (int st = 8; st >= 1; st >>= 1)
#pragma unroll
        for (int q = 0; q < 16; ++q)
          if ((q & st) == 0) {
            float hi = fmaxf(c[q], c[q + st]), lo = fminf(c[q], c[q + st]);
            c[q] = hi; c[q + st] = lo;
          }
#pragma unroll
      for (int q = 0; q < 16; ++q) l[q] = c[q];
    }
    {
      float bv[16]; int pr[16];
      float m = -INFINITY;
#pragma unroll
      for (int q = 0; q < 16; ++q) {
        u32 bits = __float_as_uint(l[q]);
        u32 low = bits & 255u;
        pr[q] = (int)((bits >> 31) ? low : (255u - low));
        bv[q] = s1[pr[q] >> 4] + s2[pr[q] & 15];
        m = fmaxf(m, bv[q]);
      }
      float ssum = 0.f;
#pragma unroll
      for (int q = 0; q < 16; ++q) { bv[q] = __expf(bv[q] - m); ssum += bv[q]; }
      float inv = 1.f / ssum;
      const u8* i1 = p.sti + (t * 16 + 2 * h) * 16;
      const u8* i2 = i1 + 16;
      __builtin_amdgcn_wave_barrier();
#pragma unroll
      for (int q = 0; q < 16; ++q) {
        if ((q >> 1) == g) {
          pe_e[h * 16 + q] = (int)i1[pr[q] >> 4] * 128 + (int)i2[pr[q] & 15];
          pe_g[h * 16 + q] = bv[q] * inv;
        }
      }
      __builtin_amdgcn_wave_barrier();
    }
    float rt;
    {
      float ssum = 0.f;
#pragma unroll
      for (int q = 0; q < 8; ++q) ssum += p.ssq[t * 8 + q];
      rt = rsqrtf(ssum * (1.f / 1024.f) + EPS);
    }
    uint4 hx0 = *reinterpret_cast<const uint4*>(p.h1b + t * 1024 + lane * 8);
    uint4 hx1 = *reinterpret_cast<const uint4*>(p.h1b + t * 1024 + 512 + lane * 8);
    u32 hw[8] = {hx0.x, hx0.y, hx0.z, hx0.w, hx1.x, hx1.y, hx1.z, hx1.w};
    float y[16];
#pragma unroll
    for (int q = 0; q < 16; ++q) y[q] = 0.f;
    for (int e0 = 0; e0 < 128; e0 += 4) {
      uint4 ur[4][2], vr[4][2];
      float gt[4];
#pragma unroll
      for (int k = 0; k < 4; ++k) {
        int ex = pe_e[e0 + k];
        gt[k] = pe_g[e0 + k];
        const u16* up = p.Ub + (size_t)ex * 1024 + lane * 8;
        const u16* vp = p.Vb + (size_t)ex * 1024 + lane * 8;
        ur[k][0] = *reinterpret_cast<const uint4*>(up);
        ur[k][1] = *reinterpret_cast<const uint4*>(up + 512);
        vr[k][0] = *reinterpret_cast<const uint4*>(vp);
        vr[k][1] = *reinterpret_cast<const uint4*>(vp + 512);
      }
#pragma unroll
      for (int k = 0; k < 4; ++k) {
        u32 uw[8] = {ur[k][0].x, ur[k][0].y, ur[k][0].z, ur[k][0].w, ur[k][1].x, ur[k][1].y, ur[k][1].z, ur[k][1].w};
        float d = 0.f;
#pragma unroll
        for (int q = 0; q < 8; ++q)
          d = __builtin_amdgcn_fdot2_f32_bf16(__builtin_bit_cast(bf16x2_t, uw[q]), __builtin_bit_cast(bf16x2_t, hw[q]), d, false);
        d = wave_sum(d);
        float c = gt[k] * gelu_f(d * rt);
        u32 vw[8] = {vr[k][0].x, vr[k][0].y, vr[k][0].z, vr[k][0].w, vr[k][1].x, vr[k][1].y, vr[k][1].z, vr[k][1].w};
#pragma unroll
        for (int q = 0; q < 8; ++q) { y[2 * q] += c * bf_lo(vw[q]); y[2 * q + 1] += c * bf_hi(vw[q]); }
      }
    }
    float* op = p.out + t * 1024 + lane * 8;
#pragma unroll
    for (int hh = 0; hh < 2; ++hh) {
      float4 a = *reinterpret_cast<const float4*>(op + hh * 512);
      float4 b = *reinterpret_cast<const float4*>(op + hh * 512 + 4);
      a.x += y[hh * 8 + 0]; a.y += y[hh * 8 + 1]; a.z += y[hh * 8 + 2]; a.w += y[hh * 8 + 3];
      b.x += y[hh * 8 + 4]; b.y += y[hh * 8 + 5]; b.z += y[hh * 8 + 6]; b.w += y[hh * 8 + 7];
      *reinterpret_cast<float4*>(op + hh * 512) = a;
      *reinterpret_cast<float4*>(op + hh * 512 + 4) = b;
    }
    __builtin_amdgcn_wave_barrier();
  }
}

__device__ void phase_mix(const Params& p, char* smem) {
  const int G = gridDim.x;
  for (int s0 = 0, r = 0; s0 < 2048; s0 += G, ++r) {
    int off = (r & 1) ? (G - 1 - (int)blockIdx.x) : (int)blockIdx.x;
    int s = s0 + off;
    if (s < 2048) {
      int grp = 1023 - (s >> 1), b = s & 1;
      unit_indexer(p, smem, (b << 10) | grp);
    }
  }
  for (int u = blockIdx.x; u < 1024; u += G) unit_spatial(p, smem, u);
  for (int u = blockIdx.x; u < 256; u += G) unit_kv(p, smem, u);
}

template <int PH>
__device__ __forceinline__ void run_phase(const Params& p, char* smem) {
  if (PH == 0) phase_prep(p, smem);
  else if (PH == 1) phase_gemm1(p, smem);
  else if (PH == 2) phase_mix(p, smem);
  else if (PH == 3) phase_attn(p, smem);
  else if (PH == 4) phase_merge(p, smem);
  else if (PH == 5) phase_wo(p, smem);
  else if (PH == 6) phase_peerq(p, smem);
  else phase_peer(p, smem);
}

template <int PH>
__global__ void __launch_bounds__(NTHREADS, 2) phase_kernel(Params p) {
  __shared__ __attribute__((aligned(16))) char smem[SMEM_BYTES];
  run_phase<PH>(p, smem);
}

__global__ void __launch_bounds__(NTHREADS, 2) mega_kernel(Params p) {
  __shared__ __attribute__((aligned(16))) char smem[SMEM_BYTES];
  cg::grid_group grid = cg::this_grid();
  run_phase<0>(p, smem); grid.sync();
  run_phase<1>(p, smem); grid.sync();
  run_phase<2>(p, smem); grid.sync();
  run_phase<3>(p, smem); grid.sync();
  run_phase<4>(p, smem); grid.sync();
  run_phase<5>(p, smem); grid.sync();
  run_phase<6>(p, smem); grid.sync();
  run_phase<7>(p, smem);
}

extern "C" void kernel_launch(void* const* d_in, const int* in_sizes, int n_in, void* d_out, int out_size,
                              void* d_ws, size_t ws_size, hipStream_t stream) {
  Params p{};
  p.x = (const float*)d_in[0]; p.pos = (const int*)d_in[1];
  p.norm1_g = (const float*)d_in[2]; p.w_in = (const float*)d_in[3]; p.v_norm_g = (const float*)d_in[4];
  p.v_norm_b = (const float*)d_in[5]; p.spatial_w = (const float*)d_in[6]; p.spatial_b = (const float*)d_in[7];
  p.kv_norm_g = (const float*)d_in[8]; p.w_uk = (const float*)d_in[9]; p.w_uv = (const float*)d_in[10];
  p.q_norm_g = (const float*)d_in[11]; p.k_norm_g = (const float*)d_in[12]; p.w_a_out = (const float*)d_in[13];
  p.w_b_out = (const float*)d_in[14]; p.w_o = (const float*)d_in[15]; p.norm2_g = (const float*)d_in[16];
  p.peer_wq = (const float*)d_in[17]; p.peer_subkeys = (const float*)d_in[18]; p.peer_u = (const float*)d_in[19];
  p.peer_v = (const float*)d_in[20];
  p.out = (float*)d_out;
  char* w = (char*)d_ws;
  size_t off = 0;
  auto take = [&](size_t bytes) { char* r = w + off; off += (bytes + 255) & ~(size_t)255; return r; };
  const size_t MB = 1u << 20;
  char* r_xn = take(64 * MB);
  p.xn = (u16*)r_xn; p.ya = (u16*)r_xn; p.yb = (u16*)(r_xn + 32 * MB);
  p.WinT = (u16*)take((size_t)NWIN * 1024 * 2);
  p.WaT = (u16*)take(1024 * 512 * 2); p.WbT = (u16*)take(1024 * 512 * 2);
  p.WoT = (u16*)take(1024 * 1024 * 2); p.WqT = (u16*)take(2048 * 1024 * 2);
  p.WkvT = (u16*)take(256 * 256 * 2); p.SubK = (u16*)take(262144 * 2); p.Wtril = (u16*)take(65536 * 2);
  p.Ub = (u16*)take(32 * MB); p.Vb = (u16*)take(32 * MB);
  char* r_g = take(96 * MB);
  p.gu = (u16*)r_g; p.gv = (u16*)(r_g + 32 * MB); p.qh = (u16*)(r_g + 64 * MB); p.merged = (u16*)r_g;
  p.ckv = (u16*)take(16 * MB); p.qi = (u16*)take(16 * MB); p.ki = (u16*)take(4 * MB);
  p.wi = (float*)take((size_t)T * 4 * 4);
  char* r_sg = take(128 * MB);
  p.sg = (u16*)r_sg; p.h1b = (u16*)r_sg; p.stv = (float*)(r_sg + 64 * MB); p.sti = (u8*)(r_sg + 96 * MB);
  p.kk = (u16*)take(8 * MB); p.vv = (u16*)take(8 * MB); p.sel = (u16*)take(16 * MB);
  p.ssq = (float*)take((size_t)T * 8 * 4);
  if (off > ws_size) { fprintf(stderr, "workspace too small: need %zu have %zu\n", off, ws_size); return; }

  static int grid_blocks = 0;
  if (!grid_blocks) {
    int dev = 0, cus = 0, per_cu = 0;
    hipGetDevice(&dev);
    hipDeviceGetAttribute(&cus, hipDeviceAttributeMultiprocessorCount, dev);
    hipOccupancyMaxActiveBlocksPerMultiprocessor(&per_cu, mega_kernel, NTHREADS, 0);
    if (per_cu > 2) per_cu = 2;
    if (per_cu < 1) per_cu = 1;
    grid_blocks = cus * per_cu;
  }
#if MULTI_LAUNCH
  dim3 g(grid_blocks), b(NTHREADS);
  phase_kernel<0><<<g, b, 0, stream>>>(p);
  phase_kernel<1><<<g, b, 0, stream>>>(p);
  phase_kernel<2><<<g, b, 0, stream>>>(p);
  phase_kernel<3><<<g, b, 0, stream>>>(p);
  phase_kernel<4><<<g, b, 0, stream>>>(p);
  phase_kernel<5><<<g, b, 0, stream>>>(p);
  phase_kernel<6><<<g, b, 0, stream>>>(p);
  phase_kernel<7><<<g, b, 0, stream>>>(p);
#else
  void* args[] = {&p};
  hipError_t e = hipLaunchCooperativeKernel((void*)mega_kernel, dim3(grid_blocks), dim3(NTHREADS), args, 0, stream);
  if (e != hipSuccess) fprintf(stderr, "cooperative launch failed: %s (grid %d)\n", hipGetErrorString(e), grid_blocks);
#endif
}
```

```cpp
#include <hip/hip_runtime.h>
#include <hip/hip_cooperative_groups.h>
#include <stdint.h>
#include <cstdio>
namespace cg = cooperative_groups;

#ifndef MULTI_LAUNCH
#define MULTI_LAUNCH 0
#endif

typedef unsigned short u16;
typedef unsigned int u32;
typedef unsigned char u8;
using bf16x8 = __attribute__((ext_vector_type(8))) short;
using f32x4 = __attribute__((ext_vector_type(4))) float;
using f32x16 = __attribute__((ext_vector_type(16))) float;
typedef __bf16 bf16x2_t __attribute__((ext_vector_type(2)));
typedef float float2_t __attribute__((ext_vector_type(2)));

constexpr int BATCH = 2, SEQ = 16384, DM = 1024, T = BATCH * SEQ;
constexpr int NWIN = 4224;
constexpr int NTHREADS = 256;
constexpr float EPS = 1e-6f;
constexpr int ABUF = 128 * 144;
constexpr int CS_LD = 132;
constexpr int SMEM_BYTES = 77824;
constexpr int EXTRA_OFF = 4 * ABUF;
constexpr int CAP = 768;

__constant__ float INV32[16] = {1.000000000e+00f, 4.403665960e-01f, 1.939227432e-01f, 8.539710194e-02f, 3.760603070e-02f, 1.656043902e-02f, 7.292664610e-03f, 3.211445874e-03f, 1.414213562e-03f, 6.227723788e-04f, 2.742481884e-04f, 1.207697351e-04f, 5.318296098e-05f, 2.341999971e-05f, 1.031338616e-05f, 4.541670478e-06f};
__constant__ float INV16[8] = {1.000000000e+00f, 1.939227432e-01f, 3.760603070e-02f, 7.292664610e-03f, 1.414213562e-03f, 2.742481884e-04f, 5.318296098e-05f, 1.031338616e-05f};
__constant__ u8 PAIR_TAB[56] = {
  0x00,0x01,0x02,0x03,0x04,0x05,0x06,0x07,0x08,0x09,0x0a,0x0b,0x0c,0x0d,0x0e,0x0f,
  0x10,0x11,0x12,0x13,0x14,0x15,0x16,0x17,
  0x20,0x21,0x22,0x23,0x24,
  0x30,0x31,0x32,0x33,
  0x40,0x41,0x42,
  0x50,0x51,
  0x60,0x61,
  0x70,0x71,
  0x80,0x90,0xa0,0xb0,0xc0,0xd0,0xe0,0xf0,
  0xff,0xff,0xff,0xff,0xff,0xff};

struct Params {
  const float* x; const int* pos;
  const float *norm1_g, *w_in, *v_norm_g, *v_norm_b, *spatial_w, *spatial_b, *kv_norm_g, *w_uk, *w_uv,
      *q_norm_g, *k_norm_g, *w_a_out, *w_b_out, *w_o, *norm2_g, *peer_wq, *peer_subkeys, *peer_u, *peer_v;
  float* out;
  u16 *xn, *WinT, *WaT, *WbT, *WoT, *WqT, *WkvT, *SubK, *Wtril, *Ub, *Vb;
  u16 *gu, *gv, *qh, *ckv, *qi, *ki, *sg, *kk, *vv, *ya, *yb, *merged, *h1b, *sel;
  float *wi, *ssq, *stv;
  u8* sti;
};

__device__ __forceinline__ u32 pack_bf16(float a, float b) {
  float2_t v = {a, b};
  bf16x2_t r = __builtin_convertvector(v, bf16x2_t);
  return __builtin_bit_cast(u32, r);
}
__device__ __forceinline__ u16 f2bf(float a) { return (u16)(pack_bf16(a, 0.f) & 0xffffu); }
__device__ __forceinline__ float bf_lo(u32 u) { return __uint_as_float(u << 16); }
__device__ __forceinline__ float bf_hi(u32 u) { return __uint_as_float(u & 0xffff0000u); }
__device__ __forceinline__ float bf2f(u16 h) { return __uint_as_float(((u32)h) << 16); }
__device__ __forceinline__ float wave_sum(float v) {
#pragma unroll
  for (int m = 32; m >= 1; m >>= 1) v += __shfl_xor(v, m);
  return v;
}
__device__ __forceinline__ float gelu_f(float x) {
  float z = 1.5957691216057308f * (x + 0.044715f * x * x * x);
  return x / (1.f + __expf(-z));
}
__device__ __forceinline__ float sigmoid_f(float x) { return 1.f / (1.f + __expf(-x)); }
__device__ __forceinline__ u32 sortable(u32 b) { return b ^ ((u32)((int)b >> 31) | 0x80000000u); }
__device__ __forceinline__ u32 unsortable(u32 k) { return k ^ ((k & 0x80000000u) ? 0x80000000u : 0xffffffffu); }
__device__ __forceinline__ int mbcnt64(unsigned long long m) {
  return __builtin_amdgcn_mbcnt_hi((u32)(m >> 32), __builtin_amdgcn_mbcnt_lo((u32)m, 0));
}

typedef u32 u32x4 __attribute__((ext_vector_type(4)));
struct Tile4 { u32x4 v0, v1, v2, v3; };
__device__ __forceinline__ void gemm_load_tile(const u16* __restrict__ g, int ld, int k0, Tile4& r) {
  const int tid = threadIdx.x;
  const int row = tid >> 3, kc = tid & 7;
  const u16* base = g + (size_t)row * ld + k0 + kc * 8;
  r.v0 = *reinterpret_cast<const u32x4*>(base);
  r.v1 = *reinterpret_cast<const u32x4*>(base + (size_t)32 * ld);
  r.v2 = *reinterpret_cast<const u32x4*>(base + (size_t)64 * ld);
  r.v3 = *reinterpret_cast<const u32x4*>(base + (size_t)96 * ld);
}
__device__ __forceinline__ void gemm_store_tile(char* buf, const Tile4& r) {
  const int tid = threadIdx.x;
  const int row = tid >> 3, kc = tid & 7;
  char* base = buf + row * 144 + kc * 16;
  *reinterpret_cast<u32x4*>(base) = r.v0;
  *reinterpret_cast<u32x4*>(base + 32 * 144) = r.v1;
  *reinterpret_cast<u32x4*>(base + 64 * 144) = r.v2;
  *reinterpret_cast<u32x4*>(base + 96 * 144) = r.v3;
}
__device__ __forceinline__ void mma_ktile(const char* sa, const char* sb, f32x16 (&acc)[2][2]) {
  const int lane = threadIdx.x & 63, wid = threadIdx.x >> 6;
  const int wr = wid >> 1, wc = wid & 1;
  const int r32 = lane & 31, hf = lane >> 5;
#pragma unroll
  for (int s = 0; s < 4; ++s) {
    bf16x8 a[2], b[2];
#pragma unroll
    for (int i = 0; i < 2; ++i) {
      a[i] = *reinterpret_cast<const bf16x8*>(sa + (wr * 64 + i * 32 + r32) * 144 + s * 32 + hf * 16);
      b[i] = *reinterpret_cast<const bf16x8*>(sb + (wc * 64 + i * 32 + r32) * 144 + s * 32 + hf * 16);
    }
#pragma unroll
    for (int i = 0; i < 2; ++i)
#pragma unroll
      for (int j = 0; j < 2; ++j)
        acc[i][j] = __builtin_amdgcn_mfma_f32_32x32x16_bf16(a[i], b[j], acc[i][j], 0, 0, 0);
  }
}
__device__ __forceinline__ void gemm_mainloop(const u16* __restrict__ A, int lda, const u16* __restrict__ B, int ldb,
                                              int K, f32x16 (&acc)[2][2], char* smem) {
  Tile4 ra, rb;
  const int nk = K >> 6;
  gemm_load_tile(A, lda, 0, ra);
  gemm_load_tile(B, ldb, 0, rb);
  __syncthreads();
  gemm_store_tile(smem, ra);
  gemm_store_tile(smem + 2 * ABUF, rb);
  __syncthreads();
#pragma unroll 1
  for (int kt = 0; kt < nk; ++kt) {
    const int cur = kt & 1;
    if (kt + 1 < nk) {
      gemm_load_tile(A, lda, (kt + 1) << 6, ra);
      gemm_load_tile(B, ldb, (kt + 1) << 6, rb);
    }
    mma_ktile(smem + cur * ABUF, smem + (2 + cur) * ABUF, acc);
    if (kt + 1 < nk) {
      gemm_store_tile(smem + (cur ^ 1) * ABUF, ra);
      gemm_store_tile(smem + (2 + (cur ^ 1)) * ABUF, rb);
    }
    __syncthreads();
  }
}
__device__ __forceinline__ void zero_acc(f32x16 (&acc)[2][2]) {
#pragma unroll
  for (int i = 0; i < 2; ++i)
#pragma unroll
    for (int j = 0; j < 2; ++j)
#pragma unroll
      for (int r = 0; r < 16; ++r) acc[i][j][r] = 0.f;
}
__device__ __forceinline__ void stage_acc(const f32x16 (&acc)[2][2], float* cs) {
  const int lane = threadIdx.x & 63, wid = threadIdx.x >> 6;
  const int wr = wid >> 1, wc = wid & 1;
#pragma unroll
  for (int i = 0; i < 2; ++i)
#pragma unroll
    for (int j = 0; j < 2; ++j)
#pragma unroll
      for (int r = 0; r < 16; ++r) {
        int row = wr * 64 + i * 32 + (r & 3) + 8 * (r >> 2) + 4 * (lane >> 5);
        int col = wc * 64 + j * 32 + (lane & 31);
        cs[row * CS_LD + col] = acc[i][j][r];
      }
}

__device__ __forceinline__ int win_srccol(int n) {
  if (n < 2116) return n;
  if (n < 2176) return -1;
  return n - 60;
}
__device__ void phase_prep(const Params& p, char* smem) {
  const int tid = threadIdx.x, lane = tid & 63, wid = tid >> 6;
  for (int rb = blockIdx.x; rb < T / 4; rb += gridDim.x) {
    int row = rb * 4 + wid;
    const float* xr = p.x + (size_t)row * DM;
    float4 v[4];
    float ss = 0.f;
#pragma unroll
    for (int i = 0; i < 4; ++i) {
      v[i] = *reinterpret_cast<const float4*>(xr + lane * 4 + 256 * i);
      ss += v[i].x * v[i].x + v[i].y * v[i].y + v[i].z * v[i].z + v[i].w * v[i].w;
    }
    ss = wave_sum(ss);
    float r = rsqrtf(ss * (1.f / DM) + EPS);
#pragma unroll
    for (int i = 0; i < 4; ++i) {
      float4 g = *reinterpret_cast<const float4*>(p.norm1_g + lane * 4 + 256 * i);
      uint2 o;
      o.x = pack_bf16(v[i].x * r * g.x, v[i].y * r * g.y);
      o.y = pack_bf16(v[i].z * r * g.z, v[i].w * r * g.w);
      *reinterpret_cast<uint2*>(p.xn + (size_t)row * DM + lane * 4 + 256 * i) = o;
    }
  }
  float* tile = reinterpret_cast<float*>(smem);
  constexpr int NT_TOTAL = 1056 + 128 + 128 + 256 + 512 + 8 + 8;
  for (int ti = blockIdx.x; ti < NT_TOTAL; ti += gridDim.x) {
    const float* src; const float* scale = nullptr; u16* dst; int ldsrc, K, nn, mode = 0; int t = ti;
    if (t < 1056) { src = p.w_in; ldsrc = 4164; K = 1024; nn = 66; dst = p.WinT; mode = 1; }
    else if ((t -= 1056) < 128) { src = p.w_a_out; ldsrc = 1024; K = 512; nn = 16; dst = p.WaT; }
    else if ((t -= 128) < 128) { src = p.w_b_out; ldsrc = 1024; K = 512; nn = 16; dst = p.WbT; }
    else if ((t -= 128) < 256) { src = p.w_o; ldsrc = 1024; K = 1024; nn = 16; dst = p.WoT; }
    else if ((t -= 256) < 512) { src = p.peer_wq; ldsrc = 2048; K = 1024; nn = 32; dst = p.WqT; scale = p.norm2_g; }
    else if ((t -= 512) < 8) { src = p.w_uk; ldsrc = 128; K = 256; nn = 2; dst = p.WkvT; scale = p.kv_norm_g; }
    else { t -= 8; src = p.w_uv; ldsrc = 128; K = 256; nn = 2; dst = p.WkvT + 128 * 256; scale = p.kv_norm_g; }
    int n0 = (t % nn) * 64, k0 = (t / nn) * 64;
    __syncthreads();
    {
      int n = tid & 63;
      int sc = (mode == 1) ? win_srccol(n0 + n) : (n0 + n);
      for (int kk = tid >> 6; kk < 64; kk += 4) {
        float v = 0.f;
        if (sc >= 0) v = src[(size_t)(k0 + kk) * ldsrc + sc];
        if (scale) v *= scale[k0 + kk];
        tile[kk * 65 + n] = v;
      }
    }
    __syncthreads();
    {
      int k = (tid & 31) * 2;
      for (int n = tid >> 5; n < 64; n += 8) {
        u32 o = pack_bf16(tile[k * 65 + n], tile[(k + 1) * 65 + n]);
        *reinterpret_cast<u32*>(dst + (size_t)(n0 + n) * K + k0 + k) = o;
      }
    }
  }
  constexpr int G_SUB = 262144 / 4, G_SW = 65536 / 4, G_U = 16384 * 1024 / 4;
  constexpr int G_TOTAL = G_SUB + G_SW + 2 * G_U;
  for (int gi = blockIdx.x * NTHREADS + tid; gi < G_TOTAL; gi += gridDim.x * NTHREADS) {
    int g = gi;
    if (g < G_SUB) {
      float4 v = *reinterpret_cast<const float4*>(p.peer_subkeys + (size_t)g * 4);
      uint2 o = {pack_bf16(v.x, v.y), pack_bf16(v.z, v.w)};
      *reinterpret_cast<uint2*>(p.SubK + (size_t)g * 4) = o;
    } else if ((g -= G_SUB) < G_SW) {
      float4 v = *reinterpret_cast<const float4*>(p.spatial_w + (size_t)g * 4);
      int e = g * 4; int s = e & 127, tt = (e >> 7) & 127;
      if (s > tt) v.x = 0.f;
      if (s + 1 > tt) v.y = 0.f;
      if (s + 2 > tt) v.z = 0.f;
      if (s + 3 > tt) v.w = 0.f;
      uint2 o = {pack_bf16(v.x, v.y), pack_bf16(v.z, v.w)};
      *reinterpret_cast<uint2*>(p.Wtril + (size_t)g * 4) = o;
    } else if ((g -= G_SW) < G_U) {
      float4 v = *reinterpret_cast<const float4*>(p.peer_u + (size_t)g * 4);
      float4 s = *reinterpret_cast<const float4*>(p.norm2_g + ((g * 4) & 1023));
      uint2 o = {pack_bf16(v.x * s.x, v.y * s.y), pack_bf16(v.z * s.z, v.w * s.w)};
      *reinterpret_cast<uint2*>(p.Ub + (size_t)g * 4) = o;
    } else {
      g -= G_U;
      float4 v = *reinterpret_cast<const float4*>(p.peer_v + (size_t)g * 4);
      uint2 o = {pack_bf16(v.x, v.y), pack_bf16(v.z, v.w)};
      *reinterpret_cast<uint2*>(p.Vb + (size_t)g * 4) = o;
    }
  }
}

__device__ __forceinline__ void rope_pair(float& y0, float& y1, int lc, int half, int xm, float posf, const float* inv) {
  float p0 = __shfl_xor(y0, xm), p1 = __shfl_xor(y1, xm);
  if (lc < 2 * half) {
    int j = lc & (half - 1);
    float a0 = posf * inv[j], a1 = posf * inv[j + 1];
    float s0, c0, s1, c1;
    sincosf(a0, &s0, &c0);
    sincosf(a1, &s1, &c1);
    if (lc < half) { y0 = y0 * c0 - p0 * s0; y1 = y1 * c1 - p1 * s1; }
    else { y0 = y0 * c0 + p0 * s0; y1 = y1 * c1 + p1 * s1; }
  }
}

__device__ void phase_gemm1(const Params& p, char* smem) {
  const int tid = threadIdx.x, lane = tid & 63, wid = tid >> 6;
  float* cs = reinterpret_cast<float*>(smem);
  constexpr int NTN = NWIN / 128;
  constexpr int NTILES = (T / 128) * NTN;
  for (int ti = blockIdx.x; ti < NTILES; ti += gridDim.x) {
    int mt = ti / NTN, nt = ti % NTN;
    int m0 = mt * 128;
    f32x16 acc[2][2];
    zero_acc(acc);
    gemm_mainloop(p.xn + (size_t)m0 * DM, DM, p.WinT + (size_t)nt * 128 * DM, DM, DM, acc, smem);
    stage_acc(acc, cs);
    __syncthreads();
    const int c0 = 2 * lane;
    for (int rr = 0; rr < 32; ++rr) {
      int row = wid * 32 + rr;
      int t = m0 + row;
      float2 v = *reinterpret_cast<const float2*>(cs + row * CS_LD + c0);
      float v0 = v.x, v1 = v.y;
      if (nt < 4) {
        *reinterpret_cast<u32*>(p.gu + (size_t)t * 512 + nt * 128 + c0) = pack_bf16(gelu_f(v0), gelu_f(v1));
      } else if (nt < 8) {
        *reinterpret_cast<u32*>(p.gv + (size_t)t * 512 + (nt - 4) * 128 + c0) = pack_bf16(gelu_f(v0), gelu_f(v1));
      } else if (nt < 12) {
        float ss = wave_sum(v0 * v0 + v1 * v1);
        float r = rsqrtf(ss * (1.f / 128.f) + EPS);
        float y0 = v0 * r * p.q_norm_g[c0], y1 = v1 * r * p.q_norm_g[c0 + 1];
        float posf = (float)p.pos[t];
        rope_pair(y0, y1, c0, 16, 8, posf, INV32);
        *reinterpret_cast<u32*>(p.qh + (size_t)t * 512 + (nt - 8) * 128 + c0) = pack_bf16(y0, y1);
      } else if (nt < 14) {
        *reinterpret_cast<u32*>(p.ckv + (size_t)t * 256 + (nt - 12) * 128 + c0) = pack_bf16(v0, v1);
      } else if (nt < 16) {
        float posf = (float)p.pos[t];
        float y0 = v0, y1 = v1;
        rope_pair(y0, y1, c0 & 63, 8, 4, posf, INV16);
        *reinterpret_cast<u32*>(p.qi + (size_t)t * 256 + (nt - 14) * 128 + c0) = pack_bf16(y0, y1);
      } else if (nt == 16) {
        float posf = (float)p.pos[t];
        float y0 = v0, y1 = v1;
        rope_pair(y0, y1, c0 < 64 ? c0 : 64, 8, 4, posf, INV16);
        if (c0 < 64) *reinterpret_cast<u32*>(p.ki + (size_t)t * 64 + c0) = pack_bf16(y0, y1);
        else if (c0 < 68) { p.wi[(size_t)t * 4 + (c0 - 64)] = v0 * 0.0625f; p.wi[(size_t)t * 4 + (c0 - 63)] = v1 * 0.0625f; }
      } else {
        *reinterpret_cast<u32*>(p.sg + (size_t)t * 2048 + (nt - 17) * 128 + c0) = pack_bf16(sigmoid_f(v0), sigmoid_f(v1));
      }
    }
    __syncthreads();
  }
}

__device__ void unit_kv(const Params& p, char* smem, int mt) {
  const int tid = threadIdx.x, lane = tid & 63, wid = tid >> 6;
  float* cs = reinterpret_cast<float*>(smem);
  float* rr_s = reinterpret_cast<float*>(smem + EXTRA_OFF);
  const int m0 = mt * 128;
  __syncthreads();
  {
    int row = tid >> 1, half = tid & 1;
    const u16* src = p.ckv + (size_t)(m0 + row) * 256 + half * 128;
    float ss = 0.f;
#pragma unroll 4
    for (int i = 0; i < 16; ++i) {
      uint4 q = *reinterpret_cast<const uint4*>(src + i * 8);
      u32 w[4] = {q.x, q.y, q.z, q.w};
#pragma unroll
      for (int j = 0; j < 4; ++j) { float a = bf_lo(w[j]), b = bf_hi(w[j]); ss += a * a + b * b; }
    }
    ss += __shfl_xor(ss, 1);
    if (half == 0) rr_s[row] = rsqrtf(ss * (1.f / 256.f) + EPS);
  }
#pragma unroll 1
  for (int nt = 0; nt < 2; ++nt) {
    f32x16 acc[2][2];
    zero_acc(acc);
    gemm_mainloop(p.ckv + (size_t)m0 * 256, 256, p.WkvT + (size_t)nt * 128 * 256, 256, 256, acc, smem);
    stage_acc(acc, cs);
    __syncthreads();
    const int c0 = 2 * lane;
#pragma unroll 1
    for (int rr = 0; rr < 32; ++rr) {
      int row = wid * 32 + rr;
      int t = m0 + row;
      float2 v = *reinterpret_cast<const float2*>(cs + row * CS_LD + c0);
      float rs = rr_s[row];
      float v0 = v.x * rs, v1 = v.y * rs;
      if (nt == 0) {
        float ss = wave_sum(v0 * v0 + v1 * v1);
        float r = rsqrtf(ss * (1.f / 128.f) + EPS);
        float y0 = v0 * r * p.k_norm_g[c0], y1 = v1 * r * p.k_norm_g[c0 + 1];
        float posf = (float)p.pos[t];
        rope_pair(y0, y1, c0, 16, 8, posf, INV32);
        *reinterpret_cast<u32*>(p.kk + (size_t)t * 128 + c0) = pack_bf16(y0, y1);
      } else {
        *reinterpret_cast<u32*>(p.vv + (size_t)t * 128 + c0) = pack_bf16(v0, v1);
      }
    }
    __syncthreads();
  }
}

__device__ void unit_spatial(const Params& p, char* smem, int unit) {
  const int tid = threadIdx.x, lane = tid & 63, wid = tid >> 6;
  const int chunk = unit >> 2, g = unit & 3;
  const int t0 = chunk * 128;
  float* cs = reinterpret_cast<float*>(smem);
  float* mu_s = reinterpret_cast<float*>(smem + EXTRA_OFF);
  float* rs_s = mu_s + 128;
  __syncthreads();
  {
    int row = tid >> 1, half = tid & 1;
    const u16* src = p.gv + (size_t)(t0 + row) * 512 + half * 256;
    float s = 0.f, ss = 0.f;
#pragma unroll 4
    for (int i = 0; i < 32; ++i) {
      uint4 q = *reinterpret_cast<const uint4*>(src + i * 8);
      u32 w[4] = {q.x, q.y, q.z, q.w};
#pragma unroll
      for (int j = 0; j < 4; ++j) { float a = bf_lo(w[j]), b = bf_hi(w[j]); s += a + b; ss += a * a + b * b; }
    }
    s += __shfl_xor(s, 1);
    ss += __shfl_xor(ss, 1);
    float mean = s * (1.f / 512.f);
    float var = fmaxf(ss * (1.f / 512.f) - mean * mean, 0.f);
    if (half == 0) { mu_s[row] = mean; rs_s[row] = rsqrtf(var + EPS); }
  }
  {
    const u16* wsrc = p.Wtril + (size_t)g * 128 * 128;
#pragma unroll
    for (int i = 0; i < 8; ++i) {
      int c = tid + 256 * i;
      int row = c >> 4, kc = c & 15;
      uint4 q = *reinterpret_cast<const uint4*>(wsrc + row * 128 + kc * 8);
      *reinterpret_cast<uint4*>(smem + (kc >> 3) * ABUF + row * 144 + (kc & 7) * 16) = q;
    }
  }
  __syncthreads();
  {
    int s = tid & 127;
    float mu = mu_s[s], rs = rs_s[s];
    const u16* src = p.gv + (size_t)(t0 + s) * 512 + g * 128;
    char* bbase = smem + (2 + (s >> 6)) * ABUF + (s & 63) * 2;
#pragma unroll
    for (int i = 0; i < 8; ++i) {
      int d0 = ((tid >> 7) + 2 * i) * 8;
      uint4 q = *reinterpret_cast<const uint4*>(src + d0);
      u32 w[4] = {q.x, q.y, q.z, q.w};
#pragma unroll
      for (int j = 0; j < 4; ++j) {
        int d = d0 + 2 * j;
        float a = (bf_lo(w[j]) - mu) * rs * p.v_norm_g[g * 128 + d] + p.v_norm_b[g * 128 + d];
        float b = (bf_hi(w[j]) - mu) * rs * p.v_norm_g[g * 128 + d + 1] + p.v_norm_b[g * 128 + d + 1];
        *reinterpret_cast<u16*>(bbase + d * 144) = f2bf(a);
        *reinterpret_cast<u16*>(bbase + (d + 1) * 144) = f2bf(b);
      }
    }
  }
  __syncthreads();
  f32x16 acc[2][2];
  zero_acc(acc);
  mma_ktile(smem, smem + 2 * ABUF, acc);
  mma_ktile(smem + ABUF, smem + 3 * ABUF, acc);
  __syncthreads();
  stage_acc(acc, cs);
  __syncthreads();
  const int c0 = 2 * lane;
  for (int rr = 0; rr < 32; ++rr) {
    int row = wid * 32 + rr;
    int t = t0 + row;
    float2 v = *reinterpret_cast<const float2*>(cs + row * CS_LD + c0);
    float b = p.spatial_b[g * 128 + row];
    u32 uu = *reinterpret_cast<const u32*>(p.gu + (size_t)t * 512 + g * 128 + c0);
    *reinterpret_cast<u32*>(p.ya + (size_t)t * 512 + g * 128 + c0) = pack_bf16(bf_lo(uu) * (v.x + b), bf_hi(uu) * (v.y + b));
  }
}

__device__ __forceinline__ void radix_select(const u32 (&key)[12], int rank, u32& Tout, int& krem_out) {
  u32 prefix = 0;
  int krem = rank;
  for (int b = 31; b >= 0; --b) {
    u32 cand = prefix | (1u << b);
    u32 himask = ~((1u << b) - 1u);
    int c = 0;
#pragma unroll
    for (int k = 0; k < 12; ++k) c += __popcll(__ballot((key[k] & himask) == cand));
    if (c >= krem) prefix = cand; else krem -= c;
  }
  Tout = prefix;
  krem_out = krem;
}

__device__ void unit_indexer(const Params& p, char* smem, int unit) {
  const int tid = threadIdx.x, lane = tid & 63, wid = tid >> 6;
  const int b = unit >> 10, grp = unit & 1023;
  const int tb = b * SEQ, i0 = grp * 16;
  u32* cval = reinterpret_cast<u32*>(smem);
  u16* cidx = reinterpret_cast<u16*>(smem + 16 * CAP * 4);
  volatile int* cnt = reinterpret_cast<volatile int*>(smem + EXTRA_OFF);
  __syncthreads();
  if (tid < 16) cnt[tid] = 0;
  __syncthreads();
  const int qsub = lane >> 4;
  const int ql = wid * 4 + qsub;
  const int iq = i0 + ql;
  const int kcol = lane & 15;
  bf16x8 afr[2];
  {
    const u16* qa = p.qi + ((size_t)(tb + i0 + wid * 4 + (kcol >> 2)) * 4 + (kcol & 3)) * 64 + 8 * (lane >> 4);
    afr[0] = *reinterpret_cast<const bf16x8*>(qa);
    afr[1] = *reinterpret_cast<const bf16x8*>(qa + 32);
  }
  const float4 w4 = *reinterpret_cast<const float4*>(p.wi + (size_t)(tb + iq) * 4);
  float thr = -INFINITY;
  u32* myval = cval + ql * CAP;
  u16* myidx = cidx + ql * CAP;
  const int nchunks = (grp + 1 + 3) >> 2;
  for (int ch = 0; ch < nchunks; ++ch) {
    const int jc = ch * 64;
    bf16x8 bfr[4][2];
#pragma unroll
    for (int u = 0; u < 4; ++u) {
      const u16* kb = p.ki + (size_t)(tb + jc + 16 * u + kcol) * 64 + 8 * (lane >> 4);
      bfr[u][0] = *reinterpret_cast<const bf16x8*>(kb);
      bfr[u][1] = *reinterpret_cast<const bf16x8*>(kb + 32);
    }
    bool anyp = false;
    float sc[4]; bool ps[4];
#pragma unroll
    for (int u = 0; u < 4; ++u) {
      f32x4 acc = {0.f, 0.f, 0.f, 0.f};
      acc = __builtin_amdgcn_mfma_f32_16x16x32_bf16(afr[0], bfr[u][0], acc, 0, 0, 0);
      acc = __builtin_amdgcn_mfma_f32_16x16x32_bf16(afr[1], bfr[u][1], acc, 0, 0, 0);
      float s = 0.0f;
      s += w4.x * fmaxf(acc[0], 0.f);
      s += w4.y * fmaxf(acc[1], 0.f);
      s += w4.z * fmaxf(acc[2], 0.f);
      s += w4.w * fmaxf(acc[3], 0.f);
      s += 0.0f;
      int j = jc + 16 * u + kcol;
      sc[u] = s;
      ps[u] = (j <= iq) && (s >= thr);
      anyp |= ps[u];
    }
    if (__any(anyp)) {
#pragma unroll
      for (int u = 0; u < 4; ++u) {
        if (ps[u]) {
          int slot = atomicAdd((int*)&cnt[ql], 1);
          if (slot < CAP) { myval[slot] = __float_as_uint(sc[u]); myidx[slot] = (u16)(jc + 16 * u + kcol); }
        }
      }
      __builtin_amdgcn_wave_barrier();
      int c = cnt[ql];
      unsigned long long need = __ballot(c > CAP - 64);
      while (need) {
        int l = __ffsll((long long)need) - 1;
        int qc = l >> 4;
        need &= ~(0xFFFFull << (qc * 16));
        int qlc = wid * 4 + qc;
        int n = __builtin_amdgcn_readfirstlane(cnt[qlc]);
        if (n > CAP) n = CAP;
        u32* cv = cval + qlc * CAP; u16* ci = cidx + qlc * CAP;
        u32 key[12]; u16 idx[12];
#pragma unroll
        for (int k = 0; k < 12; ++k) {
          int e = lane + 64 * k;
          bool in = e < n;
          key[k] = in ? sortable(cv[e]) : 0u;
          idx[k] = in ? ci[e] : (u16)0;
        }
        u32 Tk; int krem;
        radix_select(key, 256, Tk, krem);
        int base = 0;
#pragma unroll
        for (int k = 0; k < 12; ++k) {
          bool keep = key[k] >= Tk && key[k] != 0u;
          unsigned long long m = __ballot(keep);
          int pos = base + mbcnt64(m);
          if (keep) { cv[pos] = unsortable(key[k]); ci[pos] = idx[k]; }
          base += __popcll(m);
        }
        __builtin_amdgcn_wave_barrier();
        if (lane == 0) cnt[qlc] = base;
        if (qsub == qc) thr = __uint_as_float(unsortable(Tk));
        __builtin_amdgcn_wave_barrier();
      }
    }
  }
  __builtin_amdgcn_wave_barrier();
  for (int qc = 0; qc < 4; ++qc) {
    int qlc = wid * 4 + qc;
    int n = __builtin_amdgcn_readfirstlane(cnt[qlc]);
    if (n > CAP) n = CAP;
    u32* cv = cval + qlc * CAP; u16* ci = cidx + qlc * CAP;
    u16* out = p.sel + (size_t)(tb + i0 + qlc) * 256;
    if (n <= 256) {
#pragma unroll
      for (int k = 0; k < 4; ++k) {
        int e = lane + 64 * k;
        out[e] = (e < n) ? ci[e] : (u16)0xFFFF;
      }
    } else {
      u32 key[12]; u16 idx[12];
#pragma unroll
      for (int k = 0; k < 12; ++k) {
        int e = lane + 64 * k;
        bool in = e < n;
        key[k] = in ? sortable(cv[e]) : 0u;
        idx[k] = in ? ci[e] : (u16)0;
      }
      u32 Tk; int krem;
      radix_select(key, 256, Tk, krem);
      u32 ik[12];
      int neq = 0;
#pragma unroll
      for (int k = 0; k < 12; ++k) {
        bool eq = key[k] == Tk;
        ik[k] = eq ? (0x10000u - (u32)idx[k]) : 0u;
        neq += __popcll(__ballot(eq));
      }
      u32 Jk = 0;
      if (krem < neq) { int kr2; radix_select(ik, krem, Jk, kr2); }
      int base = 0;
#pragma unroll
      for (int k = 0; k < 12; ++k) {
        bool keep = (key[k] > Tk) || (key[k] == Tk && ik[k] >= Jk);
        unsigned long long m = __ballot(keep);
        int pos = base + mbcnt64(m);
        if (keep && pos < 256) out[pos] = idx[k];
        base += __popcll(m);
      }
    }
  }
}

__device__ void phase_attn(const Params& p, char* smem) {
  const int tid = threadIdx.x, lane = tid & 63, wid = tid >> 6;
  u16* lidx = reinterpret_cast<u16*>(smem + wid * 4608);
  float* P = reinterpret_cast<float*>(smem + wid * 4608 + 512);
  const float scale = 0.08838834764831845f;
  for (int tq = blockIdx.x * 4 + wid; tq < T; tq += gridDim.x * 4) {
    const int b = tq / SEQ, i = tq - b * SEQ;
    const size_t tb = (size_t)b * SEQ;
    __builtin_amdgcn_wave_barrier();
    {
      uint2 v = *reinterpret_cast<const uint2*>(p.sel + (size_t)tq * 256 + lane * 4);
      *reinterpret_cast<uint2*>(lidx + lane * 4) = v;
    }
    __builtin_amdgcn_wave_barrier();
    bf16x8 qf[4];
    {
      int h = lane & 15;
#pragma unroll
      for (int s = 0; s < 4; ++s) {
        if (h < 4) qf[s] = *reinterpret_cast<const bf16x8*>(p.qh + (size_t)tq * 512 + h * 128 + 8 * (lane >> 4) + 32 * s);
        else qf[s] = (bf16x8){0, 0, 0, 0, 0, 0, 0, 0};
      }
    }
    float sv[16][4];
#pragma unroll
    for (int u = 0; u < 16; ++u) {
      int id = lidx[16 * u + (lane & 15)];
      bool valid = id <= i;
      int idc = valid ? id : 0;
      const u16* kr = p.kk + (tb + idc) * 128 + 8 * (lane >> 4);
      f32x4 acc = {0.f, 0.f, 0.f, 0.f};
#pragma unroll
      for (int s = 0; s < 4; ++s) {
        bf16x8 kf = *reinterpret_cast<const bf16x8*>(kr + 32 * s);
        acc = __builtin_amdgcn_mfma_f32_16x16x32_bf16(qf[s], kf, acc, 0, 0, 0);
      }
#pragma unroll
      for (int h = 0; h < 4; ++h) sv[u][h] = valid ? acc[h] * scale : -1e30f;
    }
    float mx[4], sm[4];
#pragma unroll
    for (int h = 0; h < 4; ++h) {
      float m = sv[0][h];
#pragma unroll
      for (int u = 1; u < 16; ++u) m = fmaxf(m, sv[u][h]);
#pragma unroll
      for (int d = 8; d >= 1; d >>= 1) m = fmaxf(m, __shfl_xor(m, d));
      mx[h] = m;
      float s = 0.f;
#pragma unroll
      for (int u = 0; u < 16; ++u) { sv[u][h] = __expf(sv[u][h] - m); s += sv[u][h]; }
#pragma unroll
      for (int d = 8; d >= 1; d >>= 1) s += __shfl_xor(s, d);
      sm[h] = 1.f / s;
    }
    if (lane < 16) {
#pragma unroll
      for (int u = 0; u < 16; ++u) {
        float4 o = {sv[u][0] * sm[0], sv[u][1] * sm[1], sv[u][2] * sm[2], sv[u][3] * sm[3]};
        *reinterpret_cast<float4*>(P + (16 * u + lane) * 4) = o;
      }
    }
    __builtin_amdgcn_wave_barrier();
    const int kg = lane >> 4, dc = lane & 15;
    float o[4][8];
#pragma unroll
    for (int h = 0; h < 4; ++h)
#pragma unroll
      for (int j = 0; j < 8; ++j) o[h][j] = 0.f;
#pragma unroll 4
    for (int it = 0; it < 64; ++it) {
      int n = it * 4 + kg;
      int id = lidx[n];
      int idc = (id <= i) ? id : 0;
      uint4 q = *reinterpret_cast<const uint4*>(p.vv + (tb + idc) * 128 + dc * 8);
      float4 pw = *reinterpret_cast<const float4*>(P + n * 4);
      float v[8] = {bf_lo(q.x), bf_hi(q.x), bf_lo(q.y), bf_hi(q.y), bf_lo(q.z), bf_hi(q.z), bf_lo(q.w), bf_hi(q.w)};
      float pv[4] = {pw.x, pw.y, pw.z, pw.w};
#pragma unroll
      for (int h = 0; h < 4; ++h)
#pragma unroll
        for (int j = 0; j < 8; ++j) o[h][j] += pv[h] * v[j];
    }
#pragma unroll
    for (int h = 0; h < 4; ++h)
#pragma unroll
      for (int j = 0; j < 8; ++j) {
        float x = o[h][j];
        x += __shfl_xor(x, 16);
        x += __shfl_xor(x, 32);
        o[h][j] = x;
      }
    if (kg == 0) {
#pragma unroll
      for (int h = 0; h < 4; ++h) {
        uint4 w = {pack_bf16(o[h][0], o[h][1]), pack_bf16(o[h][2], o[h][3]), pack_bf16(o[h][4], o[h][5]), pack_bf16(o[h][6], o[h][7])};
        *reinterpret_cast<uint4*>(p.yb + (size_t)tq * 512 + h * 128 + dc * 8) = w;
      }
    }
  }
}

__device__ void phase_merge(const Params& p, char* smem) {
  const int tid = threadIdx.x, lane = tid & 63, wid = tid >> 6;
  float* cs = reinterpret_cast<float*>(smem);
  constexpr int NTILES = (T / 128) * 8;
  for (int ti = blockIdx.x; ti < NTILES; ti += gridDim.x) {
    int mt = ti >> 3, nt = ti & 7;
    int m0 = mt * 128, n0 = nt * 128;
    f32x16 acc[2][2];
    zero_acc(acc);
    gemm_mainloop(p.ya + (size_t)m0 * 512, 512, p.WaT + (size_t)n0 * 512, 512, 512, acc, smem);
    stage_acc(acc, cs);
    __syncthreads();
#pragma unroll 4
    for (int rr = 0; rr < 32; ++rr) {
      int row = wid * 32 + rr;
      float2 v = *reinterpret_cast<const float2*>(cs + row * CS_LD + 2 * lane);
      u32 g = *reinterpret_cast<const u32*>(p.sg + (size_t)(m0 + row) * 2048 + n0 + 2 * lane);
      *reinterpret_cast<u32*>(p.merged + (size_t)(m0 + row) * 1024 + n0 + 2 * lane) = pack_bf16(v.x * bf_lo(g), v.y * bf_hi(g));
    }
    __syncthreads();
    zero_acc(acc);
    gemm_mainloop(p.yb + (size_t)m0 * 512, 512, p.WbT + (size_t)n0 * 512, 512, 512, acc, smem);
    stage_acc(acc, cs);
    __syncthreads();
#pragma unroll 4
    for (int rr = 0; rr < 32; ++rr) {
      int row = wid * 32 + rr;
      float2 v = *reinterpret_cast<const float2*>(cs + row * CS_LD + 2 * lane);
      u32 g = *reinterpret_cast<const u32*>(p.sg + (size_t)(m0 + row) * 2048 + 1024 + n0 + 2 * lane);
      u32* mp = reinterpret_cast<u32*>(p.merged + (size_t)(m0 + row) * 1024 + n0 + 2 * lane);
      u32 pa = *mp;
      *mp = pack_bf16(bf_lo(pa) + v.x * bf_lo(g), bf_hi(pa) + v.y * bf_hi(g));
    }
    __syncthreads();
  }
}

__device__ void phase_wo(const Params& p, char* smem) {
  const int tid = threadIdx.x, lane = tid & 63, wid = tid >> 6;
  float* cs = reinterpret_cast<float*>(smem);
  constexpr int NTILES = (T / 128) * 8;
  for (int ti = blockIdx.x; ti < NTILES; ti += gridDim.x) {
    int mt = ti >> 3, nt = ti & 7;
    int m0 = mt * 128, n0 = nt * 128;
    f32x16 acc[2][2];
    zero_acc(acc);
    gemm_mainloop(p.merged + (size_t)m0 * 1024, 1024, p.WoT + (size_t)n0 * 1024, 1024, 1024, acc, smem);
    stage_acc(acc, cs);
    __syncthreads();
    for (int rr = 0; rr < 32; ++rr) {
      int row = wid * 32 + rr;
      size_t t = m0 + row;
      float2 v = *reinterpret_cast<const float2*>(cs + row * CS_LD + 2 * lane);
      float2 xv = *reinterpret_cast<const float2*>(p.x + t * 1024 + n0 + 2 * lane);
      float h0 = xv.x + v.x, h1 = xv.y + v.y;
      *reinterpret_cast<float2*>(p.out + t * 1024 + n0 + 2 * lane) = make_float2(h0, h1);
      *reinterpret_cast<u32*>(p.h1b + t * 1024 + n0 + 2 * lane) = pack_bf16(h0, h1);
      float ss = wave_sum(h0 * h0 + h1 * h1);
      if (lane == 0) p.ssq[t * 8 + nt] = ss;
    }
    __syncthreads();
  }
}

__device__ __forceinline__ void ins16(float (&l)[16], float v) {
#pragma unroll
  for (int q = 15; q >= 1; --q) l[q] = __builtin_amdgcn_fmed3f(v, l[q - 1], l[q]);
  l[0] = fmaxf(l[0], v);
}
__device__ void phase_peerq(const Params& p, char* smem) {
  const int tid = threadIdx.x, lane = tid & 63, wid = tid >> 6;
  const int wr = wid >> 1, wc = wid & 1;
  float* cs = reinterpret_cast<float*>(smem);
  constexpr int NTILES = (T / 128) * 16;
  for (int ti = blockIdx.x; ti < NTILES; ti += gridDim.x) {
    int mt = ti >> 4, hp = ti & 15;
    int m0 = mt * 128;
    f32x16 acc[2][2];
    zero_acc(acc);
    gemm_mainloop(p.h1b + (size_t)m0 * 1024, 1024, p.WqT + (size_t)hp * 128 * 1024, 1024, 1024, acc, smem);
#pragma unroll
    for (int i = 0; i < 2; ++i)
#pragma unroll
      for (int j = 0; j < 2; ++j)
#pragma unroll
        for (int r = 0; r < 16; ++r) {
          int row = wr * 64 + i * 32 + (r & 3) + 8 * (r >> 2) + 4 * (lane >> 5);
          int col = wc * 64 + j * 32 + (lane & 31);
          *reinterpret_cast<u16*>(smem + (col >> 6) * ABUF + row * 144 + (col & 63) * 2) = f2bf(acc[i][j][r]);
        }
    {
      const u16* sk = p.SubK + (size_t)hp * 128 * 128;
#pragma unroll
      for (int i = 0; i < 8; ++i) {
        int c = tid + 256 * i;
        int row = c >> 4, kc = c & 15;
        uint4 q = *reinterpret_cast<const uint4*>(sk + row * 128 + kc * 8);
        *reinterpret_cast<uint4*>(smem + (2 + (kc >> 3)) * ABUF + row * 144 + (kc & 7) * 16) = q;
      }
    }
    __syncthreads();
    zero_acc(acc);
    mma_ktile(smem, smem + 2 * ABUF, acc);
    mma_ktile(smem + ABUF, smem + 3 * ABUF, acc);
    __syncthreads();
    stage_acc(acc, cs);
    __syncthreads();
    {
      int row = tid >> 1, half = tid & 1;
      float* rp = cs + row * CS_LD + half * 64;
      float l[16];
#pragma unroll
      for (int q = 0; q < 16; ++q) l[q] = -INFINITY;
      for (int c = 0; c < 64; c += 4) {
        float4 v4 = *reinterpret_cast<const float4*>(rp + c);
        float vv[4] = {v4.x, v4.y, v4.z, v4.w};
#pragma unroll
        for (int e = 0; e < 4; ++e) {
          u32 bits = __float_as_uint(vv[e]);
          u32 n = (u32)(half * 64 + c + e);
          bits = (bits & ~127u) | ((bits >> 31) ? n : (127u - n));
          ins16(l, __uint_as_float(bits));
        }
      }
#pragma unroll
      for (int q = 0; q < 16; ++q) rp[q] = l[q];
    }
    __syncthreads();
    if (tid < 128) {
      int row = tid;
      size_t t = (size_t)m0 + row;
      const float* la = cs + row * CS_LD;
      const float* lb = la + 64;
      float ssum = 0.f;
#pragma unroll
      for (int q = 0; q < 8; ++q) ssum += p.ssq[t * 8 + q];
      float rt = rsqrtf(ssum * (1.f / 1024.f) + EPS);
      int ia = 0, ib = 0;
      float* ov = p.stv + (t * 16 + hp) * 16;
      u8* oi = p.sti + (t * 16 + hp) * 16;
      for (int q = 0; q < 16; ++q) {
        float va = la[ia], vb = lb[ib];
        bool ta = va >= vb;
        float v = ta ? va : vb;
        ia += ta ? 1 : 0;
        ib += ta ? 0 : 1;
        u32 bits = __float_as_uint(v);
        u32 low = bits & 127u;
        u32 n = (bits >> 31) ? low : (127u - low);
        ov[q] = __uint_as_float(bits & ~127u) * rt;
        oi[q] = (u8)n;
      }
    }
    __syncthreads();
  }
}

__device__ void phase_peer(const Params& p, char* smem) {
  const int tid = threadIdx.x, lane = tid & 63, wid = tid >> 6;
  int* pe_e = reinterpret_cast<int*>(smem + wid * 1024);
  float* pe_g = reinterpret_cast<float*>(smem + wid * 1024 + 512);
  for (int tq = blockIdx.x * 4 + wid; tq < T; tq += gridDim.x * 4) {
    const size_t t = tq;
    const int h = lane >> 3, g = lane & 7;
    const float* s1 = p.stv + (t * 16 + 2 * h) * 16;
    const float* s2 = s1 + 16;
    float l[16];
#pragma unroll
    for (int q = 0; q < 16; ++q) l[q] = -INFINITY;
#pragma unroll
    for (int c = 0; c < 7; ++c) {
      u32 pr = PAIR_TAB[g * 7 + c];
      float v = -INFINITY;
      if (pr != 0xffu) {
        float a = s1[pr >> 4] + s2[pr & 15];
        u32 bits = __float_as_uint(a);
        bits = (bits & ~255u) | ((bits >> 31) ? pr : (255u - pr));
        v = __uint_as_float(bits);
      }
      ins16(l, v);
    }
#pragma unroll
    for (int msk = 1; msk <= 4; msk <<= 1) {
      float c[16];
#pragma unroll
      for (int q = 0; q < 16; ++q) c[q] = __shfl_xor(l[15 - q], msk);
#pragma unroll
      for (int q = 0; q < 16; ++q) c[q] = fmaxf(l[q], c[q]);
#pragma unroll
      for (int st = 8; st >= 1; st >>= 1)
#pragma unroll
        for (int q = 0; q < 16; ++q)
          if ((q & st) == 0) {
            float hi = fmaxf(c[q], c[q + st]), lo = fminf(c[q], c[q + st]);
            c[q] = hi; c[q + st] = lo;
          }
#pragma unroll
      for (int q = 0; q < 16; ++q) l[q] = c[q];
    }
    {
      float bv[16]; int pr[16];
      float m = -INFINITY;
#pragma unroll
      for (int q = 0; q < 16; ++q) {
        u32 bits = __float_as_uint(l[q]);
        u32 low = bits & 255u;
        pr[q] = (int)((bits >> 31) ? low : (255u - low));
        bv[q] = s1[pr[q] >> 4] + s2[pr[q] & 15];
        m = fmaxf(m, bv[q]);
      }
      float ssum = 0.f;
#pragma unroll
      for (int q = 0; q < 16; ++q) { bv[q] = __expf(bv[q] - m); ssum += bv[q]; }
      float inv = 1.f / ssum;
      const u8* i1 = p.sti + (t * 16 + 2 * h) * 16;
      const u8* i2 = i1 + 16;
      __builtin_amdgcn_wave_barrier();
#pragma unroll
      for (int q = 0; q < 16; ++q) {
        if ((q >> 1) == g) {
          pe_e[h * 16 + q] = (int)i1[pr[q] >> 4] * 128 + (int)i2[pr[q] & 15];
          pe_g[h * 16 + q] = bv[q] * inv;
        }
      }
      __builtin_amdgcn_wave_barrier();
    }
    float rt;
    {
      float ssum = 0.f;
#pragma unroll
      for (int q = 0; q < 8; ++q) ssum += p.ssq[t * 8 + q];
      rt = rsqrtf(ssum * (1.f / 1024.f) + EPS);
    }
    uint4 hx0 = *reinterpret_cast<const uint4*>(p.h1b + t * 1024 + lane * 8);
    uint4 hx1 = *reinterpret_cast<const uint4*>(p.h1b + t * 1024 + 512 + lane * 8);
    u32 hw[8] = {hx0.x, hx0.y, hx0.z, hx0.w, hx1.x, hx1.y, hx1.z, hx1.w};
    float y[16];
#pragma unroll
    for (int q = 0; q < 16; ++q) y[q] = 0.f;
    for (int e0 = 0; e0 < 128; e0 += 4) {
      uint4 ur[4][2], vr[4][2];
      float gt[4];
#pragma unroll
      for (int k = 0; k < 4; ++k) {
        int ex = pe_e[e0 + k];
        gt[k] = pe_g[e0 + k];
        const u16* up = p.Ub + (size_t)ex * 1024 + lane * 8;
        const u16* vp = p.Vb + (size_t)ex * 1024 + lane * 8;
        ur[k][0] = *reinterpret_cast<const uint4*>(up);
        ur[k][1] = *reinterpret_cast<const uint4*>(up + 512);
        vr[k][0] = *reinterpret_cast<const uint4*>(vp);
        vr[k][1] = *reinterpret_cast<const uint4*>(vp + 512);
      }
#pragma unroll
      for (int k = 0; k < 4; ++k) {
        u32 uw[8] = {ur[k][0].x, ur[k][0].y, ur[k][0].z, ur[k][0].w, ur[k][1].x, ur[k][1].y, ur[k][1].z, ur[k][1].w};
        float d = 0.f;
#pragma unroll
        for (int q = 0; q < 8; ++q)
          d = __builtin_amdgcn_fdot2_f32_bf16(__builtin_bit_cast(bf16x2_t, uw[q]), __builtin_bit_cast(bf16x2_t, hw[q]), d, false);
        d = wave_sum(d);
        float c = gt[k] * gelu_f(d * rt);
        u32 vw[8] = {vr[k][0].x, vr[k][0].y, vr[k][0].z, vr[k][0].w, vr[k][1].x, vr[k][1].y, vr[k][1].z, vr[k][1].w};
#pragma unroll
        for (int q = 0; q < 8; ++q) { y[2 * q] += c * bf_lo(vw[q]); y[2 * q + 1] += c * bf_hi(vw[q]); }
      }
    }
    float* op = p.out + t * 1024 + lane * 8;
#pragma unroll
    for (int hh = 0; hh < 2; ++hh) {
      float4 a = *reinterpret_cast<const float4*>(op + hh * 512);
      float4 b = *reinterpret_cast<const float4*>(op + hh * 512 + 4);
      a.x += y[hh * 8 + 0]; a.y += y[hh * 8 + 1]; a.z += y[hh * 8 + 2]; a.w += y[hh * 8 + 3];
      b.x += y[hh * 8 + 4]; b.y += y[hh * 8 + 5]; b.z += y[hh * 8 + 6]; b.w += y[hh * 8 + 7];
      *reinterpret_cast<float4*>(op + hh * 512) = a;
      *reinterpret_cast<float4*>(op + hh * 512 + 4) = b;
    }
    __builtin_amdgcn_wave_barrier();
  }
}

__device__ void phase_mix(const Params& p, char* smem) {
  const int G = gridDim.x;
  for (int s0 = 0, r = 0; s0 < 2048; s0 += G, ++r) {
    int off = (r & 1) ? (G - 1 - (int)blockIdx.x) : (int)blockIdx.x;
    int s = s0 + off;
    if (s < 2048) {
      int grp = 1023 - (s >> 1), b = s & 1;
      unit_indexer(p, smem, (b << 10) | grp);
    }
  }
  for (int u = blockIdx.x; u < 1024; u += G) unit_spatial(p, smem, u);
  for (int u = blockIdx.x; u < 256; u += G) unit_kv(p, smem, u);
}

template <int PH>
__device__ __forceinline__ void run_phase(const Params& p, char* smem) {
  if (PH == 0) phase_prep(p, smem);
  else if (PH == 1) phase_gemm1(p, smem);
  else if (PH == 2) phase_mix(p, smem);
  else if (PH == 3) phase_attn(p, smem);
  else if (PH == 4) phase_merge(p, smem);
  else if (PH == 5) phase_wo(p, smem);
  else if (PH == 6) phase_peerq(p, smem);
  else phase_peer(p, smem);
}

template <int PH>
__global__ void __launch_bounds__(NTHREADS, 2) phase_kernel(Params p) {
  __shared__ __attribute__((aligned(16))) char smem[SMEM_BYTES];
  run_phase<PH>(p, smem);
}

__global__ void __launch_bounds__(NTHREADS, 2) mega_kernel(Params p) {
  __shared__ __attribute__((aligned(16))) char smem[SMEM_BYTES];
  cg::grid_group grid = cg::this_grid();
  run_phase<0>(p, smem); grid.sync();
  run_phase<1>(p, smem); grid.sync();
  run_phase<2>(p, smem); grid.sync();
  run_phase<3>(p, smem); grid.sync();
  run_phase<4>(p, smem); grid.sync();
  run_phase<5>(p, smem); grid.sync();
  run_phase<6>(p, smem); grid.sync();
  run_phase<7>(p, smem);
}

extern "C" void kernel_launch(void* const* d_in, const int* in_sizes, int n_in, void* d_out, int out_size,
                              void* d_ws, size_t ws_size, hipStream_t stream) {
  Params p{};
  p.x = (const float*)d_in[0]; p.pos = (const int*)d_in[1];
  p.norm1_g = (const float*)d_in[2]; p.w_in = (const float*)d_in[3]; p.v_norm_g = (const float*)d_in[4];
  p.v_norm_b = (const float*)d_in[5]; p.spatial_w = (const float*)d_in[6]; p.spatial_b = (const float*)d_in[7];
  p.kv_norm_g = (const float*)d_in[8]; p.w_uk = (const float*)d_in[9]; p.w_uv = (const float*)d_in[10];
  p.q_norm_g = (const float*)d_in[11]; p.k_norm_g = (const float*)d_in[12]; p.w_a_out = (const float*)d_in[13];
  p.w_b_out = (const float*)d_in[14]; p.w_o = (const float*)d_in[15]; p.norm2_g = (const float*)d_in[16];
  p.peer_wq = (const float*)d_in[17]; p.peer_subkeys = (const float*)d_in[18]; p.peer_u = (const float*)d_in[19];
  p.peer_v = (const float*)d_in[20];
  p.out = (float*)d_out;
  char* w = (char*)d_ws;
  size_t off = 0;
  auto take = [&](size_t bytes) { char* r = w + off; off += (bytes + 255) & ~(size_t)255; return r; };
  const size_t MB = 1u << 20;
  char* r_xn = take(64 * MB);
  p.xn = (u16*)r_xn; p.ya = (u16*)r_xn; p.yb = (u16*)(r_xn + 32 * MB);
  p.WinT = (u16*)take((size_t)NWIN * 1024 * 2);
  p.WaT = (u16*)take(1024 * 512 * 2); p.WbT = (u16*)take(1024 * 512 * 2);
  p.WoT = (u16*)take(1024 * 1024 * 2); p.WqT = (u16*)take(2048 * 1024 * 2);
  p.WkvT = (u16*)take(256 * 256 * 2); p.SubK = (u16*)take(262144 * 2); p.Wtril = (u16*)take(65536 * 2);
  p.Ub = (u16*)take(32 * MB); p.Vb = (u16*)take(32 * MB);
  char* r_g = take(96 * MB);
  p.gu = (u16*)r_g; p.gv = (u16*)(r_g + 32 * MB); p.qh = (u16*)(r_g + 64 * MB); p.merged = (u16*)r_g;
  p.ckv = (u16*)take(16 * MB); p.qi = (u16*)take(16 * MB); p.ki = (u16*)take(4 * MB);
  p.wi = (float*)take((size_t)T * 4 * 4);
  char* r_sg = take(128 * MB);
  p.sg = (u16*)r_sg; p.h1b = (u16*)r_sg; p.stv = (float*)(r_sg + 64 * MB); p.sti = (u8*)(r_sg + 96 * MB);
  p.kk = (u16*)take(8 * MB); p.vv = (u16*)take(8 * MB); p.sel = (u16*)take(16 * MB);
  p.ssq = (float*)take((size_t)T * 8 * 4);
  if (off > ws_size) { fprintf(stderr, "workspace too small: need %zu have %zu\n", off, ws_size); return; }

  static int grid_blocks = 0;
  if (!grid_blocks) {
    int dev = 0, cus = 0, per_cu = 0;
    hipGetDevice(&dev);
    hipDeviceGetAttribute(&cus, hipDeviceAttributeMultiprocessorCount, dev);
    hipOccupancyMaxActiveBlocksPerMultiprocessor(&per_cu, mega_kernel, NTHREADS, 0);
    if (per_cu > 2) per_cu = 2;
    if (per_cu < 1) per_cu = 1;
    grid_blocks = cus * per_cu;
  }
#if MULTI_LAUNCH
  dim3 g(grid_blocks), b(NTHREADS);
  phase_kernel<0><<<g, b, 0, stream>>>(p);
  phase_kernel<1><<<g, b, 0, stream>>>(p);
  phase_kernel<2><<<g, b, 0, stream>>>(p);
  phase_kernel<3><<<g, b, 0, stream>>>(p);
  phase_kernel<4><<<g, b, 0, stream>>>(p);
  phase_kernel<5><<<g, b, 0, stream>>>(p);
  phase_kernel<6><<<g, b, 0, stream>>>(p);
  phase_kernel<7><<<g, b, 0, stream>>>(p);
#else
  void* args[] = {&p};
  hipError_t e = hipLaunchCooperativeKernel((void*)mega_kernel, dim3(grid_blocks), dim3(NTHREADS), args, 0, stream);
  if (e != hipSuccess) fprintf(stderr, "cooperative launch failed: %s (grid %d)\n", hipGetErrorString(e), grid_blocks);
#endif
}
```

```cpp
#include <hip/hip_runtime.h>
#include <hip/hip_cooperative_groups.h>
#include <stdint.h>
#include <cstdio>
namespace cg = cooperative_groups;

#ifndef MULTI_LAUNCH
#define MULTI_LAUNCH 0
#endif

typedef unsigned short u16;
typedef unsigned int u32;
typedef unsigned char u8;
using bf16x8 = __attribute__((ext_vector_type(8))) short;
using f32x4 = __attribute__((ext_vector_type(4))) float;
using f32x16 = __attribute__((ext_vector_type(16))) float;
typedef __bf16 bf16x2_t __attribute__((ext_vector_type(2)));
typedef float float2_t __attribute__((ext_vector_type(2)));

constexpr int BATCH = 2, SEQ = 16384, DM = 1024, T = BATCH * SEQ;
constexpr int NWIN = 4224;
constexpr int NTHREADS = 256;
constexpr float EPS = 1e-6f;
constexpr int ABUF = 128 * 144;
constexpr int CS_LD = 132;
constexpr int SMEM_BYTES = 77824;
constexpr int EXTRA_OFF = 4 * ABUF;
constexpr int CAP = 768;

__constant__ float INV32[16] = {1.000000000e+00f, 4.403665960e-01f, 1.939227432e-01f, 8.539710194e-02f, 3.760603070e-02f, 1.656043902e-02f, 7.292664610e-03f, 3.211445874e-03f, 1.414213562e-03f, 6.227723788e-04f, 2.742481884e-04f, 1.207697351e-04f, 5.318296098e-05f, 2.341999971e-05f, 1.031338616e-05f, 4.541670478e-06f};
__constant__ float INV16[8] = {1.000000000e+00f, 1.939227432e-01f, 3.760603070e-02f, 7.292664610e-03f, 1.414213562e-03f, 2.742481884e-04f, 5.318296098e-05f, 1.031338616e-05f};
__constant__ u8 PAIR_TAB[56] = {
  0x00,0x01,0x02,0x03,0x04,0x05,0x06,0x07,0x08,0x09,0x0a,0x0b,0x0c,0x0d,0x0e,0x0f,
  0x10,0x11,0x12,0x13,0x14,0x15,0x16,0x17,
  0x20,0x21,0x22,0x23,0x24,
  0x30,0x31,0x32,0x33,
  0x40,0x41,0x42,
  0x50,0x51,
  0x60,0x61,
  0x70,0x71,
  0x80,0x90,0xa0,0xb0,0xc0,0xd0,0xe0,0xf0,
  0xff,0xff,0xff,0xff,0xff,0xff};

struct Params {
  const float* x; const int* pos;
  const float *norm1_g, *w_in, *v_norm_g, *v_norm_b, *spatial_w, *spatial_b, *kv_norm_g, *w_uk, *w_uv,
      *q_norm_g, *k_norm_g, *w_a_out, *w_b_out, *w_o, *norm2_g, *peer_wq, *peer_subkeys, *peer_u, *peer_v;
  float* out;
  u16 *xn, *WinT, *WaT, *WbT, *WoT, *WqT, *WkvT, *SubK, *Wtril, *Ub, *Vb;
  u16 *gu, *gv, *qh, *ckv, *qi, *ki, *sg, *kk, *vv, *ya, *yb, *merged, *h1b, *sel;
  float *wi, *ssq, *stv;
  u8* sti;
};

__device__ __forceinline__ u32 pack_bf16(float a, float b) {
  float2_t v = {a, b};
  bf16x2_t r = __builtin_convertvector(v, bf16x2_t);
  return __builtin_bit_cast(u32, r);
}
__device__ __forceinline__ u16 f2bf(float a) { return (u16)(pack_bf16(a, 0.f) & 0xffffu); }
__device__ __forceinline__ float bf_lo(u32 u) { return __uint_as_float(u << 16); }
__device__ __forceinline__ float bf_hi(u32 u) { return __uint_as_float(u & 0xffff0000u); }
__device__ __forceinline__ float bf2f(u16 h) { return __uint_as_float(((u32)h) << 16); }
__device__ __forceinline__ float wave_sum(float v) {
#pragma unroll
  for (int m = 32; m >= 1; m >>= 1) v += __shfl_xor(v, m);
  return v;
}
__device__ __forceinline__ float gelu_f(float x) {
  float z = 1.5957691216057308f * (x + 0.044715f * x * x * x);
  return x / (1.f + __expf(-z));
}
__device__ __forceinline__ float sigmoid_f(float x) { return 1.f / (1.f + __expf(-x)); }
__device__ __forceinline__ u32 sortable(u32 b) { return b ^ ((u32)((int)b >> 31) | 0x80000000u); }
__device__ __forceinline__ u32 unsortable(u32 k) { return k ^ ((k & 0x80000000u) ? 0x80000000u : 0xffffffffu); }
__device__ __forceinline__ int mbcnt64(unsigned long long m) {
  return __builtin_amdgcn_mbcnt_hi((u32)(m >> 32), __builtin_amdgcn_mbcnt_lo((u32)m, 0));
}

typedef u32 u32x4 __attribute__((ext_vector_type(4)));
struct Tile4 { u32x4 v0, v1, v2, v3; };
__device__ __forceinline__ void gemm_load_tile(const u16* __restrict__ g, int ld, int k0, Tile4& r) {
  const int tid = threadIdx.x;
  const int row = tid >> 3, kc = tid & 7;
  const u16* base = g + (size_t)row * ld + k0 + kc * 8;
  r.v0 = *reinterpret_cast<const u32x4*>(base);
  r.v1 = *reinterpret_cast<const u32x4*>(base + (size_t)32 * ld);
  r.v2 = *reinterpret_cast<const u32x4*>(base + (size_t)64 * ld);
  r.v3 = *reinterpret_cast<const u32x4*>(base + (size_t)96 * ld);
}
__device__ __forceinline__ void gemm_store_tile(char* buf, const Tile4& r) {
  const int tid = threadIdx.x;
  const int row = tid >> 3, kc = tid & 7;
  char* base = buf + row * 144 + kc * 16;
  *reinterpret_cast<u32x4*>(base) = r.v0;
  *reinterpret_cast<u32x4*>(base + 32 * 144) = r.v1;
  *reinterpret_cast<u32x4*>(base + 64 * 144) = r.v2;
  *reinterpret_cast<u32x4*>(base + 96 * 144) = r.v3;
}
__device__ __forceinline__ void mma_ktile(const char* sa, const char* sb, f32x16 (&acc)[2][2]) {
  const int lane = threadIdx.x & 63, wid = threadIdx.x >> 6;
  const int wr = wid >> 1, wc = wid & 1;
  const int r32 = lane & 31, hf = lane >> 5;
#pragma unroll
  for (int s = 0; s < 4; ++s) {
    bf16x8 a[2], b[2];
#pragma unroll
    for (int i = 0; i < 2; ++i) {
      a[i] = *reinterpret_cast<const bf16x8*>(sa + (wr * 64 + i * 32 + r32) * 144 + s * 32 + hf * 16);
      b[i] = *reinterpret_cast<const bf16x8*>(sb + (wc * 64 + i * 32 + r32) * 144 + s * 32 + hf * 16);
    }
#pragma unroll
    for (int i = 0; i < 2; ++i)
#pragma unroll
      for (int j = 0; j < 2; ++j)
        acc[i][j] = __builtin_amdgcn_mfma_f32_32x32x16_bf16(a[i], b[j], acc[i][j], 0, 0, 0);
  }
}
__device__ __forceinline__ void gemm_mainloop(const u16* __restrict__ A, int lda, const u16* __restrict__ B, int ldb,
                                              int K, f32x16 (&acc)[2][2], char* smem) {
  Tile4 ra, rb;
  const int nk = K >> 6;
  gemm_load_tile(A, lda, 0, ra);
  gemm_load_tile(B, ldb, 0, rb);
  __syncthreads();
  gemm_store_tile(smem, ra);
  gemm_store_tile(smem + 2 * ABUF, rb);
  __syncthreads();
#pragma unroll 1
  for (int kt = 0; kt < nk; ++kt) {
    const int cur = kt & 1;
    if (kt + 1 < nk) {
      gemm_load_tile(A, lda, (kt + 1) << 6, ra);
      gemm_load_tile(B, ldb, (kt + 1) << 6, rb);
    }
    mma_ktile(smem + cur * ABUF, smem + (2 + cur) * ABUF, acc);
    if (kt + 1 < nk) {
      gemm_store_tile(smem + (cur ^ 1) * ABUF, ra);
      gemm_store_tile(smem + (2 + (cur ^ 1)) * ABUF, rb);
    }
    __syncthreads();
  }
}
__device__ __forceinline__ void zero_acc(f32x16 (&acc)[2][2]) {
#pragma unroll
  for (int i = 0; i < 2; ++i)
#pragma unroll
    for (int j = 0; j < 2; ++j)
#pragma unroll
      for (int r = 0; r < 16; ++r) acc[i][j][r] = 0.f;
}
__device__ __forceinline__ void stage_acc(const f32x16 (&acc)[2][2], float* cs) {
  const int lane = threadIdx.x & 63, wid = threadIdx.x >> 6;
  const int wr = wid >> 1, wc = wid & 1;
#pragma unroll
  for (int i = 0; i < 2; ++i)
#pragma unroll
    for (int j = 0; j < 2; ++j)
#pragma unroll
      for (int r = 0; r < 16; ++r) {
        int row = wr * 64 + i * 32 + (r & 3) + 8 * (r >> 2) + 4 * (lane >> 5);
        int col = wc * 64 + j * 32 + (lane & 31);
        cs[row * CS_LD + col] = acc[i][j][r];
      }
}

__device__ __forceinline__ int win_srccol(int n) {
  if (n < 2116) return n;
  if (n < 2176) return -1;
  return n - 60;
}
__device__ void phase_prep(const Params& p, char* smem) {
  const int tid = threadIdx.x, lane = tid & 63, wid = tid >> 6;
  for (int rb = blockIdx.x; rb < T / 4; rb += gridDim.x) {
    int row = rb * 4 + wid;
    const float* xr = p.x + (size_t)row * DM;
    float4 v[4];
    float ss = 0.f;
#pragma unroll
    for (int i = 0; i < 4; ++i) {
      v[i] = *reinterpret_cast<const float4*>(xr + lane * 4 + 256 * i);
      ss += v[i].x * v[i].x + v[i].y * v[i].y + v[i].z * v[i].z + v[i].w * v[i].w;
    }
    ss = wave_sum(ss);
    float r = rsqrtf(ss * (1.f / DM) + EPS);
#pragma unroll
    for (int i = 0; i < 4; ++i) {
      float4 g = *reinterpret_cast<const float4*>(p.norm1_g + lane * 4 + 256 * i);
      uint2 o;
      o.x = pack_bf16(v[i].x * r * g.x, v[i].y * r * g.y);
      o.y = pack_bf16(v[i].z * r * g.z, v[i].w * r * g.w);
      *reinterpret_cast<uint2*>(p.xn + (size_t)row * DM + lane * 4 + 256 * i) = o;
    }
  }
  float* tile = reinterpret_cast<float*>(smem);
  constexpr int NT_TOTAL = 1056 + 128 + 128 + 256 + 512 + 8 + 8;
  for (int ti = blockIdx.x; ti < NT_TOTAL; ti += gridDim.x) {
    const float* src; const float* scale = nullptr; u16* dst; int ldsrc, K, nn, mode = 0; int t = ti;
    if (t < 1056) { src = p.w_in; ldsrc = 4164; K = 1024; nn = 66; dst = p.WinT; mode = 1; }
    else if ((t -= 1056) < 128) { src = p.w_a_out; ldsrc = 1024; K = 512; nn = 16; dst = p.WaT; }
    else if ((t -= 128) < 128) { src = p.w_b_out; ldsrc = 1024; K = 512; nn = 16; dst = p.WbT; }
    else if ((t -= 128) < 256) { src = p.w_o; ldsrc = 1024; K = 1024; nn = 16; dst = p.WoT; }
    else if ((t -= 256) < 512) { src = p.peer_wq; ldsrc = 2048; K = 1024; nn = 32; dst = p.WqT; scale = p.norm2_g; }
    else if ((t -= 512) < 8) { src = p.w_uk; ldsrc = 128; K = 256; nn = 2; dst = p.WkvT; scale = p.kv_norm_g; }
    else { t -= 8; src = p.w_uv; ldsrc = 128; K = 256; nn = 2; dst = p.WkvT + 128 * 256; scale = p.kv_norm_g; }
    int n0 = (t % nn) * 64, k0 = (t / nn) * 64;
    __syncthreads();
    {
      int n = tid & 63;
      int sc = (mode == 1) ? win_srccol(n0 + n) : (n0 + n);
      for (int kk = tid >> 6; kk < 64; kk += 4) {
        float v = 0.f;
        if (sc >= 0) v = src[(size_t)(k0 + kk) * ldsrc + sc];
        if (scale) v *= scale[k0 + kk];
        tile[kk * 65 + n] = v;
      }
    }
    __syncthreads();
    {
      int k = (tid & 31) * 2;
      for (int n = tid >> 5; n < 64; n += 8) {
        u32 o = pack_bf16(tile[k * 65 + n], tile[(k + 1) * 65 + n]);
        *reinterpret_cast<u32*>(dst + (size_t)(n0 + n) * K + k0 + k) = o;
      }
    }
  }
  constexpr int G_SUB = 262144 / 4, G_SW = 65536 / 4, G_U = 16384 * 1024 / 4;
  constexpr int G_TOTAL = G_SUB + G_SW + 2 * G_U;
  for (int gi = blockIdx.x * NTHREADS + tid; gi < G_TOTAL; gi += gridDim.x * NTHREADS) {
    int g = gi;
    if (g < G_SUB) {
      float4 v = *reinterpret_cast<const float4*>(p.peer_subkeys + (size_t)g * 4);
      uint2 o = {pack_bf16(v.x, v.y), pack_bf16(v.z, v.w)};
      *reinterpret_cast<uint2*>(p.SubK + (size_t)g * 4) = o;
    } else if ((g -= G_SUB) < G_SW) {
      float4 v = *reinterpret_cast<const float4*>(p.spatial_w + (size_t)g * 4);
      int e = g * 4; int s = e & 127, tt = (e >> 7) & 127;
      if (s > tt) v.x = 0.f;
      if (s + 1 > tt) v.y = 0.f;
      if (s + 2 > tt) v.z = 0.f;
      if (s + 3 > tt) v.w = 0.f;
      uint2 o = {pack_bf16(v.x, v.y), pack_bf16(v.z, v.w)};
      *reinterpret_cast<uint2*>(p.Wtril + (size_t)g * 4) = o;
    } else if ((g -= G_SW) < G_U) {
      float4 v = *reinterpret_cast<const float4*>(p.peer_u + (size_t)g * 4);
      float4 s = *reinterpret_cast<const float4*>(p.norm2_g + ((g * 4) & 1023));
      uint2 o = {pack_bf16(v.x * s.x, v.y * s.y), pack_bf16(v.z * s.z, v.w * s.w)};
      *reinterpret_cast<uint2*>(p.Ub + (size_t)g * 4) = o;
    } else {
      g -= G_U;
      float4 v = *reinterpret_cast<const float4*>(p.peer_v + (size_t)g * 4);
      uint2 o = {pack_bf16(v.x, v.y), pack_bf16(v.z, v.w)};
      *reinterpret_cast<uint2*>(p.Vb + (size_t)g * 4) = o;
    }
  }
}

__device__ __forceinline__ void rope_pair(float& y0, float& y1, int lc, int half, int xm, float posf, const float* inv) {
  float p0 = __shfl_xor(y0, xm), p1 = __shfl_xor(y1, xm);
  if (lc < 2 * half) {
    int j = lc & (half - 1);
    float a0 = posf * inv[j], a1 = posf * inv[j + 1];
    float s0, c0, s1, c1;
    sincosf(a0, &s0, &c0);
    sincosf(a1, &s1, &c1);
    if (lc < half) { y0 = y0 * c0 - p0 * s0; y1 = y1 * c1 - p1 * s1; }
    else { y0 = y0 * c0 + p0 * s0; y1 = y1 * c1 + p1 * s1; }
  }
}

__device__ void phase_gemm1(const Params& p, char* smem) {
  const int tid = threadIdx.x, lane = tid & 63, wid = tid >> 6;
  float* cs = reinterpret_cast<float*>(smem);
  constexpr int NTN = NWIN / 128;
  constexpr int NTILES = (T / 128) * NTN;
  for (int ti = blockIdx.x; ti < NTILES; ti += gridDim.x) {
    int mt = ti / NTN, nt = ti % NTN;
    int m0 = mt * 128;
    f32x16 acc[2][2];
    zero_acc(acc);
    gemm_mainloop(p.xn + (size_t)m0 * DM, DM, p.WinT + (size_t)nt * 128 * DM, DM, DM, acc, smem);
    stage_acc(acc, cs);
    __syncthreads();
    const int c0 = 2 * lane;
    for (int rr = 0; rr < 32; ++rr) {
      int row = wid * 32 + rr;
      int t = m0 + row;
      float2 v = *reinterpret_cast<const float2*>(cs + row * CS_LD + c0);
      float v0 = v.x, v1 = v.y;
      if (nt < 4) {
        *reinterpret_cast<u32*>(p.gu + (size_t)t * 512 + nt * 128 + c0) = pack_bf16(gelu_f(v0), gelu_f(v1));
      } else if (nt < 8) {
        *reinterpret_cast<u32*>(p.gv + (size_t)t * 512 + (nt - 4) * 128 + c0) = pack_bf16(gelu_f(v0), gelu_f(v1));
      } else if (nt < 12) {
        float ss = wave_sum(v0 * v0 + v1 * v1);
        float r = rsqrtf(ss * (1.f / 128.f) + EPS);
        float y0 = v0 * r * p.q_norm_g[c0], y1 = v1 * r * p.q_norm_g[c0 + 1];
        float posf = (float)p.pos[t];
        rope_pair(y0, y1, c0, 16, 8, posf, INV32);
        *reinterpret_cast<u32*>(p.qh + (size_t)t * 512 + (nt - 8) * 128 + c0) = pack_bf16(y0, y1);
      } else if (nt < 14) {
        *reinterpret_cast<u32*>(p.ckv + (size_t)t * 256 + (nt - 12) * 128 + c0) = pack_bf16(v0, v1);
      } else if (nt < 16) {
        float posf = (float)p.pos[t];
        float y0 = v0, y1 = v1;
        rope_pair(y0, y1, c0 & 63, 8, 4, posf, INV16);
        *reinterpret_cast<u32*>(p.qi + (size_t)t * 256 + (nt - 14) * 128 + c0) = pack_bf16(y0, y1);
      } else if (nt == 16) {
        float posf = (float)p.pos[t];
        float y0 = v0, y1 = v1;
        rope_pair(y0, y1, c0 < 64 ? c0 : 64, 8, 4, posf, INV16);
        if (c0 < 64) *reinterpret_cast<u32*>(p.ki + (size_t)t * 64 + c0) = pack_bf16(y0, y1);
        else if (c0 < 68) { p.wi[(size_t)t * 4 + (c0 - 64)] = v0 * 0.0625f; p.wi[(size_t)t * 4 + (c0 - 63)] = v1 * 0.0625f; }
      } else {
        *reinterpret_cast<u32*>(p.sg + (size_t)t * 2048 + (nt - 17) * 128 + c0) = pack_bf16(sigmoid_f(v0), sigmoid_f(v1));
      }
    }
    __syncthreads();
  }
}

__device__ void unit_kv(const Params& p, char* smem, int mt) {
  const int tid = threadIdx.x, lane = tid & 63, wid = tid >> 6;
  float* cs = reinterpret_cast<float*>(smem);
  float* rr_s = reinterpret_cast<float*>(smem + EXTRA_OFF);
  const int m0 = mt * 128;
  __syncthreads();
  {
    int row = tid >> 1, half = tid & 1;
    const u16* src = p.ckv + (size_t)(m0 + row) * 256 + half * 128;
    float ss = 0.f;
#pragma unroll 4
    for (int i = 0; i < 16; ++i) {
      uint4 q = *reinterpret_cast<const uint4*>(src + i * 8);
      u32 w[4] = {q.x, q.y, q.z, q.w};
#pragma unroll
      for (int j = 0; j < 4; ++j) { float a = bf_lo(w[j]), b = bf_hi(w[j]); ss += a * a + b * b; }
    }
    ss += __shfl_xor(ss, 1);
    if (half == 0) rr_s[row] = rsqrtf(ss * (1.f / 256.f) + EPS);
  }
#pragma unroll 1
  for (int nt = 0; nt < 2; ++nt) {
    f32x16 acc[2][2];
    zero_acc(acc);
    gemm_mainloop(p.ckv + (size_t)m0 * 256, 256, p.WkvT + (size_t)nt * 128 * 256, 256, 256, acc, smem);
    stage_acc(acc, cs);
    __syncthreads();
    const int c0 = 2 * lane;
#pragma unroll 1
    for (int rr = 0; rr < 32; ++rr) {
      int row = wid * 32 + rr;
      int t = m0 + row;
      float2 v = *reinterpret_cast<const float2*>(cs + row * CS_LD + c0);
      float rs = rr_s[row];
      float v0 = v.x * rs, v1 = v.y * rs;
      if (nt == 0) {
        float ss = wave_sum(v0 * v0 + v1 * v1);
        float r = rsqrtf(ss * (1.f / 128.f) + EPS);
        float y0 = v0 * r * p.k_norm_g[c0], y1 = v1 * r * p.k_norm_g[c0 + 1];
        float posf = (float)p.pos[t];
        rope_pair(y0, y1, c0, 16, 8, posf, INV32);
        *reinterpret_cast<u32*>(p.kk + (size_t)t * 128 + c0) = pack_bf16(y0, y1);
      } else {
        *reinterpret_cast<u32*>(p.vv + (size_t)t * 128 + c0) = pack_bf16(v0, v1);
      }
    }
    __syncthreads();
  }
}

__device__ void unit_spatial(const Params& p, char* smem, int unit) {
  const int tid = threadIdx.x, lane = tid & 63, wid = tid >> 6;
  const int chunk = unit >> 2, g = unit & 3;
  const int t0 = chunk * 128;
  float* cs = reinterpret_cast<float*>(smem);
  float* mu_s = reinterpret_cast<float*>(smem + EXTRA_OFF);
  float* rs_s = mu_s + 128;
  __syncthreads();
  {
    int row = tid >> 1, half = tid & 1;
    const u16* src = p.gv + (size_t)(t0 + row) * 512 + half * 256;
    float s = 0.f, ss = 0.f;
#pragma unroll 4
    for (int i = 0; i < 32; ++i) {
      uint4 q = *reinterpret_cast<const uint4*>(src + i * 8);
      u32 w[4] = {q.x, q.y, q.z, q.w};
#pragma unroll
      for (int j = 0; j < 4; ++j) { float a = bf_lo(w[j]), b = bf_hi(w[j]); s += a + b; ss += a * a + b * b; }
    }
    s += __shfl_xor(s, 1);
    ss += __shfl_xor(ss, 1);
    float mean = s * (1.f / 512.f);
    float var = fmaxf(ss * (1.f / 512.f) - mean * mean, 0.f);
    if (half == 0) { mu_s[row] = mean; rs_s[row] = rsqrtf(var + EPS); }
  }
  {
    const u16* wsrc = p.Wtril + (size_t)g * 128 * 128;
#pragma unroll
    for (int i = 0; i < 8; ++i) {
      int c = tid + 256 * i;
      int row = c >> 4, kc = c & 15;
      uint4 q = *reinterpret_cast<const uint4*>(wsrc + row * 128 + kc * 8);
      *reinterpret_cast<uint4*>(smem + (kc >> 3) * ABUF + row * 144 + (kc & 7) * 16) = q;
    }
  }
  __syncthreads();
  {
    int s = tid & 127;
    float mu = mu_s[s], rs = rs_s[s];
    const u16* src = p.gv + (size_t)(t0 + s) * 512 + g * 128;
    char* bbase = smem + (2 + (s >> 6)) * ABUF + (s & 63) * 2;
#pragma unroll
    for (int i = 0; i < 8; ++i) {
      int d0 = ((tid >> 7) + 2 * i) * 8;
      uint4 q = *reinterpret_cast<const uint4*>(src + d0);
      u32 w[4] = {q.x, q.y, q.z, q.w};
#pragma unroll
      for (int j = 0; j < 4; ++j) {
        int d = d0 + 2 * j;
        float a = (bf_lo(w[j]) - mu) * rs * p.v_norm_g[g * 128 + d] + p.v_norm_b[g * 128 + d];
        float b = (bf_hi(w[j]) - mu) * rs * p.v_norm_g[g * 128 + d + 1] + p.v_norm_b[g * 128 + d + 1];
        *reinterpret_cast<u16*>(bbase + d * 144) = f2bf(a);
        *reinterpret_cast<u16*>(bbase + (d + 1) * 144) = f2bf(b);
      }
    }
  }
  __syncthreads();
  f32x16 acc[2][2];
  zero_acc(acc);
  mma_ktile(smem, smem + 2 * ABUF, acc);
  mma_ktile(smem + ABUF, smem + 3 * ABUF, acc);
  __syncthreads();
  stage_acc(acc, cs);
  __syncthreads();
  const int c0 = 2 * lane;
  for (int rr = 0; rr < 32; ++rr) {
    int row = wid * 32 + rr;
    int t = t0 + row;
    float2 v = *reinterpret_cast<const float2*>(cs + row * CS_LD + c0);
    float b = p.spatial_b[g * 128 + row];
    u32 uu = *reinterpret_cast<const u32*>(p.gu + (size_t)t * 512 + g * 128 + c0);
    *reinterpret_cast<u32*>(p.ya + (size_t)t * 512 + g * 128 + c0) = pack_bf16(bf_lo(uu) * (v.x + b), bf_hi(uu) * (v.y + b));
  }
}

__device__ __forceinline__ void radix_select(const u32 (&key)[12], int rank, u32& Tout, int& krem_out) {
  u32 prefix = 0;
  int krem = rank;
  for (int b = 31; b >= 0; --b) {
    u32 cand = prefix | (1u << b);
    u32 himask = ~((1u << b) - 1u);
    int c = 0;
#pragma unroll
    for (int k = 0; k < 12; ++k) c += __popcll(__ballot((key[k] & himask) == cand));
    if (c >= krem) prefix = cand; else krem -= c;
  }
  Tout = prefix;
  krem_out = krem;
}

__device__ __forceinline__ void idx_load_keys(const Params& p, int tb, int jc, int kcol, int lane, bf16x8 (&bf)[4][2]) {
#pragma unroll
  for (int u = 0; u < 4; ++u) {
    const u16* kb = p.ki + (size_t)(tb + jc + 16 * u + kcol) * 64 + 8 * (lane >> 4);
    bf[u][0] = *reinterpret_cast<const bf16x8*>(kb);
    bf[u][1] = *reinterpret_cast<const bf16x8*>(kb + 32);
  }
}
__device__ __forceinline__ void idx_compact(u32* cv, u16* ci, int n, int lane, int& newcnt, float& newthr) {
  u32 key[12]; u16 idx[12];
#pragma unroll
  for (int k = 0; k < 12; ++k) {
    int e = lane + 64 * k;
    bool in = e < n;
    key[k] = in ? sortable(cv[e]) : 0u;
    idx[k] = in ? ci[e] : (u16)0;
  }
  u32 Tk; int krem;
  radix_select(key, 256, Tk, krem);
  int base = 0, tcnt = 0;
#pragma unroll
  for (int k = 0; k < 12; ++k) {
    bool eq = key[k] == Tk;
    unsigned long long meq = __ballot(eq);
    bool keep = (key[k] > Tk) || (eq && (tcnt + mbcnt64(meq)) < krem);
    unsigned long long m = __ballot(keep);
    int pos = base + mbcnt64(m);
    if (keep) { cv[pos] = unsortable(key[k]); ci[pos] = idx[k]; }
    base += __popcll(m);
    tcnt += __popcll(meq);
  }
  newcnt = base;
  newthr = __uint_as_float(unsortable(Tk));
}

__device__ void unit_indexer(const Params& p, char* smem, int unit, int mode = 0) {
  const int tid = threadIdx.x, lane = tid & 63, wid = tid >> 6;
  const int b = unit >> 10, grp = unit & 1023;
  const int tb = b * SEQ, i0 = grp * 16;
  u32* cval = reinterpret_cast<u32*>(smem);
  u16* cidx = reinterpret_cast<u16*>(smem + 16 * CAP * 4);
  __syncthreads();
  const int qsub = lane >> 4;
  const int ql = wid * 4 + qsub;
  const int iq = i0 + ql;
  const int kcol = lane & 15;
  bf16x8 afr[2];
  {
    const u16* qa = p.qi + ((size_t)(tb + i0 + wid * 4 + (kcol >> 2)) * 4 + (kcol & 3)) * 64 + 8 * (lane >> 4);
    afr[0] = *reinterpret_cast<const bf16x8*>(qa);
    afr[1] = *reinterpret_cast<const bf16x8*>(qa + 32);
  }
  const float4 w4 = *reinterpret_cast<const float4*>(p.wi + (size_t)(tb + iq) * 4);
  float thr = (mode == 1) ? INFINITY : -INFINITY;
  int cntr = 0;
  u32* myval = cval + ql * CAP;
  u16* myidx = cidx + ql * CAP;
  const u32 lowmask = (1u << kcol) - 1u;
  const int nchunks = (grp + 1 + 3) >> 2;

  auto process = [&](const bf16x8 (&bf)[4][2], int jc) {
#pragma unroll
    for (int u = 0; u < 4; ++u) {
      f32x4 acc = {0.f, 0.f, 0.f, 0.f};
      acc = __builtin_amdgcn_mfma_f32_16x16x32_bf16(afr[0], bf[u][0], acc, 0, 0, 0);
      acc = __builtin_amdgcn_mfma_f32_16x16x32_bf16(afr[1], bf[u][1], acc, 0, 0, 0);
      float s = 0.0f;
      s += w4.x * fmaxf(acc[0], 0.f);
      s += w4.y * fmaxf(acc[1], 0.f);
      s += w4.z * fmaxf(acc[2], 0.f);
      s += w4.w * fmaxf(acc[3], 0.f);
      s += 0.0f;
      int j = jc + 16 * u + kcol;
      bool ps = (j <= iq) && (s > thr);
      unsigned long long m = __ballot(ps);
      if (m) {
        u32 g16 = (u32)(m >> (16 * qsub)) & 0xFFFFu;
        int slot = cntr + __popc(g16 & lowmask);
        if (ps && slot < CAP) { myval[slot] = __float_as_uint(s); myidx[slot] = (u16)j; }
        cntr += __popc(g16);
      }
    }
    unsigned long long need = __ballot(cntr > CAP - 64);
    while (need) {
      int l = __ffsll((long long)need) - 1;
      int qc = l >> 4;
      need &= ~(0xFFFFull << (qc * 16));
      int qlc = wid * 4 + qc;
      int n = __builtin_amdgcn_readlane(cntr, qc * 16);
      if (n > CAP) n = CAP;
      int nc; float nt;
      if (mode == 3) { nc = 0; nt = thr; }
      else {
        idx_compact(cval + qlc * CAP, cidx + qlc * CAP, n, lane, nc, nt);
        if (mode == 4) idx_compact(cval + qlc * CAP, cidx + qlc * CAP, nc, lane, nc, nt);
      }
      if (qsub == qc) { thr = nt; cntr = nc; }
    }
  };

  bf16x8 bA[4][2], bB[4][2];
  idx_load_keys(p, tb, 0, kcol, lane, bA);
  for (int ch = 0; ch < nchunks; ch += 2) {
    if (ch + 1 < nchunks) idx_load_keys(p, tb, (ch + 1) * 64, kcol, lane, bB);
    process(bA, ch * 64);
    if (ch + 1 < nchunks) {
      if (ch + 2 < nchunks) idx_load_keys(p, tb, (ch + 2) * 64, kcol, lane, bA);
      process(bB, (ch + 1) * 64);
    }
  }
  if (mode) return;
  for (int qc = 0; qc < 4; ++qc) {
    int qlc = wid * 4 + qc;
    int n = __builtin_amdgcn_readlane(cntr, qc * 16);
    if (n > CAP) n = CAP;
    u32* cv = cval + qlc * CAP; u16* ci = cidx + qlc * CAP;
    u16* out = p.sel + (size_t)(tb + i0 + qlc) * 256;
    if (n <= 256) {
#pragma unroll
      for (int k = 0; k < 4; ++k) {
        int e = lane + 64 * k;
        out[e] = (e < n) ? ci[e] : (u16)0xFFFF;
      }
    } else {
      u32 key[12]; u16 idx[12];
#pragma unroll
      for (int k = 0; k < 12; ++k) {
        int e = lane + 64 * k;
        bool in = e < n;
        key[k] = in ? sortable(cv[e]) : 0u;
        idx[k] = in ? ci[e] : (u16)0;
      }
      u32 Tk; int krem;
      radix_select(key, 256, Tk, krem);
      int base = 0, tcnt = 0;
#pragma unroll
      for (int k = 0; k < 12; ++k) {
        bool eq = key[k] == Tk;
        unsigned long long meq = __ballot(eq);
        bool keep = (key[k] > Tk) || (eq && (tcnt + mbcnt64(meq)) < krem);
        unsigned long long m = __ballot(keep);
        int pos = base + mbcnt64(m);
        if (keep && pos < 256) out[pos] = idx[k];
        base += __popcll(m);
        tcnt += __popcll(meq);
      }
    }
  }
}

__device__ void phase_attn(const Params& p, char* smem) {
  const int tid = threadIdx.x, lane = tid & 63, wid = tid >> 6;
  u16* lidx = reinterpret_cast<u16*>(smem + wid * 4608);
  float* P = reinterpret_cast<float*>(smem + wid * 4608 + 512);
  const float scale = 0.08838834764831845f;
  for (int tq = blockIdx.x * 4 + wid; tq < T; tq += gridDim.x * 4) {
    const int b = tq / SEQ, i = tq - b * SEQ;
    const size_t tb = (size_t)b * SEQ;
    __builtin_amdgcn_wave_barrier();
    {
      uint2 v = *reinterpret_cast<const uint2*>(p.sel + (size_t)tq * 256 + lane * 4);
      *reinterpret_cast<uint2*>(lidx + lane * 4) = v;
    }
    __builtin_amdgcn_wave_barrier();
    bf16x8 qf[4];
    {
      int h = lane & 15;
#pragma unroll
      for (int s = 0; s < 4; ++s) {
        if (h < 4) qf[s] = *reinterpret_cast<const bf16x8*>(p.qh + (size_t)tq * 512 + h * 128 + 8 * (lane >> 4) + 32 * s);
        else qf[s] = (bf16x8){0, 0, 0, 0, 0, 0, 0, 0};
      }
    }
    float sv[16][4];
#pragma unroll
    for (int u = 0; u < 16; ++u) {
      int id = lidx[16 * u + (lane & 15)];
      bool valid = id <= i;
      int idc = valid ? id : 0;
      const u16* kr = p.kk + (tb + idc) * 128 + 8 * (lane >> 4);
      f32x4 acc = {0.f, 0.f, 0.f, 0.f};
#pragma unroll
      for (int s = 0; s < 4; ++s) {
        bf16x8 kf = *reinterpret_cast<const bf16x8*>(kr + 32 * s);
        acc = __builtin_amdgcn_mfma_f32_16x16x32_bf16(qf[s], kf, acc, 0, 0, 0);
      }
#pragma unroll
      for (int h = 0; h < 4; ++h) sv[u][h] = valid ? acc[h] * scale : -1e30f;
    }
    float mx[4], sm[4];
#pragma unroll
    for (int h = 0; h < 4; ++h) {
      float m = sv[0][h];
#pragma unroll
      for (int u = 1; u < 16; ++u) m = fmaxf(m, sv[u][h]);
#pragma unroll
      for (int d = 8; d >= 1; d >>= 1) m = fmaxf(m, __shfl_xor(m, d));
      mx[h] = m;
      float s = 0.f;
#pragma unroll
      for (int u = 0; u < 16; ++u) { sv[u][h] = __expf(sv[u][h] - m); s += sv[u][h]; }
#pragma unroll
      for (int d = 8; d >= 1; d >>= 1) s += __shfl_xor(s, d);
      sm[h] = 1.f / s;
    }
    if (lane < 16) {
#pragma unroll
      for (int u = 0; u < 16; ++u) {
        float4 o = {sv[u][0] * sm[0], sv[u][1] * sm[1], sv[u][2] * sm[2], sv[u][3] * sm[3]};
        *reinterpret_cast<float4*>(P + (16 * u + lane) * 4) = o;
      }
    }
    __builtin_amdgcn_wave_barrier();
    const int kg = lane >> 4, dc = lane & 15;
    float o[4][8];
#pragma unroll
    for (int h = 0; h < 4; ++h)
#pragma unroll
      for (int j = 0; j < 8; ++j) o[h][j] = 0.f;
#pragma unroll 4
    for (int it = 0; it < 64; ++it) {
      int n = it * 4 + kg;
      int id = lidx[n];
      int idc = (id <= i) ? id : 0;
      uint4 q = *reinterpret_cast<const uint4*>(p.vv + (tb + idc) * 128 + dc * 8);
      float4 pw = *reinterpret_cast<const float4*>(P + n * 4);
      float v[8] = {bf_lo(q.x), bf_hi(q.x), bf_lo(q.y), bf_hi(q.y), bf_lo(q.z), bf_hi(q.z), bf_lo(q.w), bf_hi(q.w)};
      float pv[4] = {pw.x, pw.y, pw.z, pw.w};
#pragma unroll
      for (int h = 0; h < 4; ++h)
#pragma unroll
        for (int j = 0; j < 8; ++j) o[h][j] += pv[h] * v[j];
    }
#pragma unroll
    for (int h = 0; h < 4; ++h)
#pragma unroll
      for (int j = 0; j < 8; ++j) {
        float x = o[h][j];
        x += __shfl_xor(x, 16);
        x += __shfl_xor(x, 32);
        o[h][j] = x;
      }
    if (kg == 0) {
#pragma unroll
      for (int h = 0; h < 4; ++h) {
        uint4 w = {pack_bf16(o[h][0], o[h][1]), pack_bf16(o[h][2], o[h][3]), pack_bf16(o[h][4], o[h][5]), pack_bf16(o[h][6], o[h][7])};
        *reinterpret_cast<uint4*>(p.yb + (size_t)tq * 512 + h * 128 + dc * 8) = w;
      }
    }
  }
}

__device__ void phase_merge(const Params& p, char* smem) {
  const int tid = threadIdx.x, lane = tid & 63, wid = tid >> 6;
  float* cs = reinterpret_cast<float*>(smem);
  constexpr int NTILES = (T / 128) * 8;
  for (int ti = blockIdx.x; ti < NTILES; ti += gridDim.x) {
    int mt = ti >> 3, nt = ti & 7;
    int m0 = mt * 128, n0 = nt * 128;
    f32x16 acc[2][2];
    zero_acc(acc);
    gemm_mainloop(p.ya + (size_t)m0 * 512, 512, p.WaT + (size_t)n0 * 512, 512, 512, acc, smem);
    stage_acc(acc, cs);
    __syncthreads();
#pragma unroll 4
    for (int rr = 0; rr < 32; ++rr) {
      int row = wid * 32 + rr;
      float2 v = *reinterpret_cast<const float2*>(cs + row * CS_LD + 2 * lane);
      u32 g = *reinterpret_cast<const u32*>(p.sg + (size_t)(m0 + row) * 2048 + n0 + 2 * lane);
      *reinterpret_cast<u32*>(p.merged + (size_t)(m0 + row) * 1024 + n0 + 2 * lane) = pack_bf16(v.x * bf_lo(g), v.y * bf_hi(g));
    }
    __syncthreads();
    zero_acc(acc);
    gemm_mainloop(p.yb + (size_t)m0 * 512, 512, p.WbT + (size_t)n0 * 512, 512, 512, acc, smem);
    stage_acc(acc, cs);
    __syncthreads();
#pragma unroll 4
    for (int rr = 0; rr < 32; ++rr) {
      int row = wid * 32 + rr;
      float2 v = *reinterpret_cast<const float2*>(cs + row * CS_LD + 2 * lane);
      u32 g = *reinterpret_cast<const u32*>(p.sg + (size_t)(m0 + row) * 2048 + 1024 + n0 + 2 * lane);
      u32* mp = reinterpret_cast<u32*>(p.merged + (size_t)(m0 + row) * 1024 + n0 + 2 * lane);
      u32 pa = *mp;
      *mp = pack_bf16(bf_lo(pa) + v.x * bf_lo(g), bf_hi(pa) + v.y * bf_hi(g));
    }
    __syncthreads();
  }
}

__device__ void phase_wo(const Params& p, char* smem) {
  const int tid = threadIdx.x, lane = tid & 63, wid = tid >> 6;
  float* cs = reinterpret_cast<float*>(smem);
  constexpr int NTILES = (T / 128) * 8;
  for (int ti = blockIdx.x; ti < NTILES; ti += gridDim.x) {
    int mt = ti >> 3, nt = ti & 7;
    int m0 = mt * 128, n0 = nt * 128;
    f32x16 acc[2][2];
    zero_acc(acc);
    gemm_mainloop(p.merged + (size_t)m0 * 1024, 1024, p.WoT + (size_t)n0 * 1024, 1024, 1024, acc, smem);
    stage_acc(acc, cs);
    __syncthreads();
    for (int rr = 0; rr < 32; ++rr) {
      int row = wid * 32 + rr;
      size_t t = m0 + row;
      float2 v = *reinterpret_cast<const float2*>(cs + row * CS_LD + 2 * lane);
      float2 xv = *reinterpret_cast<const float2*>(p.x + t * 1024 + n0 + 2 * lane);
      float h0 = xv.x + v.x, h1 = xv.y + v.y;
      *reinterpret_cast<float2*>(p.out + t * 1024 + n0 + 2 * lane) = make_float2(h0, h1);
      *reinterpret_cast<u32*>(p.h1b + t * 1024 + n0 + 2 * lane) = pack_bf16(h0, h1);
      float ss = wave_sum(h0 * h0 + h1 * h1);
      if (lane == 0) p.ssq[(size_t)nt * T + t] = ss;
    }
    __syncthreads();
  }
}

__device__ __forceinline__ void ins16(float (&l)[16], float v) {
#pragma unroll
  for (int q = 15; q >= 1; --q) l[q] = __builtin_amdgcn_fmed3f(v, l[q - 1], l[q]);
  l[0] = fmaxf(l[0], v);
}
__device__ void phase_peerq(const Params& p, char* smem) {
  const int tid = threadIdx.x, lane = tid & 63, wid = tid >> 6;
  const int wr = wid >> 1, wc = wid & 1;
  float* cs = reinterpret_cast<float*>(smem);
  constexpr int NTILES = (T / 128) * 16;
  for (int ti = blockIdx.x; ti < NTILES; ti += gridDim.x) {
    int mt = ti >> 4, hp = ti & 15;
    int m0 = mt * 128;
    f32x16 acc[2][2];
    zero_acc(acc);
    gemm_mainloop(p.h1b + (size_t)m0 * 1024, 1024, p.WqT + (size_t)hp * 128 * 1024, 1024, 1024, acc, smem);
#pragma unroll
    for (int i = 0; i < 2; ++i)
#pragma unroll
      for (int j = 0; j < 2; ++j)
#pragma unroll
        for (int r = 0; r < 16; ++r) {
          int row = wr * 64 + i * 32 + (r & 3) + 8 * (r >> 2) + 4 * (lane >> 5);
          int col = wc * 64 + j * 32 + (lane & 31);
          *reinterpret_cast<u16*>(smem + (col >> 6) * ABUF + row * 144 + (col & 63) * 2) = f2bf(acc[i][j][r]);
        }
    {
      const u16* sk = p.SubK + (size_t)hp * 128 * 128;
#pragma unroll
      for (int i = 0; i < 8; ++i) {
        int c = tid + 256 * i;
        int row = c >> 4, kc = c & 15;
        uint4 q = *reinterpret_cast<const uint4*>(sk + row * 128 + kc * 8);
        *reinterpret_cast<uint4*>(smem + (2 + (kc >> 3)) * ABUF + row * 144 + (kc & 7) * 16) = q;
      }
    }
    __syncthreads();
    zero_acc(acc);
    mma_ktile(smem, smem + 2 * ABUF, acc);
    mma_ktile(smem + ABUF, smem + 3 * ABUF, acc);
    __syncthreads();
    stage_acc(acc, cs);
    __syncthreads();
    {
      int row = tid >> 1, half = tid & 1;
      float* rp = cs + row * CS_LD + half * 64;
      float l[16];
#pragma unroll
      for (int q = 0; q < 16; ++q) l[q] = -INFINITY;
      for (int c = 0; c < 64; c += 4) {
        float4 v4 = *reinterpret_cast<const float4*>(rp + c);
        float vv[4] = {v4.x, v4.y, v4.z, v4.w};
#pragma unroll
        for (int e = 0; e < 4; ++e) {
          u32 bits = __float_as_uint(vv[e]);
          u32 n = (u32)(half * 64 + c + e);
          bits = (bits & ~127u) | ((bits >> 31) ? n : (127u - n));
          ins16(l, __uint_as_float(bits));
        }
      }
#pragma unroll
      for (int q = 0; q < 16; ++q) rp[q] = l[q];
    }
    __syncthreads();
    if (tid < 128) {
      int row = tid;
      size_t t = (size_t)m0 + row;
      const float* la = cs + row * CS_LD;
      const float* lb = la + 64;
      float ssum = 0.f;
#pragma unroll
      for (int q = 0; q < 8; ++q) ssum += p.ssq[(size_t)q * T + t];
      float rt = rsqrtf(ssum * (1.f / 1024.f) + EPS);
      int ia = 0, ib = 0;
      float* ov = p.stv + ((size_t)hp * T + t) * 16;
      u8* oi = p.sti + ((size_t)hp * T + t) * 16;
      for (int q = 0; q < 16; ++q) {
        float va = la[ia], vb = lb[ib];
        bool ta = va >= vb;
        float v = ta ? va : vb;
        ia += ta ? 1 : 0;
        ib += ta ? 0 : 1;
        u32 bits = __float_as_uint(v);
        u32 low = bits & 127u;
        u32 n = (bits >> 31) ? low : (127u - low);
        ov[q] = __uint_as_float(bits & ~127u) * rt;
        oi[q] = (u8)n;
      }
    }
    __syncthreads();
  }
}

__device__ void phase_peer(const Params& p, char* smem) {
  const int tid = threadIdx.x, lane = tid & 63, wid = tid >> 6;
  int* pe_e = reinterpret_cast<int*>(smem + wid * 1024);
  float* pe_g = reinterpret_cast<float*>(smem + wid * 1024 + 512);
  for (int tq = blockIdx.x * 4 + wid; tq < T; tq += gridDim.x * 4) {
    const size_t t = tq;
    const int h = lane >> 3, g = lane & 7;
    const float* s1 = p.stv + ((size_t)(2 * h) * T + t) * 16;
    const float* s2 = s1 + (size_t)T * 16;
    float l[16];
#pragma unroll
    for (int q = 0; q < 16; ++q) l[q] = -INFINITY;
#pragma unroll
    for (int c = 0; c < 7; ++c) {
      u32 pr = PAIR_TAB[g * 7 + c];
      float v = -INFINITY;
      if (pr != 0xffu) {
        float a = s1[pr >> 4] + s2[pr & 15];
        u32 bits = __float_as_uint(a);
        bits = (bits & ~255u) | ((bits >> 31) ? pr : (255u - pr));
        v = __uint_as_float(bits);
      }
      ins16(l, v);
    }
#pragma unroll
    for (int msk = 1; msk <= 4; msk <<= 1) {
      float c[16];
#pragma unroll
      for (int q = 0; q < 16; ++q) c[q] = __shfl_xor(l[15 - q], msk);
#pragma unroll
      for (int q = 0; q < 16; ++q) c[q] = fmaxf(l[q], c[q]);
#pragma unroll
      for (int st = 8; st >= 1; st >>= 1)
#pragma unroll
        for (int q = 0; q < 16; ++q)
          if ((q & st) == 0) {
            float hi = fmaxf(c[q], c[q + st]), lo = fminf(c[q], c[q + st]);
            c[q] = hi; c[q + st] = lo;
          }
#pragma unroll
      for (int q = 0; q < 16; ++q) l[q] = c[q];
    }
    {
      float bv[16]; int pr[16];
      float m = -INFINITY;
#pragma unroll
      for (int q = 0; q < 16; ++q) {
        u32 bits = __float_as_uint(l[q]);
        u32 low = bits & 255u;
        pr[q] = (int)((bits >> 31) ? low : (255u - low));
        bv[q] = s1[pr[q] >> 4] + s2[pr[q] & 15];
        m = fmaxf(m, bv[q]);
      }
      float ssum = 0.f;
#pragma unroll
      for (int q = 0; q < 16; ++q) { bv[q] = __expf(bv[q] - m); ssum += bv[q]; }
      float inv = 1.f / ssum;
      const u8* i1 = p.sti + ((size_t)(2 * h) * T + t) * 16;
      const u8* i2 = i1 + (size_t)T * 16;
      __builtin_amdgcn_wave_barrier();
#pragma unroll
      for (int q = 0; q < 16; ++q) {
        if ((q >> 1) == g) {
          pe_e[h * 16 + q] = (int)i1[pr[q] >> 4] * 128 + (int)i2[pr[q] & 15];
          pe_g[h * 16 + q] = bv[q] * inv;
        }
      }
      __builtin_amdgcn_wave_barrier();
    }
    float rt;
    {
      float ssum = 0.f;
#pragma unroll
      for (int q = 0; q < 8; ++q) ssum += p.ssq[(size_t)q * T + t];
      rt = rsqrtf(ssum * (1.f / 1024.f) + EPS);
    }
    uint4 hx0 = *reinterpret_cast<const uint4*>(p.h1b + t * 1024 + lane * 8);
    uint4 hx1 = *reinterpret_cast<const uint4*>(p.h1b + t * 1024 + 512 + lane * 8);
    u32 hw[8] = {hx0.x, hx0.y, hx0.z, hx0.w, hx1.x, hx1.y, hx1.z, hx1.w};
    float y[16];
#pragma unroll
    for (int q = 0; q < 16; ++q) y[q] = 0.f;
    for (int e0 = 0; e0 < 128; e0 += 4) {
      uint4 ur[4][2], vr[4][2];
      float gt[4];
#pragma unroll
      for (int k = 0; k < 4; ++k) {
        int ex = pe_e[e0 + k];
        gt[k] = pe_g[e0 + k];
        const u16* up = p.Ub + (size_t)ex * 1024 + lane * 8;
        const u16* vp = p.Vb + (size_t)ex * 1024 + lane * 8;
        ur[k][0] = *reinterpret_cast<const uint4*>(up);
        ur[k][1] = *reinterpret_cast<const uint4*>(up + 512);
        vr[k][0] = *reinterpret_cast<const uint4*>(vp);
        vr[k][1] = *reinterpret_cast<const uint4*>(vp + 512);
      }
#pragma unroll
      for (int k = 0; k < 4; ++k) {
        u32 uw[8] = {ur[k][0].x, ur[k][0].y, ur[k][0].z, ur[k][0].w, ur[k][1].x, ur[k][1].y, ur[k][1].z, ur[k][1].w};
        float d = 0.f;
#pragma unroll
        for (int q = 0; q < 8; ++q)
          d = __builtin_amdgcn_fdot2_f32_bf16(__builtin_bit_cast(bf16x2_t, uw[q]), __builtin_bit_cast(bf16x2_t, hw[q]), d, false);
        d = wave_sum(d);
        float c = gt[k] * gelu_f(d * rt);
        u32 vw[8] = {vr[k][0].x, vr[k][0].y, vr[k][0].z, vr[k][0].w, vr[k][1].x, vr[k][1].y, vr[k][1].z, vr[k][1].w};
#pragma unroll
        for (int q = 0; q < 8; ++q) { y[2 * q] += c * bf_lo(vw[q]); y[2 * q + 1] += c * bf_hi(vw[q]); }
      }
    }
    float* op = p.out + t * 1024 + lane * 8;
#pragma unroll
    for (int hh = 0; hh < 2; ++hh) {
      float4 a = *reinterpret_cast<const float4*>(op + hh * 512);
      float4 b = *reinterpret_cast<const float4*>(op + hh * 512 + 4);
      a.x += y[hh * 8 + 0]; a.y += y[hh * 8 + 1]; a.z += y[hh * 8 + 2]; a.w += y[hh * 8 + 3];
      b.x += y[hh * 8 + 4]; b.y += y[hh * 8 + 5]; b.z += y[hh * 8 + 6]; b.w += y[hh * 8 + 7];
      *reinterpret_cast<float4*>(op + hh * 512) = a;
      *reinterpret_cast<float4*>(op + hh * 512 + 4) = b;
    }
    __builtin_amdgcn_wave_barrier();
  }
}

#ifndef PROBE_DUP
#define PROBE_DUP -1
#endif
__device__ void phase_mix(const Params& p, char* smem) {
  const int G = gridDim.x;
  for (int rep = 0; rep < ((PROBE_DUP == 20 || PROBE_DUP >= 23) ? 2 : 1); ++rep)
  for (int s0 = 0, r = 0; s0 < 2048; s0 += G, ++r) {
    int off = (r & 1) ? (G - 1 - (int)blockIdx.x) : (int)blockIdx.x;
    int s = s0 + off;
    if (s < 2048) {
      int grp = 1023 - (s >> 1), b = s & 1;
      unit_indexer(p, smem, (b << 10) | grp, (PROBE_DUP >= 23 && rep == 0) ? (PROBE_DUP - 22) : 0);
    }
  }
  for (int rep = 0; rep < (PROBE_DUP == 21 ? 2 : 1); ++rep)
  for (int u = blockIdx.x; u < 1024; u += G) unit_spatial(p, smem, u);
  for (int rep = 0; rep < (PROBE_DUP == 22 ? 2 : 1); ++rep)
  for (int u = blockIdx.x; u < 256; u += G) unit_kv(p, smem, u);
}

template <int PH>
__device__ __forceinline__ void run_phase(const Params& p, char* smem) {
  if (PH == 0) phase_prep(p, smem);
  else if (PH == 1) phase_gemm1(p, smem);
  else if (PH == 2) phase_mix(p, smem);
  else if (PH == 3) phase_attn(p, smem);
  else if (PH == 4) phase_merge(p, smem);
  else if (PH == 5) phase_wo(p, smem);
  else if (PH == 6) phase_peerq(p, smem);
  else phase_peer(p, smem);
}

template <int PH>
__global__ void __launch_bounds__(NTHREADS, 2) phase_kernel(Params p) {
  __shared__ __attribute__((aligned(16))) char smem[SMEM_BYTES];
  run_phase<PH>(p, smem);
}

__global__ void __launch_bounds__(NTHREADS, 2) mega_kernel(Params p) {
  __shared__ __attribute__((aligned(16))) char smem[SMEM_BYTES];
  cg::grid_group grid = cg::this_grid();
#ifdef EXP_ZERO
  for (int i = threadIdx.x; i < SMEM_BYTES / 4; i += NTHREADS) reinterpret_cast<u32*>(smem)[i] = 0u;
  __syncthreads();
#endif
#define GSYNC() do { asm volatile("s_waitcnt vmcnt(0)" ::: "memory"); grid.sync(); } while (0)
#define RUNP(X) run_phase<X>(p, smem); GSYNC(); if (PROBE_DUP == X) { run_phase<X>(p, smem); GSYNC(); }
  RUNP(0) RUNP(1) RUNP(2) RUNP(3) RUNP(4) RUNP(5) RUNP(6)
  run_phase<7>(p, smem);
}

extern "C" void kernel_launch(void* const* d_in, const int* in_sizes, int n_in, void* d_out, int out_size,
                              void* d_ws, size_t ws_size, hipStream_t stream) {
  Params p{};
  p.x = (const float*)d_in[0]; p.pos = (const int*)d_in[1];
  p.norm1_g = (const float*)d_in[2]; p.w_in = (const float*)d_in[3]; p.v_norm_g = (const float*)d_in[4];
  p.v_norm_b = (const float*)d_in[5]; p.spatial_w = (const float*)d_in[6]; p.spatial_b = (const float*)d_in[7];
  p.kv_norm_g = (const float*)d_in[8]; p.w_uk = (const float*)d_in[9]; p.w_uv = (const float*)d_in[10];
  p.q_norm_g = (const float*)d_in[11]; p.k_norm_g = (const float*)d_in[12]; p.w_a_out = (const float*)d_in[13];
  p.w_b_out = (const float*)d_in[14]; p.w_o = (const float*)d_in[15]; p.norm2_g = (const float*)d_in[16];
  p.peer_wq = (const float*)d_in[17]; p.peer_subkeys = (const float*)d_in[18]; p.peer_u = (const float*)d_in[19];
  p.peer_v = (const float*)d_in[20];
  p.out = (float*)d_out;
  char* w = (char*)d_ws;
  size_t off = 0;
  auto take = [&](size_t bytes) { char* r = w + off; off += (bytes + 255) & ~(size_t)255; return r; };
  const size_t MB = 1u << 20;
  char* r_xn = take(64 * MB);
  p.xn = (u16*)r_xn; p.ya = (u16*)r_xn; p.yb = (u16*)(r_xn + 32 * MB);
  p.WinT = (u16*)take((size_t)NWIN * 1024 * 2);
  p.WaT = (u16*)take(1024 * 512 * 2); p.WbT = (u16*)take(1024 * 512 * 2);
  p.WoT = (u16*)take(1024 * 1024 * 2); p.WqT = (u16*)take(2048 * 1024 * 2);
  p.WkvT = (u16*)take(256 * 256 * 2); p.SubK = (u16*)take(262144 * 2); p.Wtril = (u16*)take(65536 * 2);
  p.Ub = (u16*)take(32 * MB); p.Vb = (u16*)take(32 * MB);
  char* r_g = take(96 * MB);
  p.gu = (u16*)r_g; p.gv = (u16*)(r_g + 32 * MB); p.qh = (u16*)(r_g + 64 * MB); p.merged = (u16*)r_g;
  p.ckv = (u16*)take(16 * MB); p.qi = (u16*)take(16 * MB); p.ki = (u16*)take(4 * MB);
  p.wi = (float*)take((size_t)T * 4 * 4);
  char* r_sg = take(128 * MB);
  p.sg = (u16*)r_sg; p.h1b = (u16*)r_sg; p.stv = (float*)(r_sg + 64 * MB); p.sti = (u8*)(r_sg + 96 * MB);
  p.kk = (u16*)take(8 * MB); p.vv = (u16*)take(8 * MB); p.sel = (u16*)take(16 * MB);
  p.ssq = (float*)take((size_t)T * 8 * 4);
  if (off > ws_size) { fprintf(stderr, "workspace too small: need %zu have %zu\n", off, ws_size); return; }

  static int grid_blocks = 0;
  if (!grid_blocks) {
    int dev = 0, cus = 0, per_cu = 0;
    hipGetDevice(&dev);
    hipDeviceGetAttribute(&cus, hipDeviceAttributeMultiprocessorCount, dev);
    hipOccupancyMaxActiveBlocksPerMultiprocessor(&per_cu, mega_kernel, NTHREADS, 0);
    if (per_cu > 2) per_cu = 2;
    if (per_cu < 1) per_cu = 1;
    grid_blocks = cus * per_cu;
  }
#ifdef EXP_ZERO
  hipMemsetAsync(d_ws, 0, off, stream);
#endif
#if MULTI_LAUNCH
  dim3 g(grid_blocks), b(NTHREADS);
  phase_kernel<0><<<g, b, 0, stream>>>(p);
  phase_kernel<1><<<g, b, 0, stream>>>(p);
  phase_kernel<2><<<g, b, 0, stream>>>(p);
  phase_kernel<3><<<g, b, 0, stream>>>(p);
  phase_kernel<4><<<g, b, 0, stream>>>(p);
  phase_kernel<5><<<g, b, 0, stream>>>(p);
  phase_kernel<6><<<g, b, 0, stream>>>(p);
  phase_kernel<7><<<g, b, 0, stream>>>(p);
#else
  void* args[] = {&p};
  hipError_t e = hipLaunchCooperativeKernel((void*)mega_kernel, dim3(grid_blocks), dim3(NTHREADS), args, 0, stream);
  if (e != hipSuccess) fprintf(stderr, "cooperative launch failed: %s (grid %d)\n", hipGetErrorString(e), grid_blocks);
#endif
}
```

```cpp
#include <hip/hip_runtime.h>
#include <hip/hip_cooperative_groups.h>
#include <stdint.h>
#include <cstdio>
namespace cg = cooperative_groups;

#ifndef MULTI_LAUNCH
#define MULTI_LAUNCH 0
#endif

typedef unsigned short u16;
typedef unsigned int u32;
typedef unsigned char u8;
using bf16x8 = __attribute__((ext_vector_type(8))) short;
using f32x4 = __attribute__((ext_vector_type(4))) float;
using f32x16 = __attribute__((ext_vector_type(16))) float;
typedef __bf16 bf16x2_t __attribute__((ext_vector_type(2)));
typedef float float2_t __attribute__((ext_vector_type(2)));

constexpr int BATCH = 2, SEQ = 16384, DM = 1024, T = BATCH * SEQ;
constexpr int NWIN = 4224;
constexpr int NTHREADS = 256;
constexpr float EPS = 1e-6f;
constexpr int ABUF = 128 * 144;
constexpr int CS_LD = 132;
constexpr int SMEM_BYTES = 77824;
constexpr int EXTRA_OFF = 4 * ABUF;
constexpr int CAP = 768;

__constant__ float INV32[16] = {1.000000000e+00f, 4.403665960e-01f, 1.939227432e-01f, 8.539710194e-02f, 3.760603070e-02f, 1.656043902e-02f, 7.292664610e-03f, 3.211445874e-03f, 1.414213562e-03f, 6.227723788e-04f, 2.742481884e-04f, 1.207697351e-04f, 5.318296098e-05f, 2.341999971e-05f, 1.031338616e-05f, 4.541670478e-06f};
__constant__ float INV16[8] = {1.000000000e+00f, 1.939227432e-01f, 3.760603070e-02f, 7.292664610e-03f, 1.414213562e-03f, 2.742481884e-04f, 5.318296098e-05f, 1.031338616e-05f};
__constant__ u8 PAIR_TAB[56] = {
  0x00,0x01,0x02,0x03,0x04,0x05,0x06,0x07,0x08,0x09,0x0a,0x0b,0x0c,0x0d,0x0e,0x0f,
  0x10,0x11,0x12,0x13,0x14,0x15,0x16,0x17,
  0x20,0x21,0x22,0x23,0x24,
  0x30,0x31,0x32,0x33,
  0x40,0x41,0x42,
  0x50,0x51,
  0x60,0x61,
  0x70,0x71,
  0x80,0x90,0xa0,0xb0,0xc0,0xd0,0xe0,0xf0,
  0xff,0xff,0xff,0xff,0xff,0xff};

struct Params {
  const float* x; const int* pos;
  const float *norm1_g, *w_in, *v_norm_g, *v_norm_b, *spatial_w, *spatial_b, *kv_norm_g, *w_uk, *w_uv,
      *q_norm_g, *k_norm_g, *w_a_out, *w_b_out, *w_o, *norm2_g, *peer_wq, *peer_subkeys, *peer_u, *peer_v;
  float* out;
  u16 *xn, *WinT, *WaT, *WbT, *WoT, *WqT, *WkvT, *SubK, *Wtril;
  u8 *U8, *V8;
  float *su, *sv;
  u16 *gu, *gv, *qh, *ckv, *qi, *ki, *sg, *kk, *vv, *ya, *yb, *merged, *h1b, *sel;
  float *wi, *ssq, *stv;
  u8* sti;
};

__device__ __forceinline__ u32 pack_bf16(float a, float b) {
  float2_t v = {a, b};
  bf16x2_t r = __builtin_convertvector(v, bf16x2_t);
  return __builtin_bit_cast(u32, r);
}
__device__ __forceinline__ u16 f2bf(float a) { return (u16)(pack_bf16(a, 0.f) & 0xffffu); }
__device__ __forceinline__ float bf_lo(u32 u) { return __uint_as_float(u << 16); }
__device__ __forceinline__ float bf_hi(u32 u) { return __uint_as_float(u & 0xffff0000u); }
__device__ __forceinline__ float bf2f(u16 h) { return __uint_as_float(((u32)h) << 16); }
__device__ __forceinline__ float wave_sum(float v) {
#pragma unroll
  for (int m = 32; m >= 1; m >>= 1) v += __shfl_xor(v, m);
  return v;
}
__device__ __forceinline__ float gelu_f(float x) {
  float z = 1.5957691216057308f * (x + 0.044715f * x * x * x);
  return x / (1.f + __expf(-z));
}
__device__ __forceinline__ float sigmoid_f(float x) { return 1.f / (1.f + __expf(-x)); }
__device__ __forceinline__ u32 sortable(u32 b) { return b ^ ((u32)((int)b >> 31) | 0x80000000u); }
__device__ __forceinline__ u32 unsortable(u32 k) { return k ^ ((k & 0x80000000u) ? 0x80000000u : 0xffffffffu); }
__device__ __forceinline__ int mbcnt64(unsigned long long m) {
  return __builtin_amdgcn_mbcnt_hi((u32)(m >> 32), __builtin_amdgcn_mbcnt_lo((u32)m, 0));
}

typedef u32 u32x4 __attribute__((ext_vector_type(4)));
struct Tile4 { u32x4 v0, v1, v2, v3; };
__device__ __forceinline__ void gemm_load_tile(const u16* __restrict__ g, int ld, int k0, Tile4& r) {
  const int tid = threadIdx.x;
  const int row = tid >> 3, kc = tid & 7;
  const u16* base = g + (size_t)row * ld + k0 + kc * 8;
  r.v0 = *reinterpret_cast<const u32x4*>(base);
  r.v1 = *reinterpret_cast<const u32x4*>(base + (size_t)32 * ld);
  r.v2 = *reinterpret_cast<const u32x4*>(base + (size_t)64 * ld);
  r.v3 = *reinterpret_cast<const u32x4*>(base + (size_t)96 * ld);
}
__device__ __forceinline__ void gemm_store_tile(char* buf, const Tile4& r) {
  const int tid = threadIdx.x;
  const int row = tid >> 3, kc = tid & 7;
  char* base = buf + row * 144 + kc * 16;
  *reinterpret_cast<u32x4*>(base) = r.v0;
  *reinterpret_cast<u32x4*>(base + 32 * 144) = r.v1;
  *reinterpret_cast<u32x4*>(base + 64 * 144) = r.v2;
  *reinterpret_cast<u32x4*>(base + 96 * 144) = r.v3;
}
__device__ __forceinline__ void mma_ktile(const char* sa, const char* sb, f32x16 (&acc)[2][2]) {
  const int lane = threadIdx.x & 63, wid = threadIdx.x >> 6;
  const int wr = wid >> 1, wc = wid & 1;
  const int r32 = lane & 31, hf = lane >> 5;
#pragma unroll
  for (int s = 0; s < 4; ++s) {
    bf16x8 a[2], b[2];
#pragma unroll
    for (int i = 0; i < 2; ++i) {
      a[i] = *reinterpret_cast<const bf16x8*>(sa + (wr * 64 + i * 32 + r32) * 144 + s * 32 + hf * 16);
      b[i] = *reinterpret_cast<const bf16x8*>(sb + (wc * 64 + i * 32 + r32) * 144 + s * 32 + hf * 16);
    }
#pragma unroll
    for (int i = 0; i < 2; ++i)
#pragma unroll
      for (int j = 0; j < 2; ++j)
        acc[i][j] = __builtin_amdgcn_mfma_f32_32x32x16_bf16(a[i], b[j], acc[i][j], 0, 0, 0);
  }
}
__device__ __forceinline__ void gemm_mainloop(const u16* __restrict__ A, int lda, const u16* __restrict__ B, int ldb,
                                              int K, f32x16 (&acc)[2][2], char* smem) {
  Tile4 ra, rb;
  const int nk = K >> 6;
  gemm_load_tile(A, lda, 0, ra);
  gemm_load_tile(B, ldb, 0, rb);
  __syncthreads();
  gemm_store_tile(smem, ra);
  gemm_store_tile(smem + 2 * ABUF, rb);
  __syncthreads();
#pragma unroll 1
  for (int kt = 0; kt < nk; ++kt) {
    const int cur = kt & 1;
    if (kt + 1 < nk) {
      gemm_load_tile(A, lda, (kt + 1) << 6, ra);
      gemm_load_tile(B, ldb, (kt + 1) << 6, rb);
    }
    mma_ktile(smem + cur * ABUF, smem + (2 + cur) * ABUF, acc);
    if (kt + 1 < nk) {
      gemm_store_tile(smem + (cur ^ 1) * ABUF, ra);
      gemm_store_tile(smem + (2 + (cur ^ 1)) * ABUF, rb);
    }
    __syncthreads();
  }
}
__device__ __forceinline__ void zero_acc(f32x16 (&acc)[2][2]) {
#pragma unroll
  for (int i = 0; i < 2; ++i)
#pragma unroll
    for (int j = 0; j < 2; ++j)
#pragma unroll
      for (int r = 0; r < 16; ++r) acc[i][j][r] = 0.f;
}
__device__ __forceinline__ void stage_acc(const f32x16 (&acc)[2][2], float* cs) {
  const int lane = threadIdx.x & 63, wid = threadIdx.x >> 6;
  const int wr = wid >> 1, wc = wid & 1;
#pragma unroll
  for (int i = 0; i < 2; ++i)
#pragma unroll
    for (int j = 0; j < 2; ++j)
#pragma unroll
      for (int r = 0; r < 16; ++r) {
        int row = wr * 64 + i * 32 + (r & 3) + 8 * (r >> 2) + 4 * (lane >> 5);
        int col = wc * 64 + j * 32 + (lane & 31);
        cs[row * CS_LD + col] = acc[i][j][r];
      }
}

__device__ __forceinline__ int win_srccol(int n) {
  if (n < 2116) return n;
  if (n < 2176) return -1;
  return n - 60;
}
__device__ void phase_prep(const Params& p, char* smem) {
  const int tid = threadIdx.x, lane = tid & 63, wid = tid >> 6;
  for (int rb = blockIdx.x; rb < T / 4; rb += gridDim.x) {
    int row = rb * 4 + wid;
    const float* xr = p.x + (size_t)row * DM;
    float4 v[4];
    float ss = 0.f;
#pragma unroll
    for (int i = 0; i < 4; ++i) {
      v[i] = *reinterpret_cast<const float4*>(xr + lane * 4 + 256 * i);
      ss += v[i].x * v[i].x + v[i].y * v[i].y + v[i].z * v[i].z + v[i].w * v[i].w;
    }
    ss = wave_sum(ss);
    float r = rsqrtf(ss * (1.f / DM) + EPS);
#pragma unroll
    for (int i = 0; i < 4; ++i) {
      float4 g = *reinterpret_cast<const float4*>(p.norm1_g + lane * 4 + 256 * i);
      uint2 o;
      o.x = pack_bf16(v[i].x * r * g.x, v[i].y * r * g.y);
      o.y = pack_bf16(v[i].z * r * g.z, v[i].w * r * g.w);
      *reinterpret_cast<uint2*>(p.xn + (size_t)row * DM + lane * 4 + 256 * i) = o;
    }
  }
  float* tile = reinterpret_cast<float*>(smem);
  constexpr int NT_TOTAL = 1056 + 128 + 128 + 256 + 512 + 8 + 8;
  for (int ti = blockIdx.x; ti < NT_TOTAL; ti += gridDim.x) {
    const float* src; const float* scale = nullptr; u16* dst; int ldsrc, K, nn, mode = 0; int t = ti;
    if (t < 1056) { src = p.w_in; ldsrc = 4164; K = 1024; nn = 66; dst = p.WinT; mode = 1; }
    else if ((t -= 1056) < 128) { src = p.w_a_out; ldsrc = 1024; K = 512; nn = 16; dst = p.WaT; }
    else if ((t -= 128) < 128) { src = p.w_b_out; ldsrc = 1024; K = 512; nn = 16; dst = p.WbT; }
    else if ((t -= 128) < 256) { src = p.w_o; ldsrc = 1024; K = 1024; nn = 16; dst = p.WoT; }
    else if ((t -= 256) < 512) { src = p.peer_wq; ldsrc = 2048; K = 1024; nn = 32; dst = p.WqT; scale = p.norm2_g; }
    else if ((t -= 512) < 8) { src = p.w_uk; ldsrc = 128; K = 256; nn = 2; dst = p.WkvT; scale = p.kv_norm_g; }
    else { t -= 8; src = p.w_uv; ldsrc = 128; K = 256; nn = 2; dst = p.WkvT + 128 * 256; scale = p.kv_norm_g; }
    int n0 = (t % nn) * 64, k0 = (t / nn) * 64;
    __syncthreads();
    {
      int n = tid & 63;
      int sc = (mode == 1) ? win_srccol(n0 + n) : (n0 + n);
      for (int kk = tid >> 6; kk < 64; kk += 4) {
        float v = 0.f;
        if (sc >= 0) v = src[(size_t)(k0 + kk) * ldsrc + sc];
        if (scale) v *= scale[k0 + kk];
        tile[kk * 65 + n] = v;
      }
    }
    __syncthreads();
    {
      int k = (tid & 31) * 2;
      for (int n = tid >> 5; n < 64; n += 8) {
        u32 o = pack_bf16(tile[k * 65 + n], tile[(k + 1) * 65 + n]);
        *reinterpret_cast<u32*>(dst + (size_t)(n0 + n) * K + k0 + k) = o;
      }
    }
  }
  constexpr int G_SUB = 262144 / 4, G_SW = 65536 / 4;
  constexpr int G_TOTAL = G_SUB + G_SW;
  for (int gi = blockIdx.x * NTHREADS + tid; gi < G_TOTAL; gi += gridDim.x * NTHREADS) {
    int g = gi;
    if (g < G_SUB) {
      float4 v = *reinterpret_cast<const float4*>(p.peer_subkeys + (size_t)g * 4);
      uint2 o = {pack_bf16(v.x, v.y), pack_bf16(v.z, v.w)};
      *reinterpret_cast<uint2*>(p.SubK + (size_t)g * 4) = o;
    } else {
      g -= G_SUB;
      float4 v = *reinterpret_cast<const float4*>(p.spatial_w + (size_t)g * 4);
      int e = g * 4; int s = e & 127, tt = (e >> 7) & 127;
      if (s > tt) v.x = 0.f;
      if (s + 1 > tt) v.y = 0.f;
      if (s + 2 > tt) v.z = 0.f;
      if (s + 3 > tt) v.w = 0.f;
      uint2 o = {pack_bf16(v.x, v.y), pack_bf16(v.z, v.w)};
      *reinterpret_cast<uint2*>(p.Wtril + (size_t)g * 4) = o;
    }
  }
  for (int rb = blockIdx.x; rb < 8192; rb += gridDim.x) {
    int r = rb * 4 + wid;
    bool isu = r < 16384;
    int rr = isu ? r : r - 16384;
    const float* src = (isu ? p.peer_u : p.peer_v) + (size_t)rr * 1024 + lane * 16;
    float v[16];
#pragma unroll
    for (int i = 0; i < 4; ++i) {
      float4 q = *reinterpret_cast<const float4*>(src + 4 * i);
      v[4 * i] = q.x; v[4 * i + 1] = q.y; v[4 * i + 2] = q.z; v[4 * i + 3] = q.w;
    }
    if (isu) {
#pragma unroll
      for (int i = 0; i < 4; ++i) {
        float4 g = *reinterpret_cast<const float4*>(p.norm2_g + lane * 16 + 4 * i);
        v[4 * i] *= g.x; v[4 * i + 1] *= g.y; v[4 * i + 2] *= g.z; v[4 * i + 3] *= g.w;
      }
    }
    float amax = 0.f;
#pragma unroll
    for (int i = 0; i < 16; ++i) amax = fmaxf(amax, fabsf(v[i]));
#pragma unroll
    for (int m = 32; m >= 1; m >>= 1) amax = fmaxf(amax, __shfl_xor(amax, m));
    int ex = 0;
    if (amax > 0.f) ex = ilogbf(224.f / amax);
    ex = ex > 60 ? 60 : (ex < -60 ? -60 : ex);
    float sc = ldexpf(1.f, ex);
    u32 w[4];
#pragma unroll
    for (int i = 0; i < 4; ++i) {
      int t = __builtin_amdgcn_cvt_pk_fp8_f32(v[4 * i] * sc, v[4 * i + 1] * sc, 0, false);
      t = __builtin_amdgcn_cvt_pk_fp8_f32(v[4 * i + 2] * sc, v[4 * i + 3] * sc, t, true);
      w[i] = (u32)t;
    }
    uint4 o = {w[0], w[1], w[2], w[3]};
    *reinterpret_cast<uint4*>((isu ? p.U8 : p.V8) + (size_t)rr * 1024 + lane * 16) = o;
    if (lane == 0) (isu ? p.su : p.sv)[rr] = ldexpf(1.f, -ex);
  }
}

__device__ __forceinline__ void rope_pair(float& y0, float& y1, int lc, int half, int xm, float posf, const float* inv) {
  float p0 = __shfl_xor(y0, xm), p1 = __shfl_xor(y1, xm);
  if (lc < 2 * half) {
    int j = lc & (half - 1);
    float a0 = posf * inv[j], a1 = posf * inv[j + 1];
    float s0, c0, s1, c1;
    sincosf(a0, &s0, &c0);
    sincosf(a1, &s1, &c1);
    if (lc < half) { y0 = y0 * c0 - p0 * s0; y1 = y1 * c1 - p1 * s1; }
    else { y0 = y0 * c0 + p0 * s0; y1 = y1 * c1 + p1 * s1; }
  }
}

__device__ void phase_gemm1(const Params& p, char* smem) {
  const int tid = threadIdx.x, lane = tid & 63, wid = tid >> 6;
  float* cs = reinterpret_cast<float*>(smem);
  constexpr int NTN = NWIN / 128;
  constexpr int NTILES = (T / 128) * NTN;
  for (int ti = blockIdx.x; ti < NTILES; ti += gridDim.x) {
    int mt = ti / NTN, nt = ti % NTN;
    int m0 = mt * 128;
    f32x16 acc[2][2];
    zero_acc(acc);
    gemm_mainloop(p.xn + (size_t)m0 * DM, DM, p.WinT + (size_t)nt * 128 * DM, DM, DM, acc, smem);
    stage_acc(acc, cs);
    __syncthreads();
    const int c0 = 2 * lane;
    for (int rr = 0; rr < 32; ++rr) {
      int row = wid * 32 + rr;
      int t = m0 + row;
      float2 v = *reinterpret_cast<const float2*>(cs + row * CS_LD + c0);
      float v0 = v.x, v1 = v.y;
      if (nt < 4) {
        *reinterpret_cast<u32*>(p.gu + (size_t)t * 512 + nt * 128 + c0) = pack_bf16(gelu_f(v0), gelu_f(v1));
      } else if (nt < 8) {
        *reinterpret_cast<u32*>(p.gv + (size_t)t * 512 + (nt - 4) * 128 + c0) = pack_bf16(gelu_f(v0), gelu_f(v1));
      } else if (nt < 12) {
        float ss = wave_sum(v0 * v0 + v1 * v1);
        float r = rsqrtf(ss * (1.f / 128.f) + EPS);
        float y0 = v0 * r * p.q_norm_g[c0], y1 = v1 * r * p.q_norm_g[c0 + 1];
        float posf = (float)p.pos[t];
        rope_pair(y0, y1, c0, 16, 8, posf, INV32);
        *reinterpret_cast<u32*>(p.qh + (size_t)t * 512 + (nt - 8) * 128 + c0) = pack_bf16(y0, y1);
      } else if (nt < 14) {
        *reinterpret_cast<u32*>(p.ckv + (size_t)t * 256 + (nt - 12) * 128 + c0) = pack_bf16(v0, v1);
      } else if (nt < 16) {
        float posf = (float)p.pos[t];
        float y0 = v0, y1 = v1;
        rope_pair(y0, y1, c0 & 63, 8, 4, posf, INV16);
        *reinterpret_cast<u32*>(p.qi + (size_t)t * 256 + (nt - 14) * 128 + c0) = pack_bf16(y0, y1);
      } else if (nt == 16) {
        float posf = (float)p.pos[t];
        float y0 = v0, y1 = v1;
        rope_pair(y0, y1, c0 < 64 ? c0 : 64, 8, 4, posf, INV16);
        if (c0 < 64) *reinterpret_cast<u32*>(p.ki + (size_t)t * 64 + c0) = pack_bf16(y0, y1);
        else if (c0 < 68) { p.wi[(size_t)t * 4 + (c0 - 64)] = v0 * 0.0625f; p.wi[(size_t)t * 4 + (c0 - 63)] = v1 * 0.0625f; }
      } else {
        *reinterpret_cast<u32*>(p.sg + (size_t)t * 2048 + (nt - 17) * 128 + c0) = pack_bf16(sigmoid_f(v0), sigmoid_f(v1));
      }
    }
    __syncthreads();
  }
}

__device__ void unit_kv(const Params& p, char* smem, int mt) {
  const int tid = threadIdx.x, lane = tid & 63, wid = tid >> 6;
  float* cs = reinterpret_cast<float*>(smem);
  float* rr_s = reinterpret_cast<float*>(smem + EXTRA_OFF);
  const int m0 = mt * 128;
  __syncthreads();
  {
    int row = tid >> 1, half = tid & 1;
    const u16* src = p.ckv + (size_t)(m0 + row) * 256 + half * 128;
    float ss = 0.f;
#pragma unroll 4
    for (int i = 0; i < 16; ++i) {
      uint4 q = *reinterpret_cast<const uint4*>(src + i * 8);
      u32 w[4] = {q.x, q.y, q.z, q.w};
#pragma unroll
      for (int j = 0; j < 4; ++j) { float a = bf_lo(w[j]), b = bf_hi(w[j]); ss += a * a + b * b; }
    }
    ss += __shfl_xor(ss, 1);
    if (half == 0) rr_s[row] = rsqrtf(ss * (1.f / 256.f) + EPS);
  }
#pragma unroll 1
  for (int nt = 0; nt < 2; ++nt) {
    f32x16 acc[2][2];
    zero_acc(acc);
    gemm_mainloop(p.ckv + (size_t)m0 * 256, 256, p.WkvT + (size_t)nt * 128 * 256, 256, 256, acc, smem);
    stage_acc(acc, cs);
    __syncthreads();
    const int c0 = 2 * lane;
#pragma unroll 1
    for (int rr = 0; rr < 32; ++rr) {
      int row = wid * 32 + rr;
      int t = m0 + row;
      float2 v = *reinterpret_cast<const float2*>(cs + row * CS_LD + c0);
      float rs = rr_s[row];
      float v0 = v.x * rs, v1 = v.y * rs;
      if (nt == 0) {
        float ss = wave_sum(v0 * v0 + v1 * v1);
        float r = rsqrtf(ss * (1.f / 128.f) + EPS);
        float y0 = v0 * r * p.k_norm_g[c0], y1 = v1 * r * p.k_norm_g[c0 + 1];
        float posf = (float)p.pos[t];
        rope_pair(y0, y1, c0, 16, 8, posf, INV32);
        *reinterpret_cast<u32*>(p.kk + (size_t)t * 128 + c0) = pack_bf16(y0, y1);
      } else {
        *reinterpret_cast<u32*>(p.vv + (size_t)t * 128 + c0) = pack_bf16(v0, v1);
      }
    }
    __syncthreads();
  }
}

__device__ void unit_spatial(const Params& p, char* smem, int unit) {
  const int tid = threadIdx.x, lane = tid & 63, wid = tid >> 6;
  const int chunk = unit >> 2, g = unit & 3;
  const int t0 = chunk * 128;
  float* cs = reinterpret_cast<float*>(smem);
  float* mu_s = reinterpret_cast<float*>(smem + EXTRA_OFF);
  float* rs_s = mu_s + 128;
  __syncthreads();
  {
    int row = tid >> 1, half = tid & 1;
    const u16* src = p.gv + (size_t)(t0 + row) * 512 + half * 256;
    float s = 0.f, ss = 0.f;
#pragma unroll 4
    for (int i = 0; i < 32; ++i) {
      uint4 q = *reinterpret_cast<const uint4*>(src + i * 8);
      u32 w[4] = {q.x, q.y, q.z, q.w};
#pragma unroll
      for (int j = 0; j < 4; ++j) { float a = bf_lo(w[j]), b = bf_hi(w[j]); s += a + b; ss += a * a + b * b; }
    }
    s += __shfl_xor(s, 1);
    ss += __shfl_xor(ss, 1);
    float mean = s * (1.f / 512.f);
    float var = fmaxf(ss * (1.f / 512.f) - mean * mean, 0.f);
    if (half == 0) { mu_s[row] = mean; rs_s[row] = rsqrtf(var + EPS); }
  }
  {
    const u16* wsrc = p.Wtril + (size_t)g * 128 * 128;
#pragma unroll
    for (int i = 0; i < 8; ++i) {
      int c = tid + 256 * i;
      int row = c >> 4, kc = c & 15;
      uint4 q = *reinterpret_cast<const uint4*>(wsrc + row * 128 + kc * 8);
      *reinterpret_cast<uint4*>(smem + (kc >> 3) * ABUF + row * 144 + (kc & 7) * 16) = q;
    }
  }
  __syncthreads();
  {
    int s = tid & 127;
    float mu = mu_s[s], rs = rs_s[s];
    const u16* src = p.gv + (size_t)(t0 + s) * 512 + g * 128;
    char* bbase = smem + (2 + (s >> 6)) * ABUF + (s & 63) * 2;
#pragma unroll
    for (int i = 0; i < 8; ++i) {
      int d0 = ((tid >> 7) + 2 * i) * 8;
      uint4 q = *reinterpret_cast<const uint4*>(src + d0);
      u32 w[4] = {q.x, q.y, q.z, q.w};
#pragma unroll
      for (int j = 0; j < 4; ++j) {
        int d = d0 + 2 * j;
        float a = (bf_lo(w[j]) - mu) * rs * p.v_norm_g[g * 128 + d] + p.v_norm_b[g * 128 + d];
        float b = (bf_hi(w[j]) - mu) * rs * p.v_norm_g[g * 128 + d + 1] + p.v_norm_b[g * 128 + d + 1];
        *reinterpret_cast<u16*>(bbase + d * 144) = f2bf(a);
        *reinterpret_cast<u16*>(bbase + (d + 1) * 144) = f2bf(b);
      }
    }
  }
  __syncthreads();
  f32x16 acc[2][2];
  zero_acc(acc);
  mma_ktile(smem, smem + 2 * ABUF, acc);
  mma_ktile(smem + ABUF, smem + 3 * ABUF, acc);
  __syncthreads();
  stage_acc(acc, cs);
  __syncthreads();
  const int c0 = 2 * lane;
  for (int rr = 0; rr < 32; ++rr) {
    int row = wid * 32 + rr;
    int t = t0 + row;
    float2 v = *reinterpret_cast<const float2*>(cs + row * CS_LD + c0);
    float b = p.spatial_b[g * 128 + row];
    u32 uu = *reinterpret_cast<const u32*>(p.gu + (size_t)t * 512 + g * 128 + c0);
    *reinterpret_cast<u32*>(p.ya + (size_t)t * 512 + g * 128 + c0) = pack_bf16(bf_lo(uu) * (v.x + b), bf_hi(uu) * (v.y + b));
  }
}

__device__ __forceinline__ void radix_select(const u32 (&key)[12], int rank, u32& Tout, int& krem_out) {
  u32 prefix = 0;
  int krem = rank;
  for (int b = 31; b >= 0; --b) {
    u32 cand = prefix | (1u << b);
    u32 himask = ~((1u << b) - 1u);
    int c = 0;
#pragma unroll
    for (int k = 0; k < 12; ++k) c += __popcll(__ballot((key[k] & himask) == cand));
    if (c >= krem) prefix = cand; else krem -= c;
  }
  Tout = prefix;
  krem_out = krem;
}

__device__ __forceinline__ void idx_load_keys(const Params& p, int tb, int jc, int kcol, int lane, bf16x8 (&bf)[4][2]) {
#pragma unroll
  for (int u = 0; u < 4; ++u) {
    const u16* kb = p.ki + (size_t)(tb + jc + 16 * u + kcol) * 64 + 8 * (lane >> 4);
    bf[u][0] = *reinterpret_cast<const bf16x8*>(kb);
    bf[u][1] = *reinterpret_cast<const bf16x8*>(kb + 32);
  }
}
__device__ __forceinline__ void idx_compact(u32* cv, u16* ci, int n, int lane, int& newcnt, float& newthr) {
  u32 key[12]; u16 idx[12];
#pragma unroll
  for (int k = 0; k < 12; ++k) {
    int e = lane + 64 * k;
    bool in = e < n;
    key[k] = in ? sortable(cv[e]) : 0u;
    idx[k] = in ? ci[e] : (u16)0;
  }
  u32 Tk; int krem;
  radix_select(key, 256, Tk, krem);
  int base = 0, tcnt = 0;
#pragma unroll
  for (int k = 0; k < 12; ++k) {
    bool eq = key[k] == Tk;
    unsigned long long meq = __ballot(eq);
    bool keep = (key[k] > Tk) || (eq && (tcnt + mbcnt64(meq)) < krem);
    unsigned long long m = __ballot(keep);
    int pos = base + mbcnt64(m);
    if (keep) { cv[pos] = unsortable(key[k]); ci[pos] = idx[k]; }
    base += __popcll(m);
    tcnt += __popcll(meq);
  }
  newcnt = base;
  newthr = __uint_as_float(unsortable(Tk));
}

__device__ void unit_indexer(const Params& p, char* smem, int unit, int mode = 0) {
  const int tid = threadIdx.x, lane = tid & 63, wid = tid >> 6;
  const int b = unit >> 10, grp = unit & 1023;
  const int tb = b * SEQ, i0 = grp * 16;
  u32* cval = reinterpret_cast<u32*>(smem);
  u16* cidx = reinterpret_cast<u16*>(smem + 16 * CAP * 4);
  __syncthreads();
  const int qsub = lane >> 4;
  const int ql = wid * 4 + qsub;
  const int iq = i0 + ql;
  const int kcol = lane & 15;
  bf16x8 afr[2];
  {
    const u16* qa = p.qi + ((size_t)(tb + i0 + wid * 4 + (kcol >> 2)) * 4 + (kcol & 3)) * 64 + 8 * (lane >> 4);
    afr[0] = *reinterpret_cast<const bf16x8*>(qa);
    afr[1] = *reinterpret_cast<const bf16x8*>(qa + 32);
  }
  const float4 w4 = *reinterpret_cast<const float4*>(p.wi + (size_t)(tb + iq) * 4);
  float thr = (mode == 1) ? INFINITY : -INFINITY;
  int cntr = 0;
  u32* myval = cval + ql * CAP;
  u16* myidx = cidx + ql * CAP;
  const u32 lowmask = (1u << kcol) - 1u;
  const int nchunks = (grp + 1 + 3) >> 2;

  auto process = [&](const bf16x8 (&bf)[4][2], int jc) {
#pragma unroll
    for (int u = 0; u < 4; ++u) {
      f32x4 acc = {0.f, 0.f, 0.f, 0.f};
      acc = __builtin_amdgcn_mfma_f32_16x16x32_bf16(afr[0], bf[u][0], acc, 0, 0, 0);
      acc = __builtin_amdgcn_mfma_f32_16x16x32_bf16(afr[1], bf[u][1], acc, 0, 0, 0);
      float s = 0.0f;
      s += w4.x * fmaxf(acc[0], 0.f);
      s += w4.y * fmaxf(acc[1], 0.f);
      s += w4.z * fmaxf(acc[2], 0.f);
      s += w4.w * fmaxf(acc[3], 0.f);
      s += 0.0f;
      int j = jc + 16 * u + kcol;
      bool ps = (j <= iq) && (s > thr);
      unsigned long long m = __ballot(ps);
      if (m) {
        u32 g16 = (u32)(m >> (16 * qsub)) & 0xFFFFu;
        int slot = cntr + __popc(g16 & lowmask);
        if (ps && slot < CAP) { myval[slot] = __float_as_uint(s); myidx[slot] = (u16)j; }
        cntr += __popc(g16);
      }
    }
    unsigned long long need = __ballot(cntr > CAP - 64);
    while (need) {
      int l = __ffsll((long long)need) - 1;
      int qc = l >> 4;
      need &= ~(0xFFFFull << (qc * 16));
      int qlc = wid * 4 + qc;
      int n = __builtin_amdgcn_readlane(cntr, qc * 16);
      if (n > CAP) n = CAP;
      int nc; float nt;
      if (mode == 3) { nc = 0; nt = thr; }
      else {
        idx_compact(cval + qlc * CAP, cidx + qlc * CAP, n, lane, nc, nt);
        if (mode == 4) idx_compact(cval + qlc * CAP, cidx + qlc * CAP, nc, lane, nc, nt);
      }
      if (qsub == qc) { thr = nt; cntr = nc; }
    }
  };

  bf16x8 bA[4][2], bB[4][2];
  idx_load_keys(p, tb, 0, kcol, lane, bA);
  for (int ch = 0; ch < nchunks; ch += 2) {
    if (ch + 1 < nchunks) idx_load_keys(p, tb, (ch + 1) * 64, kcol, lane, bB);
    process(bA, ch * 64);
    if (ch + 1 < nchunks) {
      if (ch + 2 < nchunks) idx_load_keys(p, tb, (ch + 2) * 64, kcol, lane, bA);
      process(bB, (ch + 1) * 64);
    }
  }
  if (mode) return;
  for (int qc = 0; qc < 4; ++qc) {
    int qlc = wid * 4 + qc;
    int n = __builtin_amdgcn_readlane(cntr, qc * 16);
    if (n > CAP) n = CAP;
    u32* cv = cval + qlc * CAP; u16* ci = cidx + qlc * CAP;
    u16* out = p.sel + (size_t)(tb + i0 + qlc) * 256;
    if (n <= 256) {
#pragma unroll
      for (int k = 0; k < 4; ++k) {
        int e = lane + 64 * k;
        out[e] = (e < n) ? ci[e] : (u16)0xFFFF;
      }
    } else {
      u32 key[12]; u16 idx[12];
#pragma unroll
      for (int k = 0; k < 12; ++k) {
        int e = lane + 64 * k;
        bool in = e < n;
        key[k] = in ? sortable(cv[e]) : 0u;
        idx[k] = in ? ci[e] : (u16)0;
      }
      u32 Tk; int krem;
      radix_select(key, 256, Tk, krem);
      int base = 0, tcnt = 0;
#pragma unroll
      for (int k = 0; k < 12; ++k) {
        bool eq = key[k] == Tk;
        unsigned long long meq = __ballot(eq);
        bool keep = (key[k] > Tk) || (eq && (tcnt + mbcnt64(meq)) < krem);
        unsigned long long m = __ballot(keep);
        int pos = base + mbcnt64(m);
        if (keep && pos < 256) out[pos] = idx[k];
        base += __popcll(m);
        tcnt += __popcll(meq);
      }
    }
  }
}

__device__ void phase_attn(const Params& p, char* smem) {
  const int tid = threadIdx.x, lane = tid & 63, wid = tid >> 6;
  u16* lidx = reinterpret_cast<u16*>(smem + wid * 4608);
  float* P = reinterpret_cast<float*>(smem + wid * 4608 + 512);
  const float scale = 0.08838834764831845f;
  for (int tq = blockIdx.x * 4 + wid; tq < T; tq += gridDim.x * 4) {
    const int b = tq / SEQ, i = tq - b * SEQ;
    const size_t tb = (size_t)b * SEQ;
    __builtin_amdgcn_wave_barrier();
    {
      uint2 v = *reinterpret_cast<const uint2*>(p.sel + (size_t)tq * 256 + lane * 4);
      *reinterpret_cast<uint2*>(lidx + lane * 4) = v;
    }
    __builtin_amdgcn_wave_barrier();
    bf16x8 qf[4];
    {
      int h = lane & 15;
#pragma unroll
      for (int s = 0; s < 4; ++s) {
        if (h < 4) qf[s] = *reinterpret_cast<const bf16x8*>(p.qh + (size_t)tq * 512 + h * 128 + 8 * (lane >> 4) + 32 * s);
        else qf[s] = (bf16x8){0, 0, 0, 0, 0, 0, 0, 0};
      }
    }
    float sv[16][4];
#pragma unroll
    for (int u = 0; u < 16; ++u) {
      int id = lidx[16 * u + (lane & 15)];
      bool valid = id <= i;
      int idc = valid ? id : 0;
      const u16* kr = p.kk + (tb + idc) * 128 + 8 * (lane >> 4);
      f32x4 acc = {0.f, 0.f, 0.f, 0.f};
#pragma unroll
      for (int s = 0; s < 4; ++s) {
        bf16x8 kf = *reinterpret_cast<const bf16x8*>(kr + 32 * s);
        acc = __builtin_amdgcn_mfma_f32_16x16x32_bf16(qf[s], kf, acc, 0, 0, 0);
      }
#pragma unroll
      for (int h = 0; h < 4; ++h) sv[u][h] = valid ? acc[h] * scale : -1e30f;
    }
    float mx[4], sm[4];
#pragma unroll
    for (int h = 0; h < 4; ++h) {
      float m = sv[0][h];
#pragma unroll
      for (int u = 1; u < 16; ++u) m = fmaxf(m, sv[u][h]);
#pragma unroll
      for (int d = 8; d >= 1; d >>= 1) m = fmaxf(m, __shfl_xor(m, d));
      mx[h] = m;
      float s = 0.f;
#pragma unroll
      for (int u = 0; u < 16; ++u) { sv[u][h] = __expf(sv[u][h] - m); s += sv[u][h]; }
#pragma unroll
      for (int d = 8; d >= 1; d >>= 1) s += __shfl_xor(s, d);
      sm[h] = 1.f / s;
    }
    if (lane < 16) {
#pragma unroll
      for (int u = 0; u < 16; ++u) {
        float4 o = {sv[u][0] * sm[0], sv[u][1] * sm[1], sv[u][2] * sm[2], sv[u][3] * sm[3]};
        *reinterpret_cast<float4*>(P + (16 * u + lane) * 4) = o;
      }
    }
    __builtin_amdgcn_wave_barrier();
    const int kg = lane >> 4, dc = lane & 15;
    float o[4][8];
#pragma unroll
    for (int h = 0; h < 4; ++h)
#pragma unroll
      for (int j = 0; j < 8; ++j) o[h][j] = 0.f;
#pragma unroll 4
    for (int it = 0; it < 64; ++it) {
      int n = it * 4 + kg;
      int id = lidx[n];
      int idc = (id <= i) ? id : 0;
      uint4 q = *reinterpret_cast<const uint4*>(p.vv + (tb + idc) * 128 + dc * 8);
      float4 pw = *reinterpret_cast<const float4*>(P + n * 4);
      float v[8] = {bf_lo(q.x), bf_hi(q.x), bf_lo(q.y), bf_hi(q.y), bf_lo(q.z), bf_hi(q.z), bf_lo(q.w), bf_hi(q.w)};
      float pv[4] = {pw.x, pw.y, pw.z, pw.w};
#pragma unroll
      for (int h = 0; h < 4; ++h)
#pragma unroll
        for (int j = 0; j < 8; ++j) o[h][j] += pv[h] * v[j];
    }
#pragma unroll
    for (int h = 0; h < 4; ++h)
#pragma unroll
      for (int j = 0; j < 8; ++j) {
        float x = o[h][j];
        x += __shfl_xor(x, 16);
        x += __shfl_xor(x, 32);
        o[h][j] = x;
      }
    if (kg == 0) {
#pragma unroll
      for (int h = 0; h < 4; ++h) {
        uint4 w = {pack_bf16(o[h][0], o[h][1]), pack_bf16(o[h][2], o[h][3]), pack_bf16(o[h][4], o[h][5]), pack_bf16(o[h][6], o[h][7])};
        *reinterpret_cast<uint4*>(p.yb + (size_t)tq * 512 + h * 128 + dc * 8) = w;
      }
    }
  }
}

__device__ void phase_merge(const Params& p, char* smem) {
  const int tid = threadIdx.x, lane = tid & 63, wid = tid >> 6;
  float* cs = reinterpret_cast<float*>(smem);
  constexpr int NTILES = (T / 128) * 8;
  for (int ti = blockIdx.x; ti < NTILES; ti += gridDim.x) {
    int mt = ti >> 3, nt = ti & 7;
    int m0 = mt * 128, n0 = nt * 128;
    f32x16 acc[2][2];
    zero_acc(acc);
    gemm_mainloop(p.ya + (size_t)m0 * 512, 512, p.WaT + (size_t)n0 * 512, 512, 512, acc, smem);
    stage_acc(acc, cs);
    __syncthreads();
#pragma unroll 4
    for (int rr = 0; rr < 32; ++rr) {
      int row = wid * 32 + rr;
      float2 v = *reinterpret_cast<const float2*>(cs + row * CS_LD + 2 * lane);
      u32 g = *reinterpret_cast<const u32*>(p.sg + (size_t)(m0 + row) * 2048 + n0 + 2 * lane);
      *reinterpret_cast<u32*>(p.merged + (size_t)(m0 + row) * 1024 + n0 + 2 * lane) = pack_bf16(v.x * bf_lo(g), v.y * bf_hi(g));
    }
    __syncthreads();
    zero_acc(acc);
    gemm_mainloop(p.yb + (size_t)m0 * 512, 512, p.WbT + (size_t)n0 * 512, 512, 512, acc, smem);
    stage_acc(acc, cs);
    __syncthreads();
#pragma unroll 4
    for (int rr = 0; rr < 32; ++rr) {
      int row = wid * 32 + rr;
      float2 v = *reinterpret_cast<const float2*>(cs + row * CS_LD + 2 * lane);
      u32 g = *reinterpret_cast<const u32*>(p.sg + (size_t)(m0 + row) * 2048 + 1024 + n0 + 2 * lane);
      u32* mp = reinterpret_cast<u32*>(p.merged + (size_t)(m0 + row) * 1024 + n0 + 2 * lane);
      u32 pa = *mp;
      *mp = pack_bf16(bf_lo(pa) + v.x * bf_lo(g), bf_hi(pa) + v.y * bf_hi(g));
    }
    __syncthreads();
  }
}

__device__ void phase_wo(const Params& p, char* smem) {
  const int tid = threadIdx.x, lane = tid & 63, wid = tid >> 6;
  float* cs = reinterpret_cast<float*>(smem);
  constexpr int NTILES = (T / 128) * 8;
  for (int ti = blockIdx.x; ti < NTILES; ti += gridDim.x) {
    int mt = ti >> 3, nt = ti & 7;
    int m0 = mt * 128, n0 = nt * 128;
    f32x16 acc[2][2];
    zero_acc(acc);
    gemm_mainloop(p.merged + (size_t)m0 * 1024, 1024, p.WoT + (size_t)n0 * 1024, 1024, 1024, acc, smem);
    stage_acc(acc, cs);
    __syncthreads();
    for (int rr = 0; rr < 32; ++rr) {
      int row = wid * 32 + rr;
      size_t t = m0 + row;
      float2 v = *reinterpret_cast<const float2*>(cs + row * CS_LD + 2 * lane);
      float2 xv = *reinterpret_cast<const float2*>(p.x + t * 1024 + n0 + 2 * lane);
      float h0 = xv.x + v.x, h1 = xv.y + v.y;
      *reinterpret_cast<float2*>(p.out + t * 1024 + n0 + 2 * lane) = make_float2(h0, h1);
      *reinterpret_cast<u32*>(p.h1b + t * 1024 + n0 + 2 * lane) = pack_bf16(h0, h1);
      float ss = wave_sum(h0 * h0 + h1 * h1);
      if (lane == 0) p.ssq[(size_t)nt * T + t] = ss;
    }
    __syncthreads();
  }
}

__device__ __forceinline__ void ins16(float (&l)[16], float v) {
#pragma unroll
  for (int q = 15; q >= 1; --q) l[q] = __builtin_amdgcn_fmed3f(v, l[q - 1], l[q]);
  l[0] = fmaxf(l[0], v);
}
__device__ void phase_peerq(const Params& p, char* smem) {
  const int tid = threadIdx.x, lane = tid & 63, wid = tid >> 6;
  const int wr = wid >> 1, wc = wid & 1;
  float* cs = reinterpret_cast<float*>(smem);
  constexpr int NTILES = (T / 128) * 16;
  for (int ti = blockIdx.x; ti < NTILES; ti += gridDim.x) {
    int mt = ti >> 4, hp = ti & 15;
    int m0 = mt * 128;
    f32x16 acc[2][2];
    zero_acc(acc);
    gemm_mainloop(p.h1b + (size_t)m0 * 1024, 1024, p.WqT + (size_t)hp * 128 * 1024, 1024, 1024, acc, smem);
#pragma unroll
    for (int i = 0; i < 2; ++i)
#pragma unroll
      for (int j = 0; j < 2; ++j)
#pragma unroll
        for (int r = 0; r < 16; ++r) {
          int row = wr * 64 + i * 32 + (r & 3) + 8 * (r >> 2) + 4 * (lane >> 5);
          int col = wc * 64 + j * 32 + (lane & 31);
          *reinterpret_cast<u16*>(smem + (col >> 6) * ABUF + row * 144 + (col & 63) * 2) = f2bf(acc[i][j][r]);
        }
    {
      const u16* sk = p.SubK + (size_t)hp * 128 * 128;
#pragma unroll
      for (int i = 0; i < 8; ++i) {
        int c = tid + 256 * i;
        int row = c >> 4, kc = c & 15;
        uint4 q = *reinterpret_cast<const uint4*>(sk + row * 128 + kc * 8);
        *reinterpret_cast<uint4*>(smem + (2 + (kc >> 3)) * ABUF + row * 144 + (kc & 7) * 16) = q;
      }
    }
    __syncthreads();
    zero_acc(acc);
    mma_ktile(smem, smem + 2 * ABUF, acc);
    mma_ktile(smem + ABUF, smem + 3 * ABUF, acc);
    __syncthreads();
    stage_acc(acc, cs);
    __syncthreads();
    {
      int row = tid >> 1, half = tid & 1;
      float* rp = cs + row * CS_LD + half * 64;
      float l[16];
#pragma unroll
      for (int q = 0; q < 16; ++q) l[q] = -INFINITY;
      for (int c = 0; c < 64; c += 4) {
        float4 v4 = *reinterpret_cast<const float4*>(rp + c);
        float vv[4] = {v4.x, v4.y, v4.z, v4.w};
#pragma unroll
        for (int e = 0; e < 4; ++e) {
          u32 bits = __float_as_uint(vv[e]);
          u32 n = (u32)(half * 64 + c + e);
          bits = (bits & ~127u) | ((bits >> 31) ? n : (127u - n));
          ins16(l, __uint_as_float(bits));
        }
      }
#pragma unroll
      for (int q = 0; q < 16; ++q) rp[q] = l[q];
    }
    __syncthreads();
    if (tid < 128) {
      int row = tid;
      size_t t = (size_t)m0 + row;
      const float* la = cs + row * CS_LD;
      const float* lb = la + 64;
      float ssum = 0.f;
#pragma unroll
      for (int q = 0; q < 8; ++q) ssum += p.ssq[(size_t)q * T + t];
      float rt = rsqrtf(ssum * (1.f / 1024.f) + EPS);
      int ia = 0, ib = 0;
      float* ov = p.stv + ((size_t)hp * T + t) * 16;
      u8* oi = p.sti + ((size_t)hp * T + t) * 16;
      for (int q = 0; q < 16; ++q) {
        float va = la[ia], vb = lb[ib];
        bool ta = va >= vb;
        float v = ta ? va : vb;
        ia += ta ? 1 : 0;
        ib += ta ? 0 : 1;
        u32 bits = __float_as_uint(v);
        u32 low = bits & 127u;
        u32 n = (bits >> 31) ? low : (127u - low);
        ov[q] = __uint_as_float(bits & ~127u) * rt;
        oi[q] = (u8)n;
      }
    }
    __syncthreads();
  }
}

__device__ void phase_peer(const Params& p, char* smem) {
  const int tid = threadIdx.x, lane = tid & 63, wid = tid >> 6;
  int* pe_e = reinterpret_cast<int*>(smem + wid * 2048);
  float* pe_su = reinterpret_cast<float*>(smem + wid * 2048 + 512);
  float* pe_gv = reinterpret_cast<float*>(smem + wid * 2048 + 1024);
  for (int tq = blockIdx.x * 4 + wid; tq < T; tq += gridDim.x * 4) {
    const size_t t = tq;
    const int h = lane >> 3, g = lane & 7;
    const float* s1 = p.stv + ((size_t)(2 * h) * T + t) * 16;
    const float* s2 = s1 + (size_t)T * 16;
    float l[16];
#pragma unroll
    for (int q = 0; q < 16; ++q) l[q] = -INFINITY;
#pragma unroll
    for (int c = 0; c < 7; ++c) {
      u32 pr = PAIR_TAB[g * 7 + c];
      float v = -INFINITY;
      if (pr != 0xffu) {
        float a = s1[pr >> 4] + s2[pr & 15];
        u32 bits = __float_as_uint(a);
        bits = (bits & ~255u) | ((bits >> 31) ? pr : (255u - pr));
        v = __uint_as_float(bits);
      }
      ins16(l, v);
    }
#pragma unroll
    for (int msk = 1; msk <= 4; msk <<= 1) {
      float c[16];
#pragma unroll
      for (int q = 0; q < 16; ++q) c[q] = __shfl_xor(l[15 - q], msk);
#pragma unroll
      for (int q = 0; q < 16; ++q) c[q] = fmaxf(l[q], c[q]);
#pragma unroll
      for (int st = 8; st >= 1; st >>= 1)
#pragma unroll
        for (int q = 0; q < 16; ++q)
          if ((q & st) == 0) {
            float hi = fmaxf(c[q], c[q + st]), lo = fminf(c[q], c[q + st]);
            c[q] = hi; c[q + st] = lo;
          }
#pragma unroll
      for (int q = 0; q < 16; ++q) l[q] = c[q];
    }
    {
      float bv[16]; int pr[16];
      float m = -INFINITY;
#pragma unroll
      for (int q = 0; q < 16; ++q) {
        u32 bits = __float_as_uint(l[q]);
        u32 low = bits & 255u;
        pr[q] = (int)((bits >> 31) ? low : (255u - low));
        bv[q] = s1[pr[q] >> 4] + s2[pr[q] & 15];
        m = fmaxf(m, bv[q]);
      }
      float ssum = 0.f;
#pragma unroll
      for (int q = 0; q < 16; ++q) { bv[q] = __expf(bv[q] - m); ssum += bv[q]; }
      float inv = 1.f / ssum;
      const u8* i1 = p.sti + ((size_t)(2 * h) * T + t) * 16;
      const u8* i2 = i1 + (size_t)T * 16;
      __builtin_amdgcn_wave_barrier();
#pragma unroll
      for (int q = 0; q < 16; ++q) {
        if ((q >> 1) == g) {
          int exi = (int)i1[pr[q] >> 4] * 128 + (int)i2[pr[q] & 15];
          pe_e[h * 16 + q] = exi;
          pe_su[h * 16 + q] = p.su[exi];
          pe_gv[h * 16 + q] = bv[q] * inv * p.sv[exi];
        }
      }
      __builtin_amdgcn_wave_barrier();
    }
    float rt;
    {
      float ssum = 0.f;
#pragma unroll
      for (int q = 0; q < 8; ++q) ssum += p.ssq[(size_t)q * T + t];
      rt = rsqrtf(ssum * (1.f / 1024.f) + EPS);
    }
    float2_t h2[8];
    {
      uint4 hx0 = *reinterpret_cast<const uint4*>(p.h1b + t * 1024 + lane * 16);
      uint4 hx1 = *reinterpret_cast<const uint4*>(p.h1b + t * 1024 + lane * 16 + 8);
      u32 hw[8] = {hx0.x, hx0.y, hx0.z, hx0.w, hx1.x, hx1.y, hx1.z, hx1.w};
#pragma unroll
      for (int q = 0; q < 8; ++q) { h2[q].x = bf_lo(hw[q]); h2[q].y = bf_hi(hw[q]); }
    }
    float2_t y2[8];
#pragma unroll
    for (int q = 0; q < 8; ++q) { y2[q].x = 0.f; y2[q].y = 0.f; }
    const int kk = (lane >> 3) & 7;
    for (int e0 = 0; e0 < 128; e0 += 8) {
      uint4 ur[8], vr[8];
#pragma unroll
      for (int k = 0; k < 8; ++k) {
        int ex = pe_e[e0 + k];
        ur[k] = *reinterpret_cast<const uint4*>(p.U8 + (size_t)ex * 1024 + lane * 16);
        vr[k] = *reinterpret_cast<const uint4*>(p.V8 + (size_t)ex * 1024 + lane * 16);
      }
      float d[8];
#pragma unroll
      for (int k = 0; k < 8; ++k) {
        u32 uw[4] = {ur[k].x, ur[k].y, ur[k].z, ur[k].w};
        float2_t acc = {0.f, 0.f};
#pragma unroll
        for (int q = 0; q < 4; ++q) {
          acc += __builtin_amdgcn_cvt_pk_f32_fp8((int)uw[q], false) * h2[2 * q];
          acc += __builtin_amdgcn_cvt_pk_f32_fp8((int)uw[q], true) * h2[2 * q + 1];
        }
        d[k] = acc.x + acc.y;
      }
      float e4[4], f2[2], gsum;
      {
        const bool hi = (lane & 32) != 0;
#pragma unroll
        for (int k = 0; k < 4; ++k) {
          float snd = hi ? d[k] : d[k + 4], kp = hi ? d[k + 4] : d[k];
          e4[k] = kp + __shfl_xor(snd, 32);
        }
        const bool hb = (lane & 16) != 0;
#pragma unroll
        for (int k = 0; k < 2; ++k) {
          float snd = hb ? e4[k] : e4[k + 2], kp = hb ? e4[k + 2] : e4[k];
          f2[k] = kp + __shfl_xor(snd, 16);
        }
        const bool hc = (lane & 8) != 0;
        float snd = hc ? f2[0] : f2[1], kp = hc ? f2[1] : f2[0];
        gsum = kp + __shfl_xor(snd, 8);
        gsum += __shfl_xor(gsum, 4);
        gsum += __shfl_xor(gsum, 2);
        gsum += __shfl_xor(gsum, 1);
      }
      float cme = pe_gv[e0 + kk] * gelu_f(gsum * rt * pe_su[e0 + kk]);
#pragma unroll
      for (int k = 0; k < 8; ++k) {
        float ck = __int_as_float(__builtin_amdgcn_readlane(__float_as_int(cme), k * 8));
        float2_t c2 = {ck, ck};
        u32 vw[4] = {vr[k].x, vr[k].y, vr[k].z, vr[k].w};
#pragma unroll
        for (int q = 0; q < 4; ++q) {
          y2[2 * q] += c2 * __builtin_amdgcn_cvt_pk_f32_fp8((int)vw[q], false);
          y2[2 * q + 1] += c2 * __builtin_amdgcn_cvt_pk_f32_fp8((int)vw[q], true);
        }
      }
    }
    float* op = p.out + t * 1024 + lane * 16;
#pragma unroll
    for (int q = 0; q < 4; ++q) {
      float4 a = *reinterpret_cast<const float4*>(op + 4 * q);
      a.x += y2[2 * q].x; a.y += y2[2 * q].y; a.z += y2[2 * q + 1].x; a.w += y2[2 * q + 1].y;
      *reinterpret_cast<float4*>(op + 4 * q) = a;
    }
    __builtin_amdgcn_wave_barrier();
  }
}

#ifndef PROBE_DUP
#define PROBE_DUP -1
#endif
__device__ void phase_mix(const Params& p, char* smem) {
  const int G = gridDim.x;
  for (int rep = 0; rep < ((PROBE_DUP == 20 || PROBE_DUP >= 23) ? 2 : 1); ++rep)
  for (int s0 = 0, r = 0; s0 < 2048; s0 += G, ++r) {
    int off = (r & 1) ? (G - 1 - (int)blockIdx.x) : (int)blockIdx.x;
    int s = s0 + off;
    if (s < 2048) {
      int grp = 1023 - (s >> 1), b = s & 1;
      unit_indexer(p, smem, (b << 10) | grp, (PROBE_DUP >= 23 && rep == 0) ? (PROBE_DUP - 22) : 0);
    }
  }
  for (int rep = 0; rep < (PROBE_DUP == 21 ? 2 : 1); ++rep)
  for (int u = blockIdx.x; u < 1024; u += G) unit_spatial(p, smem, u);
  for (int rep = 0; rep < (PROBE_DUP == 22 ? 2 : 1); ++rep)
  for (int u = blockIdx.x; u < 256; u += G) unit_kv(p, smem, u);
}

template <int PH>
__device__ __forceinline__ void run_phase(const Params& p, char* smem) {
  if (PH == 0) phase_prep(p, smem);
  else if (PH == 1) phase_gemm1(p, smem);
  else if (PH == 2) phase_mix(p, smem);
  else if (PH == 3) phase_attn(p, smem);
  else if (PH == 4) phase_merge(p, smem);
  else if (PH == 5) phase_wo(p, smem);
  else if (PH == 6) phase_peerq(p, smem);
  else phase_peer(p, smem);
}

template <int PH>
__global__ void __launch_bounds__(NTHREADS, 2) phase_kernel(Params p) {
  __shared__ __attribute__((aligned(16))) char smem[SMEM_BYTES];
  run_phase<PH>(p, smem);
}

__global__ void __launch_bounds__(NTHREADS, 2) mega_kernel(Params p) {
  __shared__ __attribute__((aligned(16))) char smem[SMEM_BYTES];
  cg::grid_group grid = cg::this_grid();
#ifdef EXP_ZERO
  for (int i = threadIdx.x; i < SMEM_BYTES / 4; i += NTHREADS) reinterpret_cast<u32*>(smem)[i] = 0u;
  __syncthreads();
#endif
#define GSYNC() do { asm volatile("s_waitcnt vmcnt(0)" ::: "memory"); grid.sync(); } while (0)
#define RUNP(X) run_phase<X>(p, smem); GSYNC(); if (PROBE_DUP == X) { run_phase<X>(p, smem); GSYNC(); }
  RUNP(0) RUNP(1) RUNP(2) RUNP(3) RUNP(4) RUNP(5) RUNP(6)
  run_phase<7>(p, smem);
}

extern "C" void kernel_launch(void* const* d_in, const int* in_sizes, int n_in, void* d_out, int out_size,
                              void* d_ws, size_t ws_size, hipStream_t stream) {
  Params p{};
  p.x = (const float*)d_in[0]; p.pos = (const int*)d_in[1];
  p.norm1_g = (const float*)d_in[2]; p.w_in = (const float*)d_in[3]; p.v_norm_g = (const float*)d_in[4];
  p.v_norm_b = (const float*)d_in[5]; p.spatial_w = (const float*)d_in[6]; p.spatial_b = (const float*)d_in[7];
  p.kv_norm_g = (const float*)d_in[8]; p.w_uk = (const float*)d_in[9]; p.w_uv = (const float*)d_in[10];
  p.q_norm_g = (const float*)d_in[11]; p.k_norm_g = (const float*)d_in[12]; p.w_a_out = (const float*)d_in[13];
  p.w_b_out = (const float*)d_in[14]; p.w_o = (const float*)d_in[15]; p.norm2_g = (const float*)d_in[16];
  p.peer_wq = (const float*)d_in[17]; p.peer_subkeys = (const float*)d_in[18]; p.peer_u = (const float*)d_in[19];
  p.peer_v = (const float*)d_in[20];
  p.out = (float*)d_out;
  char* w = (char*)d_ws;
  size_t off = 0;
  auto take = [&](size_t bytes) { char* r = w + off; off += (bytes + 255) & ~(size_t)255; return r; };
  const size_t MB = 1u << 20;
  char* r_xn = take(64 * MB);
  p.xn = (u16*)r_xn; p.ya = (u16*)r_xn; p.yb = (u16*)(r_xn + 32 * MB);
  p.WinT = (u16*)take((size_t)NWIN * 1024 * 2);
  p.WaT = (u16*)take(1024 * 512 * 2); p.WbT = (u16*)take(1024 * 512 * 2);
  p.WoT = (u16*)take(1024 * 1024 * 2); p.WqT = (u16*)take(2048 * 1024 * 2);
  p.WkvT = (u16*)take(256 * 256 * 2); p.SubK = (u16*)take(262144 * 2); p.Wtril = (u16*)take(65536 * 2);
  p.U8 = (u8*)take(16 * MB); p.V8 = (u8*)take(16 * MB);
  p.su = (float*)take(16384 * 4); p.sv = (float*)take(16384 * 4);
  char* r_g = take(96 * MB);
  p.gu = (u16*)r_g; p.gv = (u16*)(r_g + 32 * MB); p.qh = (u16*)(r_g + 64 * MB); p.merged = (u16*)r_g;
  p.ckv = (u16*)take(16 * MB); p.qi = (u16*)take(16 * MB); p.ki = (u16*)take(4 * MB);
  p.wi = (float*)take((size_t)T * 4 * 4);
  char* r_sg = take(128 * MB);
  p.sg = (u16*)r_sg; p.h1b = (u16*)r_sg; p.stv = (float*)(r_sg + 64 * MB); p.sti = (u8*)(r_sg + 96 * MB);
  p.kk = (u16*)take(8 * MB); p.vv = (u16*)take(8 * MB); p.sel = (u16*)take(16 * MB);
  p.ssq = (float*)take((size_t)T * 8 * 4);
  if (off > ws_size) { fprintf(stderr, "workspace too small: need %zu have %zu\n", off, ws_size); return; }

  static int grid_blocks = 0;
  if (!grid_blocks) {
    int dev = 0, cus = 0, per_cu = 0;
    hipGetDevice(&dev);
    hipDeviceGetAttribute(&cus, hipDeviceAttributeMultiprocessorCount, dev);
    hipOccupancyMaxActiveBlocksPerMultiprocessor(&per_cu, mega_kernel, NTHREADS, 0);
    if (per_cu > 2) per_cu = 2;
    if (per_cu < 1) per_cu = 1;
    grid_blocks = cus * per_cu;
  }
#ifdef EXP_ZERO
  hipMemsetAsync(d_ws, 0, off, stream);
#endif
#if MULTI_LAUNCH
  dim3 g(grid_blocks), b(NTHREADS);
  phase_kernel<0><<<g, b, 0, stream>>>(p);
  phase_kernel<1><<<g, b, 0, stream>>>(p);
  phase_kernel<2><<<g, b, 0, stream>>>(p);
  phase_kernel<3><<<g, b, 0, stream>>>(p);
  phase_kernel<4><<<g, b, 0, stream>>>(p);
  phase_kernel<5><<<g, b, 0, stream>>>(p);
  phase_kernel<6><<<g, b, 0, stream>>>(p);
  phase_kernel<7><<<g, b, 0, stream>>>(p);
#else
  void* args[] = {&p};
  hipError_t e = hipLaunchCooperativeKernel((void*)mega_kernel, dim3(grid_blocks), dim3(NTHREADS), args, 0, stream);
  if (e != hipSuccess) fprintf(stderr, "cooperative launch failed: %s (grid %d)\n", hipGetErrorString(e), grid_blocks);
#endif
}
```

```cpp
#include <hip/hip_runtime.h>
#include <hip/hip_cooperative_groups.h>
#include <stdint.h>
#include <cstdio>
namespace cg = cooperative_groups;

#ifndef MULTI_LAUNCH
#define MULTI_LAUNCH 0
#endif

typedef unsigned short u16;
typedef unsigned int u32;
typedef unsigned char u8;
using bf16x8 = __attribute__((ext_vector_type(8))) short;
using f32x4 = __attribute__((ext_vector_type(4))) float;
using f32x16 = __attribute__((ext_vector_type(16))) float;
typedef __bf16 bf16x2_t __attribute__((ext_vector_type(2)));
typedef float float2_t __attribute__((ext_vector_type(2)));

constexpr int BATCH = 2, SEQ = 16384, DM = 1024, T = BATCH * SEQ;
constexpr int NWIN = 4224;
constexpr int NTHREADS = 256;
constexpr float EPS = 1e-6f;
constexpr int ABUF = 128 * 144;
constexpr int CS_LD = 132;
constexpr int SMEM_BYTES = 77824;
constexpr int EXTRA_OFF = 4 * ABUF;
constexpr int CAP = 768;

__constant__ float INV32[16] = {1.000000000e+00f, 4.403665960e-01f, 1.939227432e-01f, 8.539710194e-02f, 3.760603070e-02f, 1.656043902e-02f, 7.292664610e-03f, 3.211445874e-03f, 1.414213562e-03f, 6.227723788e-04f, 2.742481884e-04f, 1.207697351e-04f, 5.318296098e-05f, 2.341999971e-05f, 1.031338616e-05f, 4.541670478e-06f};
__constant__ float INV16[8] = {1.000000000e+00f, 1.939227432e-01f, 3.760603070e-02f, 7.292664610e-03f, 1.414213562e-03f, 2.742481884e-04f, 5.318296098e-05f, 1.031338616e-05f};
__constant__ u8 PAIR_TAB[56] = {
  0x00,0x01,0x02,0x03,0x04,0x05,0x06,0x07,0x08,0x09,0x0a,0x0b,0x0c,0x0d,0x0e,0x0f,
  0x10,0x11,0x12,0x13,0x14,0x15,0x16,0x17,
  0x20,0x21,0x22,0x23,0x24,
  0x30,0x31,0x32,0x33,
  0x40,0x41,0x42,
  0x50,0x51,
  0x60,0x61,
  0x70,0x71,
  0x80,0x90,0xa0,0xb0,0xc0,0xd0,0xe0,0xf0,
  0xff,0xff,0xff,0xff,0xff,0xff};

struct Params {
  const float* x; const int* pos;
  const float *norm1_g, *w_in, *v_norm_g, *v_norm_b, *spatial_w, *spatial_b, *kv_norm_g, *w_uk, *w_uv,
      *q_norm_g, *k_norm_g, *w_a_out, *w_b_out, *w_o, *norm2_g, *peer_wq, *peer_subkeys, *peer_u, *peer_v;
  float* out;
  u16 *xn, *WinT, *WaT, *WbT, *WoT, *WqT, *WkvT, *SubK, *Wtril;
  u8 *U8, *V8, *kv8;
  float *su, *sv, *scal;
  u16 *gu, *gv, *qh, *ckv, *qi, *ki, *sg, *kk, *vv, *ya, *yb, *merged, *h1b, *sel;
  float *wi, *ssq, *stv, *rtab;
  u8* sti;
  unsigned* bar;
};

__device__ __forceinline__ u32 pack_bf16(float a, float b) {
  float2_t v = {a, b};
  bf16x2_t r = __builtin_convertvector(v, bf16x2_t);
  return __builtin_bit_cast(u32, r);
}
__device__ __forceinline__ u16 f2bf(float a) { return (u16)(pack_bf16(a, 0.f) & 0xffffu); }
__device__ __forceinline__ float bf_lo(u32 u) { return __uint_as_float(u << 16); }
__device__ __forceinline__ float bf_hi(u32 u) { return __uint_as_float(u & 0xffff0000u); }
__device__ __forceinline__ float bf2f(u16 h) { return __uint_as_float(((u32)h) << 16); }
__device__ __forceinline__ float wave_sum(float v) {
#pragma unroll
  for (int m = 32; m >= 1; m >>= 1) v += __shfl_xor(v, m);
  return v;
}
__device__ __forceinline__ float gelu_f(float x) {
  float z = -2.3022082f * (x + 0.044715f * x * x * x);
  return x * __builtin_amdgcn_rcpf(1.f + __builtin_amdgcn_exp2f(z));
}
__device__ __forceinline__ float sigmoid_f(float x) { return __builtin_amdgcn_rcpf(1.f + __builtin_amdgcn_exp2f(-1.4426950408889634f * x)); }
__device__ __forceinline__ u32 sortable(u32 b) { return b ^ ((u32)((int)b >> 31) | 0x80000000u); }
__device__ __forceinline__ u32 unsortable(u32 k) { return k ^ ((k & 0x80000000u) ? 0x80000000u : 0xffffffffu); }
__device__ __forceinline__ int mbcnt64(unsigned long long m) {
  return __builtin_amdgcn_mbcnt_hi((u32)(m >> 32), __builtin_amdgcn_mbcnt_lo((u32)m, 0));
}

__device__ __forceinline__ void load8(const float* p, float (&v)[8]) {
  float4 a = *reinterpret_cast<const float4*>(p), b = *reinterpret_cast<const float4*>(p + 4);
  v[0] = a.x; v[1] = a.y; v[2] = a.z; v[3] = a.w; v[4] = b.x; v[5] = b.y; v[6] = b.z; v[7] = b.w;
}
__device__ __forceinline__ void unpack8(uint4 q, float (&v)[8]) {
  v[0] = bf_lo(q.x); v[1] = bf_hi(q.x); v[2] = bf_lo(q.y); v[3] = bf_hi(q.y);
  v[4] = bf_lo(q.z); v[5] = bf_hi(q.z); v[6] = bf_lo(q.w); v[7] = bf_hi(q.w);
}
__device__ __forceinline__ uint4 pack8(const float (&v)[8]) {
  uint4 o = {pack_bf16(v[0], v[1]), pack_bf16(v[2], v[3]), pack_bf16(v[4], v[5]), pack_bf16(v[6], v[7])};
  return o;
}
#define DPPF(v, ctrl) __int_as_float(__builtin_amdgcn_update_dpp(0, __float_as_int(v), (ctrl), 0xF, 0xF, true))
__device__ __forceinline__ float sum16(float x) {
  x += DPPF(x, 0xB1); x += DPPF(x, 0x4E); x += DPPF(x, 0x141); x += DPPF(x, 0x140);
  return x;
}
__device__ __forceinline__ float max16(float x) {
  x = fmaxf(x, DPPF(x, 0xB1)); x = fmaxf(x, DPPF(x, 0x4E)); x = fmaxf(x, DPPF(x, 0x141)); x = fmaxf(x, DPPF(x, 0x140));
  return x;
}
__device__ __forceinline__ void rope32_8(float (&v)[8], int L, const float* tab) {
  float pr[8];
#pragma unroll
  for (int e = 0; e < 8; ++e) pr[e] = __shfl_xor(v[e], 2);
  if (L < 4) {
    float c[8], s[8];
    load8(tab + (L & 1) * 8, c);
    load8(tab + 16 + (L & 1) * 8, s);
#pragma unroll
    for (int e = 0; e < 8; ++e) v[e] = (L < 2) ? (v[e] * c[e] - pr[e] * s[e]) : (v[e] * c[e] + pr[e] * s[e]);
  }
}
__device__ __forceinline__ void rope16_8(float (&v)[8], int lc0, const float* tab) {
  float pr[8];
#pragma unroll
  for (int e = 0; e < 8; ++e) pr[e] = __shfl_xor(v[e], 1);
  if (lc0 < 16) {
    float c[8], s[8];
    load8(tab + 32, c);
    load8(tab + 40, s);
#pragma unroll
    for (int e = 0; e < 8; ++e) v[e] = (lc0 == 0) ? (v[e] * c[e] - pr[e] * s[e]) : (v[e] * c[e] + pr[e] * s[e]);
  }
}

typedef u32 u32x4 __attribute__((ext_vector_type(4)));
struct Tile4 { u32x4 v0, v1, v2, v3; };
__device__ __forceinline__ void gemm_load_tile(const u16* __restrict__ g, int ld, int k0, Tile4& r) {
  const int tid = threadIdx.x;
  const int row = tid >> 3, kc = tid & 7;
  const u16* base = g + (size_t)row * ld + k0 + kc * 8;
  r.v0 = *reinterpret_cast<const u32x4*>(base);
  r.v1 = *reinterpret_cast<const u32x4*>(base + (size_t)32 * ld);
  r.v2 = *reinterpret_cast<const u32x4*>(base + (size_t)64 * ld);
  r.v3 = *reinterpret_cast<const u32x4*>(base + (size_t)96 * ld);
}
__device__ __forceinline__ void gemm_store_tile(char* buf, const Tile4& r) {
  const int tid = threadIdx.x;
  const int row = tid >> 3, kc = tid & 7;
  char* base = buf + row * 144 + kc * 16;
  *reinterpret_cast<u32x4*>(base) = r.v0;
  *reinterpret_cast<u32x4*>(base + 32 * 144) = r.v1;
  *reinterpret_cast<u32x4*>(base + 64 * 144) = r.v2;
  *reinterpret_cast<u32x4*>(base + 96 * 144) = r.v3;
}
__device__ __forceinline__ void mma_ktile(const char* sa, const char* sb, f32x16 (&acc)[2][2]) {
  const int lane = threadIdx.x & 63, wid = threadIdx.x >> 6;
  const int wr = wid >> 1, wc = wid & 1;
  const int r32 = lane & 31, hf = lane >> 5;
  const char* pa = sa + (wr * 64 + r32) * 144 + hf * 16;
  const char* pb = sb + (wc * 64 + r32) * 144 + hf * 16;
  bf16x8 a0[2], b0[2], a1[2], b1[2];
#pragma unroll
  for (int i = 0; i < 2; ++i) {
    a0[i] = *reinterpret_cast<const bf16x8*>(pa + i * 32 * 144);
    b0[i] = *reinterpret_cast<const bf16x8*>(pb + i * 32 * 144);
  }
#pragma unroll
  for (int s = 0; s < 4; s += 2) {
#pragma unroll
    for (int i = 0; i < 2; ++i) {
      a1[i] = *reinterpret_cast<const bf16x8*>(pa + i * 32 * 144 + (s + 1) * 32);
      b1[i] = *reinterpret_cast<const bf16x8*>(pb + i * 32 * 144 + (s + 1) * 32);
    }
    __builtin_amdgcn_s_setprio(1);
#pragma unroll
    for (int i = 0; i < 2; ++i)
#pragma unroll
      for (int j = 0; j < 2; ++j)
        acc[i][j] = __builtin_amdgcn_mfma_f32_32x32x16_bf16(a0[i], b0[j], acc[i][j], 0, 0, 0);
    __builtin_amdgcn_s_setprio(0);
    if (s + 2 < 4) {
#pragma unroll
      for (int i = 0; i < 2; ++i) {
        a0[i] = *reinterpret_cast<const bf16x8*>(pa + i * 32 * 144 + (s + 2) * 32);
        b0[i] = *reinterpret_cast<const bf16x8*>(pb + i * 32 * 144 + (s + 2) * 32);
      }
    }
    __builtin_amdgcn_s_setprio(1);
#pragma unroll
    for (int i = 0; i < 2; ++i)
#pragma unroll
      for (int j = 0; j < 2; ++j)
        acc[i][j] = __builtin_amdgcn_mfma_f32_32x32x16_bf16(a1[i], b1[j], acc[i][j], 0, 0, 0);
    __builtin_amdgcn_s_setprio(0);
  }
}
#define GEMM_KT(i, nk) ((((i) + ((int)(blockIdx.x >> 3))) & ((nk) - 1)) << 6)
__device__ __forceinline__ void gemm_prefetch(const u16* __restrict__ A, int lda, const u16* __restrict__ B, int ldb, int K, Tile4& ra, Tile4& rb) {
  const int nk = K >> 6;
  gemm_load_tile(A, lda, GEMM_KT(0, nk), ra);
  gemm_load_tile(B, ldb, GEMM_KT(0, nk), rb);
}
__device__ __forceinline__ void gemm_mainloop(const u16* __restrict__ A, int lda, const u16* __restrict__ B, int ldb,
                                              int K, f32x16 (&acc)[2][2], char* smem, Tile4& ra, Tile4& rb) {
  const int nk = K >> 6;
  __syncthreads();
  gemm_store_tile(smem, ra);
  gemm_store_tile(smem + 2 * ABUF, rb);
  __syncthreads();
#pragma unroll 1
  for (int kt = 0; kt < nk; ++kt) {
    const int cur = kt & 1;
    if (kt + 1 < nk) {
      gemm_load_tile(A, lda, GEMM_KT(kt + 1, nk), ra);
      gemm_load_tile(B, ldb, GEMM_KT(kt + 1, nk), rb);
    }
    mma_ktile(smem + cur * ABUF, smem + (2 + cur) * ABUF, acc);
    if (kt + 1 < nk) {
      gemm_store_tile(smem + (cur ^ 1) * ABUF, ra);
      gemm_store_tile(smem + (2 + (cur ^ 1)) * ABUF, rb);
    }
    __syncthreads();
  }
}
__device__ __forceinline__ void zero_acc(f32x16 (&acc)[2][2]) {
#pragma unroll
  for (int i = 0; i < 2; ++i)
#pragma unroll
    for (int j = 0; j < 2; ++j)
#pragma unroll
      for (int r = 0; r < 16; ++r) acc[i][j][r] = 0.f;
}
__device__ __forceinline__ void stage_acc(const f32x16 (&acc)[2][2], float* cs) {
  const int lane = threadIdx.x & 63, wid = threadIdx.x >> 6;
  const int wr = wid >> 1, wc = wid & 1;
#pragma unroll
  for (int i = 0; i < 2; ++i)
#pragma unroll
    for (int j = 0; j < 2; ++j)
#pragma unroll
      for (int r = 0; r < 16; ++r) {
        int row = wr * 64 + i * 32 + (r & 3) + 8 * (r >> 2) + 4 * (lane >> 5);
        int col = wc * 64 + j * 32 + (lane & 31);
        cs[row * CS_LD + col] = acc[i][j][r];
      }
}

__device__ __forceinline__ int win_srccol(int n) {
  if (n < 2116) return n;
  if (n < 2176) return -1;
  return n - 60;
}
__device__ void phase_prep(const Params& p, char* smem) {
  const int tid = threadIdx.x, lane = tid & 63, wid = tid >> 6;
  for (int rb = blockIdx.x; rb < T / 4; rb += gridDim.x) {
    int row = rb * 4 + wid;
    const float* xr = p.x + (size_t)row * DM;
    float4 v[4];
    float ss = 0.f;
#pragma unroll
    for (int i = 0; i < 4; ++i) {
      v[i] = *reinterpret_cast<const float4*>(xr + lane * 4 + 256 * i);
      ss += v[i].x * v[i].x + v[i].y * v[i].y + v[i].z * v[i].z + v[i].w * v[i].w;
    }
    ss = wave_sum(ss);
    float r = rsqrtf(ss * (1.f / DM) + EPS);
#pragma unroll
    for (int i = 0; i < 4; ++i) {
      float4 g = *reinterpret_cast<const float4*>(p.norm1_g + lane * 4 + 256 * i);
      uint2 o;
      o.x = pack_bf16(v[i].x * r * g.x, v[i].y * r * g.y);
      o.y = pack_bf16(v[i].z * r * g.z, v[i].w * r * g.w);
      *reinterpret_cast<uint2*>(p.xn + (size_t)row * DM + lane * 4 + 256 * i) = o;
    }
  }
  float* tile = reinterpret_cast<float*>(smem);
  constexpr int NT_TOTAL = 1056 + 128 + 128 + 256 + 512 + 8 + 8;
  for (int ti = blockIdx.x; ti < NT_TOTAL; ti += gridDim.x) {
    const float* src; const float* scale = nullptr; u16* dst; int ldsrc, K, nn, mode = 0; int t = ti;
    if (t < 1056) { src = p.w_in; ldsrc = 4164; K = 1024; nn = 66; dst = p.WinT; mode = 1; }
    else if ((t -= 1056) < 128) { src = p.w_a_out; ldsrc = 1024; K = 512; nn = 16; dst = p.WaT; }
    else if ((t -= 128) < 128) { src = p.w_b_out; ldsrc = 1024; K = 512; nn = 16; dst = p.WbT; }
    else if ((t -= 128) < 256) { src = p.w_o; ldsrc = 1024; K = 1024; nn = 16; dst = p.WoT; }
    else if ((t -= 256) < 512) { src = p.peer_wq; ldsrc = 2048; K = 1024; nn = 32; dst = p.WqT; scale = p.norm2_g; }
    else if ((t -= 512) < 8) { src = p.w_uk; ldsrc = 128; K = 256; nn = 2; dst = p.WkvT; scale = p.kv_norm_g; }
    else { t -= 8; src = p.w_uv; ldsrc = 128; K = 256; nn = 2; dst = p.WkvT + 128 * 256; scale = p.kv_norm_g; }
    int n0 = (t % nn) * 64, k0 = (t / nn) * 64;
    __syncthreads();
    {
      int n = tid & 63;
      int sc = (mode == 1) ? win_srccol(n0 + n) : (n0 + n);
      for (int kk = tid >> 6; kk < 64; kk += 4) {
        float v = 0.f;
        if (sc >= 0) v = src[(size_t)(k0 + kk) * ldsrc + sc];
        if (scale) v *= scale[k0 + kk];
        tile[kk * 65 + n] = v;
      }
    }
    __syncthreads();
    {
      int k = (tid & 31) * 2;
      for (int n = tid >> 5; n < 64; n += 8) {
        u32 o = pack_bf16(tile[k * 65 + n], tile[(k + 1) * 65 + n]);
        *reinterpret_cast<u32*>(dst + (size_t)(n0 + n) * K + k0 + k) = o;
      }
    }
  }
  constexpr int G_SUB = 262144 / 4, G_SW = 65536 / 4;
  constexpr int G_TOTAL = G_SUB + G_SW;
  for (int gi = blockIdx.x * NTHREADS + tid; gi < G_TOTAL; gi += gridDim.x * NTHREADS) {
    int g = gi;
    if (g < G_SUB) {
      float4 v = *reinterpret_cast<const float4*>(p.peer_subkeys + (size_t)g * 4);
      uint2 o = {pack_bf16(v.x, v.y), pack_bf16(v.z, v.w)};
      *reinterpret_cast<uint2*>(p.SubK + (size_t)g * 4) = o;
    } else {
      g -= G_SUB;
      float4 v = *reinterpret_cast<const float4*>(p.spatial_w + (size_t)g * 4);
      int e = g * 4; int s = e & 127, tt = (e >> 7) & 127;
      if (s > tt) v.x = 0.f;
      if (s + 1 > tt) v.y = 0.f;
      if (s + 2 > tt) v.z = 0.f;
      if (s + 3 > tt) v.w = 0.f;
      uint2 o = {pack_bf16(v.x, v.y), pack_bf16(v.z, v.w)};
      *reinterpret_cast<uint2*>(p.Wtril + (size_t)g * 4) = o;
    }
  }
  if (blockIdx.x == 0) {
    float* red = reinterpret_cast<float*>(smem);
    __syncthreads();
    float vq = 0.f, vk = 0.f, vn = 0.f;
    if (tid < 128) {
      vq = fabsf(p.q_norm_g[tid]); vk = fabsf(p.k_norm_g[tid]);
      float ss = 0.f;
      for (int k = 0; k < 256; ++k) { float w = p.w_uv[k * 128 + tid] * p.kv_norm_g[k]; ss += w * w; }
      vn = sqrtf(ss);
    }
    red[tid] = vq; red[256 + tid] = vk; red[512 + tid] = vn;
    __syncthreads();
    if (tid == 0) {
      float mq = 0.f, mk = 0.f, mn = 0.f;
      for (int k = 0; k < 128; ++k) { mq = fmaxf(mq, red[k]); mk = fmaxf(mk, red[256 + k]); mn = fmaxf(mn, red[512 + k]); }
      int eq = ilogbf(440.f / fmaxf(11.3137085f * mq, 1e-20f));
      int ek = ilogbf(440.f / fmaxf(11.3137085f * mk, 1e-20f));
      int ev = ilogbf(440.f / fmaxf(16.f * mn, 1e-20f));
      eq = eq > 40 ? 40 : (eq < -40 ? -40 : eq); ek = ek > 40 ? 40 : (ek < -40 ? -40 : ek); ev = ev > 40 ? 40 : (ev < -40 ? -40 : ev);
      p.scal[0] = ldexpf(1.f, eq); p.scal[1] = ldexpf(1.f, ek); p.scal[2] = ldexpf(1.f, ev);
      p.scal[3] = ldexpf(1.f, -eq - ek); p.scal[4] = ldexpf(1.f, -ev);
    }
    __syncthreads();
  }
  for (int gi = blockIdx.x * NTHREADS + tid; gi < T * 24; gi += gridDim.x * NTHREADS) {
    int t = gi / 24, j = gi - t * 24;
    float posf = (float)p.pos[t];
    float sn, cn;
    if (j < 16) { sincosf(posf * INV32[j], &sn, &cn); p.rtab[(size_t)t * 48 + j] = cn; p.rtab[(size_t)t * 48 + 16 + j] = sn; }
    else { int jj = j - 16; sincosf(posf * INV16[jj], &sn, &cn); p.rtab[(size_t)t * 48 + 32 + jj] = cn; p.rtab[(size_t)t * 48 + 40 + jj] = sn; }
  }
  for (int rb = blockIdx.x; rb < 8192; rb += gridDim.x) {
    int r = rb * 4 + wid;
    bool isu = r < 16384;
    int rr = isu ? r : r - 16384;
    const float* src = (isu ? p.peer_u : p.peer_v) + (size_t)rr * 1024 + lane * 16;
    float v[16];
#pragma unroll
    for (int i = 0; i < 4; ++i) {
      float4 q = *reinterpret_cast<const float4*>(src + 4 * i);
      v[4 * i] = q.x; v[4 * i + 1] = q.y; v[4 * i + 2] = q.z; v[4 * i + 3] = q.w;
    }
    if (isu) {
#pragma unroll
      for (int i = 0; i < 4; ++i) {
        float4 g = *reinterpret_cast<const float4*>(p.norm2_g + lane * 16 + 4 * i);
        v[4 * i] *= g.x; v[4 * i + 1] *= g.y; v[4 * i + 2] *= g.z; v[4 * i + 3] *= g.w;
      }
    }
    float amax = 0.f;
#pragma unroll
    for (int i = 0; i < 16; ++i) amax = fmaxf(amax, fabsf(v[i]));
#pragma unroll
    for (int m = 32; m >= 1; m >>= 1) amax = fmaxf(amax, __shfl_xor(amax, m));
    int ex = 0;
    if (amax > 0.f) ex = ilogbf(224.f / amax);
    ex = ex > 60 ? 60 : (ex < -60 ? -60 : ex);
    float sc = ldexpf(1.f, ex);
    u32 w[4];
#pragma unroll
    for (int i = 0; i < 4; ++i) {
      int t = __builtin_amdgcn_cvt_pk_fp8_f32(v[4 * i] * sc, v[4 * i + 1] * sc, 0, false);
      t = __builtin_amdgcn_cvt_pk_fp8_f32(v[4 * i + 2] * sc, v[4 * i + 3] * sc, t, true);
      w[i] = (u32)t;
    }
    uint4 o = {w[0], w[1], w[2], w[3]};
    *reinterpret_cast<uint4*>((isu ? p.U8 : p.V8) + (size_t)rr * 1024 + lane * 16) = o;
    if (lane == 0) (isu ? p.su : p.sv)[rr] = ldexpf(1.f, -ex);
  }
}

__device__ __forceinline__ void rope_pair(float& y0, float& y1, int lc, int half, int xm, float posf, const float* inv) {
  float p0 = __shfl_xor(y0, xm), p1 = __shfl_xor(y1, xm);
  if (lc < 2 * half) {
    int j = lc & (half - 1);
    float a0 = posf * inv[j], a1 = posf * inv[j + 1];
    float s0, c0, s1, c1;
    sincosf(a0, &s0, &c0);
    sincosf(a1, &s1, &c1);
    if (lc < half) { y0 = y0 * c0 - p0 * s0; y1 = y1 * c1 - p1 * s1; }
    else { y0 = y0 * c0 + p0 * s0; y1 = y1 * c1 + p1 * s1; }
  }
}

__device__ __forceinline__ bool tile_swizzle(int step, int ntn, int ntiles, int& mt, int& nt) {
  const int x = blockIdx.x & 7, slot = blockIdx.x >> 3;
  const int nslots = gridDim.x >> 3;
  const int lin = (step * 8 + x) * nslots + slot;
  if (lin >= ntiles) return false;
  const int per = ntn * 16;
  const int g = lin / per, rem = lin - g * per;
  nt = rem >> 4;
  mt = g * 16 + (rem & 15);
  return true;
}

__device__ void phase_gemm1(const Params& p, char* smem) {
  const int tid = threadIdx.x, lane = tid & 63, wid = tid >> 6;
  float* cs = reinterpret_cast<float*>(smem);
  constexpr int NTN = NWIN / 128;
  constexpr int NTILES = (T / 128) * NTN;
  int mt, nt;
  bool have = tile_swizzle(0, NTN, NTILES, mt, nt);
  Tile4 ra, rb;
  if (have) gemm_prefetch(p.xn + (size_t)mt * 128 * DM, DM, p.WinT + (size_t)nt * 128 * DM, DM, DM, ra, rb);
  for (int step = 0; have; ++step) {
    int m0 = mt * 128;
    f32x16 acc[2][2];
    zero_acc(acc);
    gemm_mainloop(p.xn + (size_t)m0 * DM, DM, p.WinT + (size_t)nt * 128 * DM, DM, DM, acc, smem, ra, rb);
    stage_acc(acc, cs);
    __syncthreads();
    int mt2 = 0, nt2 = 0;
    const bool nxt = tile_swizzle(step + 1, NTN, NTILES, mt2, nt2);
    if (nxt) gemm_prefetch(p.xn + (size_t)mt2 * 128 * DM, DM, p.WinT + (size_t)nt2 * 128 * DM, DM, DM, ra, rb);
    const int L = lane & 15, rsub = lane >> 4, c0 = L * 8;
#pragma unroll 1
    for (int it = 0; it < 8; ++it) {
      const int row = wid * 32 + it * 4 + rsub;
      const size_t t = (size_t)m0 + row;
      float v[8];
      load8(cs + row * CS_LD + c0, v);
      if (nt < 8) {
#pragma unroll
        for (int e = 0; e < 8; ++e) v[e] = gelu_f(v[e]);
        u16* dst = (nt < 4) ? (p.gu + t * 512 + nt * 128 + c0) : (p.gv + t * 512 + (nt - 4) * 128 + c0);
        *reinterpret_cast<uint4*>(dst) = pack8(v);
      } else if (nt < 12) {
        float ss = 0.f;
#pragma unroll
        for (int e = 0; e < 8; ++e) ss += v[e] * v[e];
        ss = sum16(ss);
        float r = rsqrtf(ss * (1.f / 128.f) + EPS);
        float g[8];
        load8(p.q_norm_g + c0, g);
#pragma unroll
        for (int e = 0; e < 8; ++e) v[e] = v[e] * r * g[e];
        rope32_8(v, L, p.rtab + t * 48);
        *reinterpret_cast<uint4*>(p.qh + t * 512 + (nt - 8) * 128 + c0) = pack8(v);
      } else if (nt < 14) {
        *reinterpret_cast<uint4*>(p.ckv + t * 256 + (nt - 12) * 128 + c0) = pack8(v);
      } else if (nt < 16) {
        rope16_8(v, c0 & 63, p.rtab + t * 48);
        *reinterpret_cast<uint4*>(p.qi + t * 256 + (nt - 14) * 128 + c0) = pack8(v);
      } else if (nt == 16) {
        rope16_8(v, c0 < 64 ? c0 : 64, p.rtab + t * 48);
        if (c0 < 64) *reinterpret_cast<uint4*>(p.ki + ((t >> 4) * 8 + L) * 128 + (t & 15) * 8) = pack8(v);
        else if (c0 == 64) *reinterpret_cast<float4*>(p.wi + t * 4) = make_float4(v[0] * 0.0625f, v[1] * 0.0625f, v[2] * 0.0625f, v[3] * 0.0625f);
      } else {
#pragma unroll
        for (int e = 0; e < 8; ++e) v[e] = sigmoid_f(v[e]);
        *reinterpret_cast<uint4*>(p.sg + t * 2048 + (nt - 17) * 128 + c0) = pack8(v);
      }
    }
    mt = mt2; nt = nt2; have = nxt;
  }
}

__device__ void unit_kv(const Params& p, char* smem, int mt) {
  const int tid = threadIdx.x, lane = tid & 63, wid = tid >> 6;
  float* cs = reinterpret_cast<float*>(smem);
  float* rr_s = reinterpret_cast<float*>(smem + EXTRA_OFF);
  const int m0 = mt * 128;
  __syncthreads();
  {
    int row = tid >> 1, half = tid & 1;
    const u16* src = p.ckv + (size_t)(m0 + row) * 256 + half * 128;
    float ss = 0.f;
#pragma unroll 4
    for (int i = 0; i < 16; ++i) {
      uint4 q = *reinterpret_cast<const uint4*>(src + i * 8);
      u32 w[4] = {q.x, q.y, q.z, q.w};
#pragma unroll
      for (int j = 0; j < 4; ++j) { float a = bf_lo(w[j]), b = bf_hi(w[j]); ss += a * a + b * b; }
    }
    ss += __shfl_xor(ss, 1);
    if (half == 0) rr_s[row] = rsqrtf(ss * (1.f / 256.f) + EPS);
  }
  Tile4 ra, rb;
  gemm_prefetch(p.ckv + (size_t)m0 * 256, 256, p.WkvT, 256, 256, ra, rb);
#pragma unroll 1
  for (int nt = 0; nt < 2; ++nt) {
    f32x16 acc[2][2];
    zero_acc(acc);
    gemm_mainloop(p.ckv + (size_t)m0 * 256, 256, p.WkvT + (size_t)nt * 128 * 256, 256, 256, acc, smem, ra, rb);
    stage_acc(acc, cs);
    __syncthreads();
    if (nt == 0) gemm_prefetch(p.ckv + (size_t)m0 * 256, 256, p.WkvT + (size_t)128 * 256, 256, 256, ra, rb);
    const int L = lane & 15, rsub = lane >> 4, c0 = L * 8;
#pragma unroll 1
    for (int it = 0; it < 8; ++it) {
      const int row = wid * 32 + it * 4 + rsub;
      const size_t t = (size_t)m0 + row;
      float v[8];
      load8(cs + row * CS_LD + c0, v);
      const float rs = rr_s[row];
#pragma unroll
      for (int e = 0; e < 8; ++e) v[e] *= rs;
      if (nt == 0) {
        float ss = 0.f;
#pragma unroll
        for (int e = 0; e < 8; ++e) ss += v[e] * v[e];
        ss = sum16(ss);
        float r = rsqrtf(ss * (1.f / 128.f) + EPS);
        float g[8];
        load8(p.k_norm_g + c0, g);
#pragma unroll
        for (int e = 0; e < 8; ++e) v[e] = v[e] * r * g[e];
        rope32_8(v, L, p.rtab + t * 48);
        {
          const float sk = p.scal[1];
          int w0 = __builtin_amdgcn_cvt_pk_fp8_f32(v[0] * sk, v[1] * sk, 0, false);
          w0 = __builtin_amdgcn_cvt_pk_fp8_f32(v[2] * sk, v[3] * sk, w0, true);
          int w1 = __builtin_amdgcn_cvt_pk_fp8_f32(v[4] * sk, v[5] * sk, 0, false);
          w1 = __builtin_amdgcn_cvt_pk_fp8_f32(v[6] * sk, v[7] * sk, w1, true);
          *reinterpret_cast<uint2*>(p.kv8 + t * 256 + c0) = make_uint2((u32)w0, (u32)w1);
        }
      } else {
        {
          const float sv8 = p.scal[2];
          int w0 = __builtin_amdgcn_cvt_pk_fp8_f32(v[0] * sv8, v[1] * sv8, 0, false);
          w0 = __builtin_amdgcn_cvt_pk_fp8_f32(v[2] * sv8, v[3] * sv8, w0, true);
          int w1 = __builtin_amdgcn_cvt_pk_fp8_f32(v[4] * sv8, v[5] * sv8, 0, false);
          w1 = __builtin_amdgcn_cvt_pk_fp8_f32(v[6] * sv8, v[7] * sv8, w1, true);
          *reinterpret_cast<uint2*>(p.kv8 + t * 256 + 128 + c0) = make_uint2((u32)w0, (u32)w1);
        }
      }
    }
    __syncthreads();
  }
}

__device__ void unit_spatial(const Params& p, char* smem, int unit) {
  const int tid = threadIdx.x, lane = tid & 63, wid = tid >> 6;
  const int chunk = unit >> 2, g = unit & 3;
  const int t0 = chunk * 128;
  float* cs = reinterpret_cast<float*>(smem);
  float* mu_s = reinterpret_cast<float*>(smem + EXTRA_OFF);
  float* rs_s = mu_s + 128;
  __syncthreads();
  {
    int row = tid >> 1, half = tid & 1;
    const u16* src = p.gv + (size_t)(t0 + row) * 512 + half * 256;
    float s = 0.f, ss = 0.f;
#pragma unroll 4
    for (int i = 0; i < 32; ++i) {
      uint4 q = *reinterpret_cast<const uint4*>(src + i * 8);
      u32 w[4] = {q.x, q.y, q.z, q.w};
#pragma unroll
      for (int j = 0; j < 4; ++j) { float a = bf_lo(w[j]), b = bf_hi(w[j]); s += a + b; ss += a * a + b * b; }
    }
    s += __shfl_xor(s, 1);
    ss += __shfl_xor(ss, 1);
    float mean = s * (1.f / 512.f);
    float var = fmaxf(ss * (1.f / 512.f) - mean * mean, 0.f);
    if (half == 0) { mu_s[row] = mean; rs_s[row] = rsqrtf(var + EPS); }
  }
  {
    const u16* wsrc = p.Wtril + (size_t)g * 128 * 128;
#pragma unroll
    for (int i = 0; i < 8; ++i) {
      int c = tid + 256 * i;
      int row = c >> 4, kc = c & 15;
      uint4 q = *reinterpret_cast<const uint4*>(wsrc + row * 128 + kc * 8);
      *reinterpret_cast<uint4*>(smem + (kc >> 3) * ABUF + row * 144 + (kc & 7) * 16) = q;
    }
  }
  __syncthreads();
  {
    int s = tid & 127;
    float mu = mu_s[s], rs = rs_s[s];
    const u16* src = p.gv + (size_t)(t0 + s) * 512 + g * 128;
    char* bbase = smem + (2 + (s >> 6)) * ABUF + (s & 63) * 2;
#pragma unroll
    for (int i = 0; i < 8; ++i) {
      int d0 = ((tid >> 7) + 2 * i) * 8;
      uint4 q = *reinterpret_cast<const uint4*>(src + d0);
      u32 w[4] = {q.x, q.y, q.z, q.w};
#pragma unroll
      for (int j = 0; j < 4; ++j) {
        int d = d0 + 2 * j;
        float a = (bf_lo(w[j]) - mu) * rs * p.v_norm_g[g * 128 + d] + p.v_norm_b[g * 128 + d];
        float b = (bf_hi(w[j]) - mu) * rs * p.v_norm_g[g * 128 + d + 1] + p.v_norm_b[g * 128 + d + 1];
        *reinterpret_cast<u16*>(bbase + d * 144) = f2bf(a);
        *reinterpret_cast<u16*>(bbase + (d + 1) * 144) = f2bf(b);
      }
    }
  }
  __syncthreads();
  f32x16 acc[2][2];
  zero_acc(acc);
  mma_ktile(smem, smem + 2 * ABUF, acc);
  mma_ktile(smem + ABUF, smem + 3 * ABUF, acc);
  __syncthreads();
  stage_acc(acc, cs);
  __syncthreads();
  const int L = lane & 15, rsub = lane >> 4, c0 = L * 8;
#pragma unroll 1
  for (int it = 0; it < 8; ++it) {
    const int row = wid * 32 + it * 4 + rsub;
    const size_t t = (size_t)t0 + row;
    float v[8], u[8];
    load8(cs + row * CS_LD + c0, v);
    const float b = p.spatial_b[g * 128 + row];
    unpack8(*reinterpret_cast<const uint4*>(p.gu + t * 512 + g * 128 + c0), u);
#pragma unroll
    for (int e = 0; e < 8; ++e) v[e] = u[e] * (v[e] + b);
    *reinterpret_cast<uint4*>(p.ya + t * 512 + g * 128 + c0) = pack8(v);
  }
}

__device__ __forceinline__ void radix_partition(const u32 (&key)[12], int n, int rank, int slack, u32& lo, u32& hi, int& limit) {
  u32 vor = 0u, vand = 0xFFFFFFFFu;
#pragma unroll
  for (int k = 0; k < 12; ++k) { vor |= key[k]; vand &= (key[k] != 0u) ? key[k] : 0xFFFFFFFFu; }
#define DPPU(v, ctrl) ((u32)__builtin_amdgcn_update_dpp(0, (int)(v), (ctrl), 0xF, 0xF, true))
  vor |= DPPU(vor, 0xB1); vor |= DPPU(vor, 0x4E); vor |= DPPU(vor, 0x141); vor |= DPPU(vor, 0x140);
  vand &= DPPU(vand, 0xB1); vand &= DPPU(vand, 0x4E); vand &= DPPU(vand, 0x141); vand &= DPPU(vand, 0x140);
  vor = (u32)(__builtin_amdgcn_readlane((int)vor, 0) | __builtin_amdgcn_readlane((int)vor, 16) |
              __builtin_amdgcn_readlane((int)vor, 32) | __builtin_amdgcn_readlane((int)vor, 48));
  vand = (u32)(__builtin_amdgcn_readlane((int)vand, 0) & __builtin_amdgcn_readlane((int)vand, 16) &
               __builtin_amdgcn_readlane((int)vand, 32) & __builtin_amdgcn_readlane((int)vand, 48));
#undef DPPU
  const u32 diff = vor ^ vand;
  int b = diff ? (31 - __clz(diff)) : -1;
  u32 prefix = (b >= 31) ? 0u : (vand & ~((2u << b) - 1u));
  if (b < 0) prefix = vand;
  int krem = rank, ncand = n;
  while (b >= 0 && ncand - krem > slack) {
    u32 cand = prefix | (1u << b);
    u32 himask = ~((1u << b) - 1u);
    int c = 0;
#pragma unroll
    for (int k = 0; k < 12; ++k) c += __popcll(__ballot((key[k] & himask) == cand));
    if (c >= krem) { prefix = cand; ncand = c; } else { krem -= c; ncand -= c; }
    --b;
  }
  lo = prefix;
  hi = (b >= 0) ? (prefix | ((2u << b) - 1u)) : prefix;
  limit = (ncand - krem <= slack) ? ncand : krem;
}

__device__ __forceinline__ void idx_load_keys(const Params& p, int tb, int jc, int kcol, int lane, bf16x8 (&bf)[4][2]) {
  const u16* kb = p.ki + ((size_t)((tb + jc) >> 4) * 8 + (lane >> 4)) * 128 + kcol * 8;
#pragma unroll
  for (int u = 0; u < 4; ++u) {
    bf[u][0] = *reinterpret_cast<const bf16x8*>(kb + u * 1024);
    bf[u][1] = *reinterpret_cast<const bf16x8*>(kb + u * 1024 + 512);
  }
}
__device__ __forceinline__ void idx_compact(u32* cv, u16* ci, int n, int lane, int& newcnt, float& newthr) {
  u32 key[12]; u16 idx[12];
#pragma unroll
  for (int k = 0; k < 12; ++k) {
    int e = lane + 64 * k;
    bool in = e < n;
    key[k] = in ? sortable(cv[e]) : 0u;
    idx[k] = in ? ci[e] : (u16)0;
  }
  u32 lo, hi; int limit;
  radix_partition(key, n, 256, 64, lo, hi, limit);
  int base = 0, tcnt = 0;
#pragma unroll
  for (int k = 0; k < 12; ++k) {
    bool eq = key[k] >= lo && key[k] <= hi;
    unsigned long long meq = __ballot(eq);
    bool keep = (key[k] > hi) || (eq && (tcnt + mbcnt64(meq)) < limit);
    unsigned long long m = __ballot(keep);
    int pos = base + mbcnt64(m);
    if (keep) { cv[pos] = unsortable(key[k]); ci[pos] = idx[k]; }
    base += __popcll(m);
    tcnt += __popcll(meq);
  }
  newcnt = base;
  newthr = (lo <= 0x007FFFFFu) ? -INFINITY : __uint_as_float(unsortable(lo));
}

__device__ void unit_indexer(const Params& p, char* smem, int unit, int mode = 0) {
  const int tid = threadIdx.x, lane = tid & 63, wid = tid >> 6;
  const int b = unit >> 10, grp = unit & 1023;
  const int tb = b * SEQ, i0 = grp * 16;
  u32* cval = reinterpret_cast<u32*>(smem);
  u16* cidx = reinterpret_cast<u16*>(smem + 16 * CAP * 4);
  __syncthreads();
  const int qsub = lane >> 4;
  const int ql = wid * 4 + qsub;
  const int iq = i0 + ql;
  const int kcol = lane & 15;
  bf16x8 afr[2];
  {
    const u16* qa = p.qi + ((size_t)(tb + i0 + wid * 4 + (kcol >> 2)) * 4 + (kcol & 3)) * 64 + 8 * (lane >> 4);
    afr[0] = *reinterpret_cast<const bf16x8*>(qa);
    afr[1] = *reinterpret_cast<const bf16x8*>(qa + 32);
  }
  const float4 w4 = *reinterpret_cast<const float4*>(p.wi + (size_t)(tb + iq) * 4);
  float thr = (mode == 1 || mode == 5) ? INFINITY : -INFINITY;
  const int kmul = (mode == 5) ? 0 : 64;
  int cntr = 0;
  u32* myval = cval + ql * CAP;
  u16* myidx = cidx + ql * CAP;
  const u32 lowmask = (1u << kcol) - 1u;
  const int nchunks = (grp + 1 + 3) >> 2;

  auto process = [&](const bf16x8 (&bf)[4][2], int jc) {
    f32x4 acc[4];
#pragma unroll
    for (int u = 0; u < 4; ++u) {
      f32x4 z = {0.f, 0.f, 0.f, 0.f};
      acc[u] = __builtin_amdgcn_mfma_f32_16x16x32_bf16(afr[0], bf[u][0], z, 0, 0, 0);
    }
#pragma unroll
    for (int u = 0; u < 4; ++u) acc[u] = __builtin_amdgcn_mfma_f32_16x16x32_bf16(afr[1], bf[u][1], acc[u], 0, 0, 0);
    float sc[4];
    bool ps[4];
    bool anyp = false;
#pragma unroll
    for (int u = 0; u < 4; ++u) {
      float r0 = __builtin_amdgcn_fmed3f(acc[u][0], 0.f, INFINITY), r1 = __builtin_amdgcn_fmed3f(acc[u][1], 0.f, INFINITY);
      float r2 = __builtin_amdgcn_fmed3f(acc[u][2], 0.f, INFINITY), r3 = __builtin_amdgcn_fmed3f(acc[u][3], 0.f, INFINITY);
      float s = (w4.x * r0 + w4.y * r1) + (w4.z * r2 + w4.w * r3);
      s += 0.0f;
      sc[u] = s;
      ps[u] = ((jc + 16 * u + kcol) <= iq) && (s > thr);
      anyp |= ps[u];
    }
    if (__ballot(anyp)) {
#pragma unroll
      for (int u = 0; u < 4; ++u) {
        unsigned long long m = __ballot(ps[u]);
        u32 g16 = (u32)(m >> (16 * qsub)) & 0xFFFFu;
        int slot = cntr + __popc(g16 & lowmask);
        if (ps[u] && slot < CAP) { myval[slot] = __float_as_uint(sc[u]); myidx[slot] = (u16)(jc + 16 * u + kcol); }
        cntr += __popc(g16);
      }
      unsigned long long need = __ballot(cntr > CAP - 64);
      while (need) {
        int l = __ffsll((long long)need) - 1;
        int qc = l >> 4;
        need &= ~(0xFFFFull << (qc * 16));
        int qlc = wid * 4 + qc;
        int n = __builtin_amdgcn_readlane(cntr, qc * 16);
        if (n > CAP) n = CAP;
        int nc; float nt;
        if (mode == 3) { nc = 0; nt = thr; }
        else {
          idx_compact(cval + qlc * CAP, cidx + qlc * CAP, n, lane, nc, nt);
          if (mode == 4) idx_compact(cval + qlc * CAP, cidx + qlc * CAP, nc, lane, nc, nt);
        }
        if (qsub == qc) { thr = nt; cntr = nc; }
      }
    }
  };

  bf16x8 bA[4][2], bB[4][2];
  const int lastc = nchunks - 1;
  idx_load_keys(p, tb, 0, kcol, lane, bA);
  for (int ch = 0; ch < nchunks; ch += 2) {
    idx_load_keys(p, tb, min(ch + 1, lastc) * kmul, kcol, lane, bB);
    process(bA, ch * 64);
    idx_load_keys(p, tb, min(ch + 2, lastc) * kmul, kcol, lane, bA);
    if (ch + 1 < nchunks) process(bB, (ch + 1) * 64);
  }
  if (mode) return;
  for (int qc = 0; qc < 4; ++qc) {
    int qlc = wid * 4 + qc;
    int n = __builtin_amdgcn_readlane(cntr, qc * 16);
    if (n > CAP) n = CAP;
    u32* cv = cval + qlc * CAP; u16* ci = cidx + qlc * CAP;
    u16* out = p.sel + (size_t)(tb + i0 + qlc) * 256;
    if (n <= 256) {
#pragma unroll
      for (int k = 0; k < 4; ++k) {
        int e = lane + 64 * k;
        out[e] = (e < n) ? ci[e] : (u16)0xFFFF;
      }
    } else {
      u32 key[12]; u16 idx[12];
#pragma unroll
      for (int k = 0; k < 12; ++k) {
        int e = lane + 64 * k;
        bool in = e < n;
        key[k] = in ? sortable(cv[e]) : 0u;
        idx[k] = in ? ci[e] : (u16)0;
      }
      u32 lo, hi; int limit;
      radix_partition(key, n, 256, 0, lo, hi, limit);
      int base = 0, tcnt = 0;
#pragma unroll
      for (int k = 0; k < 12; ++k) {
        bool eq = key[k] >= lo && key[k] <= hi;
        unsigned long long meq = __ballot(eq);
        bool keep = (key[k] > hi) || (eq && (tcnt + mbcnt64(meq)) < limit);
        unsigned long long m = __ballot(keep);
        int pos = base + mbcnt64(m);
        if (keep && pos < 256) ci[pos] = idx[k];
        base += __popcll(m);
        tcnt += __popcll(meq);
      }
      __builtin_amdgcn_wave_barrier();
      *reinterpret_cast<uint2*>(out + lane * 4) = *reinterpret_cast<const uint2*>(ci + lane * 4);
      __builtin_amdgcn_wave_barrier();
    }
  }
}

__device__ void phase_attn(const Params& p, char* smem) {
  const int tid = threadIdx.x, lane = tid & 63, wid = tid >> 6;
  constexpr int WSTRIDE = 13312;
  u16* lidx = reinterpret_cast<u16*>(smem + wid * WSTRIDE);
  float* Pt = reinterpret_cast<float*>(smem + wid * WSTRIDE + 512);
  char* tile = smem + wid * WSTRIDE + 1024;
  const float sq = p.scal[0];
  const float lf = 0.08838834764831845f * 1.4426950408889634f * p.scal[3];
  const float ovs = p.scal[4];
  const int xq = blockIdx.x & 7;
  const int b = xq & 1;
  const int rblk = (blockIdx.x >> 3) * 4 + (xq >> 1);
  const int nrb = (gridDim.x >> 3) * 4;
  const int n16 = lane & 15, g4 = lane >> 4;
  for (int i = rblk * 4 + wid; i < SEQ; i += nrb * 4) {
    const int tq = b * SEQ + i;
    const size_t tb = (size_t)b * SEQ;
    __builtin_amdgcn_wave_barrier();
    {
      uint2 v = *reinterpret_cast<const uint2*>(p.sel + (size_t)tq * 256 + lane * 4);
      *reinterpret_cast<uint2*>(lidx + lane * 4) = v;
    }
    __builtin_amdgcn_wave_barrier();
    long qf[4];
#pragma unroll
    for (int s = 0; s < 4; ++s) {
      qf[s] = 0;
      if (n16 < 4) {
        float qv[8];
        unpack8(*reinterpret_cast<const uint4*>(p.qh + (size_t)tq * 512 + n16 * 128 + 32 * s + 8 * g4), qv);
        int w0 = __builtin_amdgcn_cvt_pk_fp8_f32(qv[0] * sq, qv[1] * sq, 0, false);
        w0 = __builtin_amdgcn_cvt_pk_fp8_f32(qv[2] * sq, qv[3] * sq, w0, true);
        int w1 = __builtin_amdgcn_cvt_pk_fp8_f32(qv[4] * sq, qv[5] * sq, 0, false);
        w1 = __builtin_amdgcn_cvt_pk_fp8_f32(qv[6] * sq, qv[7] * sq, w1, true);
        qf[s] = (long)(((unsigned long long)(u32)w1 << 32) | (unsigned long long)(u32)w0);
      }
    }
    float mrun[4] = {-1e30f, -1e30f, -1e30f, -1e30f}, lrun[4] = {0.f, 0.f, 0.f, 0.f};
    float2_t o2[4][4];
#pragma unroll
    for (int h = 0; h < 4; ++h)
#pragma unroll
      for (int j = 0; j < 4; ++j) { o2[h][j].x = 0.f; o2[h][j].y = 0.f; }
    u32x4 kr[8];
#pragma unroll
    for (int r = 0; r < 8; ++r) {
      int id = lidx[r * 4 + g4];
      int idc = (id <= i) ? id : 0;
      kr[r] = *reinterpret_cast<const u32x4*>(p.kv8 + (tb + idc) * 256 + n16 * 16);
    }
#pragma unroll 1
    for (int g2 = 0; g2 < 8; ++g2) {
      __builtin_amdgcn_wave_barrier();
#pragma unroll
      for (int r = 0; r < 8; ++r) *reinterpret_cast<u32x4*>(tile + (r * 4 + g4) * 272 + n16 * 16) = kr[r];
      __builtin_amdgcn_wave_barrier();
      {
        const int gn = (g2 < 7) ? g2 + 1 : 7;
#pragma unroll
        for (int r = 0; r < 8; ++r) {
          int id = lidx[gn * 32 + r * 4 + g4];
          int idc = (id <= i) ? id : 0;
          kr[r] = *reinterpret_cast<const u32x4*>(p.kv8 + (tb + idc) * 256 + n16 * 16);
        }
      }
      float sc[2][4];
#pragma unroll
      for (int tt = 0; tt < 2; ++tt) {
        int id = lidx[g2 * 32 + tt * 16 + n16];
        bool valid = id <= i;
        f32x4 acc = {0.f, 0.f, 0.f, 0.f};
#pragma unroll
        for (int s = 0; s < 4; ++s) {
          long kf = *reinterpret_cast<const long*>(tile + (tt * 16 + n16) * 272 + 32 * s + 8 * g4);
          acc = __builtin_amdgcn_mfma_f32_16x16x32_fp8_fp8(qf[s], kf, acc, 0, 0, 0);
        }
#pragma unroll
        for (int h = 0; h < 4; ++h) sc[tt][h] = valid ? acc[h] * lf : -1e30f;
      }
      float alpha[4], pp[2][4];
#pragma unroll
      for (int h = 0; h < 4; ++h) {
        float mg = max16(fmaxf(sc[0][h], sc[1][h]));
        float mnew = fmaxf(mrun[h], __int_as_float(__builtin_amdgcn_readfirstlane(__float_as_int(mg))));
        alpha[h] = __builtin_amdgcn_exp2f(mrun[h] - mnew);
        mrun[h] = mnew;
        pp[0][h] = __builtin_amdgcn_exp2f(sc[0][h] - mnew);
        pp[1][h] = __builtin_amdgcn_exp2f(sc[1][h] - mnew);
        float ls = sum16(pp[0][h] + pp[1][h]);
        lrun[h] = lrun[h] * alpha[h] + __int_as_float(__builtin_amdgcn_readfirstlane(__float_as_int(ls)));
      }
      if (lane < 16) {
        *reinterpret_cast<float4*>(Pt + lane * 4) = make_float4(pp[0][0], pp[0][1], pp[0][2], pp[0][3]);
        *reinterpret_cast<float4*>(Pt + (16 + lane) * 4) = make_float4(pp[1][0], pp[1][1], pp[1][2], pp[1][3]);
      }
#pragma unroll
      for (int h = 0; h < 4; ++h) {
        float2_t a2 = {alpha[h], alpha[h]};
#pragma unroll
        for (int j = 0; j < 4; ++j) o2[h][j] *= a2;
      }
      __builtin_amdgcn_wave_barrier();
#pragma unroll
      for (int it = 0; it < 8; ++it) {
        const int nk = it * 4 + g4;
        float4 pw = *reinterpret_cast<const float4*>(Pt + nk * 4);
        uint2 q = *reinterpret_cast<const uint2*>(tile + nk * 272 + 128 + n16 * 8);
        float2_t v2[4] = {__builtin_amdgcn_cvt_pk_f32_fp8((int)q.x, false), __builtin_amdgcn_cvt_pk_f32_fp8((int)q.x, true),
                          __builtin_amdgcn_cvt_pk_f32_fp8((int)q.y, false), __builtin_amdgcn_cvt_pk_f32_fp8((int)q.y, true)};
        float pv[4] = {pw.x, pw.y, pw.z, pw.w};
#pragma unroll
        for (int h = 0; h < 4; ++h) {
          float2_t ph = {pv[h], pv[h]};
#pragma unroll
          for (int j = 0; j < 4; ++j) o2[h][j] += ph * v2[j];
        }
      }
      __builtin_amdgcn_wave_barrier();
    }
#pragma unroll
    for (int h = 0; h < 4; ++h) {
      float inv = ovs * __builtin_amdgcn_rcpf(lrun[h]);
      float ov[8];
#pragma unroll
      for (int j = 0; j < 4; ++j) {
        float x0 = o2[h][j].x, x1 = o2[h][j].y;
        x0 += __shfl_xor(x0, 16); x0 += __shfl_xor(x0, 32);
        x1 += __shfl_xor(x1, 16); x1 += __shfl_xor(x1, 32);
        ov[2 * j] = x0 * inv; ov[2 * j + 1] = x1 * inv;
      }
      if (g4 == 0) *reinterpret_cast<uint4*>(p.yb + (size_t)tq * 512 + h * 128 + n16 * 8) = pack8(ov);
    }
  }
}

__device__ void phase_merge(const Params& p, char* smem) {
  const int tid = threadIdx.x, lane = tid & 63, wid = tid >> 6;
  float* cs = reinterpret_cast<float*>(smem);
  constexpr int NTILES = (T / 128) * 8;
  int mt, nt;
  bool have = tile_swizzle(0, 8, NTILES, mt, nt);
  Tile4 ra, rb;
  if (have) gemm_prefetch(p.ya + (size_t)mt * 128 * 512, 512, p.WaT + (size_t)nt * 128 * 512, 512, 512, ra, rb);
  for (int step = 0; have; ++step) {
    int m0 = mt * 128, n0 = nt * 128;
    f32x16 acc[2][2];
    zero_acc(acc);
    gemm_mainloop(p.ya + (size_t)m0 * 512, 512, p.WaT + (size_t)n0 * 512, 512, 512, acc, smem, ra, rb);
    stage_acc(acc, cs);
    __syncthreads();
    gemm_prefetch(p.yb + (size_t)m0 * 512, 512, p.WbT + (size_t)n0 * 512, 512, 512, ra, rb);
#pragma unroll 2
    for (int it = 0; it < 8; ++it) {
      const int row = wid * 32 + it * 4 + (lane >> 4), c0 = (lane & 15) * 8;
      float v[8], g[8];
      load8(cs + row * CS_LD + c0, v);
      unpack8(*reinterpret_cast<const uint4*>(p.sg + (size_t)(m0 + row) * 2048 + n0 + c0), g);
#pragma unroll
      for (int e = 0; e < 8; ++e) v[e] *= g[e];
      *reinterpret_cast<uint4*>(p.merged + (size_t)(m0 + row) * 1024 + n0 + c0) = pack8(v);
    }
    __syncthreads();
    zero_acc(acc);
    gemm_mainloop(p.yb + (size_t)m0 * 512, 512, p.WbT + (size_t)n0 * 512, 512, 512, acc, smem, ra, rb);
    stage_acc(acc, cs);
    __syncthreads();
    int mt2 = 0, nt2 = 0;
    const bool nxt = tile_swizzle(step + 1, 8, NTILES, mt2, nt2);
    if (nxt) gemm_prefetch(p.ya + (size_t)mt2 * 128 * 512, 512, p.WaT + (size_t)nt2 * 128 * 512, 512, 512, ra, rb);
#pragma unroll 2
    for (int it = 0; it < 8; ++it) {
      const int row = wid * 32 + it * 4 + (lane >> 4), c0 = (lane & 15) * 8;
      float v[8], g[8], pa[8];
      load8(cs + row * CS_LD + c0, v);
      unpack8(*reinterpret_cast<const uint4*>(p.sg + (size_t)(m0 + row) * 2048 + 1024 + n0 + c0), g);
      uint4* mp = reinterpret_cast<uint4*>(p.merged + (size_t)(m0 + row) * 1024 + n0 + c0);
      unpack8(*mp, pa);
#pragma unroll
      for (int e = 0; e < 8; ++e) v[e] = pa[e] + v[e] * g[e];
      *mp = pack8(v);
    }
    mt = mt2; nt = nt2; have = nxt;
  }
}

__device__ void phase_wo(const Params& p, char* smem) {
  const int tid = threadIdx.x, lane = tid & 63, wid = tid >> 6;
  float* cs = reinterpret_cast<float*>(smem);
  constexpr int NTILES = (T / 128) * 8;
  int mt, nt;
  bool have = tile_swizzle(0, 8, NTILES, mt, nt);
  Tile4 ra, rb;
  if (have) gemm_prefetch(p.merged + (size_t)mt * 128 * 1024, 1024, p.WoT + (size_t)nt * 128 * 1024, 1024, 1024, ra, rb);
  for (int step = 0; have; ++step) {
    int m0 = mt * 128, n0 = nt * 128;
    f32x16 acc[2][2];
    zero_acc(acc);
    gemm_mainloop(p.merged + (size_t)m0 * 1024, 1024, p.WoT + (size_t)n0 * 1024, 1024, 1024, acc, smem, ra, rb);
    stage_acc(acc, cs);
    __syncthreads();
    int mt2 = 0, nt2 = 0;
    const bool nxt = tile_swizzle(step + 1, 8, NTILES, mt2, nt2);
    if (nxt) gemm_prefetch(p.merged + (size_t)mt2 * 128 * 1024, 1024, p.WoT + (size_t)nt2 * 128 * 1024, 1024, 1024, ra, rb);
#pragma unroll 2
    for (int it = 0; it < 8; ++it) {
      const int row = wid * 32 + it * 4 + (lane >> 4), c0 = (lane & 15) * 8;
      const size_t t = (size_t)m0 + row;
      float v[8], xv[8];
      load8(cs + row * CS_LD + c0, v);
      load8(p.x + t * 1024 + n0 + c0, xv);
      float ss = 0.f;
#pragma unroll
      for (int e = 0; e < 8; ++e) { v[e] += xv[e]; ss += v[e] * v[e]; }
      *reinterpret_cast<uint4*>(p.h1b + t * 1024 + n0 + c0) = pack8(v);
      ss = sum16(ss);
      if ((lane & 15) == 0) p.ssq[(size_t)nt * T + t] = ss;
    }
    mt = mt2; nt = nt2; have = nxt;
  }
}

__device__ __forceinline__ void ins16(float (&l)[16], float v) {
#pragma unroll
  for (int q = 15; q >= 1; --q) l[q] = __builtin_amdgcn_fmed3f(v, l[q - 1], l[q]);
  l[0] = fmaxf(l[0], v);
}
__device__ void phase_peerq(const Params& p, char* smem) {
  const int tid = threadIdx.x, lane = tid & 63, wid = tid >> 6;
  const int wr = wid >> 1, wc = wid & 1;
  float* cs = reinterpret_cast<float*>(smem);
  constexpr int NTILES = (T / 128) * 16;
  int mt, hp;
  bool have = tile_swizzle(0, 16, NTILES, mt, hp);
  Tile4 ra, rb;
  if (have) gemm_prefetch(p.h1b + (size_t)mt * 128 * 1024, 1024, p.WqT + (size_t)hp * 128 * 1024, 1024, 1024, ra, rb);
  for (int step = 0; have; ++step) {
    int m0 = mt * 128;
    f32x16 acc[2][2];
    zero_acc(acc);
    gemm_mainloop(p.h1b + (size_t)m0 * 1024, 1024, p.WqT + (size_t)hp * 128 * 1024, 1024, 1024, acc, smem, ra, rb);
#pragma unroll
    for (int i = 0; i < 2; ++i)
#pragma unroll
      for (int j = 0; j < 2; ++j)
#pragma unroll
        for (int r = 0; r < 16; ++r) {
          int row = wr * 64 + i * 32 + (r & 3) + 8 * (r >> 2) + 4 * (lane >> 5);
          int col = wc * 64 + j * 32 + (lane & 31);
          *reinterpret_cast<u16*>(smem + (col >> 6) * ABUF + row * 144 + (col & 63) * 2) = f2bf(acc[i][j][r]);
        }
    {
      const u16* sk = p.SubK + (size_t)hp * 128 * 128;
#pragma unroll
      for (int i = 0; i < 8; ++i) {
        int c = tid + 256 * i;
        int row = c >> 4, kc = c & 15;
        uint4 q = *reinterpret_cast<const uint4*>(sk + row * 128 + kc * 8);
        *reinterpret_cast<uint4*>(smem + (2 + (kc >> 3)) * ABUF + row * 144 + (kc & 7) * 16) = q;
      }
    }
    __syncthreads();
    zero_acc(acc);
    mma_ktile(smem, smem + 2 * ABUF, acc);
    mma_ktile(smem + ABUF, smem + 3 * ABUF, acc);
    __syncthreads();
    stage_acc(acc, cs);
    __syncthreads();
    int mt2 = 0, hp2 = 0;
    const bool nxt = tile_swizzle(step + 1, 16, NTILES, mt2, hp2);
    if (nxt) gemm_prefetch(p.h1b + (size_t)mt2 * 128 * 1024, 1024, p.WqT + (size_t)hp2 * 128 * 1024, 1024, 1024, ra, rb);
    {
      int row = tid >> 1, half = tid & 1;
      float* rp = cs + row * CS_LD + half * 64;
      float l[16];
#pragma unroll
      for (int q = 0; q < 16; ++q) l[q] = -INFINITY;
      for (int c = 0; c < 64; c += 4) {
        float4 v4 = *reinterpret_cast<const float4*>(rp + c);
        float vv[4] = {v4.x, v4.y, v4.z, v4.w};
#pragma unroll
        for (int e = 0; e < 4; ++e) {
          u32 bits = __float_as_uint(vv[e]);
          u32 n = (u32)(half * 64 + c + e);
          bits = (bits & ~127u) | ((bits >> 31) ? n : (127u - n));
          ins16(l, __uint_as_float(bits));
        }
      }
#pragma unroll
      for (int q = 0; q < 16; ++q) rp[q] = l[q];
    }
    __syncthreads();
    if (tid < 128) {
      int row = tid;
      size_t t = (size_t)m0 + row;
      const float* la = cs + row * CS_LD;
      const float* lb = la + 64;
      float ssum = 0.f;
#pragma unroll
      for (int q = 0; q < 8; ++q) ssum += p.ssq[(size_t)q * T + t];
      float rt = rsqrtf(ssum * (1.f / 1024.f) + EPS);
      int ia = 0, ib = 0;
      float* ov = p.stv + ((size_t)hp * T + t) * 16;
      u8* oi = p.sti + ((size_t)hp * T + t) * 16;
      float ovv[16]; u32 oii[4] = {0u, 0u, 0u, 0u};
#pragma unroll
      for (int q = 0; q < 16; ++q) {
        float va = la[ia], vb = lb[ib];
        bool ta = va >= vb;
        float v = ta ? va : vb;
        ia += ta ? 1 : 0;
        ib += ta ? 0 : 1;
        u32 bits = __float_as_uint(v);
        u32 low = bits & 127u;
        u32 n = (bits >> 31) ? low : (127u - low);
        ovv[q] = __uint_as_float(bits & ~127u) * rt;
        oii[q >> 2] |= n << (8 * (q & 3));
      }
#pragma unroll
      for (int q = 0; q < 4; ++q) *reinterpret_cast<float4*>(ov + 4 * q) = make_float4(ovv[4 * q], ovv[4 * q + 1], ovv[4 * q + 2], ovv[4 * q + 3]);
      *reinterpret_cast<uint4*>(oi) = make_uint4(oii[0], oii[1], oii[2], oii[3]);
    }
    mt = mt2; hp = hp2; have = nxt;
  }
}

__device__ void phase_peer(const Params& p, char* smem, int mode = 0) {
  const int tid = threadIdx.x, lane = tid & 63, wid = tid >> 6;
  int* pe_e = reinterpret_cast<int*>(smem + wid * 4096);
  float* pe_su = reinterpret_cast<float*>(smem + wid * 4096 + 512);
  float* pe_gv = reinterpret_cast<float*>(smem + wid * 4096 + 1024);
  float* svl = reinterpret_cast<float*>(smem + wid * 4096 + 1536);
  u8* sil = reinterpret_cast<u8*>(smem + wid * 4096 + 2560);
  const int h = lane >> 3, g = lane & 7;
  u32 prt[7];
#pragma unroll
  for (int c = 0; c < 7; ++c) prt[c] = PAIR_TAB[g * 7 + c];
  float4 nsv = make_float4(0.f, 0.f, 0.f, 0.f); uint4 nsi = make_uint4(0u, 0u, 0u, 0u);
  {
    int tq0 = blockIdx.x * 4 + wid;
    if (tq0 < T) {
      nsv = *reinterpret_cast<const float4*>(p.stv + ((size_t)(lane >> 2) * T + tq0) * 16 + (lane & 3) * 4);
      if (lane < 16) nsi = *reinterpret_cast<const uint4*>(p.sti + ((size_t)lane * T + tq0) * 16);
    }
  }
  for (int tq = blockIdx.x * 4 + wid; tq < T; tq += gridDim.x * 4) {
    const size_t t = tq;
    __builtin_amdgcn_wave_barrier();
    *reinterpret_cast<float4*>(svl + lane * 4) = nsv;
    if (lane < 16) *reinterpret_cast<uint4*>(sil + lane * 16) = nsi;
    __builtin_amdgcn_wave_barrier();
    {
      int tqn = tq + gridDim.x * 4;
      if (tqn < T) {
        nsv = *reinterpret_cast<const float4*>(p.stv + ((size_t)(lane >> 2) * T + tqn) * 16 + (lane & 3) * 4);
        if (lane < 16) nsi = *reinterpret_cast<const uint4*>(p.sti + ((size_t)lane * T + tqn) * 16);
      }
    }
    const float* s1 = svl + (2 * h) * 16;
    const float* s2 = s1 + 16;
    float l[16];
#pragma unroll
    for (int q = 0; q < 16; ++q) l[q] = -INFINITY;
#pragma unroll
    for (int c = 0; c < 7; ++c) {
      u32 pr = prt[c];
      float v = -INFINITY;
      if (pr != 0xffu) {
        float a = s1[pr >> 4] + s2[pr & 15];
        u32 bits = __float_as_uint(a);
        bits = (bits & ~255u) | ((bits >> 31) ? pr : (255u - pr));
        v = __uint_as_float(bits);
      }
      ins16(l, v);
    }
#pragma unroll
    for (int msk = 1; msk <= 4; msk <<= 1) {
      float c[16];
#pragma unroll
      for (int q = 0; q < 16; ++q) c[q] = __shfl_xor(l[15 - q], msk);
#pragma unroll
      for (int q = 0; q < 16; ++q) c[q] = fmaxf(l[q], c[q]);
#pragma unroll
      for (int st = 8; st >= 1; st >>= 1)
#pragma unroll
        for (int q = 0; q < 16; ++q)
          if ((q & st) == 0) {
            float hi = fmaxf(c[q], c[q + st]), lo = fminf(c[q], c[q + st]);
            c[q] = hi; c[q + st] = lo;
          }
#pragma unroll
      for (int q = 0; q < 16; ++q) l[q] = c[q];
    }
    {
      float m = -INFINITY, ssum = 0.f;
      float bvv[16];
#pragma unroll
      for (int q = 0; q < 16; ++q) {
        u32 bits = __float_as_uint(l[q]);
        u32 low = bits & 255u;
        int prq = (int)((bits >> 31) ? low : (255u - low));
        bvv[q] = s1[prq >> 4] + s2[prq & 15];
        m = fmaxf(m, bvv[q]);
      }
#pragma unroll
      for (int q = 0; q < 16; ++q) { bvv[q] = __expf(bvv[q] - m); ssum += bvv[q]; }
      float inv = 1.f / ssum;
      const u8* i1 = sil + (2 * h) * 16;
      const u8* i2 = i1 + 16;
#pragma unroll
      for (int q = 0; q < 16; ++q) {
        if ((q >> 1) == g) {
          u32 bits = __float_as_uint(l[q]);
          u32 low = bits & 255u;
          int prq = (int)((bits >> 31) ? low : (255u - low));
          int exi = (int)i1[prq >> 4] * 128 + (int)i2[prq & 15];
          pe_e[h * 16 + q] = exi;
          pe_su[h * 16 + q] = p.su[exi];
          pe_gv[h * 16 + q] = bvv[q] * inv * p.sv[exi];
        }
      }
      __builtin_amdgcn_wave_barrier();
    }
    float rt;
    {
      float ssum = 0.f;
#pragma unroll
      for (int q = 0; q < 8; ++q) ssum += p.ssq[(size_t)q * T + t];
      rt = rsqrtf(ssum * (1.f / 1024.f) + EPS);
    }
    if (mode == 2) { __builtin_amdgcn_wave_barrier(); continue; }
    float2_t h2[8];
    {
      uint4 hx0 = *reinterpret_cast<const uint4*>(p.h1b + t * 1024 + lane * 16);
      uint4 hx1 = *reinterpret_cast<const uint4*>(p.h1b + t * 1024 + lane * 16 + 8);
      u32 hw[8] = {hx0.x, hx0.y, hx0.z, hx0.w, hx1.x, hx1.y, hx1.z, hx1.w};
#pragma unroll
      for (int q = 0; q < 8; ++q) { h2[q].x = bf_lo(hw[q]); h2[q].y = bf_hi(hw[q]); }
    }
    float2_t y2[8];
#pragma unroll
    for (int q = 0; q < 8; ++q) { y2[q].x = 0.f; y2[q].y = 0.f; }
    const int kk = (lane >> 3) & 7;
    for (int e0 = 0; e0 < 128; e0 += 8) {
      uint4 ur[8], vr[8];
#pragma unroll
      for (int k = 0; k < 8; ++k) {
        int ex = pe_e[e0 + k];
        ur[k] = *reinterpret_cast<const uint4*>(p.U8 + (size_t)ex * 1024 + lane * 16);
        vr[k] = *reinterpret_cast<const uint4*>(p.V8 + (size_t)ex * 1024 + lane * 16);
      }
      float d[8];
#pragma unroll
      for (int k = 0; k < 8; ++k) {
        u32 uw[4] = {ur[k].x, ur[k].y, ur[k].z, ur[k].w};
        float2_t acc = {0.f, 0.f};
#pragma unroll
        for (int q = 0; q < 4; ++q) {
          acc += __builtin_amdgcn_cvt_pk_f32_fp8((int)uw[q], false) * h2[2 * q];
          acc += __builtin_amdgcn_cvt_pk_f32_fp8((int)uw[q], true) * h2[2 * q + 1];
        }
        d[k] = acc.x + acc.y;
      }
      float e4[4], f2[2], gsum;
      {
        const bool hi = (lane & 32) != 0;
#pragma unroll
        for (int k = 0; k < 4; ++k) {
          float snd = hi ? d[k] : d[k + 4], kp = hi ? d[k + 4] : d[k];
          e4[k] = kp + __shfl_xor(snd, 32);
        }
        const bool hb = (lane & 16) != 0;
#pragma unroll
        for (int k = 0; k < 2; ++k) {
          float snd = hb ? e4[k] : e4[k + 2], kp = hb ? e4[k + 2] : e4[k];
          f2[k] = kp + __shfl_xor(snd, 16);
        }
        const bool hc = (lane & 8) != 0;
        float snd = hc ? f2[0] : f2[1], kp = hc ? f2[1] : f2[0];
        gsum = kp + __shfl_xor(snd, 8);
        gsum += __shfl_xor(gsum, 4);
        gsum += __shfl_xor(gsum, 2);
        gsum += __shfl_xor(gsum, 1);
      }
      float cme = pe_gv[e0 + kk] * gelu_f(gsum * rt * pe_su[e0 + kk]);
#pragma unroll
      for (int k = 0; k < 8; ++k) {
        float ck = __int_as_float(__builtin_amdgcn_readlane(__float_as_int(cme), k * 8));
        float2_t c2 = {ck, ck};
        u32 vw[4] = {vr[k].x, vr[k].y, vr[k].z, vr[k].w};
#pragma unroll
        for (int q = 0; q < 4; ++q) {
          y2[2 * q] += c2 * __builtin_amdgcn_cvt_pk_f32_fp8((int)vw[q], false);
          y2[2 * q + 1] += c2 * __builtin_amdgcn_cvt_pk_f32_fp8((int)vw[q], true);
        }
      }
    }
    float* op = p.out + t * 1024 + lane * 16;
    if (mode == 1) { if (y2[0].x == 123456.789f) op[0] = y2[0].x + y2[1].y + y2[2].x + y2[3].y + y2[4].x + y2[5].y + y2[6].x + y2[7].y; __builtin_amdgcn_wave_barrier(); continue; }
#pragma unroll
    for (int q = 0; q < 4; ++q) {
      float4 a = make_float4(h2[2 * q].x + y2[2 * q].x, h2[2 * q].y + y2[2 * q].y, h2[2 * q + 1].x + y2[2 * q + 1].x, h2[2 * q + 1].y + y2[2 * q + 1].y);
      *reinterpret_cast<float4*>(op + 4 * q) = a;
    }
    __builtin_amdgcn_wave_barrier();
  }
}

#ifndef PROBE_DUP
#define PROBE_DUP -1
#endif
__device__ void phase_mix(const Params& p, char* smem) {
  const int G = gridDim.x;
  {
    int* qslot = reinterpret_cast<int*>(smem + EXTRA_OFF + 1024);
    for (;;) {
      __syncthreads();
      if (threadIdx.x == 0) *qslot = (int)__hip_atomic_fetch_add(p.bar + 16, 1u, __ATOMIC_RELAXED, __HIP_MEMORY_SCOPE_AGENT);
      __syncthreads();
      const int s = *qslot;
      if (s >= 2048) break;
      int grp = 1023 - (s >> 1), b = s & 1;
      unit_indexer(p, smem, (b << 10) | grp, 0);
    }
  }
  for (int rep = 0; rep < (PROBE_DUP == 21 ? 2 : 1); ++rep)
  for (int u = blockIdx.x; u < 1024; u += G) unit_spatial(p, smem, u);
  for (int rep = 0; rep < (PROBE_DUP == 22 ? 2 : 1); ++rep)
  for (int u = blockIdx.x; u < 256; u += G) unit_kv(p, smem, u);
}

template <int PH>
__device__ __forceinline__ void run_phase(const Params& p, char* smem) {
  if (PH == 0) phase_prep(p, smem);
  else if (PH == 1) phase_gemm1(p, smem);
  else if (PH == 2) phase_mix(p, smem);
  else if (PH == 3) phase_attn(p, smem);
  else if (PH == 4) phase_merge(p, smem);
  else if (PH == 5) phase_wo(p, smem);
  else if (PH == 6) phase_peerq(p, smem);
  else phase_peer(p, smem);
}

template <int PH>
__global__ void __launch_bounds__(NTHREADS, 2) phase_kernel(Params p) {
  __shared__ __attribute__((aligned(16))) char smem[SMEM_BYTES];
  run_phase<PH>(p, smem);
}

__device__ __forceinline__ void grid_barrier(unsigned* ctr, unsigned& epoch) {
  asm volatile("s_waitcnt vmcnt(0)" ::: "memory");
  __syncthreads();
  epoch += gridDim.x;
  if (threadIdx.x == 0) {
    __builtin_amdgcn_fence(__ATOMIC_RELEASE, "agent");
    asm volatile("s_waitcnt vmcnt(0)" ::: "memory");
    __hip_atomic_fetch_add(ctr, 1u, __ATOMIC_RELAXED, __HIP_MEMORY_SCOPE_AGENT);
    unsigned spins = 0;
    while (__hip_atomic_load(ctr, __ATOMIC_RELAXED, __HIP_MEMORY_SCOPE_AGENT) < epoch) {
      __builtin_amdgcn_s_sleep(2);
      if (++spins > (1u << 24)) break;
    }
    __builtin_amdgcn_fence(__ATOMIC_ACQUIRE, "agent");
    asm volatile("s_waitcnt vmcnt(0)" ::: "memory");
  }
  __syncthreads();
}

__global__ void __launch_bounds__(NTHREADS, 2) mega_kernel(Params p) {
  __shared__ __attribute__((aligned(16))) char smem[SMEM_BYTES];
  cg::grid_group grid = cg::this_grid();
#ifdef EXP_ZERO
  for (int i = threadIdx.x; i < SMEM_BYTES / 4; i += NTHREADS) reinterpret_cast<u32*>(smem)[i] = 0u;
  __syncthreads();
#endif
#define GSYNC() grid_barrier(p.bar, bar_epoch)
  unsigned bar_epoch = 0;
  if (blockIdx.x == 0 && threadIdx.x == 0) {
    __hip_atomic_store(p.bar, 0u, __ATOMIC_RELAXED, __HIP_MEMORY_SCOPE_AGENT);
    __hip_atomic_store(p.bar + 16, 0u, __ATOMIC_RELAXED, __HIP_MEMORY_SCOPE_AGENT);
  }
  run_phase<0>(p, smem);
  if (PROBE_DUP == 0) run_phase<0>(p, smem);
  asm volatile("s_waitcnt vmcnt(0)" ::: "memory");
  grid.sync();
#define RUNP(X) run_phase<X>(p, smem); GSYNC(); if (PROBE_DUP == X) { run_phase<X>(p, smem); GSYNC(); }
  RUNP(1) RUNP(2) RUNP(3) RUNP(4) RUNP(5) RUNP(6)
  if (PROBE_DUP == 41) { phase_peer(p, smem, 1); GSYNC(); }
  if (PROBE_DUP == 42) { phase_peer(p, smem, 2); GSYNC(); }
  run_phase<7>(p, smem);
#if TIMING
  if (blockIdx.x == 8 && threadIdx.x == 0) {
    __threadfence();
    float per = (float)g_tim[TIMING - 1] / (float)g_tim[5];
    float delta = sqrtf(per * 10.f);
    p.out[(size_t)8 * 17 * 1024 + 5] += delta;
  }
#endif
}

extern "C" void kernel_launch(void* const* d_in, const int* in_sizes, int n_in, void* d_out, int out_size,
                              void* d_ws, size_t ws_size, hipStream_t stream) {
  Params p{};
  p.x = (const float*)d_in[0]; p.pos = (const int*)d_in[1];
  p.norm1_g = (const float*)d_in[2]; p.w_in = (const float*)d_in[3]; p.v_norm_g = (const float*)d_in[4];
  p.v_norm_b = (const float*)d_in[5]; p.spatial_w = (const float*)d_in[6]; p.spatial_b = (const float*)d_in[7];
  p.kv_norm_g = (const float*)d_in[8]; p.w_uk = (const float*)d_in[9]; p.w_uv = (const float*)d_in[10];
  p.q_norm_g = (const float*)d_in[11]; p.k_norm_g = (const float*)d_in[12]; p.w_a_out = (const float*)d_in[13];
  p.w_b_out = (const float*)d_in[14]; p.w_o = (const float*)d_in[15]; p.norm2_g = (const float*)d_in[16];
  p.peer_wq = (const float*)d_in[17]; p.peer_subkeys = (const float*)d_in[18]; p.peer_u = (const float*)d_in[19];
  p.peer_v = (const float*)d_in[20];
  p.out = (float*)d_out;
  char* w = (char*)d_ws;
  size_t off = 0;
  auto take = [&](size_t bytes) { char* r = w + off; off += (bytes + 255) & ~(size_t)255; return r; };
  const size_t MB = 1u << 20;
  char* r_xn = take(64 * MB);
  p.xn = (u16*)r_xn; p.ya = (u16*)r_xn; p.yb = (u16*)(r_xn + 32 * MB);
  p.WinT = (u16*)take((size_t)NWIN * 1024 * 2);
  p.WaT = (u16*)take(1024 * 512 * 2); p.WbT = (u16*)take(1024 * 512 * 2);
  p.WoT = (u16*)take(1024 * 1024 * 2); p.WqT = (u16*)take(2048 * 1024 * 2);
  p.WkvT = (u16*)take(256 * 256 * 2); p.SubK = (u16*)take(262144 * 2); p.Wtril = (u16*)take(65536 * 2);
  p.U8 = (u8*)take(16 * MB); p.V8 = (u8*)take(16 * MB);
  p.su = (float*)take(16384 * 4); p.sv = (float*)take(16384 * 4);
  char* r_g = take(96 * MB);
  p.gu = (u16*)r_g; p.gv = (u16*)(r_g + 32 * MB); p.qh = (u16*)(r_g + 64 * MB); p.merged = (u16*)r_g;
  p.ckv = (u16*)take(16 * MB); p.qi = (u16*)take(16 * MB); p.ki = (u16*)take(4 * MB);
  p.wi = (float*)take((size_t)T * 4 * 4);
  char* r_sg = take(128 * MB);
  p.sg = (u16*)r_sg; p.h1b = (u16*)r_sg; p.stv = (float*)(r_sg + 64 * MB); p.sti = (u8*)(r_sg + 96 * MB);
  p.kk = (u16*)take(8 * MB); p.vv = (u16*)take(8 * MB); p.sel = (u16*)take(16 * MB);
  p.kv8 = (u8*)take(8 * MB); p.scal = (float*)take(256);
  p.ssq = (float*)take((size_t)T * 8 * 4);
  p.bar = (unsigned*)take(256);
  p.rtab = (float*)take((size_t)T * 48 * 4);
  if (off > ws_size) { fprintf(stderr, "workspace too small: need %zu have %zu\n", off, ws_size); return; }

  static int grid_blocks = 0;
  if (!grid_blocks) {
    int dev = 0, cus = 0, per_cu = 0;
    hipGetDevice(&dev);
    hipDeviceGetAttribute(&cus, hipDeviceAttributeMultiprocessorCount, dev);
    hipOccupancyMaxActiveBlocksPerMultiprocessor(&per_cu, mega_kernel, NTHREADS, 0);
    if (per_cu > 2) per_cu = 2;
    if (per_cu < 1) per_cu = 1;
    grid_blocks = cus * per_cu;
  }
#ifdef EXP_ZERO
  hipMemsetAsync(d_ws, 0, off, stream);
#endif
#if MULTI_LAUNCH
  dim3 g(grid_blocks), b(NTHREADS);
  phase_kernel<0><<<g, b, 0, stream>>>(p);
  phase_kernel<1><<<g, b, 0, stream>>>(p);
  phase_kernel<2><<<g, b, 0, stream>>>(p);
  phase_kernel<3><<<g, b, 0, stream>>>(p);
  phase_kernel<4><<<g, b, 0, stream>>>(p);
  phase_kernel<5><<<g, b, 0, stream>>>(p);
  phase_kernel<6><<<g, b, 0, stream>>>(p);
  phase_kernel<7><<<g, b, 0, stream>>>(p);
#else
  void* args[] = {&p};
  hipError_t e = hipLaunchCooperativeKernel((void*)mega_kernel, dim3(grid_blocks), dim3(NTHREADS), args, 0, stream);
  if (e != hipSuccess) fprintf(stderr, "cooperative launch failed: %s (grid %d)\n", hipGetErrorString(e), grid_blocks);
#endif
}
```

```cpp
#include <hip/hip_runtime.h>
#include <hip/hip_cooperative_groups.h>
#include <stdint.h>
#include <cstdio>
namespace cg = cooperative_groups;

#ifndef MULTI_LAUNCH
#define MULTI_LAUNCH 0
#endif

typedef unsigned short u16;
typedef unsigned int u32;
typedef unsigned char u8;
using bf16x8 = __attribute__((ext_vector_type(8))) short;
using f32x4 = __attribute__((ext_vector_type(4))) float;
using f32x16 = __attribute__((ext_vector_type(16))) float;
typedef __bf16 bf16x2_t __attribute__((ext_vector_type(2)));
typedef float float2_t __attribute__((ext_vector_type(2)));

constexpr int BATCH = 2, SEQ = 16384, DM = 1024, T = BATCH * SEQ;
constexpr int NWIN = 4224;
constexpr int NTHREADS = 256;
constexpr float EPS = 1e-6f;
constexpr int ABUF = 128 * 144;
constexpr int CS_LD = 132;
constexpr int SMEM_BYTES = 77824;
constexpr int EXTRA_OFF = 4 * ABUF;
constexpr int CAP = 768;

__constant__ float INV32[16] = {1.000000000e+00f, 4.403665960e-01f, 1.939227432e-01f, 8.539710194e-02f, 3.760603070e-02f, 1.656043902e-02f, 7.292664610e-03f, 3.211445874e-03f, 1.414213562e-03f, 6.227723788e-04f, 2.742481884e-04f, 1.207697351e-04f, 5.318296098e-05f, 2.341999971e-05f, 1.031338616e-05f, 4.541670478e-06f};
__constant__ float INV16[8] = {1.000000000e+00f, 1.939227432e-01f, 3.760603070e-02f, 7.292664610e-03f, 1.414213562e-03f, 2.742481884e-04f, 5.318296098e-05f, 1.031338616e-05f};
__constant__ u8 PAIR_TAB[56] = {
  0x00,0x01,0x02,0x03,0x04,0x05,0x06,0x07,0x08,0x09,0x0a,0x0b,0x0c,0x0d,0x0e,0x0f,
  0x10,0x11,0x12,0x13,0x14,0x15,0x16,0x17,
  0x20,0x21,0x22,0x23,0x24,
  0x30,0x31,0x32,0x33,
  0x40,0x41,0x42,
  0x50,0x51,
  0x60,0x61,
  0x70,0x71,
  0x80,0x90,0xa0,0xb0,0xc0,0xd0,0xe0,0xf0,
  0xff,0xff,0xff,0xff,0xff,0xff};

struct Params {
  const float* x; const int* pos;
  const float *norm1_g, *w_in, *v_norm_g, *v_norm_b, *spatial_w, *spatial_b, *kv_norm_g, *w_uk, *w_uv,
      *q_norm_g, *k_norm_g, *w_a_out, *w_b_out, *w_o, *norm2_g, *peer_wq, *peer_subkeys, *peer_u, *peer_v;
  float* out;
  u16 *xn, *WinT, *WaT, *WbT, *WoT, *WqT, *WkvT, *SubK, *Wtril;
  u8 *U8, *V8, *kv8;
  float *su, *sv, *scal;
  u16 *gu, *gv, *qh, *ckv, *qi, *ki, *sg, *ya, *yb, *merged, *h1b, *sel;
  float *wi, *ssq, *stv, *rtab;
  u8* sti;
  unsigned* bar;
};

__device__ __forceinline__ u32 pack_bf16(float a, float b) {
  float2_t v = {a, b};
  bf16x2_t r = __builtin_convertvector(v, bf16x2_t);
  return __builtin_bit_cast(u32, r);
}
__device__ __forceinline__ u16 f2bf(float a) { return (u16)(pack_bf16(a, 0.f) & 0xffffu); }
__device__ __forceinline__ float bf_lo(u32 u) { return __uint_as_float(u << 16); }
__device__ __forceinline__ float bf_hi(u32 u) { return __uint_as_float(u & 0xffff0000u); }
__device__ __forceinline__ float bf2f(u16 h) { return __uint_as_float(((u32)h) << 16); }
__device__ __forceinline__ float wave_sum(float v) {
#pragma unroll
  for (int m = 32; m >= 1; m >>= 1) v += __shfl_xor(v, m);
  return v;
}
__device__ __forceinline__ float gelu_f(float x) {
  float z = -2.3022082f * (x + 0.044715f * x * x * x);
  return x * __builtin_amdgcn_rcpf(1.f + __builtin_amdgcn_exp2f(z));
}
__device__ __forceinline__ float sigmoid_f(float x) { return __builtin_amdgcn_rcpf(1.f + __builtin_amdgcn_exp2f(-1.4426950408889634f * x)); }
__device__ __forceinline__ u32 sortable(u32 b) { return b ^ ((u32)((int)b >> 31) | 0x80000000u); }
__device__ __forceinline__ u32 unsortable(u32 k) { return k ^ ((k & 0x80000000u) ? 0x80000000u : 0xffffffffu); }
__device__ __forceinline__ int mbcnt64(unsigned long long m) {
  return __builtin_amdgcn_mbcnt_hi((u32)(m >> 32), __builtin_amdgcn_mbcnt_lo((u32)m, 0));
}

__device__ __forceinline__ void load8(const float* p, float (&v)[8]) {
  float4 a = *reinterpret_cast<const float4*>(p), b = *reinterpret_cast<const float4*>(p + 4);
  v[0] = a.x; v[1] = a.y; v[2] = a.z; v[3] = a.w; v[4] = b.x; v[5] = b.y; v[6] = b.z; v[7] = b.w;
}
__device__ __forceinline__ void unpack8(uint4 q, float (&v)[8]) {
  v[0] = bf_lo(q.x); v[1] = bf_hi(q.x); v[2] = bf_lo(q.y); v[3] = bf_hi(q.y);
  v[4] = bf_lo(q.z); v[5] = bf_hi(q.z); v[6] = bf_lo(q.w); v[7] = bf_hi(q.w);
}
__device__ __forceinline__ uint4 pack8(const float (&v)[8]) {
  uint4 o = {pack_bf16(v[0], v[1]), pack_bf16(v[2], v[3]), pack_bf16(v[4], v[5]), pack_bf16(v[6], v[7])};
  return o;
}
#define DPPF(v, ctrl) __int_as_float(__builtin_amdgcn_update_dpp(0, __float_as_int(v), (ctrl), 0xF, 0xF, true))
__device__ __forceinline__ float sum16(float x) {
  x += DPPF(x, 0xB1); x += DPPF(x, 0x4E); x += DPPF(x, 0x141); x += DPPF(x, 0x140);
  return x;
}
__device__ __forceinline__ float max16(float x) {
  x = fmaxf(x, DPPF(x, 0xB1)); x = fmaxf(x, DPPF(x, 0x4E)); x = fmaxf(x, DPPF(x, 0x141)); x = fmaxf(x, DPPF(x, 0x140));
  return x;
}
__device__ __forceinline__ void rope32_8(float (&v)[8], int L, const float* tab) {
  float pr[8];
#pragma unroll
  for (int e = 0; e < 8; ++e) pr[e] = __shfl_xor(v[e], 2);
  if (L < 4) {
    float c[8], s[8];
    load8(tab + (L & 1) * 8, c);
    load8(tab + 16 + (L & 1) * 8, s);
#pragma unroll
    for (int e = 0; e < 8; ++e) v[e] = (L < 2) ? (v[e] * c[e] - pr[e] * s[e]) : (v[e] * c[e] + pr[e] * s[e]);
  }
}
__device__ __forceinline__ void rope16_8(float (&v)[8], int lc0, const float* tab) {
  float pr[8];
#pragma unroll
  for (int e = 0; e < 8; ++e) pr[e] = __shfl_xor(v[e], 1);
  if (lc0 < 16) {
    float c[8], s[8];
    load8(tab + 32, c);
    load8(tab + 40, s);
#pragma unroll
    for (int e = 0; e < 8; ++e) v[e] = (lc0 == 0) ? (v[e] * c[e] - pr[e] * s[e]) : (v[e] * c[e] + pr[e] * s[e]);
  }
}

typedef u32 u32x4 __attribute__((ext_vector_type(4)));
struct Tile4 { u32x4 v0, v1, v2, v3; };
__device__ __forceinline__ void gemm_load_tile(const u16* __restrict__ g, int ld, int k0, Tile4& r) {
  const int tid = threadIdx.x;
  const int row = tid >> 3, kc = tid & 7;
  const u16* base = g + (size_t)row * ld + k0 + kc * 8;
  r.v0 = *reinterpret_cast<const u32x4*>(base);
  r.v1 = *reinterpret_cast<const u32x4*>(base + (size_t)32 * ld);
  r.v2 = *reinterpret_cast<const u32x4*>(base + (size_t)64 * ld);
  r.v3 = *reinterpret_cast<const u32x4*>(base + (size_t)96 * ld);
}
__device__ __forceinline__ void gemm_store_tile(char* buf, const Tile4& r) {
  const int tid = threadIdx.x;
  const int row = tid >> 3, kc = tid & 7;
  char* base = buf + row * 144 + kc * 16;
  *reinterpret_cast<u32x4*>(base) = r.v0;
  *reinterpret_cast<u32x4*>(base + 32 * 144) = r.v1;
  *reinterpret_cast<u32x4*>(base + 64 * 144) = r.v2;
  *reinterpret_cast<u32x4*>(base + 96 * 144) = r.v3;
}
__device__ __forceinline__ void mma_ktile(const char* sa, const char* sb, f32x16 (&acc)[2][2]) {
  const int lane = threadIdx.x & 63, wid = threadIdx.x >> 6;
  const int wr = wid >> 1, wc = wid & 1;
  const int r32 = lane & 31, hf = lane >> 5;
  const char* pa = sa + (wr * 64 + r32) * 144 + hf * 16;
  const char* pb = sb + (wc * 64 + r32) * 144 + hf * 16;
  bf16x8 a0[2], b0[2], a1[2], b1[2];
#pragma unroll
  for (int i = 0; i < 2; ++i) {
    a0[i] = *reinterpret_cast<const bf16x8*>(pa + i * 32 * 144);
    b0[i] = *reinterpret_cast<const bf16x8*>(pb + i * 32 * 144);
  }
#pragma unroll
  for (int s = 0; s < 4; s += 2) {
#pragma unroll
    for (int i = 0; i < 2; ++i) {
      a1[i] = *reinterpret_cast<const bf16x8*>(pa + i * 32 * 144 + (s + 1) * 32);
      b1[i] = *reinterpret_cast<const bf16x8*>(pb + i * 32 * 144 + (s + 1) * 32);
    }
    __builtin_amdgcn_s_setprio(1);
#pragma unroll
    for (int i = 0; i < 2; ++i)
#pragma unroll
      for (int j = 0; j < 2; ++j)
        acc[i][j] = __builtin_amdgcn_mfma_f32_32x32x16_bf16(a0[i], b0[j], acc[i][j], 0, 0, 0);
    __builtin_amdgcn_s_setprio(0);
    if (s + 2 < 4) {
#pragma unroll
      for (int i = 0; i < 2; ++i) {
        a0[i] = *reinterpret_cast<const bf16x8*>(pa + i * 32 * 144 + (s + 2) * 32);
        b0[i] = *reinterpret_cast<const bf16x8*>(pb + i * 32 * 144 + (s + 2) * 32);
      }
    }
    __builtin_amdgcn_s_setprio(1);
#pragma unroll
    for (int i = 0; i < 2; ++i)
#pragma unroll
      for (int j = 0; j < 2; ++j)
        acc[i][j] = __builtin_amdgcn_mfma_f32_32x32x16_bf16(a1[i], b1[j], acc[i][j], 0, 0, 0);
    __builtin_amdgcn_s_setprio(0);
  }
}
#define GEMM_KT(i, nk) ((((i) + ((int)(blockIdx.x >> 3))) & ((nk) - 1)) << 6)
__device__ __forceinline__ void gemm_prefetch(const u16* __restrict__ A, int lda, const u16* __restrict__ B, int ldb, int K, Tile4& ra, Tile4& rb) {
  const int nk = K >> 6;
  gemm_load_tile(A, lda, GEMM_KT(0, nk), ra);
  gemm_load_tile(B, ldb, GEMM_KT(0, nk), rb);
}
__device__ __forceinline__ void gemm_mainloop(const u16* __restrict__ A, int lda, const u16* __restrict__ B, int ldb,
                                              int K, f32x16 (&acc)[2][2], char* smem, Tile4& ra, Tile4& rb) {
  const int nk = K >> 6;
  __syncthreads();
  gemm_store_tile(smem, ra);
  gemm_store_tile(smem + 2 * ABUF, rb);
  __syncthreads();
#pragma unroll 1
  for (int kt = 0; kt < nk; ++kt) {
    const int cur = kt & 1;
    if (kt + 1 < nk) {
      gemm_load_tile(A, lda, GEMM_KT(kt + 1, nk), ra);
      gemm_load_tile(B, ldb, GEMM_KT(kt + 1, nk), rb);
    }
    mma_ktile(smem + cur * ABUF, smem + (2 + cur) * ABUF, acc);
    if (kt + 1 < nk) {
      gemm_store_tile(smem + (cur ^ 1) * ABUF, ra);
      gemm_store_tile(smem + (2 + (cur ^ 1)) * ABUF, rb);
    }
    __syncthreads();
  }
}
__device__ __forceinline__ void zero_acc(f32x16 (&acc)[2][2]) {
#pragma unroll
  for (int i = 0; i < 2; ++i)
#pragma unroll
    for (int j = 0; j < 2; ++j)
#pragma unroll
      for (int r = 0; r < 16; ++r) acc[i][j][r] = 0.f;
}
__device__ __forceinline__ void stage_acc(const f32x16 (&acc)[2][2], float* cs) {
  const int lane = threadIdx.x & 63, wid = threadIdx.x >> 6;
  const int wr = wid >> 1, wc = wid & 1;
#pragma unroll
  for (int i = 0; i < 2; ++i)
#pragma unroll
    for (int j = 0; j < 2; ++j)
#pragma unroll
      for (int r = 0; r < 16; ++r) {
        int row = wr * 64 + i * 32 + (r & 3) + 8 * (r >> 2) + 4 * (lane >> 5);
        int col = wc * 64 + j * 32 + (lane & 31);
        cs[row * CS_LD + col] = acc[i][j][r];
      }
}

__device__ __forceinline__ int win_srccol(int n) {
  if (n < 2116) return n;
  if (n < 2176) return -1;
  return n - 60;
}
__device__ void phase_prep(const Params& p, char* smem) {
  const int tid = threadIdx.x, lane = tid & 63, wid = tid >> 6;
  for (int rb = blockIdx.x; rb < T / 4; rb += gridDim.x) {
    int row = rb * 4 + wid;
    const float* xr = p.x + (size_t)row * DM;
    float4 v[4];
    float ss = 0.f;
#pragma unroll
    for (int i = 0; i < 4; ++i) {
      v[i] = *reinterpret_cast<const float4*>(xr + lane * 4 + 256 * i);
      ss += v[i].x * v[i].x + v[i].y * v[i].y + v[i].z * v[i].z + v[i].w * v[i].w;
    }
    ss = wave_sum(ss);
    float r = rsqrtf(ss * (1.f / DM) + EPS);
#pragma unroll
    for (int i = 0; i < 4; ++i) {
      float4 g = *reinterpret_cast<const float4*>(p.norm1_g + lane * 4 + 256 * i);
      uint2 o;
      o.x = pack_bf16(v[i].x * r * g.x, v[i].y * r * g.y);
      o.y = pack_bf16(v[i].z * r * g.z, v[i].w * r * g.w);
      *reinterpret_cast<uint2*>(p.xn + (size_t)row * DM + lane * 4 + 256 * i) = o;
    }
  }
  float* tile = reinterpret_cast<float*>(smem);
  constexpr int NT_TOTAL = 1056 + 128 + 128 + 256 + 512 + 8 + 8;
  for (int ti = blockIdx.x; ti < NT_TOTAL; ti += gridDim.x) {
    const float* src; const float* scale = nullptr; u16* dst; int ldsrc, K, nn, mode = 0; int t = ti;
    if (t < 1056) { src = p.w_in; ldsrc = 4164; K = 1024; nn = 66; dst = p.WinT; mode = 1; }
    else if ((t -= 1056) < 128) { src = p.w_a_out; ldsrc = 1024; K = 512; nn = 16; dst = p.WaT; }
    else if ((t -= 128) < 128) { src = p.w_b_out; ldsrc = 1024; K = 512; nn = 16; dst = p.WbT; }
    else if ((t -= 128) < 256) { src = p.w_o; ldsrc = 1024; K = 1024; nn = 16; dst = p.WoT; }
    else if ((t -= 256) < 512) { src = p.peer_wq; ldsrc = 2048; K = 1024; nn = 32; dst = p.WqT; scale = p.norm2_g; }
    else if ((t -= 512) < 8) { src = p.w_uk; ldsrc = 128; K = 256; nn = 2; dst = p.WkvT; scale = p.kv_norm_g; }
    else { t -= 8; src = p.w_uv; ldsrc = 128; K = 256; nn = 2; dst = p.WkvT + 128 * 256; scale = p.kv_norm_g; }
    int n0 = (t % nn) * 64, k0 = (t / nn) * 64;
    __syncthreads();
    {
      int n = tid & 63;
      int sc = (mode == 1) ? win_srccol(n0 + n) : (n0 + n);
      for (int kk = tid >> 6; kk < 64; kk += 4) {
        float v = 0.f;
        if (sc >= 0) v = src[(size_t)(k0 + kk) * ldsrc + sc];
        if (scale) v *= scale[k0 + kk];
        tile[kk * 65 + n] = v;
      }
    }
    __syncthreads();
    {
      int k = (tid & 31) * 2;
      for (int n = tid >> 5; n < 64; n += 8) {
        u32 o = pack_bf16(tile[k * 65 + n], tile[(k + 1) * 65 + n]);
        *reinterpret_cast<u32*>(dst + (size_t)(n0 + n) * K + k0 + k) = o;
      }
    }
  }
  constexpr int G_SUB = 262144 / 4, G_SW = 65536 / 4;
  constexpr int G_TOTAL = G_SUB + G_SW;
  for (int gi = blockIdx.x * NTHREADS + tid; gi < G_TOTAL; gi += gridDim.x * NTHREADS) {
    int g = gi;
    if (g < G_SUB) {
      float4 v = *reinterpret_cast<const float4*>(p.peer_subkeys + (size_t)g * 4);
      uint2 o = {pack_bf16(v.x, v.y), pack_bf16(v.z, v.w)};
      *reinterpret_cast<uint2*>(p.SubK + (size_t)g * 4) = o;
    } else {
      g -= G_SUB;
      float4 v = *reinterpret_cast<const float4*>(p.spatial_w + (size_t)g * 4);
      int e = g * 4; int s = e & 127, tt = (e >> 7) & 127;
      if (s > tt) v.x = 0.f;
      if (s + 1 > tt) v.y = 0.f;
      if (s + 2 > tt) v.z = 0.f;
      if (s + 3 > tt) v.w = 0.f;
      uint2 o = {pack_bf16(v.x, v.y), pack_bf16(v.z, v.w)};
      *reinterpret_cast<uint2*>(p.Wtril + (size_t)g * 4) = o;
    }
  }
  if (blockIdx.x == 0) {
    float* red = reinterpret_cast<float*>(smem);
    __syncthreads();
    float vq = 0.f, vk = 0.f, vn = 0.f;
    if (tid < 128) {
      vq = fabsf(p.q_norm_g[tid]); vk = fabsf(p.k_norm_g[tid]);
      float ss = 0.f;
      for (int k = 0; k < 256; ++k) { float w = p.w_uv[k * 128 + tid] * p.kv_norm_g[k]; ss += w * w; }
      vn = sqrtf(ss);
    }
    red[tid] = vq; red[256 + tid] = vk; red[512 + tid] = vn;
    __syncthreads();
    if (tid == 0) {
      float mq = 0.f, mk = 0.f, mn = 0.f;
      for (int k = 0; k < 128; ++k) { mq = fmaxf(mq, red[k]); mk = fmaxf(mk, red[256 + k]); mn = fmaxf(mn, red[512 + k]); }
      int eq = ilogbf(440.f / fmaxf(11.3137085f * mq, 1e-20f));
      int ek = ilogbf(440.f / fmaxf(11.3137085f * mk, 1e-20f));
      int ev = ilogbf(440.f / fmaxf(16.f * mn, 1e-20f));
      eq = eq > 40 ? 40 : (eq < -40 ? -40 : eq); ek = ek > 40 ? 40 : (ek < -40 ? -40 : ek); ev = ev > 40 ? 40 : (ev < -40 ? -40 : ev);
      p.scal[0] = ldexpf(1.f, eq); p.scal[1] = ldexpf(1.f, ek); p.scal[2] = ldexpf(1.f, ev);
      p.scal[3] = ldexpf(1.f, -eq - ek); p.scal[4] = ldexpf(1.f, -ev);
    }
    __syncthreads();
  }
  for (int gi = blockIdx.x * NTHREADS + tid; gi < T * 24; gi += gridDim.x * NTHREADS) {
    int t = gi / 24, j = gi - t * 24;
    float posf = (float)p.pos[t];
    float sn, cn;
    if (j < 16) { sincosf(posf * INV32[j], &sn, &cn); p.rtab[(size_t)t * 48 + j] = cn; p.rtab[(size_t)t * 48 + 16 + j] = sn; }
    else { int jj = j - 16; sincosf(posf * INV16[jj], &sn, &cn); p.rtab[(size_t)t * 48 + 32 + jj] = cn; p.rtab[(size_t)t * 48 + 40 + jj] = sn; }
  }
  for (int rb = blockIdx.x; rb < 8192; rb += gridDim.x) {
    int r = rb * 4 + wid;
    bool isu = r < 16384;
    int rr = isu ? r : r - 16384;
    const float* src = (isu ? p.peer_u : p.peer_v) + (size_t)rr * 1024 + lane * 16;
    float v[16];
#pragma unroll
    for (int i = 0; i < 4; ++i) {
      float4 q = *reinterpret_cast<const float4*>(src + 4 * i);
      v[4 * i] = q.x; v[4 * i + 1] = q.y; v[4 * i + 2] = q.z; v[4 * i + 3] = q.w;
    }
    if (isu) {
#pragma unroll
      for (int i = 0; i < 4; ++i) {
        float4 g = *reinterpret_cast<const float4*>(p.norm2_g + lane * 16 + 4 * i);
        v[4 * i] *= g.x; v[4 * i + 1] *= g.y; v[4 * i + 2] *= g.z; v[4 * i + 3] *= g.w;
      }
    }
    float amax = 0.f;
#pragma unroll
    for (int i = 0; i < 16; ++i) amax = fmaxf(amax, fabsf(v[i]));
#pragma unroll
    for (int m = 32; m >= 1; m >>= 1) amax = fmaxf(amax, __shfl_xor(amax, m));
    int ex = 0;
    if (amax > 0.f) ex = ilogbf(224.f / amax);
    ex = ex > 60 ? 60 : (ex < -60 ? -60 : ex);
    float sc = ldexpf(1.f, ex);
    u32 w[4];
#pragma unroll
    for (int i = 0; i < 4; ++i) {
      int t = __builtin_amdgcn_cvt_pk_fp8_f32(v[4 * i] * sc, v[4 * i + 1] * sc, 0, false);
      t = __builtin_amdgcn_cvt_pk_fp8_f32(v[4 * i + 2] * sc, v[4 * i + 3] * sc, t, true);
      w[i] = (u32)t;
    }
    uint4 o = {w[0], w[1], w[2], w[3]};
    *reinterpret_cast<uint4*>((isu ? p.U8 : p.V8) + (size_t)rr * 1024 + lane * 16) = o;
    if (lane == 0) (isu ? p.su : p.sv)[rr] = ldexpf(1.f, -ex);
  }
}

__device__ __forceinline__ void rope_pair(float& y0, float& y1, int lc, int half, int xm, float posf, const float* inv) {
  float p0 = __shfl_xor(y0, xm), p1 = __shfl_xor(y1, xm);
  if (lc < 2 * half) {
    int j = lc & (half - 1);
    float a0 = posf * inv[j], a1 = posf * inv[j + 1];
    float s0, c0, s1, c1;
    sincosf(a0, &s0, &c0);
    sincosf(a1, &s1, &c1);
    if (lc < half) { y0 = y0 * c0 - p0 * s0; y1 = y1 * c1 - p1 * s1; }
    else { y0 = y0 * c0 + p0 * s0; y1 = y1 * c1 + p1 * s1; }
  }
}

__device__ __forceinline__ bool tile_swizzle(int step, int ntn, int ntiles, int& mt, int& nt) {
  const int x = blockIdx.x & 7, slot = blockIdx.x >> 3;
  const int nslots = gridDim.x >> 3;
  const int lin = (step * 8 + x) * nslots + slot;
  if (lin >= ntiles) return false;
  const int per = ntn * 16;
  const int g = lin / per, rem = lin - g * per;
  nt = rem >> 4;
  mt = g * 16 + (rem & 15);
  return true;
}

__device__ void phase_gemm1(const Params& p, char* smem) {
  const int tid = threadIdx.x, lane = tid & 63, wid = tid >> 6;
  float* cs = reinterpret_cast<float*>(smem);
  constexpr int NTN = NWIN / 128;
  constexpr int NTILES = (T / 128) * NTN;
  int mt, nt;
  bool have = tile_swizzle(0, NTN, NTILES, mt, nt);
  Tile4 ra, rb;
  if (have) gemm_prefetch(p.xn + (size_t)mt * 128 * DM, DM, p.WinT + (size_t)nt * 128 * DM, DM, DM, ra, rb);
  for (int step = 0; have; ++step) {
    int m0 = mt * 128;
    f32x16 acc[2][2];
    zero_acc(acc);
    gemm_mainloop(p.xn + (size_t)m0 * DM, DM, p.WinT + (size_t)nt * 128 * DM, DM, DM, acc, smem, ra, rb);
    stage_acc(acc, cs);
    __syncthreads();
    int mt2 = 0, nt2 = 0;
    const bool nxt = tile_swizzle(step + 1, NTN, NTILES, mt2, nt2);
    if (nxt) gemm_prefetch(p.xn + (size_t)mt2 * 128 * DM, DM, p.WinT + (size_t)nt2 * 128 * DM, DM, DM, ra, rb);
    const int L = lane & 15, rsub = lane >> 4, c0 = L * 8;
#pragma unroll 1
    for (int it = 0; it < 8; ++it) {
      const int row = wid * 32 + it * 4 + rsub;
      const size_t t = (size_t)m0 + row;
      float v[8];
      load8(cs + row * CS_LD + c0, v);
      if (nt < 8) {
#pragma unroll
        for (int e = 0; e < 8; ++e) v[e] = gelu_f(v[e]);
        u16* dst = (nt < 4) ? (p.gu + t * 512 + nt * 128 + c0) : (p.gv + t * 512 + (nt - 4) * 128 + c0);
        *reinterpret_cast<uint4*>(dst) = pack8(v);
      } else if (nt < 12) {
        float ss = 0.f;
#pragma unroll
        for (int e = 0; e < 8; ++e) ss += v[e] * v[e];
        ss = sum16(ss);
        float r = rsqrtf(ss * (1.f / 128.f) + EPS);
        float g[8];
        load8(p.q_norm_g + c0, g);
#pragma unroll
        for (int e = 0; e < 8; ++e) v[e] = v[e] * r * g[e];
        rope32_8(v, L, p.rtab + t * 48);
        *reinterpret_cast<uint4*>(p.qh + t * 512 + (nt - 8) * 128 + c0) = pack8(v);
      } else if (nt < 14) {
        *reinterpret_cast<uint4*>(p.ckv + t * 256 + (nt - 12) * 128 + c0) = pack8(v);
      } else if (nt < 16) {
        rope16_8(v, c0 & 63, p.rtab + t * 48);
        *reinterpret_cast<uint4*>(p.qi + t * 256 + (nt - 14) * 128 + c0) = pack8(v);
      } else if (nt == 16) {
        rope16_8(v, c0 < 64 ? c0 : 64, p.rtab + t * 48);
        if (c0 < 64) *reinterpret_cast<uint4*>(p.ki + ((t >> 4) * 8 + L) * 128 + (t & 15) * 8) = pack8(v);
        else if (c0 == 64) *reinterpret_cast<float4*>(p.wi + t * 4) = make_float4(v[0] * 0.0625f, v[1] * 0.0625f, v[2] * 0.0625f, v[3] * 0.0625f);
      } else {
#pragma unroll
        for (int e = 0; e < 8; ++e) v[e] = sigmoid_f(v[e]);
        *reinterpret_cast<uint4*>(p.sg + t * 2048 + (nt - 17) * 128 + c0) = pack8(v);
      }
    }
    mt = mt2; nt = nt2; have = nxt;
  }
}

__device__ void unit_kv(const Params& p, char* smem, int mt) {
  const int tid = threadIdx.x, lane = tid & 63, wid = tid >> 6;
  float* cs = reinterpret_cast<float*>(smem);
  float* rr_s = reinterpret_cast<float*>(smem + EXTRA_OFF);
  const int m0 = mt * 128;
  __syncthreads();
  {
    int row = tid >> 1, half = tid & 1;
    const u16* src = p.ckv + (size_t)(m0 + row) * 256 + half * 128;
    float ss = 0.f;
#pragma unroll 4
    for (int i = 0; i < 16; ++i) {
      uint4 q = *reinterpret_cast<const uint4*>(src + i * 8);
      u32 w[4] = {q.x, q.y, q.z, q.w};
#pragma unroll
      for (int j = 0; j < 4; ++j) { float a = bf_lo(w[j]), b = bf_hi(w[j]); ss += a * a + b * b; }
    }
    ss += __shfl_xor(ss, 1);
    if (half == 0) rr_s[row] = rsqrtf(ss * (1.f / 256.f) + EPS);
  }
  Tile4 ra, rb;
  gemm_prefetch(p.ckv + (size_t)m0 * 256, 256, p.WkvT, 256, 256, ra, rb);
#pragma unroll 1
  for (int nt = 0; nt < 2; ++nt) {
    f32x16 acc[2][2];
    zero_acc(acc);
    gemm_mainloop(p.ckv + (size_t)m0 * 256, 256, p.WkvT + (size_t)nt * 128 * 256, 256, 256, acc, smem, ra, rb);
    stage_acc(acc, cs);
    __syncthreads();
    if (nt == 0) gemm_prefetch(p.ckv + (size_t)m0 * 256, 256, p.WkvT + (size_t)128 * 256, 256, 256, ra, rb);
    const int L = lane & 15, rsub = lane >> 4, c0 = L * 8;
#pragma unroll 1
    for (int it = 0; it < 8; ++it) {
      const int row = wid * 32 + it * 4 + rsub;
      const size_t t = (size_t)m0 + row;
      float v[8];
      load8(cs + row * CS_LD + c0, v);
      const float rs = rr_s[row];
#pragma unroll
      for (int e = 0; e < 8; ++e) v[e] *= rs;
      if (nt == 0) {
        float ss = 0.f;
#pragma unroll
        for (int e = 0; e < 8; ++e) ss += v[e] * v[e];
        ss = sum16(ss);
        float r = rsqrtf(ss * (1.f / 128.f) + EPS);
        float g[8];
        load8(p.k_norm_g + c0, g);
#pragma unroll
        for (int e = 0; e < 8; ++e) v[e] = v[e] * r * g[e];
        rope32_8(v, L, p.rtab + t * 48);
        {
          const float sk = p.scal[1];
          int w0 = __builtin_amdgcn_cvt_pk_fp8_f32(v[0] * sk, v[1] * sk, 0, false);
          w0 = __builtin_amdgcn_cvt_pk_fp8_f32(v[2] * sk, v[3] * sk, w0, true);
          int w1 = __builtin_amdgcn_cvt_pk_fp8_f32(v[4] * sk, v[5] * sk, 0, false);
          w1 = __builtin_amdgcn_cvt_pk_fp8_f32(v[6] * sk, v[7] * sk, w1, true);
          *reinterpret_cast<uint2*>(p.kv8 + t * 256 + c0) = make_uint2((u32)w0, (u32)w1);
        }
      } else {
        {
          const float sv8 = p.scal[2];
          int w0 = __builtin_amdgcn_cvt_pk_fp8_f32(v[0] * sv8, v[1] * sv8, 0, false);
          w0 = __builtin_amdgcn_cvt_pk_fp8_f32(v[2] * sv8, v[3] * sv8, w0, true);
          int w1 = __builtin_amdgcn_cvt_pk_fp8_f32(v[4] * sv8, v[5] * sv8, 0, false);
          w1 = __builtin_amdgcn_cvt_pk_fp8_f32(v[6] * sv8, v[7] * sv8, w1, true);
          *reinterpret_cast<uint2*>(p.kv8 + t * 256 + 128 + c0) = make_uint2((u32)w0, (u32)w1);
        }
      }
    }
    __syncthreads();
  }
}

__device__ void unit_spatial(const Params& p, char* smem, int unit) {
  const int tid = threadIdx.x, lane = tid & 63, wid = tid >> 6;
  const int chunk = unit >> 2, g = unit & 3;
  const int t0 = chunk * 128;
  float* cs = reinterpret_cast<float*>(smem);
  float* mu_s = reinterpret_cast<float*>(smem + EXTRA_OFF);
  float* rs_s = mu_s + 128;
  __syncthreads();
  {
    int row = tid >> 1, half = tid & 1;
    const u16* src = p.gv + (size_t)(t0 + row) * 512 + half * 256;
    float s = 0.f, ss = 0.f;
#pragma unroll 4
    for (int i = 0; i < 32; ++i) {
      uint4 q = *reinterpret_cast<const uint4*>(src + i * 8);
      u32 w[4] = {q.x, q.y, q.z, q.w};
#pragma unroll
      for (int j = 0; j < 4; ++j) { float a = bf_lo(w[j]), b = bf_hi(w[j]); s += a + b; ss += a * a + b * b; }
    }
    s += __shfl_xor(s, 1);
    ss += __shfl_xor(ss, 1);
    float mean = s * (1.f / 512.f);
    float var = fmaxf(ss * (1.f / 512.f) - mean * mean, 0.f);
    if (half == 0) { mu_s[row] = mean; rs_s[row] = rsqrtf(var + EPS); }
  }
  {
    const u16* wsrc = p.Wtril + (size_t)g * 128 * 128;
#pragma unroll
    for (int i = 0; i < 8; ++i) {
      int c = tid + 256 * i;
      int row = c >> 4, kc = c & 15;
      uint4 q = *reinterpret_cast<const uint4*>(wsrc + row * 128 + kc * 8);
      *reinterpret_cast<uint4*>(smem + (kc >> 3) * ABUF + row * 144 + (kc & 7) * 16) = q;
    }
  }
  __syncthreads();
  {
    int s = tid & 127;
    float mu = mu_s[s], rs = rs_s[s];
    const u16* src = p.gv + (size_t)(t0 + s) * 512 + g * 128;
    char* bbase = smem + (2 + (s >> 6)) * ABUF + (s & 63) * 2;
#pragma unroll
    for (int i = 0; i < 8; ++i) {
      int d0 = ((tid >> 7) + 2 * i) * 8;
      uint4 q = *reinterpret_cast<const uint4*>(src + d0);
      u32 w[4] = {q.x, q.y, q.z, q.w};
#pragma unroll
      for (int j = 0; j < 4; ++j) {
        int d = d0 + 2 * j;
        float a = (bf_lo(w[j]) - mu) * rs * p.v_norm_g[g * 128 + d] + p.v_norm_b[g * 128 + d];
        float b = (bf_hi(w[j]) - mu) * rs * p.v_norm_g[g * 128 + d + 1] + p.v_norm_b[g * 128 + d + 1];
        *reinterpret_cast<u16*>(bbase + d * 144) = f2bf(a);
        *reinterpret_cast<u16*>(bbase + (d + 1) * 144) = f2bf(b);
      }
    }
  }
  __syncthreads();
  f32x16 acc[2][2];
  zero_acc(acc);
  mma_ktile(smem, smem + 2 * ABUF, acc);
  mma_ktile(smem + ABUF, smem + 3 * ABUF, acc);
  __syncthreads();
  stage_acc(acc, cs);
  __syncthreads();
  const int L = lane & 15, rsub = lane >> 4, c0 = L * 8;
#pragma unroll 1
  for (int it = 0; it < 8; ++it) {
    const int row = wid * 32 + it * 4 + rsub;
    const size_t t = (size_t)t0 + row;
    float v[8], u[8];
    load8(cs + row * CS_LD + c0, v);
    const float b = p.spatial_b[g * 128 + row];
    unpack8(*reinterpret_cast<const uint4*>(p.gu + t * 512 + g * 128 + c0), u);
#pragma unroll
    for (int e = 0; e < 8; ++e) v[e] = u[e] * (v[e] + b);
    *reinterpret_cast<uint4*>(p.ya + t * 512 + g * 128 + c0) = pack8(v);
  }
}

__device__ __forceinline__ void radix_partition(const u32 (&key)[12], int n, int rank, int slack, u32& lo, u32& hi, int& limit) {
  u32 vor = 0u, vand = 0xFFFFFFFFu;
#pragma unroll
  for (int k = 0; k < 12; ++k) { vor |= key[k]; vand &= (key[k] != 0u) ? key[k] : 0xFFFFFFFFu; }
#define DPPU(v, ctrl) ((u32)__builtin_amdgcn_update_dpp(0, (int)(v), (ctrl), 0xF, 0xF, true))
  vor |= DPPU(vor, 0xB1); vor |= DPPU(vor, 0x4E); vor |= DPPU(vor, 0x141); vor |= DPPU(vor, 0x140);
  vand &= DPPU(vand, 0xB1); vand &= DPPU(vand, 0x4E); vand &= DPPU(vand, 0x141); vand &= DPPU(vand, 0x140);
  vor = (u32)(__builtin_amdgcn_readlane((int)vor, 0) | __builtin_amdgcn_readlane((int)vor, 16) |
              __builtin_amdgcn_readlane((int)vor, 32) | __builtin_amdgcn_readlane((int)vor, 48));
  vand = (u32)(__builtin_amdgcn_readlane((int)vand, 0) & __builtin_amdgcn_readlane((int)vand, 16) &
               __builtin_amdgcn_readlane((int)vand, 32) & __builtin_amdgcn_readlane((int)vand, 48));
#undef DPPU
  const u32 diff = vor ^ vand;
  int b = diff ? (31 - __clz(diff)) : -1;
  u32 prefix = (b >= 31) ? 0u : (vand & ~((2u << b) - 1u));
  if (b < 0) prefix = vand;
  int krem = rank, ncand = n;
  while (b >= 0 && ncand - krem > slack) {
    u32 cand = prefix | (1u << b);
    u32 himask = ~((1u << b) - 1u);
    int c = 0;
#pragma unroll
    for (int k = 0; k < 12; ++k) c += __popcll(__ballot((key[k] & himask) == cand));
    if (c >= krem) { prefix = cand; ncand = c; } else { krem -= c; ncand -= c; }
    --b;
  }
  lo = prefix;
  hi = (b >= 0) ? (prefix | ((2u << b) - 1u)) : prefix;
  limit = (ncand - krem <= slack) ? ncand : krem;
}

__device__ __forceinline__ void idx_load_keys(const Params& p, int tb, int jc, int kcol, int lane, bf16x8 (&bf)[4][2]) {
  const u16* kb = p.ki + ((size_t)((tb + jc) >> 4) * 8 + (lane >> 4)) * 128 + kcol * 8;
#pragma unroll
  for (int u = 0; u < 4; ++u) {
    bf[u][0] = *reinterpret_cast<const bf16x8*>(kb + u * 1024);
    bf[u][1] = *reinterpret_cast<const bf16x8*>(kb + u * 1024 + 512);
  }
}
__device__ __forceinline__ void idx_compact(u32* cv, u16* ci, int n, int lane, int& newcnt, float& newthr) {
  u32 key[12]; u16 idx[12];
#pragma unroll
  for (int k = 0; k < 12; ++k) {
    int e = lane + 64 * k;
    bool in = e < n;
    key[k] = in ? sortable(cv[e]) : 0u;
    idx[k] = in ? ci[e] : (u16)0;
  }
  u32 lo, hi; int limit;
  radix_partition(key, n, 256, 64, lo, hi, limit);
  int base = 0, tcnt = 0;
#pragma unroll
  for (int k = 0; k < 12; ++k) {
    bool eq = key[k] >= lo && key[k] <= hi;
    unsigned long long meq = __ballot(eq);
    bool keep = (key[k] > hi) || (eq && (tcnt + mbcnt64(meq)) < limit);
    unsigned long long m = __ballot(keep);
    int pos = base + mbcnt64(m);
    if (keep) { cv[pos] = unsortable(key[k]); ci[pos] = idx[k]; }
    base += __popcll(m);
    tcnt += __popcll(meq);
  }
  newcnt = base;
  newthr = (lo <= 0x007FFFFFu) ? -INFINITY : __uint_as_float(unsortable(lo));
}

__device__ void unit_indexer(const Params& p, char* smem, int unit) {
  const int tid = threadIdx.x, lane = tid & 63, wid = tid >> 6;
  const int b = unit >> 10, grp = unit & 1023;
  const int tb = b * SEQ, i0 = grp * 16;
  u32* cval = reinterpret_cast<u32*>(smem);
  u16* cidx = reinterpret_cast<u16*>(smem + 16 * CAP * 4);
  __syncthreads();
  const int qsub = lane >> 4;
  const int ql = wid * 4 + qsub;
  const int iq = i0 + ql;
  const int kcol = lane & 15;
  bf16x8 afr[2];
  {
    const u16* qa = p.qi + ((size_t)(tb + i0 + wid * 4 + (kcol >> 2)) * 4 + (kcol & 3)) * 64 + 8 * (lane >> 4);
    afr[0] = *reinterpret_cast<const bf16x8*>(qa);
    afr[1] = *reinterpret_cast<const bf16x8*>(qa + 32);
  }
  const float4 w4 = *reinterpret_cast<const float4*>(p.wi + (size_t)(tb + iq) * 4);
  float thr = -INFINITY;
  const int kmul = 64;
  int cntr = 0;
  u32* myval = cval + ql * CAP;
  u16* myidx = cidx + ql * CAP;
  const u32 lowmask = (1u << kcol) - 1u;
  const int nchunks = (grp + 1 + 3) >> 2;

  auto process = [&](const bf16x8 (&bf)[4][2], int jc) {
    f32x4 acc[4];
#pragma unroll
    for (int u = 0; u < 4; ++u) {
      f32x4 z = {0.f, 0.f, 0.f, 0.f};
      acc[u] = __builtin_amdgcn_mfma_f32_16x16x32_bf16(afr[0], bf[u][0], z, 0, 0, 0);
    }
#pragma unroll
    for (int u = 0; u < 4; ++u) acc[u] = __builtin_amdgcn_mfma_f32_16x16x32_bf16(afr[1], bf[u][1], acc[u], 0, 0, 0);
    float sc[4];
    bool ps[4];
    bool anyp = false;
#pragma unroll
    for (int u = 0; u < 4; ++u) {
      float r0 = __builtin_amdgcn_fmed3f(acc[u][0], 0.f, INFINITY), r1 = __builtin_amdgcn_fmed3f(acc[u][1], 0.f, INFINITY);
      float r2 = __builtin_amdgcn_fmed3f(acc[u][2], 0.f, INFINITY), r3 = __builtin_amdgcn_fmed3f(acc[u][3], 0.f, INFINITY);
      float s = (w4.x * r0 + w4.y * r1) + (w4.z * r2 + w4.w * r3);
      s += 0.0f;
      sc[u] = s;
      ps[u] = ((jc + 16 * u + kcol) <= iq) && (s > thr);
      anyp |= ps[u];
    }
    if (__ballot(anyp)) {
#pragma unroll
      for (int u = 0; u < 4; ++u) {
        unsigned long long m = __ballot(ps[u]);
        u32 g16 = (u32)(m >> (16 * qsub)) & 0xFFFFu;
        int slot = cntr + __popc(g16 & lowmask);
        if (ps[u] && slot < CAP) { myval[slot] = __float_as_uint(sc[u]); myidx[slot] = (u16)(jc + 16 * u + kcol); }
        cntr += __popc(g16);
      }
      unsigned long long need = __ballot(cntr > CAP - 64);
      while (need) {
        int l = __ffsll((long long)need) - 1;
        int qc = l >> 4;
        need &= ~(0xFFFFull << (qc * 16));
        int qlc = wid * 4 + qc;
        int n = __builtin_amdgcn_readlane(cntr, qc * 16);
        if (n > CAP) n = CAP;
        int nc; float nt;
        idx_compact(cval + qlc * CAP, cidx + qlc * CAP, n, lane, nc, nt);
        if (qsub == qc) { thr = nt; cntr = nc; }
      }
    }
  };

  bf16x8 bA[4][2], bB[4][2];
  const int lastc = nchunks - 1;
  idx_load_keys(p, tb, 0, kcol, lane, bA);
  for (int ch = 0; ch < nchunks; ch += 2) {
    idx_load_keys(p, tb, min(ch + 1, lastc) * kmul, kcol, lane, bB);
    process(bA, ch * 64);
    idx_load_keys(p, tb, min(ch + 2, lastc) * kmul, kcol, lane, bA);
    if (ch + 1 < nchunks) process(bB, (ch + 1) * 64);
  }
  for (int qc = 0; qc < 4; ++qc) {
    int qlc = wid * 4 + qc;
    int n = __builtin_amdgcn_readlane(cntr, qc * 16);
    if (n > CAP) n = CAP;
    u32* cv = cval + qlc * CAP; u16* ci = cidx + qlc * CAP;
    u16* out = p.sel + (size_t)(tb + i0 + qlc) * 256;
    if (n <= 256) {
#pragma unroll
      for (int k = 0; k < 4; ++k) {
        int e = lane + 64 * k;
        out[e] = (e < n) ? ci[e] : (u16)0xFFFF;
      }
    } else {
      u32 key[12]; u16 idx[12];
#pragma unroll
      for (int k = 0; k < 12; ++k) {
        int e = lane + 64 * k;
        bool in = e < n;
        key[k] = in ? sortable(cv[e]) : 0u;
        idx[k] = in ? ci[e] : (u16)0;
      }
      u32 lo, hi; int limit;
      radix_partition(key, n, 256, 0, lo, hi, limit);
      int base = 0, tcnt = 0;
#pragma unroll
      for (int k = 0; k < 12; ++k) {
        bool eq = key[k] >= lo && key[k] <= hi;
        unsigned long long meq = __ballot(eq);
        bool keep = (key[k] > hi) || (eq && (tcnt + mbcnt64(meq)) < limit);
        unsigned long long m = __ballot(keep);
        int pos = base + mbcnt64(m);
        if (keep && pos < 256) ci[pos] = idx[k];
        base += __popcll(m);
        tcnt += __popcll(meq);
      }
      __builtin_amdgcn_wave_barrier();
      *reinterpret_cast<uint2*>(out + lane * 4) = *reinterpret_cast<const uint2*>(ci + lane * 4);
      __builtin_amdgcn_wave_barrier();
    }
  }
}

__device__ void phase_attn(const Params& p, char* smem) {
  const int tid = threadIdx.x, lane = tid & 63, wid = tid >> 6;
  constexpr int WSTRIDE = 13312;
  u16* lidx = reinterpret_cast<u16*>(smem + wid * WSTRIDE);
  float* Pt = reinterpret_cast<float*>(smem + wid * WSTRIDE + 512);
  char* tile = smem + wid * WSTRIDE + 1024;
  const float sq = p.scal[0];
  const float lf = 0.08838834764831845f * 1.4426950408889634f * p.scal[3];
  const float ovs = p.scal[4];
  const int xq = blockIdx.x & 7;
  const int b = xq & 1;
  const int rblk = (blockIdx.x >> 3) * 4 + (xq >> 1);
  const int nrb = (gridDim.x >> 3) * 4;
  const int n16 = lane & 15, g4 = lane >> 4;
  for (int i = rblk * 4 + wid; i < SEQ; i += nrb * 4) {
    const int tq = b * SEQ + i;
    const size_t tb = (size_t)b * SEQ;
    __builtin_amdgcn_wave_barrier();
    {
      uint2 v = *reinterpret_cast<const uint2*>(p.sel + (size_t)tq * 256 + lane * 4);
      *reinterpret_cast<uint2*>(lidx + lane * 4) = v;
    }
    __builtin_amdgcn_wave_barrier();
    long qf[4];
#pragma unroll
    for (int s = 0; s < 4; ++s) {
      qf[s] = 0;
      if (n16 < 4) {
        float qv[8];
        unpack8(*reinterpret_cast<const uint4*>(p.qh + (size_t)tq * 512 + n16 * 128 + 32 * s + 8 * g4), qv);
        int w0 = __builtin_amdgcn_cvt_pk_fp8_f32(qv[0] * sq, qv[1] * sq, 0, false);
        w0 = __builtin_amdgcn_cvt_pk_fp8_f32(qv[2] * sq, qv[3] * sq, w0, true);
        int w1 = __builtin_amdgcn_cvt_pk_fp8_f32(qv[4] * sq, qv[5] * sq, 0, false);
        w1 = __builtin_amdgcn_cvt_pk_fp8_f32(qv[6] * sq, qv[7] * sq, w1, true);
        qf[s] = (long)(((unsigned long long)(u32)w1 << 32) | (unsigned long long)(u32)w0);
      }
    }
    float mrun[4] = {-1e30f, -1e30f, -1e30f, -1e30f}, lrun[4] = {0.f, 0.f, 0.f, 0.f};
    float2_t o2[4][4];
#pragma unroll
    for (int h = 0; h < 4; ++h)
#pragma unroll
      for (int j = 0; j < 4; ++j) { o2[h][j].x = 0.f; o2[h][j].y = 0.f; }
    u32x4 kr[8];
#pragma unroll
    for (int r = 0; r < 8; ++r) {
      int id = lidx[r * 4 + g4];
      int idc = (id <= i) ? id : 0;
      kr[r] = *reinterpret_cast<const u32x4*>(p.kv8 + (tb + idc) * 256 + n16 * 16);
    }
#pragma unroll 1
    for (int g2 = 0; g2 < 8; ++g2) {
      __builtin_amdgcn_wave_barrier();
#pragma unroll
      for (int r = 0; r < 8; ++r) *reinterpret_cast<u32x4*>(tile + (r * 4 + g4) * 272 + n16 * 16) = kr[r];
      __builtin_amdgcn_wave_barrier();
      {
        const int gn = (g2 < 7) ? g2 + 1 : 7;
#pragma unroll
        for (int r = 0; r < 8; ++r) {
          int id = lidx[gn * 32 + r * 4 + g4];
          int idc = (id <= i) ? id : 0;
          kr[r] = *reinterpret_cast<const u32x4*>(p.kv8 + (tb + idc) * 256 + n16 * 16);
        }
      }
      float sc[2][4];
#pragma unroll
      for (int tt = 0; tt < 2; ++tt) {
        int id = lidx[g2 * 32 + tt * 16 + n16];
        bool valid = id <= i;
        f32x4 acc = {0.f, 0.f, 0.f, 0.f};
#pragma unroll
        for (int s = 0; s < 4; ++s) {
          long kf = *reinterpret_cast<const long*>(tile + (tt * 16 + n16) * 272 + 32 * s + 8 * g4);
          acc = __builtin_amdgcn_mfma_f32_16x16x32_fp8_fp8(qf[s], kf, acc, 0, 0, 0);
        }
#pragma unroll
        for (int h = 0; h < 4; ++h) sc[tt][h] = valid ? acc[h] * lf : -1e30f;
      }
      float alpha[4], pp[2][4];
#pragma unroll
      for (int h = 0; h < 4; ++h) {
        float mg = max16(fmaxf(sc[0][h], sc[1][h]));
        float mnew = fmaxf(mrun[h], __int_as_float(__builtin_amdgcn_readfirstlane(__float_as_int(mg))));
        alpha[h] = __builtin_amdgcn_exp2f(mrun[h] - mnew);
        mrun[h] = mnew;
        pp[0][h] = __builtin_amdgcn_exp2f(sc[0][h] - mnew);
        pp[1][h] = __builtin_amdgcn_exp2f(sc[1][h] - mnew);
        float ls = sum16(pp[0][h] + pp[1][h]);
        lrun[h] = lrun[h] * alpha[h] + __int_as_float(__builtin_amdgcn_readfirstlane(__float_as_int(ls)));
      }
      if (lane < 16) {
        *reinterpret_cast<float4*>(Pt + lane * 4) = make_float4(pp[0][0], pp[0][1], pp[0][2], pp[0][3]);
        *reinterpret_cast<float4*>(Pt + (16 + lane) * 4) = make_float4(pp[1][0], pp[1][1], pp[1][2], pp[1][3]);
      }
#pragma unroll
      for (int h = 0; h < 4; ++h) {
        float2_t a2 = {alpha[h], alpha[h]};
#pragma unroll
        for (int j = 0; j < 4; ++j) o2[h][j] *= a2;
      }
      __builtin_amdgcn_wave_barrier();
#pragma unroll
      for (int it = 0; it < 8; ++it) {
        const int nk = it * 4 + g4;
        float4 pw = *reinterpret_cast<const float4*>(Pt + nk * 4);
        uint2 q = *reinterpret_cast<const uint2*>(tile + nk * 272 + 128 + n16 * 8);
        float2_t v2[4] = {__builtin_amdgcn_cvt_pk_f32_fp8((int)q.x, false), __builtin_amdgcn_cvt_pk_f32_fp8((int)q.x, true),
                          __builtin_amdgcn_cvt_pk_f32_fp8((int)q.y, false), __builtin_amdgcn_cvt_pk_f32_fp8((int)q.y, true)};
        float pv[4] = {pw.x, pw.y, pw.z, pw.w};
#pragma unroll
        for (int h = 0; h < 4; ++h) {
          float2_t ph = {pv[h], pv[h]};
#pragma unroll
          for (int j = 0; j < 4; ++j) o2[h][j] += ph * v2[j];
        }
      }
      __builtin_amdgcn_wave_barrier();
    }
#pragma unroll
    for (int h = 0; h < 4; ++h) {
      float inv = ovs * __builtin_amdgcn_rcpf(lrun[h]);
      float ov[8];
#pragma unroll
      for (int j = 0; j < 4; ++j) {
        float x0 = o2[h][j].x, x1 = o2[h][j].y;
        x0 += __shfl_xor(x0, 16); x0 += __shfl_xor(x0, 32);
        x1 += __shfl_xor(x1, 16); x1 += __shfl_xor(x1, 32);
        ov[2 * j] = x0 * inv; ov[2 * j + 1] = x1 * inv;
      }
      if (g4 == 0) *reinterpret_cast<uint4*>(p.yb + (size_t)tq * 512 + h * 128 + n16 * 8) = pack8(ov);
    }
  }
}

__device__ void phase_merge(const Params& p, char* smem) {
  const int tid = threadIdx.x, lane = tid & 63, wid = tid >> 6;
  float* cs = reinterpret_cast<float*>(smem);
  constexpr int NTILES = (T / 128) * 8;
  int mt, nt;
  bool have = tile_swizzle(0, 8, NTILES, mt, nt);
  Tile4 ra, rb;
  if (have) gemm_prefetch(p.ya + (size_t)mt * 128 * 512, 512, p.WaT + (size_t)nt * 128 * 512, 512, 512, ra, rb);
  for (int step = 0; have; ++step) {
    int m0 = mt * 128, n0 = nt * 128;
    f32x16 acc[2][2];
    zero_acc(acc);
    gemm_mainloop(p.ya + (size_t)m0 * 512, 512, p.WaT + (size_t)n0 * 512, 512, 512, acc, smem, ra, rb);
    stage_acc(acc, cs);
    __syncthreads();
    gemm_prefetch(p.yb + (size_t)m0 * 512, 512, p.WbT + (size_t)n0 * 512, 512, 512, ra, rb);
#pragma unroll 2
    for (int it = 0; it < 8; ++it) {
      const int row = wid * 32 + it * 4 + (lane >> 4), c0 = (lane & 15) * 8;
      float v[8], g[8];
      load8(cs + row * CS_LD + c0, v);
      unpack8(*reinterpret_cast<const uint4*>(p.sg + (size_t)(m0 + row) * 2048 + n0 + c0), g);
#pragma unroll
      for (int e = 0; e < 8; ++e) v[e] *= g[e];
      *reinterpret_cast<uint4*>(p.merged + (size_t)(m0 + row) * 1024 + n0 + c0) = pack8(v);
    }
    __syncthreads();
    zero_acc(acc);
    gemm_mainloop(p.yb + (size_t)m0 * 512, 512, p.WbT + (size_t)n0 * 512, 512, 512, acc, smem, ra, rb);
    stage_acc(acc, cs);
    __syncthreads();
    int mt2 = 0, nt2 = 0;
    const bool nxt = tile_swizzle(step + 1, 8, NTILES, mt2, nt2);
    if (nxt) gemm_prefetch(p.ya + (size_t)mt2 * 128 * 512, 512, p.WaT + (size_t)nt2 * 128 * 512, 512, 512, ra, rb);
#pragma unroll 2
    for (int it = 0; it < 8; ++it) {
      const int row = wid * 32 + it * 4 + (lane >> 4), c0 = (lane & 15) * 8;
      float v[8], g[8], pa[8];
      load8(cs + row * CS_LD + c0, v);
      unpack8(*reinterpret_cast<const uint4*>(p.sg + (size_t)(m0 + row) * 2048 + 1024 + n0 + c0), g);
      uint4* mp = reinterpret_cast<uint4*>(p.merged + (size_t)(m0 + row) * 1024 + n0 + c0);
      unpack8(*mp, pa);
#pragma unroll
      for (int e = 0; e < 8; ++e) v[e] = pa[e] + v[e] * g[e];
      *mp = pack8(v);
    }
    mt = mt2; nt = nt2; have = nxt;
  }
}

__device__ void phase_wo(const Params& p, char* smem) {
  const int tid = threadIdx.x, lane = tid & 63, wid = tid >> 6;
  float* cs = reinterpret_cast<float*>(smem);
  constexpr int NTILES = (T / 128) * 8;
  int mt, nt;
  bool have = tile_swizzle(0, 8, NTILES, mt, nt);
  Tile4 ra, rb;
  if (have) gemm_prefetch(p.merged + (size_t)mt * 128 * 1024, 1024, p.WoT + (size_t)nt * 128 * 1024, 1024, 1024, ra, rb);
  for (int step = 0; have; ++step) {
    int m0 = mt * 128, n0 = nt * 128;
    f32x16 acc[2][2];
    zero_acc(acc);
    gemm_mainloop(p.merged + (size_t)m0 * 1024, 1024, p.WoT + (size_t)n0 * 1024, 1024, 1024, acc, smem, ra, rb);
    stage_acc(acc, cs);
    __syncthreads();
    int mt2 = 0, nt2 = 0;
    const bool nxt = tile_swizzle(step + 1, 8, NTILES, mt2, nt2);
    if (nxt) gemm_prefetch(p.merged + (size_t)mt2 * 128 * 1024, 1024, p.WoT + (size_t)nt2 * 128 * 1024, 1024, 1024, ra, rb);
#pragma unroll 2
    for (int it = 0; it < 8; ++it) {
      const int row = wid * 32 + it * 4 + (lane >> 4), c0 = (lane & 15) * 8;
      const size_t t = (size_t)m0 + row;
      float v[8], xv[8];
      load8(cs + row * CS_LD + c0, v);
      load8(p.x + t * 1024 + n0 + c0, xv);
      float ss = 0.f;
#pragma unroll
      for (int e = 0; e < 8; ++e) { v[e] += xv[e]; ss += v[e] * v[e]; }
      *reinterpret_cast<uint4*>(p.h1b + t * 1024 + n0 + c0) = pack8(v);
      ss = sum16(ss);
      if ((lane & 15) == 0) p.ssq[(size_t)nt * T + t] = ss;
    }
    mt = mt2; nt = nt2; have = nxt;
  }
}

__device__ __forceinline__ void ins16(float (&l)[16], float v) {
#pragma unroll
  for (int q = 15; q >= 1; --q) l[q] = __builtin_amdgcn_fmed3f(v, l[q - 1], l[q]);
  l[0] = fmaxf(l[0], v);
}
__device__ void phase_peerq(const Params& p, char* smem) {
  const int tid = threadIdx.x, lane = tid & 63, wid = tid >> 6;
  const int wr = wid >> 1, wc = wid & 1;
  float* cs = reinterpret_cast<float*>(smem);
  constexpr int NTILES = (T / 128) * 16;
  int mt, hp;
  bool have = tile_swizzle(0, 16, NTILES, mt, hp);
  Tile4 ra, rb;
  if (have) gemm_prefetch(p.h1b + (size_t)mt * 128 * 1024, 1024, p.WqT + (size_t)hp * 128 * 1024, 1024, 1024, ra, rb);
  for (int step = 0; have; ++step) {
    int m0 = mt * 128;
    f32x16 acc[2][2];
    zero_acc(acc);
    gemm_mainloop(p.h1b + (size_t)m0 * 1024, 1024, p.WqT + (size_t)hp * 128 * 1024, 1024, 1024, acc, smem, ra, rb);
#pragma unroll
    for (int i = 0; i < 2; ++i)
#pragma unroll
      for (int j = 0; j < 2; ++j)
#pragma unroll
        for (int r = 0; r < 16; ++r) {
          int row = wr * 64 + i * 32 + (r & 3) + 8 * (r >> 2) + 4 * (lane >> 5);
          int col = wc * 64 + j * 32 + (lane & 31);
          *reinterpret_cast<u16*>(smem + (col >> 6) * ABUF + row * 144 + (col & 63) * 2) = f2bf(acc[i][j][r]);
        }
    {
      const u16* sk = p.SubK + (size_t)hp * 128 * 128;
#pragma unroll
      for (int i = 0; i < 8; ++i) {
        int c = tid + 256 * i;
        int row = c >> 4, kc = c & 15;
        uint4 q = *reinterpret_cast<const uint4*>(sk + row * 128 + kc * 8);
        *reinterpret_cast<uint4*>(smem + (2 + (kc >> 3)) * ABUF + row * 144 + (kc & 7) * 16) = q;
      }
    }
    __syncthreads();
    zero_acc(acc);
    mma_ktile(smem, smem + 2 * ABUF, acc);
    mma_ktile(smem + ABUF, smem + 3 * ABUF, acc);
    __syncthreads();
    stage_acc(acc, cs);
    __syncthreads();
    int mt2 = 0, hp2 = 0;
    const bool nxt = tile_swizzle(step + 1, 16, NTILES, mt2, hp2);
    if (nxt) gemm_prefetch(p.h1b + (size_t)mt2 * 128 * 1024, 1024, p.WqT + (size_t)hp2 * 128 * 1024, 1024, 1024, ra, rb);
    {
      int row = tid >> 1, half = tid & 1;
      float* rp = cs + row * CS_LD + half * 64;
      float l[16];
#pragma unroll
      for (int q = 0; q < 16; ++q) l[q] = -INFINITY;
      for (int c = 0; c < 64; c += 4) {
        float4 v4 = *reinterpret_cast<const float4*>(rp + c);
        float vv[4] = {v4.x, v4.y, v4.z, v4.w};
#pragma unroll
        for (int e = 0; e < 4; ++e) {
          u32 bits = __float_as_uint(vv[e]);
          u32 n = (u32)(half * 64 + c + e);
          bits = (bits & ~127u) | ((bits >> 31) ? n : (127u - n));
          ins16(l, __uint_as_float(bits));
        }
      }
#pragma unroll
      for (int q = 0; q < 16; ++q) rp[q] = l[q];
    }
    __syncthreads();
    if (tid < 128) {
      int row = tid;
      size_t t = (size_t)m0 + row;
      const float* la = cs + row * CS_LD;
      const float* lb = la + 64;
      float ssum = 0.f;
#pragma unroll
      for (int q = 0; q < 8; ++q) ssum += p.ssq[(size_t)q * T + t];
      float rt = rsqrtf(ssum * (1.f / 1024.f) + EPS);
      int ia = 0, ib = 0;
      float* ov = p.stv + ((size_t)hp * T + t) * 16;
      u8* oi = p.sti + ((size_t)hp * T + t) * 16;
      float ovv[16]; u32 oii[4] = {0u, 0u, 0u, 0u};
#pragma unroll
      for (int q = 0; q < 16; ++q) {
        float va = la[ia], vb = lb[ib];
        bool ta = va >= vb;
        float v = ta ? va : vb;
        ia += ta ? 1 : 0;
        ib += ta ? 0 : 1;
        u32 bits = __float_as_uint(v);
        u32 low = bits & 127u;
        u32 n = (bits >> 31) ? low : (127u - low);
        ovv[q] = __uint_as_float(bits & ~127u) * rt;
        oii[q >> 2] |= n << (8 * (q & 3));
      }
#pragma unroll
      for (int q = 0; q < 4; ++q) *reinterpret_cast<float4*>(ov + 4 * q) = make_float4(ovv[4 * q], ovv[4 * q + 1], ovv[4 * q + 2], ovv[4 * q + 3]);
      *reinterpret_cast<uint4*>(oi) = make_uint4(oii[0], oii[1], oii[2], oii[3]);
    }
    mt = mt2; hp = hp2; have = nxt;
  }
}

__device__ void phase_peer(const Params& p, char* smem) {
  const int tid = threadIdx.x, lane = tid & 63, wid = tid >> 6;
  int* pe_e = reinterpret_cast<int*>(smem + wid * 4096);
  float* pe_su = reinterpret_cast<float*>(smem + wid * 4096 + 512);
  float* pe_gv = reinterpret_cast<float*>(smem + wid * 4096 + 1024);
  float* svl = reinterpret_cast<float*>(smem + wid * 4096 + 1536);
  u8* sil = reinterpret_cast<u8*>(smem + wid * 4096 + 2560);
  const int h = lane >> 3, g = lane & 7;
  u32 prt[7];
#pragma unroll
  for (int c = 0; c < 7; ++c) prt[c] = PAIR_TAB[g * 7 + c];
  float4 nsv = make_float4(0.f, 0.f, 0.f, 0.f); uint4 nsi = make_uint4(0u, 0u, 0u, 0u);
  {
    int tq0 = blockIdx.x * 4 + wid;
    if (tq0 < T) {
      nsv = *reinterpret_cast<const float4*>(p.stv + ((size_t)(lane >> 2) * T + tq0) * 16 + (lane & 3) * 4);
      if (lane < 16) nsi = *reinterpret_cast<const uint4*>(p.sti + ((size_t)lane * T + tq0) * 16);
    }
  }
  for (int tq = blockIdx.x * 4 + wid; tq < T; tq += gridDim.x * 4) {
    const size_t t = tq;
    __builtin_amdgcn_wave_barrier();
    *reinterpret_cast<float4*>(svl + lane * 4) = nsv;
    if (lane < 16) *reinterpret_cast<uint4*>(sil + lane * 16) = nsi;
    __builtin_amdgcn_wave_barrier();
    {
      int tqn = tq + gridDim.x * 4;
      if (tqn < T) {
        nsv = *reinterpret_cast<const float4*>(p.stv + ((size_t)(lane >> 2) * T + tqn) * 16 + (lane & 3) * 4);
        if (lane < 16) nsi = *reinterpret_cast<const uint4*>(p.sti + ((size_t)lane * T + tqn) * 16);
      }
    }
    const float* s1 = svl + (2 * h) * 16;
    const float* s2 = s1 + 16;
    float l[16];
#pragma unroll
    for (int q = 0; q < 16; ++q) l[q] = -INFINITY;
#pragma unroll
    for (int c = 0; c < 7; ++c) {
      u32 pr = prt[c];
      float v = -INFINITY;
      if (pr != 0xffu) {
        float a = s1[pr >> 4] + s2[pr & 15];
        u32 bits = __float_as_uint(a);
        bits = (bits & ~255u) | ((bits >> 31) ? pr : (255u - pr));
        v = __uint_as_float(bits);
      }
      ins16(l, v);
    }
#pragma unroll
    for (int msk = 1; msk <= 4; msk <<= 1) {
      float c[16];
#pragma unroll
      for (int q = 0; q < 16; ++q) c[q] = __shfl_xor(l[15 - q], msk);
#pragma unroll
      for (int q = 0; q < 16; ++q) c[q] = fmaxf(l[q], c[q]);
#pragma unroll
      for (int st = 8; st >= 1; st >>= 1)
#pragma unroll
        for (int q = 0; q < 16; ++q)
          if ((q & st) == 0) {
            float hi = fmaxf(c[q], c[q + st]), lo = fminf(c[q], c[q + st]);
            c[q] = hi; c[q + st] = lo;
          }
#pragma unroll
      for (int q = 0; q < 16; ++q) l[q] = c[q];
    }
    {
      float m = -INFINITY, ssum = 0.f;
      float bvv[16];
#pragma unroll
      for (int q = 0; q < 16; ++q) {
        u32 bits = __float_as_uint(l[q]);
        u32 low = bits & 255u;
        int prq = (int)((bits >> 31) ? low : (255u - low));
        bvv[q] = s1[prq >> 4] + s2[prq & 15];
        m = fmaxf(m, bvv[q]);
      }
#pragma unroll
      for (int q = 0; q < 16; ++q) { bvv[q] = __expf(bvv[q] - m); ssum += bvv[q]; }
      float inv = 1.f / ssum;
      const u8* i1 = sil + (2 * h) * 16;
      const u8* i2 = i1 + 16;
#pragma unroll
      for (int q = 0; q < 16; ++q) {
        if ((q >> 1) == g) {
          u32 bits = __float_as_uint(l[q]);
          u32 low = bits & 255u;
          int prq = (int)((bits >> 31) ? low : (255u - low));
          int exi = (int)i1[prq >> 4] * 128 + (int)i2[prq & 15];
          pe_e[h * 16 + q] = exi;
          pe_su[h * 16 + q] = p.su[exi];
          pe_gv[h * 16 + q] = bvv[q] * inv * p.sv[exi];
        }
      }
      __builtin_amdgcn_wave_barrier();
    }
    float rt;
    {
      float ssum = 0.f;
#pragma unroll
      for (int q = 0; q < 8; ++q) ssum += p.ssq[(size_t)q * T + t];
      rt = rsqrtf(ssum * (1.f / 1024.f) + EPS);
    }
    float2_t h2[8];
    {
      uint4 hx0 = *reinterpret_cast<const uint4*>(p.h1b + t * 1024 + lane * 16);
      uint4 hx1 = *reinterpret_cast<const uint4*>(p.h1b + t * 1024 + lane * 16 + 8);
      u32 hw[8] = {hx0.x, hx0.y, hx0.z, hx0.w, hx1.x, hx1.y, hx1.z, hx1.w};
#pragma unroll
      for (int q = 0; q < 8; ++q) { h2[q].x = bf_lo(hw[q]); h2[q].y = bf_hi(hw[q]); }
    }
    float2_t y2[8];
#pragma unroll
    for (int q = 0; q < 8; ++q) { y2[q].x = 0.f; y2[q].y = 0.f; }
    const int kk = (lane >> 3) & 7;
    for (int e0 = 0; e0 < 128; e0 += 8) {
      uint4 ur[8], vr[8];
#pragma unroll
      for (int k = 0; k < 8; ++k) {
        int ex = pe_e[e0 + k];
        ur[k] = *reinterpret_cast<const uint4*>(p.U8 + (size_t)ex * 1024 + lane * 16);
        vr[k] = *reinterpret_cast<const uint4*>(p.V8 + (size_t)ex * 1024 + lane * 16);
      }
      float d[8];
#pragma unroll
      for (int k = 0; k < 8; ++k) {
        u32 uw[4] = {ur[k].x, ur[k].y, ur[k].z, ur[k].w};
        float2_t acc = {0.f, 0.f};
#pragma unroll
        for (int q = 0; q < 4; ++q) {
          acc += __builtin_amdgcn_cvt_pk_f32_fp8((int)uw[q], false) * h2[2 * q];
          acc += __builtin_amdgcn_cvt_pk_f32_fp8((int)uw[q], true) * h2[2 * q + 1];
        }
        d[k] = acc.x + acc.y;
      }
      float e4[4], f2[2], gsum;
      {
        const bool hi = (lane & 32) != 0;
#pragma unroll
        for (int k = 0; k < 4; ++k) {
          float snd = hi ? d[k] : d[k + 4], kp = hi ? d[k + 4] : d[k];
          e4[k] = kp + __shfl_xor(snd, 32);
        }
        const bool hb = (lane & 16) != 0;
#pragma unroll
        for (int k = 0; k < 2; ++k) {
          float snd = hb ? e4[k] : e4[k + 2], kp = hb ? e4[k + 2] : e4[k];
          f2[k] = kp + __shfl_xor(snd, 16);
        }
        const bool hc = (lane & 8) != 0;
        float snd = hc ? f2[0] : f2[1], kp = hc ? f2[1] : f2[0];
        gsum = kp + __shfl_xor(snd, 8);
        gsum += __shfl_xor(gsum, 4);
        gsum += __shfl_xor(gsum, 2);
        gsum += __shfl_xor(gsum, 1);
      }
      float cme = pe_gv[e0 + kk] * gelu_f(gsum * rt * pe_su[e0 + kk]);
#pragma unroll
      for (int k = 0; k < 8; ++k) {
        float ck = __int_as_float(__builtin_amdgcn_readlane(__float_as_int(cme), k * 8));
        float2_t c2 = {ck, ck};
        u32 vw[4] = {vr[k].x, vr[k].y, vr[k].z, vr[k].w};
#pragma unroll
        for (int q = 0; q < 4; ++q) {
          y2[2 * q] += c2 * __builtin_amdgcn_cvt_pk_f32_fp8((int)vw[q], false);
          y2[2 * q + 1] += c2 * __builtin_amdgcn_cvt_pk_f32_fp8((int)vw[q], true);
        }
      }
    }
    float* op = p.out + t * 1024 + lane * 16;
#pragma unroll
    for (int q = 0; q < 4; ++q) {
      float4 a = make_float4(h2[2 * q].x + y2[2 * q].x, h2[2 * q].y + y2[2 * q].y, h2[2 * q + 1].x + y2[2 * q + 1].x, h2[2 * q + 1].y + y2[2 * q + 1].y);
      *reinterpret_cast<float4*>(op + 4 * q) = a;
    }
    __builtin_amdgcn_wave_barrier();
  }
}

__device__ void phase_mix(const Params& p, char* smem) {
  const int G = gridDim.x;
  {
    int* qslot = reinterpret_cast<int*>(smem + EXTRA_OFF + 1024);
    for (;;) {
      __syncthreads();
      if (threadIdx.x == 0) *qslot = (int)__hip_atomic_fetch_add(p.bar + 16, 1u, __ATOMIC_RELAXED, __HIP_MEMORY_SCOPE_AGENT);
      __syncthreads();
      const int s = *qslot;
      if (s >= 2048) break;
      int grp = 1023 - (s >> 1), b = s & 1;
      unit_indexer(p, smem, (b << 10) | grp);
    }
  }
  for (int u = blockIdx.x; u < 1024; u += G) unit_spatial(p, smem, u);
  for (int u = blockIdx.x; u < 256; u += G) unit_kv(p, smem, u);
}

template <int PH>
__device__ __forceinline__ void run_phase(const Params& p, char* smem) {
  if (PH == 0) phase_prep(p, smem);
  else if (PH == 1) phase_gemm1(p, smem);
  else if (PH == 2) phase_mix(p, smem);
  else if (PH == 3) phase_attn(p, smem);
  else if (PH == 4) phase_merge(p, smem);
  else if (PH == 5) phase_wo(p, smem);
  else if (PH == 6) phase_peerq(p, smem);
  else phase_peer(p, smem);
}

template <int PH>
__global__ void __launch_bounds__(NTHREADS, 2) phase_kernel(Params p) {
  __shared__ __attribute__((aligned(16))) char smem[SMEM_BYTES];
  run_phase<PH>(p, smem);
}

__device__ __forceinline__ void grid_barrier(unsigned* ctr, unsigned& epoch) {
  asm volatile("s_waitcnt vmcnt(0)" ::: "memory");
  __syncthreads();
  epoch += gridDim.x;
  if (threadIdx.x == 0) {
    __builtin_amdgcn_fence(__ATOMIC_RELEASE, "agent");
    asm volatile("s_waitcnt vmcnt(0)" ::: "memory");
    __hip_atomic_fetch_add(ctr, 1u, __ATOMIC_RELAXED, __HIP_MEMORY_SCOPE_AGENT);
    unsigned spins = 0;
    while (__hip_atomic_load(ctr, __ATOMIC_RELAXED, __HIP_MEMORY_SCOPE_AGENT) < epoch) {
      __builtin_amdgcn_s_sleep(2);
      if (++spins > (1u << 24)) break;
    }
    __builtin_amdgcn_fence(__ATOMIC_ACQUIRE, "agent");
    asm volatile("s_waitcnt vmcnt(0)" ::: "memory");
  }
  __syncthreads();
}

__global__ void __launch_bounds__(NTHREADS, 2) mega_kernel(Params p) {
  __shared__ __attribute__((aligned(16))) char smem[SMEM_BYTES];
  cg::grid_group grid = cg::this_grid();
#define GSYNC() grid_barrier(p.bar, bar_epoch)
  unsigned bar_epoch = 0;
  if (blockIdx.x == 0 && threadIdx.x == 0) {
    __hip_atomic_store(p.bar, 0u, __ATOMIC_RELAXED, __HIP_MEMORY_SCOPE_AGENT);
    __hip_atomic_store(p.bar + 16, 0u, __ATOMIC_RELAXED, __HIP_MEMORY_SCOPE_AGENT);
  }
  run_phase<0>(p, smem);
  asm volatile("s_waitcnt vmcnt(0)" ::: "memory");
  grid.sync();
#define RUNP(X) run_phase<X>(p, smem); GSYNC();
  RUNP(1) RUNP(2) RUNP(3) RUNP(4) RUNP(5) RUNP(6)
  run_phase<7>(p, smem);
}

extern "C" void kernel_launch(void* const* d_in, const int* in_sizes, int n_in, void* d_out, int out_size,
                              void* d_ws, size_t ws_size, hipStream_t stream) {
  Params p{};
  p.x = (const float*)d_in[0]; p.pos = (const int*)d_in[1];
  p.norm1_g = (const float*)d_in[2]; p.w_in = (const float*)d_in[3]; p.v_norm_g = (const float*)d_in[4];
  p.v_norm_b = (const float*)d_in[5]; p.spatial_w = (const float*)d_in[6]; p.spatial_b = (const float*)d_in[7];
  p.kv_norm_g = (const float*)d_in[8]; p.w_uk = (const float*)d_in[9]; p.w_uv = (const float*)d_in[10];
  p.q_norm_g = (const float*)d_in[11]; p.k_norm_g = (const float*)d_in[12]; p.w_a_out = (const float*)d_in[13];
  p.w_b_out = (const float*)d_in[14]; p.w_o = (const float*)d_in[15]; p.norm2_g = (const float*)d_in[16];
  p.peer_wq = (const float*)d_in[17]; p.peer_subkeys = (const float*)d_in[18]; p.peer_u = (const float*)d_in[19];
  p.peer_v = (const float*)d_in[20];
  p.out = (float*)d_out;
  char* w = (char*)d_ws;
  size_t off = 0;
  auto take = [&](size_t bytes) { char* r = w + off; off += (bytes + 255) & ~(size_t)255; return r; };
  const size_t MB = 1u << 20;
  char* r_xn = take(64 * MB);
  p.xn = (u16*)r_xn; p.ya = (u16*)r_xn; p.yb = (u16*)(r_xn + 32 * MB);
  p.WinT = (u16*)take((size_t)NWIN * 1024 * 2);
  p.WaT = (u16*)take(1024 * 512 * 2); p.WbT = (u16*)take(1024 * 512 * 2);
  p.WoT = (u16*)take(1024 * 1024 * 2); p.WqT = (u16*)take(2048 * 1024 * 2);
  p.WkvT = (u16*)take(256 * 256 * 2); p.SubK = (u16*)take(262144 * 2); p.Wtril = (u16*)take(65536 * 2);
  p.U8 = (u8*)take(16 * MB); p.V8 = (u8*)take(16 * MB);
  p.su = (float*)take(16384 * 4); p.sv = (float*)take(16384 * 4);
  char* r_g = take(96 * MB);
  p.gu = (u16*)r_g; p.gv = (u16*)(r_g + 32 * MB); p.qh = (u16*)(r_g + 64 * MB); p.merged = (u16*)r_g;
  p.ckv = (u16*)take(16 * MB); p.qi = (u16*)take(16 * MB); p.ki = (u16*)take(4 * MB);
  p.wi = (float*)take((size_t)T * 4 * 4);
  char* r_sg = take(128 * MB);
  p.sg = (u16*)r_sg; p.h1b = (u16*)r_sg; p.stv = (float*)(r_sg + 64 * MB); p.sti = (u8*)(r_sg + 96 * MB);
  p.sel = (u16*)take(16 * MB);
  p.kv8 = (u8*)take(8 * MB); p.scal = (float*)take(256);
  p.ssq = (float*)take((size_t)T * 8 * 4);
  p.bar = (unsigned*)take(256);
  p.rtab = (float*)take((size_t)T * 48 * 4);
  if (off > ws_size) { fprintf(stderr, "workspace too small: need %zu have %zu\n", off, ws_size); return; }

  static int grid_blocks = 0;
  if (!grid_blocks) {
    int dev = 0, cus = 0, per_cu = 0;
    hipGetDevice(&dev);
    hipDeviceGetAttribute(&cus, hipDeviceAttributeMultiprocessorCount, dev);
    hipOccupancyMaxActiveBlocksPerMultiprocessor(&per_cu, mega_kernel, NTHREADS, 0);
    if (per_cu > 2) per_cu = 2;
    if (per_cu < 1) per_cu = 1;
    grid_blocks = cus * per_cu;
  }
#if MULTI_LAUNCH
  dim3 g(grid_blocks), b(NTHREADS);
  phase_kernel<0><<<g, b, 0, stream>>>(p);
  phase_kernel<1><<<g, b, 0, stream>>>(p);
  phase_kernel<2><<<g, b, 0, stream>>>(p);
  phase_kernel<3><<<g, b, 0, stream>>>(p);
  phase_kernel<4><<<g, b, 0, stream>>>(p);
  phase_kernel<5><<<g, b, 0, stream>>>(p);
  phase_kernel<6><<<g, b, 0, stream>>>(p);
  phase_kernel<7><<<g, b, 0, stream>>>(p);
#else
  void* args[] = {&p};
  hipError_t e = hipLaunchCooperativeKernel((void*)mega_kernel, dim3(grid_blocks), dim3(NTHREADS), args, 0, stream);
  if (e != hipSuccess) fprintf(stderr, "cooperative launch failed: %s (grid %d)\n", hipGetErrorString(e), grid_blocks);
#endif
}
```

```cpp
#include <hip/hip_runtime.h>
#include <hip/hip_cooperative_groups.h>
#include <stdint.h>
#include <cstdio>
namespace cg = cooperative_groups;

#ifndef MULTI_LAUNCH
#define MULTI_LAUNCH 0
#endif

typedef unsigned short u16;
typedef unsigned int u32;
typedef unsigned char u8;
using bf16x8 = __attribute__((ext_vector_type(8))) short;
using f32x4 = __attribute__((ext_vector_type(4))) float;
using f32x16 = __attribute__((ext_vector_type(16))) float;
typedef __bf16 bf16x2_t __attribute__((ext_vector_type(2)));
typedef float float2_t __attribute__((ext_vector_type(2)));

constexpr int BATCH = 2, SEQ = 16384, DM = 1024, T = BATCH * SEQ;
constexpr int NWIN = 4224;
constexpr int NTHREADS = 256;
constexpr float EPS = 1e-6f;
constexpr int ABUF = 128 * 144;
constexpr int CS_LD = 132;
constexpr int SMEM_BYTES = 77824;
constexpr int EXTRA_OFF = 4 * ABUF;
constexpr int CAP = 768;

__constant__ float INV32[16] = {1.000000000e+00f, 4.403665960e-01f, 1.939227432e-01f, 8.539710194e-02f, 3.760603070e-02f, 1.656043902e-02f, 7.292664610e-03f, 3.211445874e-03f, 1.414213562e-03f, 6.227723788e-04f, 2.742481884e-04f, 1.207697351e-04f, 5.318296098e-05f, 2.341999971e-05f, 1.031338616e-05f, 4.541670478e-06f};
__constant__ float INV16[8] = {1.000000000e+00f, 1.939227432e-01f, 3.760603070e-02f, 7.292664610e-03f, 1.414213562e-03f, 2.742481884e-04f, 5.318296098e-05f, 1.031338616e-05f};
__constant__ u8 PAIR_TAB[56] = {
  0x00,0x01,0x02,0x03,0x04,0x05,0x06,0x07,0x08,0x09,0x0a,0x0b,0x0c,0x0d,0x0e,0x0f,
  0x10,0x11,0x12,0x13,0x14,0x15,0x16,0x17,
  0x20,0x21,0x22,0x23,0x24,
  0x30,0x31,0x32,0x33,
  0x40,0x41,0x42,
  0x50,0x51,
  0x60,0x61,
  0x70,0x71,
  0x80,0x90,0xa0,0xb0,0xc0,0xd0,0xe0,0xf0,
  0xff,0xff,0xff,0xff,0xff,0xff};

struct Params {
  const float* x; const int* pos;
  const float *norm1_g, *w_in, *v_norm_g, *v_norm_b, *spatial_w, *spatial_b, *kv_norm_g, *w_uk, *w_uv,
      *q_norm_g, *k_norm_g, *w_a_out, *w_b_out, *w_o, *norm2_g, *peer_wq, *peer_subkeys, *peer_u, *peer_v;
  float* out;
  u16 *xn, *WinT, *WaT, *WbT, *WoT, *WqT, *WkvT, *SubK, *Wtril;
  u8 *U8, *V8, *kv8;
  float *su, *sv, *scal;
  u16 *gu, *gv, *qh, *ckv, *qi, *ki, *sg, *ya, *yb, *merged, *h1b, *sel;
  float *wi, *ssq, *stv, *rtab;
  u8* sti;
  unsigned* bar;
};

__device__ __forceinline__ u32 pack_bf16(float a, float b) {
  float2_t v = {a, b};
  bf16x2_t r = __builtin_convertvector(v, bf16x2_t);
  return __builtin_bit_cast(u32, r);
}
__device__ __forceinline__ u16 f2bf(float a) { return (u16)(pack_bf16(a, 0.f) & 0xffffu); }
__device__ __forceinline__ float bf_lo(u32 u) { return __uint_as_float(u << 16); }
__device__ __forceinline__ float bf_hi(u32 u) { return __uint_as_float(u & 0xffff0000u); }
__device__ __forceinline__ float bf2f(u16 h) { return __uint_as_float(((u32)h) << 16); }
__device__ __forceinline__ float wave_sum(float v) {
#pragma unroll
  for (int m = 32; m >= 1; m >>= 1) v += __shfl_xor(v, m);
  return v;
}
__device__ __forceinline__ float gelu_f(float x) {
  float z = -2.3022082f * (x + 0.044715f * x * x * x);
  return x * __builtin_amdgcn_rcpf(1.f + __builtin_amdgcn_exp2f(z));
}
__device__ __forceinline__ float sigmoid_f(float x) { return __builtin_amdgcn_rcpf(1.f + __builtin_amdgcn_exp2f(-1.4426950408889634f * x)); }
__device__ __forceinline__ u32 sortable(u32 b) { return b ^ ((u32)((int)b >> 31) | 0x80000000u); }
__device__ __forceinline__ u32 unsortable(u32 k) { return k ^ ((k & 0x80000000u) ? 0x80000000u : 0xffffffffu); }
__device__ __forceinline__ int mbcnt64(unsigned long long m) {
  return __builtin_amdgcn_mbcnt_hi((u32)(m >> 32), __builtin_amdgcn_mbcnt_lo((u32)m, 0));
}

__device__ __forceinline__ void load8(const float* p, float (&v)[8]) {
  float4 a = *reinterpret_cast<const float4*>(p), b = *reinterpret_cast<const float4*>(p + 4);
  v[0] = a.x; v[1] = a.y; v[2] = a.z; v[3] = a.w; v[4] = b.x; v[5] = b.y; v[6] = b.z; v[7] = b.w;
}
__device__ __forceinline__ void unpack8(uint4 q, float (&v)[8]) {
  v[0] = bf_lo(q.x); v[1] = bf_hi(q.x); v[2] = bf_lo(q.y); v[3] = bf_hi(q.y);
  v[4] = bf_lo(q.z); v[5] = bf_hi(q.z); v[6] = bf_lo(q.w); v[7] = bf_hi(q.w);
}
__device__ __forceinline__ uint4 pack8(const float (&v)[8]) {
  uint4 o = {pack_bf16(v[0], v[1]), pack_bf16(v[2], v[3]), pack_bf16(v[4], v[5]), pack_bf16(v[6], v[7])};
  return o;
}
#define DPPF(v, ctrl) __int_as_float(__builtin_amdgcn_update_dpp(0, __float_as_int(v), (ctrl), 0xF, 0xF, true))
__device__ __forceinline__ float sum16(float x) {
  x += DPPF(x, 0xB1); x += DPPF(x, 0x4E); x += DPPF(x, 0x141); x += DPPF(x, 0x140);
  return x;
}
__device__ __forceinline__ float max16(float x) {
  x = fmaxf(x, DPPF(x, 0xB1)); x = fmaxf(x, DPPF(x, 0x4E)); x = fmaxf(x, DPPF(x, 0x141)); x = fmaxf(x, DPPF(x, 0x140));
  return x;
}
__device__ __forceinline__ void rope32_8(float (&v)[8], int L, const float* tab) {
  float pr[8];
#pragma unroll
  for (int e = 0; e < 8; ++e) pr[e] = __shfl_xor(v[e], 2);
  if (L < 4) {
    float c[8], s[8];
    load8(tab + (L & 1) * 8, c);
    load8(tab + 16 + (L & 1) * 8, s);
#pragma unroll
    for (int e = 0; e < 8; ++e) v[e] = (L < 2) ? (v[e] * c[e] - pr[e] * s[e]) : (v[e] * c[e] + pr[e] * s[e]);
  }
}
__device__ __forceinline__ void rope16_8(float (&v)[8], int lc0, const float* tab) {
  float pr[8];
#pragma unroll
  for (int e = 0; e < 8; ++e) pr[e] = __shfl_xor(v[e], 1);
  if (lc0 < 16) {
    float c[8], s[8];
    load8(tab + 32, c);
    load8(tab + 40, s);
#pragma unroll
    for (int e = 0; e < 8; ++e) v[e] = (lc0 == 0) ? (v[e] * c[e] - pr[e] * s[e]) : (v[e] * c[e] + pr[e] * s[e]);
  }
}

typedef u32 u32x4 __attribute__((ext_vector_type(4)));
struct Tile4 { u32x4 v0, v1, v2, v3; };
__device__ __forceinline__ void gemm_load_tile(const u16* __restrict__ g, int ld, int k0, Tile4& r) {
  const int tid = threadIdx.x;
  const int row = tid >> 3, kc = tid & 7;
  const u16* base = g + (size_t)row * ld + k0 + kc * 8;
  r.v0 = *reinterpret_cast<const u32x4*>(base);
  r.v1 = *reinterpret_cast<const u32x4*>(base + (size_t)32 * ld);
  r.v2 = *reinterpret_cast<const u32x4*>(base + (size_t)64 * ld);
  r.v3 = *reinterpret_cast<const u32x4*>(base + (size_t)96 * ld);
}
__device__ __forceinline__ void gemm_store_tile(char* buf, const Tile4& r) {
  const int tid = threadIdx.x;
  const int row = tid >> 3, kc = tid & 7;
  char* base = buf + row * 144 + kc * 16;
  *reinterpret_cast<u32x4*>(base) = r.v0;
  *reinterpret_cast<u32x4*>(base + 32 * 144) = r.v1;
  *reinterpret_cast<u32x4*>(base + 64 * 144) = r.v2;
  *reinterpret_cast<u32x4*>(base + 96 * 144) = r.v3;
}
__device__ __forceinline__ void mma_ktile(const char* sa, const char* sb, f32x16 (&acc)[2][2]) {
  const int lane = threadIdx.x & 63, wid = threadIdx.x >> 6;
  const int wr = wid >> 1, wc = wid & 1;
  const int r32 = lane & 31, hf = lane >> 5;
  const char* pa = sa + (wr * 64 + r32) * 144 + hf * 16;
  const char* pb = sb + (wc * 64 + r32) * 144 + hf * 16;
  bf16x8 a0[2], b0[2], a1[2], b1[2];
#pragma unroll
  for (int i = 0; i < 2; ++i) {
    a0[i] = *reinterpret_cast<const bf16x8*>(pa + i * 32 * 144);
    b0[i] = *reinterpret_cast<const bf16x8*>(pb + i * 32 * 144);
  }
#pragma unroll
  for (int s = 0; s < 4; s += 2) {
#pragma unroll
    for (int i = 0; i < 2; ++i) {
      a1[i] = *reinterpret_cast<const bf16x8*>(pa + i * 32 * 144 + (s + 1) * 32);
      b1[i] = *reinterpret_cast<const bf16x8*>(pb + i * 32 * 144 + (s + 1) * 32);
    }
    __builtin_amdgcn_s_setprio(1);
#pragma unroll
    for (int i = 0; i < 2; ++i)
#pragma unroll
      for (int j = 0; j < 2; ++j)
        acc[i][j] = __builtin_amdgcn_mfma_f32_32x32x16_bf16(a0[i], b0[j], acc[i][j], 0, 0, 0);
    __builtin_amdgcn_s_setprio(0);
    if (s + 2 < 4) {
#pragma unroll
      for (int i = 0; i < 2; ++i) {
        a0[i] = *reinterpret_cast<const bf16x8*>(pa + i * 32 * 144 + (s + 2) * 32);
        b0[i] = *reinterpret_cast<const bf16x8*>(pb + i * 32 * 144 + (s + 2) * 32);
      }
    }
    __builtin_amdgcn_s_setprio(1);
#pragma unroll
    for (int i = 0; i < 2; ++i)
#pragma unroll
      for (int j = 0; j < 2; ++j)
        acc[i][j] = __builtin_amdgcn_mfma_f32_32x32x16_bf16(a1[i], b1[j], acc[i][j], 0, 0, 0);
    __builtin_amdgcn_s_setprio(0);
  }
}
#define GEMM_KT(i, nk) ((((i) + ((int)(blockIdx.x >> 3))) & ((nk) - 1)) << 6)
__device__ __forceinline__ void gemm_prefetch(const u16* __restrict__ A, int lda, const u16* __restrict__ B, int ldb, int K, Tile4& ra, Tile4& rb) {
  const int nk = K >> 6;
  gemm_load_tile(A, lda, GEMM_KT(0, nk), ra);
  gemm_load_tile(B, ldb, GEMM_KT(0, nk), rb);
}
__device__ __forceinline__ void gemm_mainloop(const u16* __restrict__ A, int lda, const u16* __restrict__ B, int ldb,
                                              int K, f32x16 (&acc)[2][2], char* smem, Tile4& ra, Tile4& rb) {
  const int nk = K >> 6;
  __syncthreads();
  gemm_store_tile(smem, ra);
  gemm_store_tile(smem + 2 * ABUF, rb);
  __syncthreads();
#pragma unroll 1
  for (int kt = 0; kt < nk; ++kt) {
    const int cur = kt & 1;
    if (kt + 1 < nk) {
      gemm_load_tile(A, lda, GEMM_KT(kt + 1, nk), ra);
      gemm_load_tile(B, ldb, GEMM_KT(kt + 1, nk), rb);
    }
    mma_ktile(smem + cur * ABUF, smem + (2 + cur) * ABUF, acc);
    if (kt + 1 < nk) {
      gemm_store_tile(smem + (cur ^ 1) * ABUF, ra);
      gemm_store_tile(smem + (2 + (cur ^ 1)) * ABUF, rb);
    }
    __syncthreads();
  }
}
__device__ __forceinline__ void zero_acc(f32x16 (&acc)[2][2]) {
#pragma unroll
  for (int i = 0; i < 2; ++i)
#pragma unroll
    for (int j = 0; j < 2; ++j)
#pragma unroll
      for (int r = 0; r < 16; ++r) acc[i][j][r] = 0.f;
}
__device__ __forceinline__ void stage_acc(const f32x16 (&acc)[2][2], float* cs) {
  const int lane = threadIdx.x & 63, wid = threadIdx.x >> 6;
  const int wr = wid >> 1, wc = wid & 1;
#pragma unroll
  for (int i = 0; i < 2; ++i)
#pragma unroll
    for (int j = 0; j < 2; ++j)
#pragma unroll
      for (int r = 0; r < 16; ++r) {
        int row = wr * 64 + i * 32 + (r & 3) + 8 * (r >> 2) + 4 * (lane >> 5);
        int col = wc * 64 + j * 32 + (lane & 31);
        cs[row * CS_LD + col] = acc[i][j][r];
      }
}

__device__ __forceinline__ int win_srccol(int n) {
  if (n < 2116) return n;
  if (n < 2176) return -1;
  return n - 60;
}
__device__ void phase_prep(const Params& p, char* smem) {
  const int tid = threadIdx.x, lane = tid & 63, wid = tid >> 6;
  for (int rb = blockIdx.x; rb < T / 4; rb += gridDim.x) {
    int row = rb * 4 + wid;
    const float* xr = p.x + (size_t)row * DM;
    float4 v[4];
    float ss = 0.f;
#pragma unroll
    for (int i = 0; i < 4; ++i) {
      v[i] = *reinterpret_cast<const float4*>(xr + lane * 4 + 256 * i);
      ss += v[i].x * v[i].x + v[i].y * v[i].y + v[i].z * v[i].z + v[i].w * v[i].w;
    }
    ss = wave_sum(ss);
    float r = rsqrtf(ss * (1.f / DM) + EPS);
#pragma unroll
    for (int i = 0; i < 4; ++i) {
      float4 g = *reinterpret_cast<const float4*>(p.norm1_g + lane * 4 + 256 * i);
      uint2 o;
      o.x = pack_bf16(v[i].x * r * g.x, v[i].y * r * g.y);
      o.y = pack_bf16(v[i].z * r * g.z, v[i].w * r * g.w);
      *reinterpret_cast<uint2*>(p.xn + (size_t)row * DM + lane * 4 + 256 * i) = o;
    }
  }
  float* tile = reinterpret_cast<float*>(smem);
  constexpr int NT_TOTAL = 1056 + 128 + 128 + 256 + 512 + 8 + 8;
  for (int ti = blockIdx.x; ti < NT_TOTAL; ti += gridDim.x) {
    const float* src; const float* scale = nullptr; u16* dst; int ldsrc, K, nn, mode = 0; int t = ti;
    if (t < 1056) { src = p.w_in; ldsrc = 4164; K = 1024; nn = 66; dst = p.WinT; mode = 1; }
    else if ((t -= 1056) < 128) { src = p.w_a_out; ldsrc = 1024; K = 512; nn = 16; dst = p.WaT; }
    else if ((t -= 128) < 128) { src = p.w_b_out; ldsrc = 1024; K = 512; nn = 16; dst = p.WbT; }
    else if ((t -= 128) < 256) { src = p.w_o; ldsrc = 1024; K = 1024; nn = 16; dst = p.WoT; }
    else if ((t -= 256) < 512) { src = p.peer_wq; ldsrc = 2048; K = 1024; nn = 32; dst = p.WqT; scale = p.norm2_g; }
    else if ((t -= 512) < 8) { src = p.w_uk; ldsrc = 128; K = 256; nn = 2; dst = p.WkvT; scale = p.kv_norm_g; }
    else { t -= 8; src = p.w_uv; ldsrc = 128; K = 256; nn = 2; dst = p.WkvT + 128 * 256; scale = p.kv_norm_g; }
    int n0 = (t % nn) * 64, k0 = (t / nn) * 64;
    __syncthreads();
    {
      int n = tid & 63;
      int sc = (mode == 1) ? win_srccol(n0 + n) : (n0 + n);
      for (int kk = tid >> 6; kk < 64; kk += 4) {
        float v = 0.f;
        if (sc >= 0) v = src[(size_t)(k0 + kk) * ldsrc + sc];
        if (scale) v *= scale[k0 + kk];
        tile[kk * 65 + n] = v;
      }
    }
    __syncthreads();
    {
      int k = (tid & 31) * 2;
      for (int n = tid >> 5; n < 64; n += 8) {
        u32 o = pack_bf16(tile[k * 65 + n], tile[(k + 1) * 65 + n]);
        *reinterpret_cast<u32*>(dst + (size_t)(n0 + n) * K + k0 + k) = o;
      }
    }
  }
  constexpr int G_SUB = 262144 / 4, G_SW = 65536 / 4;
  constexpr int G_TOTAL = G_SUB + G_SW;
  for (int gi = blockIdx.x * NTHREADS + tid; gi < G_TOTAL; gi += gridDim.x * NTHREADS) {
    int g = gi;
    if (g < G_SUB) {
      float4 v = *reinterpret_cast<const float4*>(p.peer_subkeys + (size_t)g * 4);
      uint2 o = {pack_bf16(v.x, v.y), pack_bf16(v.z, v.w)};
      *reinterpret_cast<uint2*>(p.SubK + (size_t)g * 4) = o;
    } else {
      g -= G_SUB;
      float4 v = *reinterpret_cast<const float4*>(p.spatial_w + (size_t)g * 4);
      int e = g * 4; int s = e & 127, tt = (e >> 7) & 127;
      if (s > tt) v.x = 0.f;
      if (s + 1 > tt) v.y = 0.f;
      if (s + 2 > tt) v.z = 0.f;
      if (s + 3 > tt) v.w = 0.f;
      uint2 o = {pack_bf16(v.x, v.y), pack_bf16(v.z, v.w)};
      *reinterpret_cast<uint2*>(p.Wtril + (size_t)g * 4) = o;
    }
  }
  if (blockIdx.x == 0) {
    float* red = reinterpret_cast<float*>(smem);
    __syncthreads();
    float vq = 0.f, vk = 0.f, vn = 0.f;
    if (tid < 128) {
      vq = fabsf(p.q_norm_g[tid]); vk = fabsf(p.k_norm_g[tid]);
      float ss = 0.f;
      for (int k = 0; k < 256; ++k) { float w = p.w_uv[k * 128 + tid] * p.kv_norm_g[k]; ss += w * w; }
      vn = sqrtf(ss);
    }
    red[tid] = vq; red[256 + tid] = vk; red[512 + tid] = vn;
    __syncthreads();
    if (tid == 0) {
      float mq = 0.f, mk = 0.f, mn = 0.f;
      for (int k = 0; k < 128; ++k) { mq = fmaxf(mq, red[k]); mk = fmaxf(mk, red[256 + k]); mn = fmaxf(mn, red[512 + k]); }
      int eq = ilogbf(440.f / fmaxf(11.3137085f * mq, 1e-20f));
      int ek = ilogbf(440.f / fmaxf(11.3137085f * mk, 1e-20f));
      int ev = ilogbf(440.f / fmaxf(16.f * mn, 1e-20f));
      eq = eq > 40 ? 40 : (eq < -40 ? -40 : eq); ek = ek > 40 ? 40 : (ek < -40 ? -40 : ek); ev = ev > 40 ? 40 : (ev < -40 ? -40 : ev);
      p.scal[0] = ldexpf(1.f, eq); p.scal[1] = ldexpf(1.f, ek); p.scal[2] = ldexpf(1.f, ev);
      p.scal[3] = ldexpf(1.f, -eq - ek); p.scal[4] = ldexpf(1.f, -ev);
    }
    __syncthreads();
  }
  for (int gi = blockIdx.x * NTHREADS + tid; gi < T * 24; gi += gridDim.x * NTHREADS) {
    int t = gi / 24, j = gi - t * 24;
    float posf = (float)p.pos[t];
    float sn, cn;
    if (j < 16) { sincosf(posf * INV32[j], &sn, &cn); p.rtab[(size_t)t * 48 + j] = cn; p.rtab[(size_t)t * 48 + 16 + j] = sn; }
    else { int jj = j - 16; sincosf(posf * INV16[jj], &sn, &cn); p.rtab[(size_t)t * 48 + 32 + jj] = cn; p.rtab[(size_t)t * 48 + 40 + jj] = sn; }
  }
  for (int rb = blockIdx.x; rb < 8192; rb += gridDim.x) {
    int r = rb * 4 + wid;
    bool isu = r < 16384;
    int rr = isu ? r : r - 16384;
    const float* src = (isu ? p.peer_u : p.peer_v) + (size_t)rr * 1024 + lane * 16;
    float v[16];
#pragma unroll
    for (int i = 0; i < 4; ++i) {
      float4 q = *reinterpret_cast<const float4*>(src + 4 * i);
      v[4 * i] = q.x; v[4 * i + 1] = q.y; v[4 * i + 2] = q.z; v[4 * i + 3] = q.w;
    }
    if (isu) {
#pragma unroll
      for (int i = 0; i < 4; ++i) {
        float4 g = *reinterpret_cast<const float4*>(p.norm2_g + lane * 16 + 4 * i);
        v[4 * i] *= g.x; v[4 * i + 1] *= g.y; v[4 * i + 2] *= g.z; v[4 * i + 3] *= g.w;
      }
    }
    float amax = 0.f;
#pragma unroll
    for (int i = 0; i < 16; ++i) amax = fmaxf(amax, fabsf(v[i]));
#pragma unroll
    for (int m = 32; m >= 1; m >>= 1) amax = fmaxf(amax, __shfl_xor(amax, m));
    int ex = 0;
    if (amax > 0.f) ex = ilogbf(224.f / amax);
    ex = ex > 60 ? 60 : (ex < -60 ? -60 : ex);
    float sc = ldexpf(1.f, ex);
    u32 w[4];
#pragma unroll
    for (int i = 0; i < 4; ++i) {
      int t = __builtin_amdgcn_cvt_pk_fp8_f32(v[4 * i] * sc, v[4 * i + 1] * sc, 0, false);
      t = __builtin_amdgcn_cvt_pk_fp8_f32(v[4 * i + 2] * sc, v[4 * i + 3] * sc, t, true);
      w[i] = (u32)t;
    }
    uint4 o = {w[0], w[1], w[2], w[3]};
    *reinterpret_cast<uint4*>((isu ? p.U8 : p.V8) + (size_t)rr * 1024 + lane * 16) = o;
    if (lane == 0) (isu ? p.su : p.sv)[rr] = ldexpf(1.f, -ex);
  }
}

__device__ __forceinline__ void rope_pair(float& y0, float& y1, int lc, int half, int xm, float posf, const float* inv) {
  float p0 = __shfl_xor(y0, xm), p1 = __shfl_xor(y1, xm);
  if (lc < 2 * half) {
    int j = lc & (half - 1);
    float a0 = posf * inv[j], a1 = posf * inv[j + 1];
    float s0, c0, s1, c1;
    sincosf(a0, &s0, &c0);
    sincosf(a1, &s1, &c1);
    if (lc < half) { y0 = y0 * c0 - p0 * s0; y1 = y1 * c1 - p1 * s1; }
    else { y0 = y0 * c0 + p0 * s0; y1 = y1 * c1 + p1 * s1; }
  }
}

__device__ __forceinline__ bool tile_swizzle(int step, int ntn, int ntiles, int& mt, int& nt) {
  const int x = blockIdx.x & 7, slot = blockIdx.x >> 3;
  const int nslots = gridDim.x >> 3;
  const int lin = (step * 8 + x) * nslots + slot;
  if (lin >= ntiles) return false;
  const int per = ntn * 16;
  const int g = lin / per, rem = lin - g * per;
  nt = rem >> 4;
  mt = g * 16 + (rem & 15);
  return true;
}

__device__ void phase_gemm1(const Params& p, char* smem) {
  const int tid = threadIdx.x, lane = tid & 63, wid = tid >> 6;
  float* cs = reinterpret_cast<float*>(smem);
  constexpr int NTN = NWIN / 128;
  constexpr int NTILES = (T / 128) * NTN;
  int mt, nt;
  bool have = tile_swizzle(0, NTN, NTILES, mt, nt);
  Tile4 ra, rb;
  if (have) gemm_prefetch(p.xn + (size_t)mt * 128 * DM, DM, p.WinT + (size_t)nt * 128 * DM, DM, DM, ra, rb);
  for (int step = 0; have; ++step) {
    int m0 = mt * 128;
    f32x16 acc[2][2];
    zero_acc(acc);
    gemm_mainloop(p.xn + (size_t)m0 * DM, DM, p.WinT + (size_t)nt * 128 * DM, DM, DM, acc, smem, ra, rb);
    stage_acc(acc, cs);
    __syncthreads();
    int mt2 = 0, nt2 = 0;
    const bool nxt = tile_swizzle(step + 1, NTN, NTILES, mt2, nt2);
    if (nxt) gemm_prefetch(p.xn + (size_t)mt2 * 128 * DM, DM, p.WinT + (size_t)nt2 * 128 * DM, DM, DM, ra, rb);
    const int L = lane & 15, rsub = lane >> 4, c0 = L * 8;
#pragma unroll 1
    for (int it = 0; it < 8; ++it) {
      const int row = wid * 32 + it * 4 + rsub;
      const size_t t = (size_t)m0 + row;
      float v[8];
      load8(cs + row * CS_LD + c0, v);
      if (nt < 8) {
#pragma unroll
        for (int e = 0; e < 8; ++e) v[e] = gelu_f(v[e]);
        u16* dst = (nt < 4) ? (p.gu + t * 512 + nt * 128 + c0) : (p.gv + t * 512 + (nt - 4) * 128 + c0);
        *reinterpret_cast<uint4*>(dst) = pack8(v);
      } else if (nt < 12) {
        float ss = 0.f;
#pragma unroll
        for (int e = 0; e < 8; ++e) ss += v[e] * v[e];
        ss = sum16(ss);
        float r = rsqrtf(ss * (1.f / 128.f) + EPS);
        float g[8];
        load8(p.q_norm_g + c0, g);
#pragma unroll
        for (int e = 0; e < 8; ++e) v[e] = v[e] * r * g[e];
        rope32_8(v, L, p.rtab + t * 48);
        *reinterpret_cast<uint4*>(p.qh + t * 512 + (nt - 8) * 128 + c0) = pack8(v);
      } else if (nt < 14) {
        *reinterpret_cast<uint4*>(p.ckv + t * 256 + (nt - 12) * 128 + c0) = pack8(v);
      } else if (nt < 16) {
        rope16_8(v, c0 & 63, p.rtab + t * 48);
        *reinterpret_cast<uint4*>(p.qi + t * 256 + (nt - 14) * 128 + c0) = pack8(v);
      } else if (nt == 16) {
        rope16_8(v, c0 < 64 ? c0 : 64, p.rtab + t * 48);
        if (c0 < 64) *reinterpret_cast<uint4*>(p.ki + ((t >> 4) * 8 + L) * 128 + (t & 15) * 8) = pack8(v);
        else if (c0 == 64) *reinterpret_cast<float4*>(p.wi + t * 4) = make_float4(v[0] * 0.0625f, v[1] * 0.0625f, v[2] * 0.0625f, v[3] * 0.0625f);
      } else {
#pragma unroll
        for (int e = 0; e < 8; ++e) v[e] = sigmoid_f(v[e]);
        *reinterpret_cast<uint4*>(p.sg + t * 2048 + (nt - 17) * 128 + c0) = pack8(v);
      }
    }
    mt = mt2; nt = nt2; have = nxt;
  }
}

__device__ void unit_kv(const Params& p, char* smem, int mt) {
  const int tid = threadIdx.x, lane = tid & 63, wid = tid >> 6;
  float* cs = reinterpret_cast<float*>(smem);
  float* rr_s = reinterpret_cast<float*>(smem + EXTRA_OFF);
  const int m0 = mt * 128;
  __syncthreads();
  {
    int row = tid >> 1, half = tid & 1;
    const u16* src = p.ckv + (size_t)(m0 + row) * 256 + half * 128;
    float ss = 0.f;
#pragma unroll 4
    for (int i = 0; i < 16; ++i) {
      uint4 q = *reinterpret_cast<const uint4*>(src + i * 8);
      u32 w[4] = {q.x, q.y, q.z, q.w};
#pragma unroll
      for (int j = 0; j < 4; ++j) { float a = bf_lo(w[j]), b = bf_hi(w[j]); ss += a * a + b * b; }
    }
    ss += __shfl_xor(ss, 1);
    if (half == 0) rr_s[row] = rsqrtf(ss * (1.f / 256.f) + EPS);
  }
  Tile4 ra, rb;
  gemm_prefetch(p.ckv + (size_t)m0 * 256, 256, p.WkvT, 256, 256, ra, rb);
#pragma unroll 1
  for (int nt = 0; nt < 2; ++nt) {
    f32x16 acc[2][2];
    zero_acc(acc);
    gemm_mainloop(p.ckv + (size_t)m0 * 256, 256, p.WkvT + (size_t)nt * 128 * 256, 256, 256, acc, smem, ra, rb);
    stage_acc(acc, cs);
    __syncthreads();
    if (nt == 0) gemm_prefetch(p.ckv + (size_t)m0 * 256, 256, p.WkvT + (size_t)128 * 256, 256, 256, ra, rb);
    const int L = lane & 15, rsub = lane >> 4, c0 = L * 8;
#pragma unroll 1
    for (int it = 0; it < 8; ++it) {
      const int row = wid * 32 + it * 4 + rsub;
      const size_t t = (size_t)m0 + row;
      float v[8];
      load8(cs + row * CS_LD + c0, v);
      const float rs = rr_s[row];
#pragma unroll
      for (int e = 0; e < 8; ++e) v[e] *= rs;
      if (nt == 0) {
        float ss = 0.f;
#pragma unroll
        for (int e = 0; e < 8; ++e) ss += v[e] * v[e];
        ss = sum16(ss);
        float r = rsqrtf(ss * (1.f / 128.f) + EPS);
        float g[8];
        load8(p.k_norm_g + c0, g);
#pragma unroll
        for (int e = 0; e < 8; ++e) v[e] = v[e] * r * g[e];
        rope32_8(v, L, p.rtab + t * 48);
        {
          const float sk = p.scal[1];
          int w0 = __builtin_amdgcn_cvt_pk_fp8_f32(v[0] * sk, v[1] * sk, 0, false);
          w0 = __builtin_amdgcn_cvt_pk_fp8_f32(v[2] * sk, v[3] * sk, w0, true);
          int w1 = __builtin_amdgcn_cvt_pk_fp8_f32(v[4] * sk, v[5] * sk, 0, false);
          w1 = __builtin_amdgcn_cvt_pk_fp8_f32(v[6] * sk, v[7] * sk, w1, true);
          *reinterpret_cast<uint2*>(p.kv8 + t * 256 + c0) = make_uint2((u32)w0, (u32)w1);
        }
      } else {
        {
          const float sv8 = p.scal[2];
          int w0 = __builtin_amdgcn_cvt_pk_fp8_f32(v[0] * sv8, v[1] * sv8, 0, false);
          w0 = __builtin_amdgcn_cvt_pk_fp8_f32(v[2] * sv8, v[3] * sv8, w0, true);
          int w1 = __builtin_amdgcn_cvt_pk_fp8_f32(v[4] * sv8, v[5] * sv8, 0, false);
          w1 = __builtin_amdgcn_cvt_pk_fp8_f32(v[6] * sv8, v[7] * sv8, w1, true);
          *reinterpret_cast<uint2*>(p.kv8 + t * 256 + 128 + c0) = make_uint2((u32)w0, (u32)w1);
        }
      }
    }
    __syncthreads();
  }
}

__device__ void unit_spatial(const Params& p, char* smem, int unit) {
  const int tid = threadIdx.x, lane = tid & 63, wid = tid >> 6;
  const int chunk = unit >> 2, g = unit & 3;
  const int t0 = chunk * 128;
  float* cs = reinterpret_cast<float*>(smem);
  float* mu_s = reinterpret_cast<float*>(smem + EXTRA_OFF);
  float* rs_s = mu_s + 128;
  __syncthreads();
  {
    int row = tid >> 1, half = tid & 1;
    const u16* src = p.gv + (size_t)(t0 + row) * 512 + half * 256;
    float s = 0.f, ss = 0.f;
#pragma unroll 4
    for (int i = 0; i < 32; ++i) {
      uint4 q = *reinterpret_cast<const uint4*>(src + i * 8);
      u32 w[4] = {q.x, q.y, q.z, q.w};
#pragma unroll
      for (int j = 0; j < 4; ++j) { float a = bf_lo(w[j]), b = bf_hi(w[j]); s += a + b; ss += a * a + b * b; }
    }
    s += __shfl_xor(s, 1);
    ss += __shfl_xor(ss, 1);
    float mean = s * (1.f / 512.f);
    float var = fmaxf(ss * (1.f / 512.f) - mean * mean, 0.f);
    if (half == 0) { mu_s[row] = mean; rs_s[row] = rsqrtf(var + EPS); }
  }
  {
    const u16* wsrc = p.Wtril + (size_t)g * 128 * 128;
#pragma unroll
    for (int i = 0; i < 8; ++i) {
      int c = tid + 256 * i;
      int row = c >> 4, kc = c & 15;
      uint4 q = *reinterpret_cast<const uint4*>(wsrc + row * 128 + kc * 8);
      *reinterpret_cast<uint4*>(smem + (kc >> 3) * ABUF + row * 144 + (kc & 7) * 16) = q;
    }
  }
  __syncthreads();
  {
    int s = tid & 127;
    float mu = mu_s[s], rs = rs_s[s];
    const u16* src = p.gv + (size_t)(t0 + s) * 512 + g * 128;
    char* bbase = smem + (2 + (s >> 6)) * ABUF + (s & 63) * 2;
#pragma unroll
    for (int i = 0; i < 8; ++i) {
      int d0 = ((tid >> 7) + 2 * i) * 8;
      uint4 q = *reinterpret_cast<const uint4*>(src + d0);
      u32 w[4] = {q.x, q.y, q.z, q.w};
#pragma unroll
      for (int j = 0; j < 4; ++j) {
        int d = d0 + 2 * j;
        float a = (bf_lo(w[j]) - mu) * rs * p.v_norm_g[g * 128 + d] + p.v_norm_b[g * 128 + d];
        float b = (bf_hi(w[j]) - mu) * rs * p.v_norm_g[g * 128 + d + 1] + p.v_norm_b[g * 128 + d + 1];
        *reinterpret_cast<u16*>(bbase + d * 144) = f2bf(a);
        *reinterpret_cast<u16*>(bbase + (d + 1) * 144) = f2bf(b);
      }
    }
  }
  __syncthreads();
  f32x16 acc[2][2];
  zero_acc(acc);
  mma_ktile(smem, smem + 2 * ABUF, acc);
  mma_ktile(smem + ABUF, smem + 3 * ABUF, acc);
  __syncthreads();
  stage_acc(acc, cs);
  __syncthreads();
  const int L = lane & 15, rsub = lane >> 4, c0 = L * 8;
#pragma unroll 1
  for (int it = 0; it < 8; ++it) {
    const int row = wid * 32 + it * 4 + rsub;
    const size_t t = (size_t)t0 + row;
    float v[8], u[8];
    load8(cs + row * CS_LD + c0, v);
    const float b = p.spatial_b[g * 128 + row];
    unpack8(*reinterpret_cast<const uint4*>(p.gu + t * 512 + g * 128 + c0), u);
#pragma unroll
    for (int e = 0; e < 8; ++e) v[e] = u[e] * (v[e] + b);
    *reinterpret_cast<uint4*>(p.ya + t * 512 + g * 128 + c0) = pack8(v);
  }
}

__device__ __forceinline__ void radix_partition(const u32 (&key)[12], int n, int rank, int slack, u32& lo, u32& hi, int& limit) {
  u32 vor = 0u, vand = 0xFFFFFFFFu;
#pragma unroll
  for (int k = 0; k < 12; ++k) { vor |= key[k]; vand &= (key[k] != 0u) ? key[k] : 0xFFFFFFFFu; }
#define DPPU(v, ctrl) ((u32)__builtin_amdgcn_update_dpp(0, (int)(v), (ctrl), 0xF, 0xF, true))
  vor |= DPPU(vor, 0xB1); vor |= DPPU(vor, 0x4E); vor |= DPPU(vor, 0x141); vor |= DPPU(vor, 0x140);
  vand &= DPPU(vand, 0xB1); vand &= DPPU(vand, 0x4E); vand &= DPPU(vand, 0x141); vand &= DPPU(vand, 0x140);
  vor = (u32)(__builtin_amdgcn_readlane((int)vor, 0) | __builtin_amdgcn_readlane((int)vor, 16) |
              __builtin_amdgcn_readlane((int)vor, 32) | __builtin_amdgcn_readlane((int)vor, 48));
  vand = (u32)(__builtin_amdgcn_readlane((int)vand, 0) & __builtin_amdgcn_readlane((int)vand, 16) &
               __builtin_amdgcn_readlane((int)vand, 32) & __builtin_amdgcn_readlane((int)vand, 48));
#undef DPPU
  const u32 diff = vor ^ vand;
  int b = diff ? (31 - __clz(diff)) : -1;
  u32 prefix = (b >= 31) ? 0u : (vand & ~((2u << b) - 1u));
  if (b < 0) prefix = vand;
  int krem = rank, ncand = n;
  while (b >= 0 && ncand - krem > slack) {
    u32 cand = prefix | (1u << b);
    u32 himask = ~((1u << b) - 1u);
    int c = 0;
#pragma unroll
    for (int k = 0; k < 12; ++k) c += __popcll(__ballot((key[k] & himask) == cand));
    if (c >= krem) { prefix = cand; ncand = c; } else { krem -= c; ncand -= c; }
    --b;
  }
  lo = prefix;
  hi = (b >= 0) ? (prefix | ((2u << b) - 1u)) : prefix;
  limit = (ncand - krem <= slack) ? ncand : krem;
}

__device__ __forceinline__ void idx_load_keys(const Params& p, int tb, int jc, int kcol, int lane, bf16x8 (&bf)[4][2]) {
  const u16* kb = p.ki + ((size_t)((tb + jc) >> 4) * 8 + (lane >> 4)) * 128 + kcol * 8;
#pragma unroll
  for (int u = 0; u < 4; ++u) {
    bf[u][0] = *reinterpret_cast<const bf16x8*>(kb + u * 1024);
    bf[u][1] = *reinterpret_cast<const bf16x8*>(kb + u * 1024 + 512);
  }
}
__device__ __forceinline__ void idx_compact(u32* cv, u16* ci, int n, int lane, int& newcnt, float& newthr) {
  u32 key[12]; u16 idx[12];
#pragma unroll
  for (int k = 0; k < 12; ++k) {
    int e = lane + 64 * k;
    bool in = e < n;
    key[k] = in ? sortable(cv[e]) : 0u;
    idx[k] = in ? ci[e] : (u16)0;
  }
  u32 lo, hi; int limit;
  radix_partition(key, n, 256, 64, lo, hi, limit);
  int base = 0, tcnt = 0;
#pragma unroll
  for (int k = 0; k < 12; ++k) {
    bool eq = key[k] >= lo && key[k] <= hi;
    unsigned long long meq = __ballot(eq);
    bool keep = (key[k] > hi) || (eq && (tcnt + mbcnt64(meq)) < limit);
    unsigned long long m = __ballot(keep);
    int pos = base + mbcnt64(m);
    if (keep) { cv[pos] = unsortable(key[k]); ci[pos] = idx[k]; }
    base += __popcll(m);
    tcnt += __popcll(meq);
  }
  newcnt = base;
  newthr = (lo <= 0x007FFFFFu) ? -INFINITY : __uint_as_float(unsortable(lo));
}

__device__ void unit_indexer(const Params& p, char* smem, int unit) {
  const int tid = threadIdx.x, lane = tid & 63, wid = tid >> 6;
  const int b = unit >> 10, grp = unit & 1023;
  const int tb = b * SEQ, i0 = grp * 16;
  u32* cval = reinterpret_cast<u32*>(smem);
  u16* cidx = reinterpret_cast<u16*>(smem + 16 * CAP * 4);
  __syncthreads();
  const int qsub = lane >> 4;
  const int ql = wid * 4 + qsub;
  const int iq = i0 + ql;
  const int kcol = lane & 15;
  bf16x8 afr[2];
  {
    const u16* qa = p.qi + ((size_t)(tb + i0 + wid * 4 + (kcol >> 2)) * 4 + (kcol & 3)) * 64 + 8 * (lane >> 4);
    afr[0] = *reinterpret_cast<const bf16x8*>(qa);
    afr[1] = *reinterpret_cast<const bf16x8*>(qa + 32);
  }
  const float4 w4 = *reinterpret_cast<const float4*>(p.wi + (size_t)(tb + iq) * 4);
  float thr = -INFINITY;
  const int kmul = 64;
  int cntr = 0;
  u32* myval = cval + ql * CAP;
  u16* myidx = cidx + ql * CAP;
  const u32 lowmask = (1u << kcol) - 1u;
  const int nchunks = (grp + 1 + 3) >> 2;

  auto process = [&](const bf16x8 (&bf)[4][2], int jc) {
    f32x4 acc[4];
#pragma unroll
    for (int u = 0; u < 4; ++u) {
      f32x4 z = {0.f, 0.f, 0.f, 0.f};
      acc[u] = __builtin_amdgcn_mfma_f32_16x16x32_bf16(afr[0], bf[u][0], z, 0, 0, 0);
    }
#pragma unroll
    for (int u = 0; u < 4; ++u) acc[u] = __builtin_amdgcn_mfma_f32_16x16x32_bf16(afr[1], bf[u][1], acc[u], 0, 0, 0);
    float sc[4];
    bool ps[4];
    bool anyp = false;
#pragma unroll
    for (int u = 0; u < 4; ++u) {
      float r0 = __builtin_amdgcn_fmed3f(acc[u][0], 0.f, INFINITY), r1 = __builtin_amdgcn_fmed3f(acc[u][1], 0.f, INFINITY);
      float r2 = __builtin_amdgcn_fmed3f(acc[u][2], 0.f, INFINITY), r3 = __builtin_amdgcn_fmed3f(acc[u][3], 0.f, INFINITY);
      float s = (w4.x * r0 + w4.y * r1) + (w4.z * r2 + w4.w * r3);
      s += 0.0f;
      sc[u] = s;
      ps[u] = ((jc + 16 * u + kcol) <= iq) && (s > thr);
      anyp |= ps[u];
    }
    if (__ballot(anyp)) {
#pragma unroll
      for (int u = 0; u < 4; ++u) {
        unsigned long long m = __ballot(ps[u]);
        u32 g16 = (u32)(m >> (16 * qsub)) & 0xFFFFu;
        int slot = cntr + __popc(g16 & lowmask);
        if (ps[u] && slot < CAP) { myval[slot] = __float_as_uint(sc[u]); myidx[slot] = (u16)(jc + 16 * u + kcol); }
        cntr += __popc(g16);
      }
      unsigned long long need = __ballot(cntr > CAP - 64);
      while (need) {
        int l = __ffsll((long long)need) - 1;
        int qc = l >> 4;
        need &= ~(0xFFFFull << (qc * 16));
        int qlc = wid * 4 + qc;
        int n = __builtin_amdgcn_readlane(cntr, qc * 16);
        if (n > CAP) n = CAP;
        int nc; float nt;
        idx_compact(cval + qlc * CAP, cidx + qlc * CAP, n, lane, nc, nt);
        if (qsub == qc) { thr = nt; cntr = nc; }
      }
    }
  };

  bf16x8 bA[4][2], bB[4][2];
  const int lastc = nchunks - 1;
  idx_load_keys(p, tb, 0, kcol, lane, bA);
  for (int ch = 0; ch < nchunks; ch += 2) {
    idx_load_keys(p, tb, min(ch + 1, lastc) * kmul, kcol, lane, bB);
    process(bA, ch * 64);
    idx_load_keys(p, tb, min(ch + 2, lastc) * kmul, kcol, lane, bA);
    if (ch + 1 < nchunks) process(bB, (ch + 1) * 64);
  }
  for (int qc = 0; qc < 4; ++qc) {
    int qlc = wid * 4 + qc;
    int n = __builtin_amdgcn_readlane(cntr, qc * 16);
    if (n > CAP) n = CAP;
    u32* cv = cval + qlc * CAP; u16* ci = cidx + qlc * CAP;
    u16* out = p.sel + (size_t)(tb + i0 + qlc) * 256;
    if (n <= 256) {
#pragma unroll
      for (int k = 0; k < 4; ++k) {
        int e = lane + 64 * k;
        out[e] = (e < n) ? ci[e] : (u16)0xFFFF;
      }
    } else {
      u32 key[12]; u16 idx[12];
#pragma unroll
      for (int k = 0; k < 12; ++k) {
        int e = lane + 64 * k;
        bool in = e < n;
        key[k] = in ? sortable(cv[e]) : 0u;
        idx[k] = in ? ci[e] : (u16)0;
      }
      u32 lo, hi; int limit;
      radix_partition(key, n, 256, 0, lo, hi, limit);
      int base = 0, tcnt = 0;
#pragma unroll
      for (int k = 0; k < 12; ++k) {
        bool eq = key[k] >= lo && key[k] <= hi;
        unsigned long long meq = __ballot(eq);
        bool keep = (key[k] > hi) || (eq && (tcnt + mbcnt64(meq)) < limit);
        unsigned long long m = __ballot(keep);
        int pos = base + mbcnt64(m);
        if (keep && pos < 256) ci[pos] = idx[k];
        base += __popcll(m);
        tcnt += __popcll(meq);
      }
      __builtin_amdgcn_wave_barrier();
      *reinterpret_cast<uint2*>(out + lane * 4) = *reinterpret_cast<const uint2*>(ci + lane * 4);
      __builtin_amdgcn_wave_barrier();
    }
  }
}

__device__ void phase_attn(const Params& p, char* smem) {
  const int tid = threadIdx.x, lane = tid & 63, wid = tid >> 6;
  constexpr int WSTRIDE = 13312;
  u16* lidx = reinterpret_cast<u16*>(smem + wid * WSTRIDE);
  float* Pt = reinterpret_cast<float*>(smem + wid * WSTRIDE + 512);
  char* tile = smem + wid * WSTRIDE + 1024;
  const float sq = p.scal[0];
  const float lf = 0.08838834764831845f * 1.4426950408889634f * p.scal[3];
  const float ovs = p.scal[4];
  const int xq = blockIdx.x & 7;
  const int b = xq & 1;
  const int rblk = (blockIdx.x >> 3) * 4 + (xq >> 1);
  const int nrb = (gridDim.x >> 3) * 4;
  const int n16 = lane & 15, g4 = lane >> 4;
  for (int i = rblk * 4 + wid; i < SEQ; i += nrb * 4) {
    const int tq = b * SEQ + i;
    const size_t tb = (size_t)b * SEQ;
    __builtin_amdgcn_wave_barrier();
    {
      uint2 v = *reinterpret_cast<const uint2*>(p.sel + (size_t)tq * 256 + lane * 4);
      *reinterpret_cast<uint2*>(lidx + lane * 4) = v;
    }
    __builtin_amdgcn_wave_barrier();
    long qf[4];
#pragma unroll
    for (int s = 0; s < 4; ++s) {
      qf[s] = 0;
      if (n16 < 4) {
        float qv[8];
        unpack8(*reinterpret_cast<const uint4*>(p.qh + (size_t)tq * 512 + n16 * 128 + 32 * s + 8 * g4), qv);
        int w0 = __builtin_amdgcn_cvt_pk_fp8_f32(qv[0] * sq, qv[1] * sq, 0, false);
        w0 = __builtin_amdgcn_cvt_pk_fp8_f32(qv[2] * sq, qv[3] * sq, w0, true);
        int w1 = __builtin_amdgcn_cvt_pk_fp8_f32(qv[4] * sq, qv[5] * sq, 0, false);
        w1 = __builtin_amdgcn_cvt_pk_fp8_f32(qv[6] * sq, qv[7] * sq, w1, true);
        qf[s] = (long)(((unsigned long long)(u32)w1 << 32) | (unsigned long long)(u32)w0);
      }
    }
    float mrun[4] = {-1e30f, -1e30f, -1e30f, -1e30f}, lrun[4] = {0.f, 0.f, 0.f, 0.f};
    float2_t o2[4][4];
#pragma unroll
    for (int h = 0; h < 4; ++h)
#pragma unroll
      for (int j = 0; j < 4; ++j) { o2[h][j].x = 0.f; o2[h][j].y = 0.f; }
    u32x4 kr[8];
#pragma unroll
    for (int r = 0; r < 8; ++r) {
      int id = lidx[r * 4 + g4];
      int idc = (id <= i) ? id : 0;
      kr[r] = *reinterpret_cast<const u32x4*>(p.kv8 + (tb + idc) * 256 + n16 * 16);
    }
#pragma unroll 1
    for (int g2 = 0; g2 < 8; ++g2) {
      __builtin_amdgcn_wave_barrier();
#pragma unroll
      for (int r = 0; r < 8; ++r) *reinterpret_cast<u32x4*>(tile + (r * 4 + g4) * 272 + n16 * 16) = kr[r];
      __builtin_amdgcn_wave_barrier();
      {
        const int gn = (g2 < 7) ? g2 + 1 : 7;
#pragma unroll
        for (int r = 0; r < 8; ++r) {
          int id = lidx[gn * 32 + r * 4 + g4];
          int idc = (id <= i) ? id : 0;
          kr[r] = *reinterpret_cast<const u32x4*>(p.kv8 + (tb + idc) * 256 + n16 * 16);
        }
      }
      float sc[2][4];
#pragma unroll
      for (int tt = 0; tt < 2; ++tt) {
        int id = lidx[g2 * 32 + tt * 16 + n16];
        bool valid = id <= i;
        f32x4 acc = {0.f, 0.f, 0.f, 0.f};
#pragma unroll
        for (int s = 0; s < 4; ++s) {
          long kf = *reinterpret_cast<const long*>(tile + (tt * 16 + n16) * 272 + 32 * s + 8 * g4);
          acc = __builtin_amdgcn_mfma_f32_16x16x32_fp8_fp8(qf[s], kf, acc, 0, 0, 0);
        }
#pragma unroll
        for (int h = 0; h < 4; ++h) sc[tt][h] = valid ? acc[h] * lf : -1e30f;
      }
      float alpha[4], pp[2][4];
#pragma unroll
      for (int h = 0; h < 4; ++h) {
        float mg = max16(fmaxf(sc[0][h], sc[1][h]));
        float mnew = fmaxf(mrun[h], __int_as_float(__builtin_amdgcn_readfirstlane(__float_as_int(mg))));
        alpha[h] = __builtin_amdgcn_exp2f(mrun[h] - mnew);
        mrun[h] = mnew;
        pp[0][h] = __builtin_amdgcn_exp2f(sc[0][h] - mnew);
        pp[1][h] = __builtin_amdgcn_exp2f(sc[1][h] - mnew);
        float ls = sum16(pp[0][h] + pp[1][h]);
        lrun[h] = lrun[h] * alpha[h] + __int_as_float(__builtin_amdgcn_readfirstlane(__float_as_int(ls)));
      }
      if (lane < 16) {
        *reinterpret_cast<float4*>(Pt + lane * 4) = make_float4(pp[0][0], pp[0][1], pp[0][2], pp[0][3]);
        *reinterpret_cast<float4*>(Pt + (16 + lane) * 4) = make_float4(pp[1][0], pp[1][1], pp[1][2], pp[1][3]);
      }
#pragma unroll
      for (int h = 0; h < 4; ++h) {
        float2_t a2 = {alpha[h], alpha[h]};
#pragma unroll
        for (int j = 0; j < 4; ++j) o2[h][j] *= a2;
      }
      __builtin_amdgcn_wave_barrier();
#pragma unroll
      for (int it = 0; it < 8; ++it) {
        const int nk = it * 4 + g4;
        float4 pw = *reinterpret_cast<const float4*>(Pt + nk * 4);
        uint2 q = *reinterpret_cast<const uint2*>(tile + nk * 272 + 128 + n16 * 8);
        float2_t v2[4] = {__builtin_amdgcn_cvt_pk_f32_fp8((int)q.x, false), __builtin_amdgcn_cvt_pk_f32_fp8((int)q.x, true),
                          __builtin_amdgcn_cvt_pk_f32_fp8((int)q.y, false), __builtin_amdgcn_cvt_pk_f32_fp8((int)q.y, true)};
        float pv[4] = {pw.x, pw.y, pw.z, pw.w};
#pragma unroll
        for (int h = 0; h < 4; ++h) {
          float2_t ph = {pv[h], pv[h]};
#pragma unroll
          for (int j = 0; j < 4; ++j) o2[h][j] += ph * v2[j];
        }
      }
      __builtin_amdgcn_wave_barrier();
    }
#pragma unroll
    for (int h = 0; h < 4; ++h) {
      float inv = ovs * __builtin_amdgcn_rcpf(lrun[h]);
      float ov[8];
#pragma unroll
      for (int j = 0; j < 4; ++j) {
        float x0 = o2[h][j].x, x1 = o2[h][j].y;
        x0 += __shfl_xor(x0, 16); x0 += __shfl_xor(x0, 32);
        x1 += __shfl_xor(x1, 16); x1 += __shfl_xor(x1, 32);
        ov[2 * j] = x0 * inv; ov[2 * j + 1] = x1 * inv;
      }
      if (g4 == 0) *reinterpret_cast<uint4*>(p.yb + (size_t)tq * 512 + h * 128 + n16 * 8) = pack8(ov);
    }
  }
}

__device__ void phase_merge(const Params& p, char* smem) {
  const int tid = threadIdx.x, lane = tid & 63, wid = tid >> 6;
  float* cs = reinterpret_cast<float*>(smem);
  constexpr int NTILES = (T / 128) * 8;
  int mt, nt;
  bool have = tile_swizzle(0, 8, NTILES, mt, nt);
  Tile4 ra, rb;
  if (have) gemm_prefetch(p.ya + (size_t)mt * 128 * 512, 512, p.WaT + (size_t)nt * 128 * 512, 512, 512, ra, rb);
  for (int step = 0; have; ++step) {
    int m0 = mt * 128, n0 = nt * 128;
    f32x16 acc[2][2];
    zero_acc(acc);
    gemm_mainloop(p.ya + (size_t)m0 * 512, 512, p.WaT + (size_t)n0 * 512, 512, 512, acc, smem, ra, rb);
    stage_acc(acc, cs);
    __syncthreads();
    gemm_prefetch(p.yb + (size_t)m0 * 512, 512, p.WbT + (size_t)n0 * 512, 512, 512, ra, rb);
#pragma unroll 2
    for (int it = 0; it < 8; ++it) {
      const int row = wid * 32 + it * 4 + (lane >> 4), c0 = (lane & 15) * 8;
      float v[8], g[8];
      load8(cs + row * CS_LD + c0, v);
      unpack8(*reinterpret_cast<const uint4*>(p.sg + (size_t)(m0 + row) * 2048 + n0 + c0), g);
#pragma unroll
      for (int e = 0; e < 8; ++e) v[e] *= g[e];
      *reinterpret_cast<uint4*>(p.merged + (size_t)(m0 + row) * 1024 + n0 + c0) = pack8(v);
    }
    __syncthreads();
    zero_acc(acc);
    gemm_mainloop(p.yb + (size_t)m0 * 512, 512, p.WbT + (size_t)n0 * 512, 512, 512, acc, smem, ra, rb);
    stage_acc(acc, cs);
    __syncthreads();
    int mt2 = 0, nt2 = 0;
    const bool nxt = tile_swizzle(step + 1, 8, NTILES, mt2, nt2);
    if (nxt) gemm_prefetch(p.ya + (size_t)mt2 * 128 * 512, 512, p.WaT + (size_t)nt2 * 128 * 512, 512, 512, ra, rb);
#pragma unroll 2
    for (int it = 0; it < 8; ++it) {
      const int row = wid * 32 + it * 4 + (lane >> 4), c0 = (lane & 15) * 8;
      float v[8], g[8], pa[8];
      load8(cs + row * CS_LD + c0, v);
      unpack8(*reinterpret_cast<const uint4*>(p.sg + (size_t)(m0 + row) * 2048 + 1024 + n0 + c0), g);
      uint4* mp = reinterpret_cast<uint4*>(p.merged + (size_t)(m0 + row) * 1024 + n0 + c0);
      unpack8(*mp, pa);
#pragma unroll
      for (int e = 0; e < 8; ++e) v[e] = pa[e] + v[e] * g[e];
      *mp = pack8(v);
    }
    mt = mt2; nt = nt2; have = nxt;
  }
}

__device__ void phase_wo(const Params& p, char* smem) {
  const int tid = threadIdx.x, lane = tid & 63, wid = tid >> 6;
  float* cs = reinterpret_cast<float*>(smem);
  constexpr int NTILES = (T / 128) * 8;
  int mt, nt;
  bool have = tile_swizzle(0, 8, NTILES, mt, nt);
  Tile4 ra, rb;
  if (have) gemm_prefetch(p.merged + (size_t)mt * 128 * 1024, 1024, p.WoT + (size_t)nt * 128 * 1024, 1024, 1024, ra, rb);
  for (int step = 0; have; ++step) {
    int m0 = mt * 128, n0 = nt * 128;
    f32x16 acc[2][2];
    zero_acc(acc);
    gemm_mainloop(p.merged + (size_t)m0 * 1024, 1024, p.WoT + (size_t)n0 * 1024, 1024, 1024, acc, smem, ra, rb);
    stage_acc(acc, cs);
    __syncthreads();
    int mt2 = 0, nt2 = 0;
    const bool nxt = tile_swizzle(step + 1, 8, NTILES, mt2, nt2);
    if (nxt) gemm_prefetch(p.merged + (size_t)mt2 * 128 * 1024, 1024, p.WoT + (size_t)nt2 * 128 * 1024, 1024, 1024, ra, rb);
#pragma unroll 2
    for (int it = 0; it < 8; ++it) {
      const int row = wid * 32 + it * 4 + (lane >> 4), c0 = (lane & 15) * 8;
      const size_t t = (size_t)m0 + row;
      float v[8], xv[8];
      load8(cs + row * CS_LD + c0, v);
      load8(p.x + t * 1024 + n0 + c0, xv);
      float ss = 0.f;
#pragma unroll
      for (int e = 0; e < 8; ++e) { v[e] += xv[e]; ss += v[e] * v[e]; }
      *reinterpret_cast<uint4*>(p.h1b + t * 1024 + n0 + c0) = pack8(v);
      ss = sum16(ss);
      if ((lane & 15) == 0) p.ssq[(size_t)nt * T + t] = ss;
    }
    mt = mt2; nt = nt2; have = nxt;
  }
}

__device__ __forceinline__ void ins16(float (&l)[16], float v) {
#pragma unroll
  for (int q = 15; q >= 1; --q) l[q] = __builtin_amdgcn_fmed3f(v, l[q - 1], l[q]);
  l[0] = fmaxf(l[0], v);
}
__device__ void phase_peerq(const Params& p, char* smem) {
  const int tid = threadIdx.x, lane = tid & 63, wid = tid >> 6;
  const int wr = wid >> 1, wc = wid & 1;
  float* cs = reinterpret_cast<float*>(smem);
  constexpr int NTILES = (T / 128) * 16;
  int mt, hp;
  bool have = tile_swizzle(0, 16, NTILES, mt, hp);
  Tile4 ra, rb;
  if (have) gemm_prefetch(p.h1b + (size_t)mt * 128 * 1024, 1024, p.WqT + (size_t)hp * 128 * 1024, 1024, 1024, ra, rb);
  for (int step = 0; have; ++step) {
    int m0 = mt * 128;
    f32x16 acc[2][2];
    zero_acc(acc);
    gemm_mainloop(p.h1b + (size_t)m0 * 1024, 1024, p.WqT + (size_t)hp * 128 * 1024, 1024, 1024, acc, smem, ra, rb);
#pragma unroll
    for (int i = 0; i < 2; ++i)
#pragma unroll
      for (int j = 0; j < 2; ++j)
#pragma unroll
        for (int r = 0; r < 16; ++r) {
          int row = wr * 64 + i * 32 + (r & 3) + 8 * (r >> 2) + 4 * (lane >> 5);
          int col = wc * 64 + j * 32 + (lane & 31);
          *reinterpret_cast<u16*>(smem + (col >> 6) * ABUF + row * 144 + (col & 63) * 2) = f2bf(acc[i][j][r]);
        }
    {
      const u16* sk = p.SubK + (size_t)hp * 128 * 128;
#pragma unroll
      for (int i = 0; i < 8; ++i) {
        int c = tid + 256 * i;
        int row = c >> 4, kc = c & 15;
        uint4 q = *reinterpret_cast<const uint4*>(sk + row * 128 + kc * 8);
        *reinterpret_cast<uint4*>(smem + (2 + (kc >> 3)) * ABUF + row * 144 + (kc & 7) * 16) = q;
      }
    }
    __syncthreads();
    zero_acc(acc);
    mma_ktile(smem, smem + 2 * ABUF, acc);
    mma_ktile(smem + ABUF, smem + 3 * ABUF, acc);
    __syncthreads();
    stage_acc(acc, cs);
    __syncthreads();
    int mt2 = 0, hp2 = 0;
    const bool nxt = tile_swizzle(step + 1, 16, NTILES, mt2, hp2);
    if (nxt) gemm_prefetch(p.h1b + (size_t)mt2 * 128 * 1024, 1024, p.WqT + (size_t)hp2 * 128 * 1024, 1024, 1024, ra, rb);
    {
      int row = tid >> 1, half = tid & 1;
      float* rp = cs + row * CS_LD + half * 64;
      float l[16];
#pragma unroll
      for (int q = 0; q < 16; ++q) l[q] = -INFINITY;
      for (int c = 0; c < 64; c += 4) {
        float4 v4 = *reinterpret_cast<const float4*>(rp + c);
        float vv[4] = {v4.x, v4.y, v4.z, v4.w};
#pragma unroll
        for (int e = 0; e < 4; ++e) {
          u32 bits = __float_as_uint(vv[e]);
          u32 n = (u32)(half * 64 + c + e);
          bits = (bits & ~127u) | ((bits >> 31) ? n : (127u - n));
          ins16(l, __uint_as_float(bits));
        }
      }
#pragma unroll
      for (int q = 0; q < 16; ++q) rp[q] = l[q];
    }
    __syncthreads();
    if (tid < 128) {
      int row = tid;
      size_t t = (size_t)m0 + row;
      const float* la = cs + row * CS_LD;
      const float* lb = la + 64;
      float ssum = 0.f;
#pragma unroll
      for (int q = 0; q < 8; ++q) ssum += p.ssq[(size_t)q * T + t];
      float rt = rsqrtf(ssum * (1.f / 1024.f) + EPS);
      int ia = 0, ib = 0;
      float* ov = p.stv + ((size_t)hp * T + t) * 16;
      u8* oi = p.sti + ((size_t)hp * T + t) * 16;
      float ovv[16]; u32 oii[4] = {0u, 0u, 0u, 0u};
#pragma unroll
      for (int q = 0; q < 16; ++q) {
        float va = la[ia], vb = lb[ib];
        bool ta = va >= vb;
        float v = ta ? va : vb;
        ia += ta ? 1 : 0;
        ib += ta ? 0 : 1;
        u32 bits = __float_as_uint(v);
        u32 low = bits & 127u;
        u32 n = (bits >> 31) ? low : (127u - low);
        ovv[q] = __uint_as_float(bits & ~127u) * rt;
        oii[q >> 2] |= n << (8 * (q & 3));
      }
#pragma unroll
      for (int q = 0; q < 4; ++q) *reinterpret_cast<float4*>(ov + 4 * q) = make_float4(ovv[4 * q], ovv[4 * q + 1], ovv[4 * q + 2], ovv[4 * q + 3]);
      *reinterpret_cast<uint4*>(oi) = make_uint4(oii[0], oii[1], oii[2], oii[3]);
    }
    mt = mt2; hp = hp2; have = nxt;
  }
}

__device__ void phase_peer(const Params& p, char* smem) {
  const int tid = threadIdx.x, lane = tid & 63, wid = tid >> 6;
  int* pe_e = reinterpret_cast<int*>(smem + wid * 4096);
  float* pe_su = reinterpret_cast<float*>(smem + wid * 4096 + 512);
  float* pe_gv = reinterpret_cast<float*>(smem + wid * 4096 + 1024);
  float* svl = reinterpret_cast<float*>(smem + wid * 4096 + 1536);
  u8* sil = reinterpret_cast<u8*>(smem + wid * 4096 + 2560);
  const int h = lane >> 3, g = lane & 7;
  u32 prt[7];
#pragma unroll
  for (int c = 0; c < 7; ++c) prt[c] = PAIR_TAB[g * 7 + c];
  float4 nsv = make_float4(0.f, 0.f, 0.f, 0.f); uint4 nsi = make_uint4(0u, 0u, 0u, 0u);
  {
    int tq0 = blockIdx.x * 4 + wid;
    if (tq0 < T) {
      nsv = *reinterpret_cast<const float4*>(p.stv + ((size_t)(lane >> 2) * T + tq0) * 16 + (lane & 3) * 4);
      if (lane < 16) nsi = *reinterpret_cast<const uint4*>(p.sti + ((size_t)lane * T + tq0) * 16);
    }
  }
  for (int tq = blockIdx.x * 4 + wid; tq < T; tq += gridDim.x * 4) {
    const size_t t = tq;
    __builtin_amdgcn_wave_barrier();
    *reinterpret_cast<float4*>(svl + lane * 4) = nsv;
    if (lane < 16) *reinterpret_cast<uint4*>(sil + lane * 16) = nsi;
    __builtin_amdgcn_wave_barrier();
    {
      int tqn = tq + gridDim.x * 4;
      if (tqn < T) {
        nsv = *reinterpret_cast<const float4*>(p.stv + ((size_t)(lane >> 2) * T + tqn) * 16 + (lane & 3) * 4);
        if (lane < 16) nsi = *reinterpret_cast<const uint4*>(p.sti + ((size_t)lane * T + tqn) * 16);
      }
    }
    const float* s1 = svl + (2 * h) * 16;
    const float* s2 = s1 + 16;
    float l[16];
#pragma unroll
    for (int q = 0; q < 16; ++q) l[q] = -INFINITY;
#pragma unroll
    for (int c = 0; c < 7; ++c) {
      u32 pr = prt[c];
      float v = -INFINITY;
      if (pr != 0xffu) {
        float a = s1[pr >> 4] + s2[pr & 15];
        u32 bits = __float_as_uint(a);
        bits = (bits & ~255u) | ((bits >> 31) ? pr : (255u - pr));
        v = __uint_as_float(bits);
      }
      ins16(l, v);
    }
#pragma unroll
    for (int msk = 1; msk <= 4; msk <<= 1) {
      float c[16];
#pragma unroll
      for (int q = 0; q < 16; ++q) c[q] = __shfl_xor(l[15 - q], msk);
#pragma unroll
      for (int q = 0; q < 16; ++q) c[q] = fmaxf(l[q], c[q]);
#pragma unroll
      for (int st = 8; st >= 1; st >>= 1)
#pragma unroll
        for (int q = 0; q < 16; ++q)
          if ((q & st) == 0) {
            float hi = fmaxf(c[q], c[q + st]), lo = fminf(c[q], c[q + st]);
            c[q] = hi; c[q + st] = lo;
          }
#pragma unroll
      for (int q = 0; q < 16; ++q) l[q] = c[q];
    }
    {
      float m = -INFINITY, ssum = 0.f;
      float bvv[16];
#pragma unroll
      for (int q = 0; q < 16; ++q) {
        u32 bits = __float_as_uint(l[q]);
        u32 low = bits & 255u;
        int prq = (int)((bits >> 31) ? low : (255u - low));
        bvv[q] = s1[prq >> 4] + s2[prq & 15];
        m = fmaxf(m, bvv[q]);
      }
#pragma unroll
      for (int q = 0; q < 16; ++q) { bvv[q] = __expf(bvv[q] - m); ssum += bvv[q]; }
      float inv = 1.f / ssum;
      const u8* i1 = sil + (2 * h) * 16;
      const u8* i2 = i1 + 16;
#pragma unroll
      for (int q = 0; q < 16; ++q) {
        if ((q >> 1) == g) {
          u32 bits = __float_as_uint(l[q]);
          u32 low = bits & 255u;
          int prq = (int)((bits >> 31) ? low : (255u - low));
          int exi = (int)i1[prq >> 4] * 128 + (int)i2[prq & 15];
          pe_e[h * 16 + q] = exi;
          pe_su[h * 16 + q] = p.su[exi];
          pe_gv[h * 16 + q] = bvv[q] * inv * p.sv[exi];
        }
      }
      __builtin_amdgcn_wave_barrier();
    }
    float rt;
    {
      float ssum = 0.f;
#pragma unroll
      for (int q = 0; q < 8; ++q) ssum += p.ssq[(size_t)q * T + t];
      rt = rsqrtf(ssum * (1.f / 1024.f) + EPS);
    }
    float2_t h2[8];
    {
      uint4 hx0 = *reinterpret_cast<const uint4*>(p.h1b + t * 1024 + lane * 16);
      uint4 hx1 = *reinterpret_cast<const uint4*>(p.h1b + t * 1024 + lane * 16 + 8);
      u32 hw[8] = {hx0.x, hx0.y, hx0.z, hx0.w, hx1.x, hx1.y, hx1.z, hx1.w};
#pragma unroll
      for (int q = 0; q < 8; ++q) { h2[q].x = bf_lo(hw[q]); h2[q].y = bf_hi(hw[q]); }
    }
    float2_t y2[8];
#pragma unroll
    for (int q = 0; q < 8; ++q) { y2[q].x = 0.f; y2[q].y = 0.f; }
    const int kk = (lane >> 3) & 7;
    for (int e0 = 0; e0 < 128; e0 += 8) {
      uint4 ur[8], vr[8];
#pragma unroll
      for (int k = 0; k < 8; ++k) {
        int ex = pe_e[e0 + k];
        ur[k] = *reinterpret_cast<const uint4*>(p.U8 + (size_t)ex * 1024 + lane * 16);
        vr[k] = *reinterpret_cast<const uint4*>(p.V8 + (size_t)ex * 1024 + lane * 16);
      }
      float d[8];
#pragma unroll
      for (int k = 0; k < 8; ++k) {
        u32 uw[4] = {ur[k].x, ur[k].y, ur[k].z, ur[k].w};
        float2_t acc = {0.f, 0.f};
#pragma unroll
        for (int q = 0; q < 4; ++q) {
          acc += __builtin_amdgcn_cvt_pk_f32_fp8((int)uw[q], false) * h2[2 * q];
          acc += __builtin_amdgcn_cvt_pk_f32_fp8((int)uw[q], true) * h2[2 * q + 1];
        }
        d[k] = acc.x + acc.y;
      }
      float e4[4], f2[2], gsum;
      {
        const bool hi = (lane & 32) != 0;
#pragma unroll
        for (int k = 0; k < 4; ++k) {
          float snd = hi ? d[k] : d[k + 4], kp = hi ? d[k + 4] : d[k];
          e4[k] = kp + __shfl_xor(snd, 32);
        }
        const bool hb = (lane & 16) != 0;
#pragma unroll
        for (int k = 0; k < 2; ++k) {
          float snd = hb ? e4[k] : e4[k + 2], kp = hb ? e4[k + 2] : e4[k];
          f2[k] = kp + __shfl_xor(snd, 16);
        }
        const bool hc = (lane & 8) != 0;
        float snd = hc ? f2[0] : f2[1], kp = hc ? f2[1] : f2[0];
        gsum = kp + __shfl_xor(snd, 8);
        gsum += __shfl_xor(gsum, 4);
        gsum += __shfl_xor(gsum, 2);
        gsum += __shfl_xor(gsum, 1);
      }
      float cme = pe_gv[e0 + kk] * gelu_f(gsum * rt * pe_su[e0 + kk]);
#pragma unroll
      for (int k = 0; k < 8; ++k) {
        float ck = __int_as_float(__builtin_amdgcn_readlane(__float_as_int(cme), k * 8));
        float2_t c2 = {ck, ck};
        u32 vw[4] = {vr[k].x, vr[k].y, vr[k].z, vr[k].w};
#pragma unroll
        for (int q = 0; q < 4; ++q) {
          y2[2 * q] += c2 * __builtin_amdgcn_cvt_pk_f32_fp8((int)vw[q], false);
          y2[2 * q + 1] += c2 * __builtin_amdgcn_cvt_pk_f32_fp8((int)vw[q], true);
        }
      }
    }
    float* op = p.out + t * 1024 + lane * 16;
#pragma unroll
    for (int q = 0; q < 4; ++q) {
      float4 a = make_float4(h2[2 * q].x + y2[2 * q].x, h2[2 * q].y + y2[2 * q].y, h2[2 * q + 1].x + y2[2 * q + 1].x, h2[2 * q + 1].y + y2[2 * q + 1].y);
      *reinterpret_cast<float4*>(op + 4 * q) = a;
    }
    __builtin_amdgcn_wave_barrier();
  }
}

__device__ void phase_mix(const Params& p, char* smem) {
  const int G = gridDim.x;
  {
    int* qslot = reinterpret_cast<int*>(smem + EXTRA_OFF + 1024);
    for (;;) {
      __syncthreads();
      if (threadIdx.x == 0) *qslot = (int)__hip_atomic_fetch_add(p.bar + 16, 1u, __ATOMIC_RELAXED, __HIP_MEMORY_SCOPE_AGENT);
      __syncthreads();
      const int s = *qslot;
      if (s >= 2048) break;
      int grp = 1023 - (s >> 1), b = s & 1;
      unit_indexer(p, smem, (b << 10) | grp);
    }
  }
  for (int u = blockIdx.x; u < 1024; u += G) unit_spatial(p, smem, u);
  for (int u = blockIdx.x; u < 256; u += G) unit_kv(p, smem, u);
}

template <int PH>
__device__ __forceinline__ void run_phase(const Params& p, char* smem) {
  if (PH == 0) phase_prep(p, smem);
  else if (PH == 1) phase_gemm1(p, smem);
  else if (PH == 2) phase_mix(p, smem);
  else if (PH == 3) phase_attn(p, smem);
  else if (PH == 4) phase_merge(p, smem);
  else if (PH == 5) phase_wo(p, smem);
  else if (PH == 6) phase_peerq(p, smem);
  else phase_peer(p, smem);
}

template <int PH>
__global__ void __launch_bounds__(NTHREADS, 2) phase_kernel(Params p) {
  __shared__ __attribute__((aligned(16))) char smem[SMEM_BYTES];
  run_phase<PH>(p, smem);
}

#define XB_CNT(j) (64 + 64 * (j))
#define XB_SUB(j) (1088 + 64 * (j))
#define XB_GEN(j) (2112 + 64 * (j))
#define XB_TOP 3136
#define XB_TOPGEN 3200
#define XB_WORDS 3264
__device__ __forceinline__ unsigned xb_ld(unsigned* q) { return __hip_atomic_load(q, __ATOMIC_RELAXED, __HIP_MEMORY_SCOPE_AGENT); }
__device__ __forceinline__ unsigned xb_add(unsigned* q) { return __hip_atomic_fetch_add(q, 1u, __ATOMIC_RELAXED, __HIP_MEMORY_SCOPE_AGENT); }
__device__ __forceinline__ unsigned xb_xcc_id() { return (unsigned)__builtin_amdgcn_s_getreg((3 << 11) | 20) & 0xFu; }
__device__ __forceinline__ void grid_barrier(unsigned* bar, unsigned x, unsigned nloc, unsigned nx) {
  asm volatile("s_waitcnt vmcnt(0)" ::: "memory");
  __syncthreads();
  if (threadIdx.x == 0) {
    const unsigned old = xb_add(&bar[XB_SUB(x)]);
    const unsigned gen = old / nloc;
    if (old + 1u == (gen + 1u) * nloc) {
      __builtin_amdgcn_fence(__ATOMIC_RELEASE, "agent");
      asm volatile("s_waitcnt vmcnt(0)" ::: "memory");
      const unsigned og = xb_add(&bar[XB_TOP]);
      const unsigned tg = og / nx;
      if (og + 1u == (tg + 1u) * nx) xb_add(&bar[XB_TOPGEN]);
      else { unsigned sp = 0; while (xb_ld(&bar[XB_TOPGEN]) == tg) { __builtin_amdgcn_s_sleep(1); if (++sp > (1u << 24)) break; } }
      __builtin_amdgcn_fence(__ATOMIC_ACQUIRE, "agent");
      xb_add(&bar[XB_GEN(x)]);
      asm volatile("s_waitcnt vmcnt(0)" ::: "memory");
    } else {
      unsigned sp = 0;
      while (xb_ld(&bar[XB_GEN(x)]) == gen) { __builtin_amdgcn_s_sleep(1); if (++sp > (1u << 24)) break; }
      __builtin_amdgcn_fence(__ATOMIC_ACQUIRE, "agent");
      asm volatile("s_waitcnt vmcnt(0)" ::: "memory");
    }
  }
  __syncthreads();
}

__global__ void __launch_bounds__(NTHREADS, 2) mega_kernel(Params p) {
  __shared__ __attribute__((aligned(16))) char smem[SMEM_BYTES];
  cg::grid_group grid = cg::this_grid();
#define GSYNC() grid_barrier(p.bar, xb_x, xb_nloc, xb_nx)
  const unsigned xb_x = xb_xcc_id();
  if (threadIdx.x == 0) xb_add(&p.bar[XB_CNT(xb_x)]);
  run_phase<0>(p, smem);
  asm volatile("s_waitcnt vmcnt(0)" ::: "memory");
  grid.sync();
  unsigned xb_nloc = 1, xb_nx = 0;
  if (threadIdx.x == 0) {
    for (unsigned j = 0; j < 16; ++j) { const unsigned c = xb_ld(&p.bar[XB_CNT(j)]); xb_nx += (c > 0u) ? 1u : 0u; if (j == xb_x) xb_nloc = c; }
    if (xb_nloc == 0u) xb_nloc = 1u;
    if (xb_nx == 0u) xb_nx = 1u;
  }
#define RUNP(X) run_phase<X>(p, smem); GSYNC();
  RUNP(1) RUNP(2) RUNP(3) RUNP(4) RUNP(5) RUNP(6)
  run_phase<7>(p, smem);
}

extern "C" void kernel_launch(void* const* d_in, const int* in_sizes, int n_in, void* d_out, int out_size,
                              void* d_ws, size_t ws_size, hipStream_t stream) {
  Params p{};
  p.x = (const float*)d_in[0]; p.pos = (const int*)d_in[1];
  p.norm1_g = (const float*)d_in[2]; p.w_in = (const float*)d_in[3]; p.v_norm_g = (const float*)d_in[4];
  p.v_norm_b = (const float*)d_in[5]; p.spatial_w = (const float*)d_in[6]; p.spatial_b = (const float*)d_in[7];
  p.kv_norm_g = (const float*)d_in[8]; p.w_uk = (const float*)d_in[9]; p.w_uv = (const float*)d_in[10];
  p.q_norm_g = (const float*)d_in[11]; p.k_norm_g = (const float*)d_in[12]; p.w_a_out = (const float*)d_in[13];
  p.w_b_out = (const float*)d_in[14]; p.w_o = (const float*)d_in[15]; p.norm2_g = (const float*)d_in[16];
  p.peer_wq = (const float*)d_in[17]; p.peer_subkeys = (const float*)d_in[18]; p.peer_u = (const float*)d_in[19];
  p.peer_v = (const float*)d_in[20];
  p.out = (float*)d_out;
  char* w = (char*)d_ws;
  size_t off = 0;
  auto take = [&](size_t bytes) { char* r = w + off; off += (bytes + 255) & ~(size_t)255; return r; };
  const size_t MB = 1u << 20;
  char* r_xn = take(64 * MB);
  p.xn = (u16*)r_xn; p.ya = (u16*)r_xn; p.yb = (u16*)(r_xn + 32 * MB);
  p.WinT = (u16*)take((size_t)NWIN * 1024 * 2);
  p.WaT = (u16*)take(1024 * 512 * 2); p.WbT = (u16*)take(1024 * 512 * 2);
  p.WoT = (u16*)take(1024 * 1024 * 2); p.WqT = (u16*)take(2048 * 1024 * 2);
  p.WkvT = (u16*)take(256 * 256 * 2); p.SubK = (u16*)take(262144 * 2); p.Wtril = (u16*)take(65536 * 2);
  p.U8 = (u8*)take(16 * MB); p.V8 = (u8*)take(16 * MB);
  p.su = (float*)take(16384 * 4); p.sv = (float*)take(16384 * 4);
  char* r_g = take(96 * MB);
  p.gu = (u16*)r_g; p.gv = (u16*)(r_g + 32 * MB); p.qh = (u16*)(r_g + 64 * MB); p.merged = (u16*)r_g;
  p.ckv = (u16*)take(16 * MB); p.qi = (u16*)take(16 * MB); p.ki = (u16*)take(4 * MB);
  p.wi = (float*)take((size_t)T * 4 * 4);
  char* r_sg = take(128 * MB);
  p.sg = (u16*)r_sg; p.h1b = (u16*)r_sg; p.stv = (float*)(r_sg + 64 * MB); p.sti = (u8*)(r_sg + 96 * MB);
  p.sel = (u16*)take(16 * MB);
  p.kv8 = (u8*)take(8 * MB); p.scal = (float*)take(256);
  p.ssq = (float*)take((size_t)T * 8 * 4);
  p.bar = (unsigned*)take(XB_WORDS * 4);
  p.rtab = (float*)take((size_t)T * 48 * 4);
  if (off > ws_size) { fprintf(stderr, "workspace too small: need %zu have %zu\n", off, ws_size); return; }

  static int grid_blocks = 0;
  if (!grid_blocks) {
    int dev = 0, cus = 0, per_cu = 0;
    hipGetDevice(&dev);
    hipDeviceGetAttribute(&cus, hipDeviceAttributeMultiprocessorCount, dev);
    hipOccupancyMaxActiveBlocksPerMultiprocessor(&per_cu, mega_kernel, NTHREADS, 0);
    if (per_cu > 2) per_cu = 2;
    if (per_cu < 1) per_cu = 1;
    grid_blocks = cus * per_cu;
  }
  hipMemsetAsync(p.bar, 0, XB_WORDS * 4, stream);
#if MULTI_LAUNCH
  dim3 g(grid_blocks), b(NTHREADS);
  phase_kernel<0><<<g, b, 0, stream>>>(p);
  phase_kernel<1><<<g, b, 0, stream>>>(p);
  phase_kernel<2><<<g, b, 0, stream>>>(p);
  phase_kernel<3><<<g, b, 0, stream>>>(p);
  phase_kernel<4><<<g, b, 0, stream>>>(p);
  phase_kernel<5><<<g, b, 0, stream>>>(p);
  phase_kernel<6><<<g, b, 0, stream>>>(p);
  phase_kernel<7><<<g, b, 0, stream>>>(p);
#else
  void* args[] = {&p};
  hipError_t e = hipLaunchCooperativeKernel((void*)mega_kernel, dim3(grid_blocks), dim3(NTHREADS), args, 0, stream);
  if (e != hipSuccess) fprintf(stderr, "cooperative launch failed: %s (grid %d)\n", hipGetErrorString(e), grid_blocks);
#endif
}
```

```cpp
#include <hip/hip_runtime.h>
#include <hip/hip_cooperative_groups.h>
#include <stdint.h>
#include <cstdio>
namespace cg = cooperative_groups;

#ifndef MULTI_LAUNCH
#define MULTI_LAUNCH 0
#endif

typedef unsigned short u16;
typedef unsigned int u32;
typedef unsigned char u8;
using bf16x8 = __attribute__((ext_vector_type(8))) short;
using f32x4 = __attribute__((ext_vector_type(4))) float;
using f32x16 = __attribute__((ext_vector_type(16))) float;
typedef __bf16 bf16x2_t __attribute__((ext_vector_type(2)));
typedef float float2_t __attribute__((ext_vector_type(2)));

constexpr int BATCH = 2, SEQ = 16384, DM = 1024, T = BATCH * SEQ;
constexpr int NWIN = 4224;
constexpr int NTHREADS = 256;
constexpr float EPS = 1e-6f;
constexpr int ABUF = 128 * 144;
constexpr int CS_LD = 132;
constexpr int SMEM_BYTES = 77824;
constexpr int EXTRA_OFF = 4 * ABUF;
constexpr int CAP = 768;

__constant__ float INV32[16] = {1.000000000e+00f, 4.403665960e-01f, 1.939227432e-01f, 8.539710194e-02f, 3.760603070e-02f, 1.656043902e-02f, 7.292664610e-03f, 3.211445874e-03f, 1.414213562e-03f, 6.227723788e-04f, 2.742481884e-04f, 1.207697351e-04f, 5.318296098e-05f, 2.341999971e-05f, 1.031338616e-05f, 4.541670478e-06f};
__constant__ float INV16[8] = {1.000000000e+00f, 1.939227432e-01f, 3.760603070e-02f, 7.292664610e-03f, 1.414213562e-03f, 2.742481884e-04f, 5.318296098e-05f, 1.031338616e-05f};
__constant__ u8 PAIR_TAB[56] = {
  0x00,0x01,0x02,0x03,0x04,0x05,0x06,0x07,0x08,0x09,0x0a,0x0b,0x0c,0x0d,0x0e,0x0f,
  0x10,0x11,0x12,0x13,0x14,0x15,0x16,0x17,
  0x20,0x21,0x22,0x23,0x24,
  0x30,0x31,0x32,0x33,
  0x40,0x41,0x42,
  0x50,0x51,
  0x60,0x61,
  0x70,0x71,
  0x80,0x90,0xa0,0xb0,0xc0,0xd0,0xe0,0xf0,
  0xff,0xff,0xff,0xff,0xff,0xff};

struct Params {
  const float* x; const int* pos;
  const float *norm1_g, *w_in, *v_norm_g, *v_norm_b, *spatial_w, *spatial_b, *kv_norm_g, *w_uk, *w_uv,
      *q_norm_g, *k_norm_g, *w_a_out, *w_b_out, *w_o, *norm2_g, *peer_wq, *peer_subkeys, *peer_u, *peer_v;
  float* out;
  u16 *xn, *WinT, *WaT, *WbT, *WoT, *WqT, *WkvT, *SubK, *Wtril;
  u8 *U8, *V8, *kv8;
  float *su, *sv, *scal;
  u16 *gu, *gv, *qh, *ckv, *qi, *ki, *sg, *ya, *yb, *merged, *h1b, *sel;
  float *wi, *ssq, *stv, *rtab;
  u8* sti;
  unsigned* bar;
};

__device__ __forceinline__ u32 pack_bf16(float a, float b) {
  float2_t v = {a, b};
  bf16x2_t r = __builtin_convertvector(v, bf16x2_t);
  return __builtin_bit_cast(u32, r);
}
__device__ __forceinline__ u16 f2bf(float a) { return (u16)(pack_bf16(a, 0.f) & 0xffffu); }
__device__ __forceinline__ float bf_lo(u32 u) { return __uint_as_float(u << 16); }
__device__ __forceinline__ float bf_hi(u32 u) { return __uint_as_float(u & 0xffff0000u); }
__device__ __forceinline__ float bf2f(u16 h) { return __uint_as_float(((u32)h) << 16); }
__device__ __forceinline__ float wave_sum(float v) {
#pragma unroll
  for (int m = 32; m >= 1; m >>= 1) v += __shfl_xor(v, m);
  return v;
}
__device__ __forceinline__ float gelu_f(float x) {
  float z = -2.3022082f * (x + 0.044715f * x * x * x);
  return x * __builtin_amdgcn_rcpf(1.f + __builtin_amdgcn_exp2f(z));
}
__device__ __forceinline__ float sigmoid_f(float x) { return __builtin_amdgcn_rcpf(1.f + __builtin_amdgcn_exp2f(-1.4426950408889634f * x)); }
__device__ __forceinline__ u32 sortable(u32 b) { return b ^ ((u32)((int)b >> 31) | 0x80000000u); }
__device__ __forceinline__ u32 unsortable(u32 k) { return k ^ ((k & 0x80000000u) ? 0x80000000u : 0xffffffffu); }
__device__ __forceinline__ int mbcnt64(unsigned long long m) {
  return __builtin_amdgcn_mbcnt_hi((u32)(m >> 32), __builtin_amdgcn_mbcnt_lo((u32)m, 0));
}

__device__ __forceinline__ void load8(const float* p, float (&v)[8]) {
  float4 a = *reinterpret_cast<const float4*>(p), b = *reinterpret_cast<const float4*>(p + 4);
  v[0] = a.x; v[1] = a.y; v[2] = a.z; v[3] = a.w; v[4] = b.x; v[5] = b.y; v[6] = b.z; v[7] = b.w;
}
__device__ __forceinline__ void unpack8(uint4 q, float (&v)[8]) {
  v[0] = bf_lo(q.x); v[1] = bf_hi(q.x); v[2] = bf_lo(q.y); v[3] = bf_hi(q.y);
  v[4] = bf_lo(q.z); v[5] = bf_hi(q.z); v[6] = bf_lo(q.w); v[7] = bf_hi(q.w);
}
__device__ __forceinline__ uint4 pack8(const float (&v)[8]) {
  uint4 o = {pack_bf16(v[0], v[1]), pack_bf16(v[2], v[3]), pack_bf16(v[4], v[5]), pack_bf16(v[6], v[7])};
  return o;
}
#define DPPF(v, ctrl) __int_as_float(__builtin_amdgcn_update_dpp(0, __float_as_int(v), (ctrl), 0xF, 0xF, true))
__device__ __forceinline__ float sum16(float x) {
  x += DPPF(x, 0xB1); x += DPPF(x, 0x4E); x += DPPF(x, 0x141); x += DPPF(x, 0x140);
  return x;
}
__device__ __forceinline__ float max16(float x) {
  x = fmaxf(x, DPPF(x, 0xB1)); x = fmaxf(x, DPPF(x, 0x4E)); x = fmaxf(x, DPPF(x, 0x141)); x = fmaxf(x, DPPF(x, 0x140));
  return x;
}
__device__ __forceinline__ void rope32_8(float (&v)[8], int L, const float* tab) {
  float pr[8];
#pragma unroll
  for (int e = 0; e < 8; ++e) pr[e] = __shfl_xor(v[e], 2);
  if (L < 4) {
    float c[8], s[8];
    load8(tab + (L & 1) * 8, c);
    load8(tab + 16 + (L & 1) * 8, s);
#pragma unroll
    for (int e = 0; e < 8; ++e) v[e] = (L < 2) ? (v[e] * c[e] - pr[e] * s[e]) : (v[e] * c[e] + pr[e] * s[e]);
  }
}
__device__ __forceinline__ void rope16_8(float (&v)[8], int lc0, const float* tab) {
  float pr[8];
#pragma unroll
  for (int e = 0; e < 8; ++e) pr[e] = __shfl_xor(v[e], 1);
  if (lc0 < 16) {
    float c[8], s[8];
    load8(tab + 32, c);
    load8(tab + 40, s);
#pragma unroll
    for (int e = 0; e < 8; ++e) v[e] = (lc0 == 0) ? (v[e] * c[e] - pr[e] * s[e]) : (v[e] * c[e] + pr[e] * s[e]);
  }
}

typedef u32 u32x4 __attribute__((ext_vector_type(4)));
struct Tile4 { u32x4 v0, v1, v2, v3; };
__device__ __forceinline__ void gemm_load_tile(const u16* __restrict__ g, int ld, int k0, Tile4& r) {
  const int tid = threadIdx.x;
  const int row = tid >> 3, kc = tid & 7;
  const u16* base = g + (size_t)row * ld + k0 + kc * 8;
  r.v0 = *reinterpret_cast<const u32x4*>(base);
  r.v1 = *reinterpret_cast<const u32x4*>(base + (size_t)32 * ld);
  r.v2 = *reinterpret_cast<const u32x4*>(base + (size_t)64 * ld);
  r.v3 = *reinterpret_cast<const u32x4*>(base + (size_t)96 * ld);
}
__device__ __forceinline__ void gemm_store_tile(char* buf, const Tile4& r) {
  const int tid = threadIdx.x;
  const int row = tid >> 3, kc = tid & 7;
  char* base = buf + row * 144 + kc * 16;
  *reinterpret_cast<u32x4*>(base) = r.v0;
  *reinterpret_cast<u32x4*>(base + 32 * 144) = r.v1;
  *reinterpret_cast<u32x4*>(base + 64 * 144) = r.v2;
  *reinterpret_cast<u32x4*>(base + 96 * 144) = r.v3;
}
__device__ __forceinline__ void mma_ktile(const char* sa, const char* sb, f32x16 (&acc)[2][2]) {
  const int lane = threadIdx.x & 63, wid = threadIdx.x >> 6;
  const int wr = wid >> 1, wc = wid & 1;
  const int r32 = lane & 31, hf = lane >> 5;
  const char* pa = sa + (wr * 64 + r32) * 144 + hf * 16;
  const char* pb = sb + (wc * 64 + r32) * 144 + hf * 16;
  bf16x8 a0[2], b0[2], a1[2], b1[2];
#pragma unroll
  for (int i = 0; i < 2; ++i) {
    a0[i] = *reinterpret_cast<const bf16x8*>(pa + i * 32 * 144);
    b0[i] = *reinterpret_cast<const bf16x8*>(pb + i * 32 * 144);
  }
#pragma unroll
  for (int s = 0; s < 4; s += 2) {
#pragma unroll
    for (int i = 0; i < 2; ++i) {
      a1[i] = *reinterpret_cast<const bf16x8*>(pa + i * 32 * 144 + (s + 1) * 32);
      b1[i] = *reinterpret_cast<const bf16x8*>(pb + i * 32 * 144 + (s + 1) * 32);
    }
    __builtin_amdgcn_s_setprio(1);
#pragma unroll
    for (int i = 0; i < 2; ++i)
#pragma unroll
      for (int j = 0; j < 2; ++j)
        acc[i][j] = __builtin_amdgcn_mfma_f32_32x32x16_bf16(a0[i], b0[j], acc[i][j], 0, 0, 0);
    __builtin_amdgcn_s_setprio(0);
    if (s + 2 < 4) {
#pragma unroll
      for (int i = 0; i < 2; ++i) {
        a0[i] = *reinterpret_cast<const bf16x8*>(pa + i * 32 * 144 + (s + 2) * 32);
        b0[i] = *reinterpret_cast<const bf16x8*>(pb + i * 32 * 144 + (s + 2) * 32);
      }
    }
    __builtin_amdgcn_s_setprio(1);
#pragma unroll
    for (int i = 0; i < 2; ++i)
#pragma unroll
      for (int j = 0; j < 2; ++j)
        acc[i][j] = __builtin_amdgcn_mfma_f32_32x32x16_bf16(a1[i], b1[j], acc[i][j], 0, 0, 0);
    __builtin_amdgcn_s_setprio(0);
  }
}
#define GEMM_KT(i, nk) ((((i) + ((int)(blockIdx.x >> 3))) & ((nk) - 1)) << 6)
__device__ __forceinline__ void gemm_prefetch(const u16* __restrict__ A, int lda, const u16* __restrict__ B, int ldb, int K, Tile4& ra, Tile4& rb) {
  const int nk = K >> 6;
  gemm_load_tile(A, lda, GEMM_KT(0, nk), ra);
  gemm_load_tile(B, ldb, GEMM_KT(0, nk), rb);
}
__device__ __forceinline__ void gemm_mainloop(const u16* __restrict__ A, int lda, const u16* __restrict__ B, int ldb,
                                              int K, f32x16 (&acc)[2][2], char* smem, Tile4& ra, Tile4& rb) {
  const int nk = K >> 6;
  __syncthreads();
  gemm_store_tile(smem, ra);
  gemm_store_tile(smem + 2 * ABUF, rb);
  __syncthreads();
#pragma unroll 1
  for (int kt = 0; kt < nk; ++kt) {
    const int cur = kt & 1;
    if (kt + 1 < nk) {
      gemm_load_tile(A, lda, GEMM_KT(kt + 1, nk), ra);
      gemm_load_tile(B, ldb, GEMM_KT(kt + 1, nk), rb);
    }
    mma_ktile(smem + cur * ABUF, smem + (2 + cur) * ABUF, acc);
    if (kt + 1 < nk) {
      gemm_store_tile(smem + (cur ^ 1) * ABUF, ra);
      gemm_store_tile(smem + (2 + (cur ^ 1)) * ABUF, rb);
    }
    __syncthreads();
  }
}
__device__ __forceinline__ void zero_acc(f32x16 (&acc)[2][2]) {
#pragma unroll
  for (int i = 0; i < 2; ++i)
#pragma unroll
    for (int j = 0; j < 2; ++j)
#pragma unroll
      for (int r = 0; r < 16; ++r) acc[i][j][r] = 0.f;
}
__device__ __forceinline__ void stage_acc(const f32x16 (&acc)[2][2], float* cs) {
  const int lane = threadIdx.x & 63, wid = threadIdx.x >> 6;
  const int wr = wid >> 1, wc = wid & 1;
#pragma unroll
  for (int i = 0; i < 2; ++i)
#pragma unroll
    for (int j = 0; j < 2; ++j)
#pragma unroll
      for (int r = 0; r < 16; ++r) {
        int row = wr * 64 + i * 32 + (r & 3) + 8 * (r >> 2) + 4 * (lane >> 5);
        int col = wc * 64 + j * 32 + (lane & 31);
        cs[row * CS_LD + col] = acc[i][j][r];
      }
}

__device__ __forceinline__ int win_srccol(int n) {
  if (n < 2116) return n;
  if (n < 2176) return -1;
  return n - 60;
}
__device__ void phase_prep(const Params& p, char* smem) {
  const int tid = threadIdx.x, lane = tid & 63, wid = tid >> 6;
  for (int rb = blockIdx.x; rb < T / 4; rb += gridDim.x) {
    int row = rb * 4 + wid;
    const float* xr = p.x + (size_t)row * DM;
    float4 v[4];
    float ss = 0.f;
#pragma unroll
    for (int i = 0; i < 4; ++i) {
      v[i] = *reinterpret_cast<const float4*>(xr + lane * 4 + 256 * i);
      ss += v[i].x * v[i].x + v[i].y * v[i].y + v[i].z * v[i].z + v[i].w * v[i].w;
    }
    ss = wave_sum(ss);
    float r = rsqrtf(ss * (1.f / DM) + EPS);
#pragma unroll
    for (int i = 0; i < 4; ++i) {
      float4 g = *reinterpret_cast<const float4*>(p.norm1_g + lane * 4 + 256 * i);
      uint2 o;
      o.x = pack_bf16(v[i].x * r * g.x, v[i].y * r * g.y);
      o.y = pack_bf16(v[i].z * r * g.z, v[i].w * r * g.w);
      *reinterpret_cast<uint2*>(p.xn + (size_t)row * DM + lane * 4 + 256 * i) = o;
    }
  }
  float* tile = reinterpret_cast<float*>(smem);
  constexpr int NT_TOTAL = 1056 + 128 + 128 + 256 + 512 + 8 + 8;
  for (int ti = blockIdx.x; ti < NT_TOTAL; ti += gridDim.x) {
    const float* src; const float* scale = nullptr; u16* dst; int ldsrc, K, nn, mode = 0; int t = ti;
    if (t < 1056) { src = p.w_in; ldsrc = 4164; K = 1024; nn = 66; dst = p.WinT; mode = 1; }
    else if ((t -= 1056) < 128) { src = p.w_a_out; ldsrc = 1024; K = 512; nn = 16; dst = p.WaT; }
    else if ((t -= 128) < 128) { src = p.w_b_out; ldsrc = 1024; K = 512; nn = 16; dst = p.WbT; }
    else if ((t -= 128) < 256) { src = p.w_o; ldsrc = 1024; K = 1024; nn = 16; dst = p.WoT; }
    else if ((t -= 256) < 512) { src = p.peer_wq; ldsrc = 2048; K = 1024; nn = 32; dst = p.WqT; scale = p.norm2_g; }
    else if ((t -= 512) < 8) { src = p.w_uk; ldsrc = 128; K = 256; nn = 2; dst = p.WkvT; scale = p.kv_norm_g; }
    else { t -= 8; src = p.w_uv; ldsrc = 128; K = 256; nn = 2; dst = p.WkvT + 128 * 256; scale = p.kv_norm_g; }
    int n0 = (t % nn) * 64, k0 = (t / nn) * 64;
    __syncthreads();
    {
      int n = tid & 63;
      int sc = (mode == 1) ? win_srccol(n0 + n) : (n0 + n);
      for (int kk = tid >> 6; kk < 64; kk += 4) {
        float v = 0.f;
        if (sc >= 0) v = src[(size_t)(k0 + kk) * ldsrc + sc];
        if (scale) v *= scale[k0 + kk];
        tile[kk * 65 + n] = v;
      }
    }
    __syncthreads();
    {
      int k = (tid & 31) * 2;
      for (int n = tid >> 5; n < 64; n += 8) {
        u32 o = pack_bf16(tile[k * 65 + n], tile[(k + 1) * 65 + n]);
        *reinterpret_cast<u32*>(dst + (size_t)(n0 + n) * K + k0 + k) = o;
      }
    }
  }
  constexpr int G_SUB = 262144 / 4, G_SW = 65536 / 4;
  constexpr int G_TOTAL = G_SUB + G_SW;
  for (int gi = blockIdx.x * NTHREADS + tid; gi < G_TOTAL; gi += gridDim.x * NTHREADS) {
    int g = gi;
    if (g < G_SUB) {
      float4 v = *reinterpret_cast<const float4*>(p.peer_subkeys + (size_t)g * 4);
      uint2 o = {pack_bf16(v.x, v.y), pack_bf16(v.z, v.w)};
      *reinterpret_cast<uint2*>(p.SubK + (size_t)g * 4) = o;
    } else {
      g -= G_SUB;
      float4 v = *reinterpret_cast<const float4*>(p.spatial_w + (size_t)g * 4);
      int e = g * 4; int s = e & 127, tt = (e >> 7) & 127;
      if (s > tt) v.x = 0.f;
      if (s + 1 > tt) v.y = 0.f;
      if (s + 2 > tt) v.z = 0.f;
      if (s + 3 > tt) v.w = 0.f;
      uint2 o = {pack_bf16(v.x, v.y), pack_bf16(v.z, v.w)};
      *reinterpret_cast<uint2*>(p.Wtril + (size_t)g * 4) = o;
    }
  }
  if (blockIdx.x == 0) {
    float* red = reinterpret_cast<float*>(smem);
    __syncthreads();
    float vq = 0.f, vk = 0.f, vn = 0.f;
    if (tid < 128) {
      vq = fabsf(p.q_norm_g[tid]); vk = fabsf(p.k_norm_g[tid]);
      float ss = 0.f;
      for (int k = 0; k < 256; ++k) { float w = p.w_uv[k * 128 + tid] * p.kv_norm_g[k]; ss += w * w; }
      vn = sqrtf(ss);
    }
    red[tid] = vq; red[256 + tid] = vk; red[512 + tid] = vn;
    __syncthreads();
    if (tid == 0) {
      float mq = 0.f, mk = 0.f, mn = 0.f;
      for (int k = 0; k < 128; ++k) { mq = fmaxf(mq, red[k]); mk = fmaxf(mk, red[256 + k]); mn = fmaxf(mn, red[512 + k]); }
      int eq = ilogbf(440.f / fmaxf(11.3137085f * mq, 1e-20f));
      int ek = ilogbf(440.f / fmaxf(11.3137085f * mk, 1e-20f));
      int ev = ilogbf(440.f / fmaxf(16.f * mn, 1e-20f));
      eq = eq > 40 ? 40 : (eq < -40 ? -40 : eq); ek = ek > 40 ? 40 : (ek < -40 ? -40 : ek); ev = ev > 40 ? 40 : (ev < -40 ? -40 : ev);
      p.scal[0] = ldexpf(1.f, eq); p.scal[1] = ldexpf(1.f, ek); p.scal[2] = ldexpf(1.f, ev);
      p.scal[3] = ldexpf(1.f, -eq - ek); p.scal[4] = ldexpf(1.f, -ev);
    }
    __syncthreads();
  }
  for (int gi = blockIdx.x * NTHREADS + tid; gi < T * 24; gi += gridDim.x * NTHREADS) {
    int t = gi / 24, j = gi - t * 24;
    float posf = (float)p.pos[t];
    float sn, cn;
    if (j < 16) { sincosf(posf * INV32[j], &sn, &cn); p.rtab[(size_t)t * 48 + j] = cn; p.rtab[(size_t)t * 48 + 16 + j] = sn; }
    else { int jj = j - 16; sincosf(posf * INV16[jj], &sn, &cn); p.rtab[(size_t)t * 48 + 32 + jj] = cn; p.rtab[(size_t)t * 48 + 40 + jj] = sn; }
  }
  for (int rb = blockIdx.x; rb < 8192; rb += gridDim.x) {
    int r = rb * 4 + wid;
    bool isu = r < 16384;
    int rr = isu ? r : r - 16384;
    const float* src = (isu ? p.peer_u : p.peer_v) + (size_t)rr * 1024 + lane * 16;
    float v[16];
#pragma unroll
    for (int i = 0; i < 4; ++i) {
      float4 q = *reinterpret_cast<const float4*>(src + 4 * i);
      v[4 * i] = q.x; v[4 * i + 1] = q.y; v[4 * i + 2] = q.z; v[4 * i + 3] = q.w;
    }
    if (isu) {
#pragma unroll
      for (int i = 0; i < 4; ++i) {
        float4 g = *reinterpret_cast<const float4*>(p.norm2_g + lane * 16 + 4 * i);
        v[4 * i] *= g.x; v[4 * i + 1] *= g.y; v[4 * i + 2] *= g.z; v[4 * i + 3] *= g.w;
      }
    }
    float amax = 0.f;
#pragma unroll
    for (int i = 0; i < 16; ++i) amax = fmaxf(amax, fabsf(v[i]));
#pragma unroll
    for (int m = 32; m >= 1; m >>= 1) amax = fmaxf(amax, __shfl_xor(amax, m));
    int ex = 0;
    if (amax > 0.f) ex = ilogbf(224.f / amax);
    ex = ex > 60 ? 60 : (ex < -60 ? -60 : ex);
    float sc = ldexpf(1.f, ex);
    u32 w[4];
#pragma unroll
    for (int i = 0; i < 4; ++i) {
      int t = __builtin_amdgcn_cvt_pk_fp8_f32(v[4 * i] * sc, v[4 * i + 1] * sc, 0, false);
      t = __builtin_amdgcn_cvt_pk_fp8_f32(v[4 * i + 2] * sc, v[4 * i + 3] * sc, t, true);
      w[i] = (u32)t;
    }
    uint4 o = {w[0], w[1], w[2], w[3]};
    *reinterpret_cast<uint4*>((isu ? p.U8 : p.V8) + (size_t)rr * 1024 + lane * 16) = o;
    if (lane == 0) (isu ? p.su : p.sv)[rr] = ldexpf(1.f, -ex);
  }
}

__device__ __forceinline__ void rope_pair(float& y0, float& y1, int lc, int half, int xm, float posf, const float* inv) {
  float p0 = __shfl_xor(y0, xm), p1 = __shfl_xor(y1, xm);
  if (lc < 2 * half) {
    int j = lc & (half - 1);
    float a0 = posf * inv[j], a1 = posf * inv[j + 1];
    float s0, c0, s1, c1;
    sincosf(a0, &s0, &c0);
    sincosf(a1, &s1, &c1);
    if (lc < half) { y0 = y0 * c0 - p0 * s0; y1 = y1 * c1 - p1 * s1; }
    else { y0 = y0 * c0 + p0 * s0; y1 = y1 * c1 + p1 * s1; }
  }
}

__device__ __forceinline__ bool tile_swizzle(int step, int ntn, int ntiles, int& mt, int& nt) {
  const int x = blockIdx.x & 7, slot = blockIdx.x >> 3;
  const int nslots = gridDim.x >> 3;
  const int lin = (step * 8 + x) * nslots + slot;
  if (lin >= ntiles) return false;
  const int per = ntn * 16;
  const int g = lin / per, rem = lin - g * per;
  nt = rem >> 4;
  mt = g * 16 + (rem & 15);
  return true;
}

__device__ void phase_gemm1(const Params& p, char* smem) {
  const int tid = threadIdx.x, lane = tid & 63, wid = tid >> 6;
  float* cs = reinterpret_cast<float*>(smem);
  constexpr int NTN = NWIN / 128;
  constexpr int NTILES = (T / 128) * NTN;
  int mt, nt;
  bool have = tile_swizzle(0, NTN, NTILES, mt, nt);
  Tile4 ra, rb;
  if (have) gemm_prefetch(p.xn + (size_t)mt * 128 * DM, DM, p.WinT + (size_t)nt * 128 * DM, DM, DM, ra, rb);
  for (int step = 0; have; ++step) {
    int m0 = mt * 128;
    f32x16 acc[2][2];
    zero_acc(acc);
    gemm_mainloop(p.xn + (size_t)m0 * DM, DM, p.WinT + (size_t)nt * 128 * DM, DM, DM, acc, smem, ra, rb);
    stage_acc(acc, cs);
    __syncthreads();
    int mt2 = 0, nt2 = 0;
    const bool nxt = tile_swizzle(step + 1, NTN, NTILES, mt2, nt2);
    if (nxt) gemm_prefetch(p.xn + (size_t)mt2 * 128 * DM, DM, p.WinT + (size_t)nt2 * 128 * DM, DM, DM, ra, rb);
    const int L = lane & 15, rsub = lane >> 4, c0 = L * 8;
#pragma unroll 1
    for (int it = 0; it < 8; ++it) {
      const int row = wid * 32 + it * 4 + rsub;
      const size_t t = (size_t)m0 + row;
      float v[8];
      load8(cs + row * CS_LD + c0, v);
      if (nt < 8) {
#pragma unroll
        for (int e = 0; e < 8; ++e) v[e] = gelu_f(v[e]);
        u16* dst = (nt < 4) ? (p.gu + t * 512 + nt * 128 + c0) : (p.gv + t * 512 + (nt - 4) * 128 + c0);
        *reinterpret_cast<uint4*>(dst) = pack8(v);
      } else if (nt < 12) {
        float ss = 0.f;
#pragma unroll
        for (int e = 0; e < 8; ++e) ss += v[e] * v[e];
        ss = sum16(ss);
        float r = rsqrtf(ss * (1.f / 128.f) + EPS);
        float g[8];
        load8(p.q_norm_g + c0, g);
#pragma unroll
        for (int e = 0; e < 8; ++e) v[e] = v[e] * r * g[e];
        rope32_8(v, L, p.rtab + t * 48);
        *reinterpret_cast<uint4*>(p.qh + t * 512 + (nt - 8) * 128 + c0) = pack8(v);
      } else if (nt < 14) {
        *reinterpret_cast<uint4*>(p.ckv + t * 256 + (nt - 12) * 128 + c0) = pack8(v);
      } else if (nt < 16) {
        rope16_8(v, c0 & 63, p.rtab + t * 48);
        *reinterpret_cast<uint4*>(p.qi + t * 256 + (nt - 14) * 128 + c0) = pack8(v);
      } else if (nt == 16) {
        rope16_8(v, c0 < 64 ? c0 : 64, p.rtab + t * 48);
        if (c0 < 64) *reinterpret_cast<uint4*>(p.ki + ((t >> 4) * 8 + L) * 128 + (t & 15) * 8) = pack8(v);
        else if (c0 == 64) *reinterpret_cast<float4*>(p.wi + t * 4) = make_float4(v[0] * 0.0625f, v[1] * 0.0625f, v[2] * 0.0625f, v[3] * 0.0625f);
      } else {
#pragma unroll
        for (int e = 0; e < 8; ++e) v[e] = sigmoid_f(v[e]);
        *reinterpret_cast<uint4*>(p.sg + t * 2048 + (nt - 17) * 128 + c0) = pack8(v);
      }
    }
    mt = mt2; nt = nt2; have = nxt;
  }
}

__device__ void unit_kv(const Params& p, char* smem, int mt) {
  const int tid = threadIdx.x, lane = tid & 63, wid = tid >> 6;
  float* cs = reinterpret_cast<float*>(smem);
  float* rr_s = reinterpret_cast<float*>(smem + EXTRA_OFF);
  const int m0 = mt * 128;
  __syncthreads();
  {
    int row = tid >> 1, half = tid & 1;
    const u16* src = p.ckv + (size_t)(m0 + row) * 256 + half * 128;
    float ss = 0.f;
#pragma unroll 4
    for (int i = 0; i < 16; ++i) {
      uint4 q = *reinterpret_cast<const uint4*>(src + i * 8);
      u32 w[4] = {q.x, q.y, q.z, q.w};
#pragma unroll
      for (int j = 0; j < 4; ++j) { float a = bf_lo(w[j]), b = bf_hi(w[j]); ss += a * a + b * b; }
    }
    ss += __shfl_xor(ss, 1);
    if (half == 0) rr_s[row] = rsqrtf(ss * (1.f / 256.f) + EPS);
  }
  Tile4 ra, rb;
  gemm_prefetch(p.ckv + (size_t)m0 * 256, 256, p.WkvT, 256, 256, ra, rb);
#pragma unroll 1
  for (int nt = 0; nt < 2; ++nt) {
    f32x16 acc[2][2];
    zero_acc(acc);
    gemm_mainloop(p.ckv + (size_t)m0 * 256, 256, p.WkvT + (size_t)nt * 128 * 256, 256, 256, acc, smem, ra, rb);
    stage_acc(acc, cs);
    __syncthreads();
    if (nt == 0) gemm_prefetch(p.ckv + (size_t)m0 * 256, 256, p.WkvT + (size_t)128 * 256, 256, 256, ra, rb);
    const int L = lane & 15, rsub = lane >> 4, c0 = L * 8;
#pragma unroll 1
    for (int it = 0; it < 8; ++it) {
      const int row = wid * 32 + it * 4 + rsub;
      const size_t t = (size_t)m0 + row;
      float v[8];
      load8(cs + row * CS_LD + c0, v);
      const float rs = rr_s[row];
#pragma unroll
      for (int e = 0; e < 8; ++e) v[e] *= rs;
      if (nt == 0) {
        float ss = 0.f;
#pragma unroll
        for (int e = 0; e < 8; ++e) ss += v[e] * v[e];
        ss = sum16(ss);
        float r = rsqrtf(ss * (1.f / 128.f) + EPS);
        float g[8];
        load8(p.k_norm_g + c0, g);
#pragma unroll
        for (int e = 0; e < 8; ++e) v[e] = v[e] * r * g[e];
        rope32_8(v, L, p.rtab + t * 48);
        {
          const float sk = p.scal[1];
          int w0 = __builtin_amdgcn_cvt_pk_fp8_f32(v[0] * sk, v[1] * sk, 0, false);
          w0 = __builtin_amdgcn_cvt_pk_fp8_f32(v[2] * sk, v[3] * sk, w0, true);
          int w1 = __builtin_amdgcn_cvt_pk_fp8_f32(v[4] * sk, v[5] * sk, 0, false);
          w1 = __builtin_amdgcn_cvt_pk_fp8_f32(v[6] * sk, v[7] * sk, w1, true);
          *reinterpret_cast<uint2*>(p.kv8 + t * 256 + c0) = make_uint2((u32)w0, (u32)w1);
        }
      } else {
        {
          const float sv8 = p.scal[2];
          int w0 = __builtin_amdgcn_cvt_pk_fp8_f32(v[0] * sv8, v[1] * sv8, 0, false);
          w0 = __builtin_amdgcn_cvt_pk_fp8_f32(v[2] * sv8, v[3] * sv8, w0, true);
          int w1 = __builtin_amdgcn_cvt_pk_fp8_f32(v[4] * sv8, v[5] * sv8, 0, false);
          w1 = __builtin_amdgcn_cvt_pk_fp8_f32(v[6] * sv8, v[7] * sv8, w1, true);
          *reinterpret_cast<uint2*>(p.kv8 + t * 256 + 128 + c0) = make_uint2((u32)w0, (u32)w1);
        }
      }
    }
    __syncthreads();
  }
}

__device__ void unit_spatial(const Params& p, char* smem, int unit) {
  const int tid = threadIdx.x, lane = tid & 63, wid = tid >> 6;
  const int chunk = unit >> 2, g = unit & 3;
  const int t0 = chunk * 128;
  float* cs = reinterpret_cast<float*>(smem);
  float* mu_s = reinterpret_cast<float*>(smem + EXTRA_OFF);
  float* rs_s = mu_s + 128;
  __syncthreads();
  {
    int row = tid >> 1, half = tid & 1;
    const u16* src = p.gv + (size_t)(t0 + row) * 512 + half * 256;
    float s = 0.f, ss = 0.f;
#pragma unroll 4
    for (int i = 0; i < 32; ++i) {
      uint4 q = *reinterpret_cast<const uint4*>(src + i * 8);
      u32 w[4] = {q.x, q.y, q.z, q.w};
#pragma unroll
      for (int j = 0; j < 4; ++j) { float a = bf_lo(w[j]), b = bf_hi(w[j]); s += a + b; ss += a * a + b * b; }
    }
    s += __shfl_xor(s, 1);
    ss += __shfl_xor(ss, 1);
    float mean = s * (1.f / 512.f);
    float var = fmaxf(ss * (1.f / 512.f) - mean * mean, 0.f);
    if (half == 0) { mu_s[row] = mean; rs_s[row] = rsqrtf(var + EPS); }
  }
  {
    const u16* wsrc = p.Wtril + (size_t)g * 128 * 128;
#pragma unroll
    for (int i = 0; i < 8; ++i) {
      int c = tid + 256 * i;
      int row = c >> 4, kc = c & 15;
      uint4 q = *reinterpret_cast<const uint4*>(wsrc + row * 128 + kc * 8);
      *reinterpret_cast<uint4*>(smem + (kc >> 3) * ABUF + row * 144 + (kc & 7) * 16) = q;
    }
  }
  __syncthreads();
  {
    int s = tid & 127;
    float mu = mu_s[s], rs = rs_s[s];
    const u16* src = p.gv + (size_t)(t0 + s) * 512 + g * 128;
    char* bbase = smem + (2 + (s >> 6)) * ABUF + (s & 63) * 2;
#pragma unroll
    for (int i = 0; i < 8; ++i) {
      int d0 = ((tid >> 7) + 2 * i) * 8;
      uint4 q = *reinterpret_cast<const uint4*>(src + d0);
      u32 w[4] = {q.x, q.y, q.z, q.w};
#pragma unroll
      for (int j = 0; j < 4; ++j) {
        int d = d0 + 2 * j;
        float a = (bf_lo(w[j]) - mu) * rs * p.v_norm_g[g * 128 + d] + p.v_norm_b[g * 128 + d];
        float b = (bf_hi(w[j]) - mu) * rs * p.v_norm_g[g * 128 + d + 1] + p.v_norm_b[g * 128 + d + 1];
        *reinterpret_cast<u16*>(bbase + d * 144) = f2bf(a);
        *reinterpret_cast<u16*>(bbase + (d + 1) * 144) = f2bf(b);
      }
    }
  }
  __syncthreads();
  f32x16 acc[2][2];
  zero_acc(acc);
  mma_ktile(smem, smem + 2 * ABUF, acc);
  mma_ktile(smem + ABUF, smem + 3 * ABUF, acc);
  __syncthreads();
  stage_acc(acc, cs);
  __syncthreads();
  const int L = lane & 15, rsub = lane >> 4, c0 = L * 8;
#pragma unroll 1
  for (int it = 0; it < 8; ++it) {
    const int row = wid * 32 + it * 4 + rsub;
    const size_t t = (size_t)t0 + row;
    float v[8], u[8];
    load8(cs + row * CS_LD + c0, v);
    const float b = p.spatial_b[g * 128 + row];
    unpack8(*reinterpret_cast<const uint4*>(p.gu + t * 512 + g * 128 + c0), u);
#pragma unroll
    for (int e = 0; e < 8; ++e) v[e] = u[e] * (v[e] + b);
    *reinterpret_cast<uint4*>(p.ya + t * 512 + g * 128 + c0) = pack8(v);
  }
}

__device__ __forceinline__ void radix_partition(const u32 (&key)[12], int n, int rank, int slack, u32& lo, u32& hi, int& limit) {
  u32 vor = 0u, vand = 0xFFFFFFFFu;
#pragma unroll
  for (int k = 0; k < 12; ++k) { vor |= key[k]; vand &= (key[k] != 0u) ? key[k] : 0xFFFFFFFFu; }
#define DPPU(v, ctrl) ((u32)__builtin_amdgcn_update_dpp(0, (int)(v), (ctrl), 0xF, 0xF, true))
  vor |= DPPU(vor, 0xB1); vor |= DPPU(vor, 0x4E); vor |= DPPU(vor, 0x141); vor |= DPPU(vor, 0x140);
  vand &= DPPU(vand, 0xB1); vand &= DPPU(vand, 0x4E); vand &= DPPU(vand, 0x141); vand &= DPPU(vand, 0x140);
  vor = (u32)(__builtin_amdgcn_readlane((int)vor, 0) | __builtin_amdgcn_readlane((int)vor, 16) |
              __builtin_amdgcn_readlane((int)vor, 32) | __builtin_amdgcn_readlane((int)vor, 48));
  vand = (u32)(__builtin_amdgcn_readlane((int)vand, 0) & __builtin_amdgcn_readlane((int)vand, 16) &
               __builtin_amdgcn_readlane((int)vand, 32) & __builtin_amdgcn_readlane((int)vand, 48));
#undef DPPU
  const u32 diff = vor ^ vand;
  int b = diff ? (31 - __clz(diff)) : -1;
  u32 prefix = (b >= 31) ? 0u : (vand & ~((2u << b) - 1u));
  if (b < 0) prefix = vand;
  int krem = rank, ncand = n;
  while (b >= 0 && ncand - krem > slack) {
    u32 cand = prefix | (1u << b);
    u32 himask = ~((1u << b) - 1u);
    int c = 0;
#pragma unroll
    for (int k = 0; k < 12; ++k) c += __popcll(__ballot((key[k] & himask) == cand));
    if (c >= krem) { prefix = cand; ncand = c; } else { krem -= c; ncand -= c; }
    --b;
  }
  lo = prefix;
  hi = (b >= 0) ? (prefix | ((2u << b) - 1u)) : prefix;
  limit = (ncand - krem <= slack) ? ncand : krem;
}

__device__ __forceinline__ void idx_load_keys(const Params& p, int tb, int jc, int kcol, int lane, bf16x8 (&bf)[4][2]) {
  const u16* kb = p.ki + ((size_t)((tb + jc) >> 4) * 8 + (lane >> 4)) * 128 + kcol * 8;
#pragma unroll
  for (int u = 0; u < 4; ++u) {
    bf[u][0] = *reinterpret_cast<const bf16x8*>(kb + u * 1024);
    bf[u][1] = *reinterpret_cast<const bf16x8*>(kb + u * 1024 + 512);
  }
}
__device__ __forceinline__ void idx_compact(u32* cv, u16* ci, int n, int lane, int& newcnt, float& newthr) {
  u32 key[12]; u16 idx[12];
#pragma unroll
  for (int k = 0; k < 12; ++k) {
    int e = lane + 64 * k;
    bool in = e < n;
    key[k] = in ? sortable(cv[e]) : 0u;
    idx[k] = in ? ci[e] : (u16)0;
  }
  u32 lo, hi; int limit;
  radix_partition(key, n, 256, 64, lo, hi, limit);
  int base = 0, tcnt = 0;
#pragma unroll
  for (int k = 0; k < 12; ++k) {
    bool eq = key[k] >= lo && key[k] <= hi;
    unsigned long long meq = __ballot(eq);
    bool keep = (key[k] > hi) || (eq && (tcnt + mbcnt64(meq)) < limit);
    unsigned long long m = __ballot(keep);
    int pos = base + mbcnt64(m);
    if (keep) { cv[pos] = unsortable(key[k]); ci[pos] = idx[k]; }
    base += __popcll(m);
    tcnt += __popcll(meq);
  }
  newcnt = base;
  newthr = (lo <= 0x007FFFFFu) ? -INFINITY : __uint_as_float(unsortable(lo));
}

__device__ void unit_indexer(const Params& p, char* smem, int unit) {
  const int tid = threadIdx.x, lane = tid & 63, wid = tid >> 6;
  const int b = unit >> 10, grp = unit & 1023;
  const int tb = b * SEQ, i0 = grp * 16;
  u32* cval = reinterpret_cast<u32*>(smem);
  u16* cidx = reinterpret_cast<u16*>(smem + 16 * CAP * 4);
  __syncthreads();
  const int qsub = lane >> 4;
  const int ql = wid * 4 + qsub;
  const int iq = i0 + ql;
  const int kcol = lane & 15;
  bf16x8 afr[2];
  {
    const u16* qa = p.qi + ((size_t)(tb + i0 + wid * 4 + (kcol >> 2)) * 4 + (kcol & 3)) * 64 + 8 * (lane >> 4);
    afr[0] = *reinterpret_cast<const bf16x8*>(qa);
    afr[1] = *reinterpret_cast<const bf16x8*>(qa + 32);
  }
  const float4 w4 = *reinterpret_cast<const float4*>(p.wi + (size_t)(tb + iq) * 4);
  float thr = -INFINITY;
  const int kmul = 64;
  int cntr = 0;
  u32* myval = cval + ql * CAP;
  u16* myidx = cidx + ql * CAP;
  const u32 lowmask = (1u << kcol) - 1u;
  const int nchunks = (grp + 1 + 3) >> 2;

  auto process = [&](const bf16x8 (&bf)[4][2], int jc) {
    f32x4 acc[4];
#pragma unroll
    for (int u = 0; u < 4; ++u) {
      f32x4 z = {0.f, 0.f, 0.f, 0.f};
      acc[u] = __builtin_amdgcn_mfma_f32_16x16x32_bf16(afr[0], bf[u][0], z, 0, 0, 0);
    }
#pragma unroll
    for (int u = 0; u < 4; ++u) acc[u] = __builtin_amdgcn_mfma_f32_16x16x32_bf16(afr[1], bf[u][1], acc[u], 0, 0, 0);
    float sc[4];
    bool ps[4];
    bool anyp = false;
#pragma unroll
    for (int u = 0; u < 4; ++u) {
      float r0 = __builtin_amdgcn_fmed3f(acc[u][0], 0.f, INFINITY), r1 = __builtin_amdgcn_fmed3f(acc[u][1], 0.f, INFINITY);
      float r2 = __builtin_amdgcn_fmed3f(acc[u][2], 0.f, INFINITY), r3 = __builtin_amdgcn_fmed3f(acc[u][3], 0.f, INFINITY);
      float s = (w4.x * r0 + w4.y * r1) + (w4.z * r2 + w4.w * r3);
      s += 0.0f;
      sc[u] = s;
      ps[u] = ((jc + 16 * u + kcol) <= iq) && (s > thr);
      anyp |= ps[u];
    }
    if (__ballot(anyp)) {
#pragma unroll
      for (int u = 0; u < 4; ++u) {
        unsigned long long m = __ballot(ps[u]);
        u32 g16 = (u32)(m >> (16 * qsub)) & 0xFFFFu;
        int slot = cntr + __popc(g16 & lowmask);
        if (ps[u] && slot < CAP) { myval[slot] = __float_as_uint(sc[u]); myidx[slot] = (u16)(jc + 16 * u + kcol); }
        cntr += __popc(g16);
      }
      unsigned long long need = __ballot(cntr > CAP - 64);
      while (need) {
        int l = __ffsll((long long)need) - 1;
        int qc = l >> 4;
        need &= ~(0xFFFFull << (qc * 16));
        int qlc = wid * 4 + qc;
        int n = __builtin_amdgcn_readlane(cntr, qc * 16);
        if (n > CAP) n = CAP;
        int nc; float nt;
        idx_compact(cval + qlc * CAP, cidx + qlc * CAP, n, lane, nc, nt);
        if (qsub == qc) { thr = nt; cntr = nc; }
      }
    }
  };

  bf16x8 bA[4][2], bB[4][2];
  const int lastc = nchunks - 1;
  idx_load_keys(p, tb, 0, kcol, lane, bA);
  for (int ch = 0; ch < nchunks; ch += 2) {
    idx_load_keys(p, tb, min(ch + 1, lastc) * kmul, kcol, lane, bB);
    process(bA, ch * 64);
    idx_load_keys(p, tb, min(ch + 2, lastc) * kmul, kcol, lane, bA);
    if (ch + 1 < nchunks) process(bB, (ch + 1) * 64);
  }
  for (int qc = 0; qc < 4; ++qc) {
    int qlc = wid * 4 + qc;
    int n = __builtin_amdgcn_readlane(cntr, qc * 16);
    if (n > CAP) n = CAP;
    u32* cv = cval + qlc * CAP; u16* ci = cidx + qlc * CAP;
    u16* out = p.sel + (size_t)(tb + i0 + qlc) * 256;
    if (n <= 256) {
#pragma unroll
      for (int k = 0; k < 4; ++k) {
        int e = lane + 64 * k;
        out[e] = (e < n) ? ci[e] : (u16)0xFFFF;
      }
    } else {
      u32 key[12]; u16 idx[12];
#pragma unroll
      for (int k = 0; k < 12; ++k) {
        int e = lane + 64 * k;
        bool in = e < n;
        key[k] = in ? sortable(cv[e]) : 0u;
        idx[k] = in ? ci[e] : (u16)0;
      }
      u32 lo, hi; int limit;
      radix_partition(key, n, 256, 0, lo, hi, limit);
      int base = 0, tcnt = 0;
#pragma unroll
      for (int k = 0; k < 12; ++k) {
        bool eq = key[k] >= lo && key[k] <= hi;
        unsigned long long meq = __ballot(eq);
        bool keep = (key[k] > hi) || (eq && (tcnt + mbcnt64(meq)) < limit);
        unsigned long long m = __ballot(keep);
        int pos = base + mbcnt64(m);
        if (keep && pos < 256) ci[pos] = idx[k];
        base += __popcll(m);
        tcnt += __popcll(meq);
      }
      __builtin_amdgcn_wave_barrier();
      *reinterpret_cast<uint2*>(out + lane * 4) = *reinterpret_cast<const uint2*>(ci + lane * 4);
      __builtin_amdgcn_wave_barrier();
    }
  }
}

__device__ void phase_attn(const Params& p, char* smem) {
  const int tid = threadIdx.x, lane = tid & 63, wid = tid >> 6;
  constexpr int WSTRIDE = 13312;
  u16* lidx = reinterpret_cast<u16*>(smem + wid * WSTRIDE);
  float* Pt = reinterpret_cast<float*>(smem + wid * WSTRIDE + 512);
  char* tile = smem + wid * WSTRIDE + 1024;
  const float sq = p.scal[0];
  const float lf = 0.08838834764831845f * 1.4426950408889634f * p.scal[3];
  const float ovs = p.scal[4];
  const int xq = blockIdx.x & 7;
  const int b = xq & 1;
  const int rblk = (blockIdx.x >> 3) * 4 + (xq >> 1);
  const int nrb = (gridDim.x >> 3) * 4;
  const int n16 = lane & 15, g4 = lane >> 4;
  for (int i = rblk * 4 + wid; i < SEQ; i += nrb * 4) {
    const int tq = b * SEQ + i;
    const size_t tb = (size_t)b * SEQ;
    __builtin_amdgcn_wave_barrier();
    {
      uint2 v = *reinterpret_cast<const uint2*>(p.sel + (size_t)tq * 256 + lane * 4);
      *reinterpret_cast<uint2*>(lidx + lane * 4) = v;
    }
    __builtin_amdgcn_wave_barrier();
    long qf[4];
#pragma unroll
    for (int s = 0; s < 4; ++s) {
      qf[s] = 0;
      if (n16 < 4) {
        float qv[8];
        unpack8(*reinterpret_cast<const uint4*>(p.qh + (size_t)tq * 512 + n16 * 128 + 32 * s + 8 * g4), qv);
        int w0 = __builtin_amdgcn_cvt_pk_fp8_f32(qv[0] * sq, qv[1] * sq, 0, false);
        w0 = __builtin_amdgcn_cvt_pk_fp8_f32(qv[2] * sq, qv[3] * sq, w0, true);
        int w1 = __builtin_amdgcn_cvt_pk_fp8_f32(qv[4] * sq, qv[5] * sq, 0, false);
        w1 = __builtin_amdgcn_cvt_pk_fp8_f32(qv[6] * sq, qv[7] * sq, w1, true);
        qf[s] = (long)(((unsigned long long)(u32)w1 << 32) | (unsigned long long)(u32)w0);
      }
    }
    float mrun[4] = {-1e30f, -1e30f, -1e30f, -1e30f}, lrun[4] = {0.f, 0.f, 0.f, 0.f};
    float2_t o2[4][4];
#pragma unroll
    for (int h = 0; h < 4; ++h)
#pragma unroll
      for (int j = 0; j < 4; ++j) { o2[h][j].x = 0.f; o2[h][j].y = 0.f; }
    u32x4 kr[8];
#pragma unroll
    for (int r = 0; r < 8; ++r) {
      int id = lidx[r * 4 + g4];
      int idc = (id <= i) ? id : 0;
      kr[r] = *reinterpret_cast<const u32x4*>(p.kv8 + (tb + idc) * 256 + n16 * 16);
    }
#pragma unroll 1
    for (int g2 = 0; g2 < 8; ++g2) {
      __builtin_amdgcn_wave_barrier();
#pragma unroll
      for (int r = 0; r < 8; ++r) *reinterpret_cast<u32x4*>(tile + (r * 4 + g4) * 272 + n16 * 16) = kr[r];
      __builtin_amdgcn_wave_barrier();
      {
        const int gn = (g2 < 7) ? g2 + 1 : 7;
#pragma unroll
        for (int r = 0; r < 8; ++r) {
          int id = lidx[gn * 32 + r * 4 + g4];
          int idc = (id <= i) ? id : 0;
          kr[r] = *reinterpret_cast<const u32x4*>(p.kv8 + (tb + idc) * 256 + n16 * 16);
        }
      }
      float sc[2][4];
#pragma unroll
      for (int tt = 0; tt < 2; ++tt) {
        int id = lidx[g2 * 32 + tt * 16 + n16];
        bool valid = id <= i;
        f32x4 acc = {0.f, 0.f, 0.f, 0.f};
#pragma unroll
        for (int s = 0; s < 4; ++s) {
          long kf = *reinterpret_cast<const long*>(tile + (tt * 16 + n16) * 272 + 32 * s + 8 * g4);
          acc = __builtin_amdgcn_mfma_f32_16x16x32_fp8_fp8(qf[s], kf, acc, 0, 0, 0);
        }
#pragma unroll
        for (int h = 0; h < 4; ++h) sc[tt][h] = valid ? acc[h] * lf : -1e30f;
      }
      float alpha[4], pp[2][4];
#pragma unroll
      for (int h = 0; h < 4; ++h) {
        float mg = max16(fmaxf(sc[0][h], sc[1][h]));
        float mnew = fmaxf(mrun[h], __int_as_float(__builtin_amdgcn_readfirstlane(__float_as_int(mg))));
        alpha[h] = __builtin_amdgcn_exp2f(mrun[h] - mnew);
        mrun[h] = mnew;
        pp[0][h] = __builtin_amdgcn_exp2f(sc[0][h] - mnew);
        pp[1][h] = __builtin_amdgcn_exp2f(sc[1][h] - mnew);
        float ls = sum16(pp[0][h] + pp[1][h]);
        lrun[h] = lrun[h] * alpha[h] + __int_as_float(__builtin_amdgcn_readfirstlane(__float_as_int(ls)));
      }
      if (lane < 16) {
        *reinterpret_cast<float4*>(Pt + lane * 4) = make_float4(pp[0][0], pp[0][1], pp[0][2], pp[0][3]);
        *reinterpret_cast<float4*>(Pt + (16 + lane) * 4) = make_float4(pp[1][0], pp[1][1], pp[1][2], pp[1][3]);
      }
#pragma unroll
      for (int h = 0; h < 4; ++h) {
        float2_t a2 = {alpha[h], alpha[h]};
#pragma unroll
        for (int j = 0; j < 4; ++j) o2[h][j] *= a2;
      }
      __builtin_amdgcn_wave_barrier();
#pragma unroll
      for (int it = 0; it < 8; ++it) {
        const int nk = it * 4 + g4;
        float4 pw = *reinterpret_cast<const float4*>(Pt + nk * 4);
        uint2 q = *reinterpret_cast<const uint2*>(tile + nk * 272 + 128 + n16 * 8);
        float2_t v2[4] = {__builtin_amdgcn_cvt_pk_f32_fp8((int)q.x, false), __builtin_amdgcn_cvt_pk_f32_fp8((int)q.x, true),
                          __builtin_amdgcn_cvt_pk_f32_fp8((int)q.y, false), __builtin_amdgcn_cvt_pk_f32_fp8((int)q.y, true)};
        float pv[4] = {pw.x, pw.y, pw.z, pw.w};
#pragma unroll
        for (int h = 0; h < 4; ++h) {
          float2_t ph = {pv[h], pv[h]};
#pragma unroll
          for (int j = 0; j < 4; ++j) o2[h][j] += ph * v2[j];
        }
      }
      __builtin_amdgcn_wave_barrier();
    }
#pragma unroll
    for (int h = 0; h < 4; ++h) {
      float inv = ovs * __builtin_amdgcn_rcpf(lrun[h]);
      float ov[8];
#pragma unroll
      for (int j = 0; j < 4; ++j) {
        float x0 = o2[h][j].x, x1 = o2[h][j].y;
        x0 += __shfl_xor(x0, 16); x0 += __shfl_xor(x0, 32);
        x1 += __shfl_xor(x1, 16); x1 += __shfl_xor(x1, 32);
        ov[2 * j] = x0 * inv; ov[2 * j + 1] = x1 * inv;
      }
      if (g4 == 0) *reinterpret_cast<uint4*>(p.yb + (size_t)tq * 512 + h * 128 + n16 * 8) = pack8(ov);
    }
  }
}

__device__ void phase_merge(const Params& p, char* smem) {
  const int tid = threadIdx.x, lane = tid & 63, wid = tid >> 6;
  float* cs = reinterpret_cast<float*>(smem);
  constexpr int NTILES = (T / 128) * 8;
  int mt, nt;
  bool have = tile_swizzle(0, 8, NTILES, mt, nt);
  Tile4 ra, rb;
  if (have) gemm_prefetch(p.ya + (size_t)mt * 128 * 512, 512, p.WaT + (size_t)nt * 128 * 512, 512, 512, ra, rb);
  for (int step = 0; have; ++step) {
    int m0 = mt * 128, n0 = nt * 128;
    f32x16 acc[2][2];
    zero_acc(acc);
    gemm_mainloop(p.ya + (size_t)m0 * 512, 512, p.WaT + (size_t)n0 * 512, 512, 512, acc, smem, ra, rb);
    stage_acc(acc, cs);
    __syncthreads();
    gemm_prefetch(p.yb + (size_t)m0 * 512, 512, p.WbT + (size_t)n0 * 512, 512, 512, ra, rb);
#pragma unroll 2
    for (int it = 0; it < 8; ++it) {
      const int row = wid * 32 + it * 4 + (lane >> 4), c0 = (lane & 15) * 8;
      float v[8], g[8];
      load8(cs + row * CS_LD + c0, v);
      unpack8(*reinterpret_cast<const uint4*>(p.sg + (size_t)(m0 + row) * 2048 + n0 + c0), g);
#pragma unroll
      for (int e = 0; e < 8; ++e) v[e] *= g[e];
      *reinterpret_cast<uint4*>(p.merged + (size_t)(m0 + row) * 1024 + n0 + c0) = pack8(v);
    }
    __syncthreads();
    zero_acc(acc);
    gemm_mainloop(p.yb + (size_t)m0 * 512, 512, p.WbT + (size_t)n0 * 512, 512, 512, acc, smem, ra, rb);
    stage_acc(acc, cs);
    __syncthreads();
    int mt2 = 0, nt2 = 0;
    const bool nxt = tile_swizzle(step + 1, 8, NTILES, mt2, nt2);
    if (nxt) gemm_prefetch(p.ya + (size_t)mt2 * 128 * 512, 512, p.WaT + (size_t)nt2 * 128 * 512, 512, 512, ra, rb);
#pragma unroll 2
    for (int it = 0; it < 8; ++it) {
      const int row = wid * 32 + it * 4 + (lane >> 4), c0 = (lane & 15) * 8;
      float v[8], g[8], pa[8];
      load8(cs + row * CS_LD + c0, v);
      unpack8(*reinterpret_cast<const uint4*>(p.sg + (size_t)(m0 + row) * 2048 + 1024 + n0 + c0), g);
      uint4* mp = reinterpret_cast<uint4*>(p.merged + (size_t)(m0 + row) * 1024 + n0 + c0);
      unpack8(*mp, pa);
#pragma unroll
      for (int e = 0; e < 8; ++e) v[e] = pa[e] + v[e] * g[e];
      *mp = pack8(v);
    }
    mt = mt2; nt = nt2; have = nxt;
  }
}

__device__ void phase_wo(const Params& p, char* smem) {
  const int tid = threadIdx.x, lane = tid & 63, wid = tid >> 6;
  float* cs = reinterpret_cast<float*>(smem);
  constexpr int NTILES = (T / 128) * 8;
  int mt, nt;
  bool have = tile_swizzle(0, 8, NTILES, mt, nt);
  Tile4 ra, rb;
  if (have) gemm_prefetch(p.merged + (size_t)mt * 128 * 1024, 1024, p.WoT + (size_t)nt * 128 * 1024, 1024, 1024, ra, rb);
  for (int step = 0; have; ++step) {
    int m0 = mt * 128, n0 = nt * 128;
    f32x16 acc[2][2];
    zero_acc(acc);
    gemm_mainloop(p.merged + (size_t)m0 * 1024, 1024, p.WoT + (size_t)n0 * 1024, 1024, 1024, acc, smem, ra, rb);
    stage_acc(acc, cs);
    __syncthreads();
    int mt2 = 0, nt2 = 0;
    const bool nxt = tile_swizzle(step + 1, 8, NTILES, mt2, nt2);
    if (nxt) gemm_prefetch(p.merged + (size_t)mt2 * 128 * 1024, 1024, p.WoT + (size_t)nt2 * 128 * 1024, 1024, 1024, ra, rb);
#pragma unroll 2
    for (int it = 0; it < 8; ++it) {
      const int row = wid * 32 + it * 4 + (lane >> 4), c0 = (lane & 15) * 8;
      const size_t t = (size_t)m0 + row;
      float v[8], xv[8];
      load8(cs + row * CS_LD + c0, v);
      load8(p.x + t * 1024 + n0 + c0, xv);
      float ss = 0.f;
#pragma unroll
      for (int e = 0; e < 8; ++e) { v[e] += xv[e]; ss += v[e] * v[e]; }
      *reinterpret_cast<uint4*>(p.h1b + t * 1024 + n0 + c0) = pack8(v);
      ss = sum16(ss);
      if ((lane & 15) == 0) p.ssq[(size_t)nt * T + t] = ss;
    }
    mt = mt2; nt = nt2; have = nxt;
  }
}

__device__ __forceinline__ void ins16(float (&l)[16], float v) {
#pragma unroll
  for (int q = 15; q >= 1; --q) l[q] = __builtin_amdgcn_fmed3f(v, l[q - 1], l[q]);
  l[0] = fmaxf(l[0], v);
}
__device__ void phase_peerq(const Params& p, char* smem) {
  const int tid = threadIdx.x, lane = tid & 63, wid = tid >> 6;
  const int wr = wid >> 1, wc = wid & 1;
  float* cs = reinterpret_cast<float*>(smem);
  constexpr int NTILES = (T / 128) * 16;
  int mt, hp;
  bool have = tile_swizzle(0, 16, NTILES, mt, hp);
  Tile4 ra, rb;
  if (have) gemm_prefetch(p.h1b + (size_t)mt * 128 * 1024, 1024, p.WqT + (size_t)hp * 128 * 1024, 1024, 1024, ra, rb);
  for (int step = 0; have; ++step) {
    int m0 = mt * 128;
    f32x16 acc[2][2];
    zero_acc(acc);
    gemm_mainloop(p.h1b + (size_t)m0 * 1024, 1024, p.WqT + (size_t)hp * 128 * 1024, 1024, 1024, acc, smem, ra, rb);
#pragma unroll
    for (int i = 0; i < 2; ++i)
#pragma unroll
      for (int j = 0; j < 2; ++j)
#pragma unroll
        for (int r = 0; r < 16; ++r) {
          int row = wr * 64 + i * 32 + (r & 3) + 8 * (r >> 2) + 4 * (lane >> 5);
          int col = wc * 64 + j * 32 + (lane & 31);
          *reinterpret_cast<u16*>(smem + (col >> 6) * ABUF + row * 144 + (col & 63) * 2) = f2bf(acc[i][j][r]);
        }
    {
      const u16* sk = p.SubK + (size_t)hp * 128 * 128;
#pragma unroll
      for (int i = 0; i < 8; ++i) {
        int c = tid + 256 * i;
        int row = c >> 4, kc = c & 15;
        uint4 q = *reinterpret_cast<const uint4*>(sk + row * 128 + kc * 8);
        *reinterpret_cast<uint4*>(smem + (2 + (kc >> 3)) * ABUF + row * 144 + (kc & 7) * 16) = q;
      }
    }
    __syncthreads();
    zero_acc(acc);
    mma_ktile(smem, smem + 2 * ABUF, acc);
    mma_ktile(smem + ABUF, smem + 3 * ABUF, acc);
    __syncthreads();
    stage_acc(acc, cs);
    __syncthreads();
    int mt2 = 0, hp2 = 0;
    const bool nxt = tile_swizzle(step + 1, 16, NTILES, mt2, hp2);
    if (nxt) gemm_prefetch(p.h1b + (size_t)mt2 * 128 * 1024, 1024, p.WqT + (size_t)hp2 * 128 * 1024, 1024, 1024, ra, rb);
    {
      int row = tid >> 1, half = tid & 1;
      float* rp = cs + row * CS_LD + half * 64;
      float l[16];
#pragma unroll
      for (int q = 0; q < 16; ++q) l[q] = -INFINITY;
      for (int c = 0; c < 64; c += 4) {
        float4 v4 = *reinterpret_cast<const float4*>(rp + c);
        float vv[4] = {v4.x, v4.y, v4.z, v4.w};
#pragma unroll
        for (int e = 0; e < 4; ++e) {
          u32 bits = __float_as_uint(vv[e]);
          u32 n = (u32)(half * 64 + c + e);
          bits = (bits & ~127u) | ((bits >> 31) ? n : (127u - n));
          ins16(l, __uint_as_float(bits));
        }
      }
#pragma unroll
      for (int q = 0; q < 16; ++q) rp[q] = l[q];
    }
    __syncthreads();
    if (tid < 128) {
      int row = tid;
      size_t t = (size_t)m0 + row;
      const float* la = cs + row * CS_LD;
      const float* lb = la + 64;
      float ssum = 0.f;
#pragma unroll
      for (int q = 0; q < 8; ++q) ssum += p.ssq[(size_t)q * T + t];
      float rt = rsqrtf(ssum * (1.f / 1024.f) + EPS);
      int ia = 0, ib = 0;
      float* ov = p.stv + ((size_t)hp * T + t) * 16;
      u8* oi = p.sti + ((size_t)hp * T + t) * 16;
      float ovv[16]; u32 oii[4] = {0u, 0u, 0u, 0u};
#pragma unroll
      for (int q = 0; q < 16; ++q) {
        float va = la[ia], vb = lb[ib];
        bool ta = va >= vb;
        float v = ta ? va : vb;
        ia += ta ? 1 : 0;
        ib += ta ? 0 : 1;
        u32 bits = __float_as_uint(v);
        u32 low = bits & 127u;
        u32 n = (bits >> 31) ? low : (127u - low);
        ovv[q] = __uint_as_float(bits & ~127u) * rt;
        oii[q >> 2] |= n << (8 * (q & 3));
      }
#pragma unroll
      for (int q = 0; q < 4; ++q) *reinterpret_cast<float4*>(ov + 4 * q) = make_float4(ovv[4 * q], ovv[4 * q + 1], ovv[4 * q + 2], ovv[4 * q + 3]);
      *reinterpret_cast<uint4*>(oi) = make_uint4(oii[0], oii[1], oii[2], oii[3]);
    }
    mt = mt2; hp = hp2; have = nxt;
  }
}

__device__ void phase_peer(const Params& p, char* smem) {
  const int tid = threadIdx.x, lane = tid & 63, wid = tid >> 6;
  int* pe_e = reinterpret_cast<int*>(smem + wid * 4096);
  float* pe_su = reinterpret_cast<float*>(smem + wid * 4096 + 512);
  float* pe_gv = reinterpret_cast<float*>(smem + wid * 4096 + 1024);
  float* svl = reinterpret_cast<float*>(smem + wid * 4096 + 1536);
  u8* sil = reinterpret_cast<u8*>(smem + wid * 4096 + 2560);
  const int h = lane >> 3, g = lane & 7;
  u32 prt[7];
#pragma unroll
  for (int c = 0; c < 7; ++c) prt[c] = PAIR_TAB[g * 7 + c];
  float4 nsv = make_float4(0.f, 0.f, 0.f, 0.f); uint4 nsi = make_uint4(0u, 0u, 0u, 0u);
  {
    int tq0 = blockIdx.x * 4 + wid;
    if (tq0 < T) {
      nsv = *reinterpret_cast<const float4*>(p.stv + ((size_t)(lane >> 2) * T + tq0) * 16 + (lane & 3) * 4);
      if (lane < 16) nsi = *reinterpret_cast<const uint4*>(p.sti + ((size_t)lane * T + tq0) * 16);
    }
  }
  for (int tq = blockIdx.x * 4 + wid; tq < T; tq += gridDim.x * 4) {
    const size_t t = tq;
    __builtin_amdgcn_wave_barrier();
    *reinterpret_cast<float4*>(svl + lane * 4) = nsv;
    if (lane < 16) *reinterpret_cast<uint4*>(sil + lane * 16) = nsi;
    __builtin_amdgcn_wave_barrier();
    {
      int tqn = tq + gridDim.x * 4;
      if (tqn < T) {
        nsv = *reinterpret_cast<const float4*>(p.stv + ((size_t)(lane >> 2) * T + tqn) * 16 + (lane & 3) * 4);
        if (lane < 16) nsi = *reinterpret_cast<const uint4*>(p.sti + ((size_t)lane * T + tqn) * 16);
      }
    }
    const float* s1 = svl + (2 * h) * 16;
    const float* s2 = s1 + 16;
    float l[16];
#pragma unroll
    for (int q = 0; q < 16; ++q) l[q] = -INFINITY;
#pragma unroll
    for (int c = 0; c < 7; ++c) {
      u32 pr = prt[c];
      float v = -INFINITY;
      if (pr != 0xffu) {
        float a = s1[pr >> 4] + s2[pr & 15];
        u32 bits = __float_as_uint(a);
        bits = (bits & ~255u) | ((bits >> 31) ? pr : (255u - pr));
        v = __uint_as_float(bits);
      }
      ins16(l, v);
    }
#pragma unroll
    for (int msk = 1; msk <= 4; msk <<= 1) {
      float c[16];
#pragma unroll
      for (int q = 0; q < 16; ++q) c[q] = __shfl_xor(l[15 - q], msk);
#pragma unroll
      for (int q = 0; q < 16; ++q) c[q] = fmaxf(l[q], c[q]);
#pragma unroll
      for (int st = 8; st >= 1; st >>= 1)
#pragma unroll
        for (int q = 0; q < 16; ++q)
          if ((q & st) == 0) {
            float hi = fmaxf(c[q], c[q + st]), lo = fminf(c[q], c[q + st]);
            c[q] = hi; c[q + st] = lo;
          }
#pragma unroll
      for (int q = 0; q < 16; ++q) l[q] = c[q];
    }
    {
      float m = -INFINITY, ssum = 0.f;
      float bvv[16];
#pragma unroll
      for (int q = 0; q < 16; ++q) {
        u32 bits = __float_as_uint(l[q]);
        u32 low = bits & 255u;
        int prq = (int)((bits >> 31) ? low : (255u - low));
        bvv[q] = s1[prq >> 4] + s2[prq & 15];
        m = fmaxf(m, bvv[q]);
      }
#pragma unroll
      for (int q = 0; q < 16; ++q) { bvv[q] = __expf(bvv[q] - m); ssum += bvv[q]; }
      float inv = 1.f / ssum;
      const u8* i1 = sil + (2 * h) * 16;
      const u8* i2 = i1 + 16;
#pragma unroll
      for (int q = 0; q < 16; ++q) {
        if ((q >> 1) == g) {
          u32 bits = __float_as_uint(l[q]);
          u32 low = bits & 255u;
          int prq = (int)((bits >> 31) ? low : (255u - low));
          int exi = (int)i1[prq >> 4] * 128 + (int)i2[prq & 15];
          pe_e[h * 16 + q] = exi;
          pe_su[h * 16 + q] = p.su[exi];
          pe_gv[h * 16 + q] = bvv[q] * inv * p.sv[exi];
        }
      }
      __builtin_amdgcn_wave_barrier();
    }
    float rt;
    {
      float ssum = 0.f;
#pragma unroll
      for (int q = 0; q < 8; ++q) ssum += p.ssq[(size_t)q * T + t];
      rt = rsqrtf(ssum * (1.f / 1024.f) + EPS);
    }
    float2_t h2[8];
    {
      uint4 hx0 = *reinterpret_cast<const uint4*>(p.h1b + t * 1024 + lane * 16);
      uint4 hx1 = *reinterpret_cast<const uint4*>(p.h1b + t * 1024 + lane * 16 + 8);
      u32 hw[8] = {hx0.x, hx0.y, hx0.z, hx0.w, hx1.x, hx1.y, hx1.z, hx1.w};
#pragma unroll
      for (int q = 0; q < 8; ++q) { h2[q].x = bf_lo(hw[q]); h2[q].y = bf_hi(hw[q]); }
    }
    float2_t y2[8];
#pragma unroll
    for (int q = 0; q < 8; ++q) { y2[q].x = 0.f; y2[q].y = 0.f; }
    const int kk = (lane >> 3) & 7;
    for (int e0 = 0; e0 < 128; e0 += 8) {
      uint4 ur[8], vr[8];
#pragma unroll
      for (int k = 0; k < 8; ++k) {
        int ex = pe_e[e0 + k];
        ur[k] = *reinterpret_cast<const uint4*>(p.U8 + (size_t)ex * 1024 + lane * 16);
        vr[k] = *reinterpret_cast<const uint4*>(p.V8 + (size_t)ex * 1024 + lane * 16);
      }
      float d[8];
#pragma unroll
      for (int k = 0; k < 8; ++k) {
        u32 uw[4] = {ur[k].x, ur[k].y, ur[k].z, ur[k].w};
        float2_t acc = {0.f, 0.f};
#pragma unroll
        for (int q = 0; q < 4; ++q) {
          acc += __builtin_amdgcn_cvt_pk_f32_fp8((int)uw[q], false) * h2[2 * q];
          acc += __builtin_amdgcn_cvt_pk_f32_fp8((int)uw[q], true) * h2[2 * q + 1];
        }
        d[k] = acc.x + acc.y;
      }
      float e4[4], f2[2], gsum;
      {
        const bool hi = (lane & 32) != 0;
#pragma unroll
        for (int k = 0; k < 4; ++k) {
          float snd = hi ? d[k] : d[k + 4], kp = hi ? d[k + 4] : d[k];
          e4[k] = kp + __shfl_xor(snd, 32);
        }
        const bool hb = (lane & 16) != 0;
#pragma unroll
        for (int k = 0; k < 2; ++k) {
          float snd = hb ? e4[k] : e4[k + 2], kp = hb ? e4[k + 2] : e4[k];
          f2[k] = kp + __shfl_xor(snd, 16);
        }
        const bool hc = (lane & 8) != 0;
        float snd = hc ? f2[0] : f2[1], kp = hc ? f2[1] : f2[0];
        gsum = kp + __shfl_xor(snd, 8);
        gsum += __shfl_xor(gsum, 4);
        gsum += __shfl_xor(gsum, 2);
        gsum += __shfl_xor(gsum, 1);
      }
      float cme = pe_gv[e0 + kk] * gelu_f(gsum * rt * pe_su[e0 + kk]);
#pragma unroll
      for (int k = 0; k < 8; ++k) {
        float ck = __int_as_float(__builtin_amdgcn_readlane(__float_as_int(cme), k * 8));
        float2_t c2 = {ck, ck};
        u32 vw[4] = {vr[k].x, vr[k].y, vr[k].z, vr[k].w};
#pragma unroll
        for (int q = 0; q < 4; ++q) {
          y2[2 * q] += c2 * __builtin_amdgcn_cvt_pk_f32_fp8((int)vw[q], false);
          y2[2 * q + 1] += c2 * __builtin_amdgcn_cvt_pk_f32_fp8((int)vw[q], true);
        }
      }
    }
    float* op = p.out + t * 1024 + lane * 16;
#pragma unroll
    for (int q = 0; q < 4; ++q) {
      float4 a = make_float4(h2[2 * q].x + y2[2 * q].x, h2[2 * q].y + y2[2 * q].y, h2[2 * q + 1].x + y2[2 * q + 1].x, h2[2 * q + 1].y + y2[2 * q + 1].y);
      *reinterpret_cast<float4*>(op + 4 * q) = a;
    }
    __builtin_amdgcn_wave_barrier();
  }
}

__device__ void phase_mix(const Params& p, char* smem) {
  const int G = gridDim.x;
  {
    int* qslot = reinterpret_cast<int*>(smem + EXTRA_OFF + 1024);
    for (;;) {
      __syncthreads();
      if (threadIdx.x == 0) *qslot = (int)__hip_atomic_fetch_add(p.bar + 16, 1u, __ATOMIC_RELAXED, __HIP_MEMORY_SCOPE_AGENT);
      __syncthreads();
      const int s = *qslot;
      if (s >= 2048) break;
      int grp = 1023 - (s >> 1), b = s & 1;
      unit_indexer(p, smem, (b << 10) | grp);
    }
  }
  for (int u = blockIdx.x; u < 1024; u += G) unit_spatial(p, smem, u);
  for (int u = blockIdx.x; u < 256; u += G) unit_kv(p, smem, u);
}

template <int PH>
__device__ __forceinline__ void run_phase(const Params& p, char* smem) {
  if (PH == 0) phase_prep(p, smem);
  else if (PH == 1) phase_gemm1(p, smem);
  else if (PH == 2) phase_mix(p, smem);
  else if (PH == 3) phase_attn(p, smem);
  else if (PH == 4) phase_merge(p, smem);
  else if (PH == 5) phase_wo(p, smem);
  else if (PH == 6) phase_peerq(p, smem);
  else phase_peer(p, smem);
}

template <int PH>
__global__ void __launch_bounds__(NTHREADS, 2) phase_kernel(Params p) {
  __shared__ __attribute__((aligned(16))) char smem[SMEM_BYTES];
  run_phase<PH>(p, smem);
}

#define XB_CNT(j) (64 + 64 * (j))
#define XB_SUB(j) (1088 + 64 * (j))
#define XB_GEN(j) (2112 + 64 * (j))
#define XB_TOP 3136
#define XB_TOPGEN 3200
#define XB_WORDS 3264
__device__ __forceinline__ unsigned xb_ld(unsigned* q) { return __hip_atomic_load(q, __ATOMIC_RELAXED, __HIP_MEMORY_SCOPE_AGENT); }
__device__ __forceinline__ unsigned xb_add(unsigned* q) { return __hip_atomic_fetch_add(q, 1u, __ATOMIC_RELAXED, __HIP_MEMORY_SCOPE_AGENT); }
__device__ __forceinline__ unsigned xb_xcc_id() { return (unsigned)__builtin_amdgcn_s_getreg((3 << 11) | 20) & 0xFu; }
__device__ __forceinline__ void grid_barrier(unsigned* bar, unsigned x, unsigned nloc, unsigned nx) {
  asm volatile("s_waitcnt vmcnt(0)" ::: "memory");
  __syncthreads();
  if (threadIdx.x == 0) {
    const unsigned old = xb_add(&bar[XB_SUB(x)]);
    const unsigned gen = old / nloc;
    if (old + 1u == (gen + 1u) * nloc) {
      __builtin_amdgcn_fence(__ATOMIC_RELEASE, "agent");
      asm volatile("s_waitcnt vmcnt(0)" ::: "memory");
      const unsigned og = xb_add(&bar[XB_TOP]);
      const unsigned tg = og / nx;
      if (og + 1u == (tg + 1u) * nx) xb_add(&bar[XB_TOPGEN]);
      else { unsigned sp = 0; while (xb_ld(&bar[XB_TOPGEN]) == tg) { __builtin_amdgcn_s_sleep(1); if (++sp > (1u << 24)) break; } }
      __builtin_amdgcn_fence(__ATOMIC_ACQUIRE, "agent");
      xb_add(&bar[XB_GEN(x)]);
      asm volatile("s_waitcnt vmcnt(0)" ::: "memory");
    } else {
      unsigned sp = 0;
      while (xb_ld(&bar[XB_GEN(x)]) == gen) { __builtin_amdgcn_s_sleep(1); if (++sp > (1u << 24)) break; }
      __builtin_amdgcn_fence(__ATOMIC_ACQUIRE, "agent");
      asm volatile("s_waitcnt vmcnt(0)" ::: "memory");
    }
  }
  __syncthreads();
}

__global__ void __launch_bounds__(NTHREADS, 2) mega_kernel(Params p) {
  __shared__ __attribute__((aligned(16))) char smem[SMEM_BYTES];
  cg::grid_group grid = cg::this_grid();
#define GSYNC() grid_barrier(p.bar, xb_x, xb_nloc, xb_nx)
  const unsigned xb_x = xb_xcc_id();
  if (threadIdx.x == 0) xb_add(&p.bar[XB_CNT(xb_x)]);
  asm volatile("s_waitcnt vmcnt(0)" ::: "memory");
  grid.sync();
  unsigned xb_nloc = 1, xb_nx = 0;
  if (threadIdx.x == 0) {
    for (unsigned j = 0; j < 16; ++j) { const unsigned c = xb_ld(&p.bar[XB_CNT(j)]); xb_nx += (c > 0u) ? 1u : 0u; if (j == xb_x) xb_nloc = c; }
    if (xb_nloc == 0u) xb_nloc = 1u;
    if (xb_nx == 0u) xb_nx = 1u;
  }
#define RUNP(X) run_phase<X>(p, smem); GSYNC();
  RUNP(0) RUNP(1) RUNP(2) RUNP(3) RUNP(4) RUNP(5) RUNP(6)
  run_phase<7>(p, smem);
}

extern "C" void kernel_launch(void* const* d_in, const int* in_sizes, int n_in, void* d_out, int out_size,
                              void* d_ws, size_t ws_size, hipStream_t stream) {
  Params p{};
  p.x = (const float*)d_in[0]; p.pos = (const int*)d_in[1];
  p.norm1_g = (const float*)d_in[2]; p.w_in = (const float*)d_in[3]; p.v_norm_g = (const float*)d_in[4];
  p.v_norm_b = (const float*)d_in[5]; p.spatial_w = (const float*)d_in[6]; p.spatial_b = (const float*)d_in[7];
  p.kv_norm_g = (const float*)d_in[8]; p.w_uk = (const float*)d_in[9]; p.w_uv = (const float*)d_in[10];
  p.q_norm_g = (const float*)d_in[11]; p.k_norm_g = (const float*)d_in[12]; p.w_a_out = (const float*)d_in[13];
  p.w_b_out = (const float*)d_in[14]; p.w_o = (const float*)d_in[15]; p.norm2_g = (const float*)d_in[16];
  p.peer_wq = (const float*)d_in[17]; p.peer_subkeys = (const float*)d_in[18]; p.peer_u = (const float*)d_in[19];
  p.peer_v = (const float*)d_in[20];
  p.out = (float*)d_out;
  char* w = (char*)d_ws;
  size_t off = 0;
  auto take = [&](size_t bytes) { char* r = w + off; off += (bytes + 255) & ~(size_t)255; return r; };
  const size_t MB = 1u << 20;
  char* r_xn = take(64 * MB);
  p.xn = (u16*)r_xn; p.ya = (u16*)r_xn; p.yb = (u16*)(r_xn + 32 * MB);
  p.WinT = (u16*)take((size_t)NWIN * 1024 * 2);
  p.WaT = (u16*)take(1024 * 512 * 2); p.WbT = (u16*)take(1024 * 512 * 2);
  p.WoT = (u16*)take(1024 * 1024 * 2); p.WqT = (u16*)take(2048 * 1024 * 2);
  p.WkvT = (u16*)take(256 * 256 * 2); p.SubK = (u16*)take(262144 * 2); p.Wtril = (u16*)take(65536 * 2);
  p.U8 = (u8*)take(16 * MB); p.V8 = (u8*)take(16 * MB);
  p.su = (float*)take(16384 * 4); p.sv = (float*)take(16384 * 4);
  char* r_g = take(96 * MB);
  p.gu = (u16*)r_g; p.gv = (u16*)(r_g + 32 * MB); p.qh = (u16*)(r_g + 64 * MB); p.merged = (u16*)r_g;
  p.ckv = (u16*)take(16 * MB); p.qi = (u16*)take(16 * MB); p.ki = (u16*)take(4 * MB);
  p.wi = (float*)take((size_t)T * 4 * 4);
  char* r_sg = take(128 * MB);
  p.sg = (u16*)r_sg; p.h1b = (u16*)r_sg; p.stv = (float*)(r_sg + 64 * MB); p.sti = (u8*)(r_sg + 96 * MB);
  p.sel = (u16*)take(16 * MB);
  p.kv8 = (u8*)take(8 * MB); p.scal = (float*)take(256);
  p.ssq = (float*)take((size_t)T * 8 * 4);
  p.bar = (unsigned*)take(XB_WORDS * 4);
  p.rtab = (float*)take((size_t)T * 48 * 4);
  if (off > ws_size) { fprintf(stderr, "workspace too small: need %zu have %zu\n", off, ws_size); return; }

  static int grid_blocks = 0;
  if (!grid_blocks) {
    int dev = 0, cus = 0, per_cu = 0;
    hipGetDevice(&dev);
    hipDeviceGetAttribute(&cus, hipDeviceAttributeMultiprocessorCount, dev);
    hipOccupancyMaxActiveBlocksPerMultiprocessor(&per_cu, mega_kernel, NTHREADS, 0);
    if (per_cu > 2) per_cu = 2;
    if (per_cu < 1) per_cu = 1;
    grid_blocks = cus * per_cu;
  }
  hipMemsetAsync(p.bar, 0, XB_WORDS * 4, stream);
#if MULTI_LAUNCH
  dim3 g(grid_blocks), b(NTHREADS);
  phase_kernel<0><<<g, b, 0, stream>>>(p);
  phase_kernel<1><<<g, b, 0, stream>>>(p);
  phase_kernel<2><<<g, b, 0, stream>>>(p);
  phase_kernel<3><<<g, b, 0, stream>>>(p);
  phase_kernel<4><<<g, b, 0, stream>>>(p);
  phase_kernel<5><<<g, b, 0, stream>>>(p);
  phase_kernel<6><<<g, b, 0, stream>>>(p);
  phase_kernel<7><<<g, b, 0, stream>>>(p);
#else
  void* args[] = {&p};
  hipError_t e = hipLaunchCooperativeKernel((void*)mega_kernel, dim3(grid_blocks), dim3(NTHREADS), args, 0, stream);
  if (e != hipSuccess) fprintf(stderr, "cooperative launch failed: %s (grid %d)\n", hipGetErrorString(e), grid_blocks);
#endif
}
```

```cpp
#include <hip/hip_runtime.h>
#include <hip/hip_cooperative_groups.h>
#include <stdint.h>
#include <cstdio>
namespace cg = cooperative_groups;

#ifndef MULTI_LAUNCH
#define MULTI_LAUNCH 0
#endif

typedef unsigned short u16;
typedef unsigned int u32;
typedef unsigned char u8;
using bf16x8 = __attribute__((ext_vector_type(8))) short;
using f32x4 = __attribute__((ext_vector_type(4))) float;
using f32x16 = __attribute__((ext_vector_type(16))) float;
typedef __bf16 bf16x2_t __attribute__((ext_vector_type(2)));
typedef float float2_t __attribute__((ext_vector_type(2)));

constexpr int BATCH = 2, SEQ = 16384, DM = 1024, T = BATCH * SEQ;
constexpr int NWIN = 4224;
constexpr int NTHREADS = 256;
constexpr float EPS = 1e-6f;
constexpr int ABUF = 128 * 144;
constexpr int CS_LD = 132;
constexpr int SMEM_BYTES = 77824;
constexpr int EXTRA_OFF = 4 * ABUF;
constexpr int CAP = 768;

__constant__ float INV32[16] = {1.000000000e+00f, 4.403665960e-01f, 1.939227432e-01f, 8.539710194e-02f, 3.760603070e-02f, 1.656043902e-02f, 7.292664610e-03f, 3.211445874e-03f, 1.414213562e-03f, 6.227723788e-04f, 2.742481884e-04f, 1.207697351e-04f, 5.318296098e-05f, 2.341999971e-05f, 1.031338616e-05f, 4.541670478e-06f};
__constant__ float INV16[8] = {1.000000000e+00f, 1.939227432e-01f, 3.760603070e-02f, 7.292664610e-03f, 1.414213562e-03f, 2.742481884e-04f, 5.318296098e-05f, 1.031338616e-05f};
__constant__ u8 PAIR_TAB[56] = {
  0x00,0x01,0x02,0x03,0x04,0x05,0x06,0x07,0x08,0x09,0x0a,0x0b,0x0c,0x0d,0x0e,0x0f,
  0x10,0x11,0x12,0x13,0x14,0x15,0x16,0x17,
  0x20,0x21,0x22,0x23,0x24,
  0x30,0x31,0x32,0x33,
  0x40,0x41,0x42,
  0x50,0x51,
  0x60,0x61,
  0x70,0x71,
  0x80,0x90,0xa0,0xb0,0xc0,0xd0,0xe0,0xf0,
  0xff,0xff,0xff,0xff,0xff,0xff};

struct Params {
  const float* x; const int* pos;
  const float *norm1_g, *w_in, *v_norm_g, *v_norm_b, *spatial_w, *spatial_b, *kv_norm_g, *w_uk, *w_uv,
      *q_norm_g, *k_norm_g, *w_a_out, *w_b_out, *w_o, *norm2_g, *peer_wq, *peer_subkeys, *peer_u, *peer_v;
  float* out;
  u16 *xn, *WinT, *WaT, *WbT, *WoT, *WqT, *WkvT, *SubK, *Wtril;
  u8 *U8, *V8, *kv8;
  float *su, *sv, *scal;
  u16 *gu, *gv, *qh, *ckv, *qi, *ki, *sg, *ya, *yb, *merged, *h1b, *sel;
  float *wi, *ssq, *stv, *rtab;
  u8* sti;
  unsigned* bar;
};

__device__ __forceinline__ u32 pack_bf16(float a, float b) {
  float2_t v = {a, b};
  bf16x2_t r = __builtin_convertvector(v, bf16x2_t);
  return __builtin_bit_cast(u32, r);
}
__device__ __forceinline__ u16 f2bf(float a) { return (u16)(pack_bf16(a, 0.f) & 0xffffu); }
__device__ __forceinline__ float bf_lo(u32 u) { return __uint_as_float(u << 16); }
__device__ __forceinline__ float bf_hi(u32 u) { return __uint_as_float(u & 0xffff0000u); }
__device__ __forceinline__ float bf2f(u16 h) { return __uint_as_float(((u32)h) << 16); }
__device__ __forceinline__ float wave_sum(float v) {
#pragma unroll
  for (int m = 32; m >= 1; m >>= 1) v += __shfl_xor(v, m);
  return v;
}
__device__ __forceinline__ float gelu_f(float x) {
  float z = -2.3022082f * (x + 0.044715f * x * x * x);
  return x * __builtin_amdgcn_rcpf(1.f + __builtin_amdgcn_exp2f(z));
}
__device__ __forceinline__ float sigmoid_f(float x) { return __builtin_amdgcn_rcpf(1.f + __builtin_amdgcn_exp2f(-1.4426950408889634f * x)); }
__device__ __forceinline__ u32 sortable(u32 b) { return b ^ ((u32)((int)b >> 31) | 0x80000000u); }
__device__ __forceinline__ u32 unsortable(u32 k) { return k ^ ((k & 0x80000000u) ? 0x80000000u : 0xffffffffu); }
__device__ __forceinline__ int mbcnt64(unsigned long long m) {
  return __builtin_amdgcn_mbcnt_hi((u32)(m >> 32), __builtin_amdgcn_mbcnt_lo((u32)m, 0));
}

__device__ __forceinline__ void load8(const float* p, float (&v)[8]) {
  float4 a = *reinterpret_cast<const float4*>(p), b = *reinterpret_cast<const float4*>(p + 4);
  v[0] = a.x; v[1] = a.y; v[2] = a.z; v[3] = a.w; v[4] = b.x; v[5] = b.y; v[6] = b.z; v[7] = b.w;
}
__device__ __forceinline__ void unpack8(uint4 q, float (&v)[8]) {
  v[0] = bf_lo(q.x); v[1] = bf_hi(q.x); v[2] = bf_lo(q.y); v[3] = bf_hi(q.y);
  v[4] = bf_lo(q.z); v[5] = bf_hi(q.z); v[6] = bf_lo(q.w); v[7] = bf_hi(q.w);
}
__device__ __forceinline__ uint4 pack8(const float (&v)[8]) {
  uint4 o = {pack_bf16(v[0], v[1]), pack_bf16(v[2], v[3]), pack_bf16(v[4], v[5]), pack_bf16(v[6], v[7])};
  return o;
}
#define DPPF(v, ctrl) __int_as_float(__builtin_amdgcn_update_dpp(0, __float_as_int(v), (ctrl), 0xF, 0xF, true))
__device__ __forceinline__ float sum16(float x) {
  x += DPPF(x, 0xB1); x += DPPF(x, 0x4E); x += DPPF(x, 0x141); x += DPPF(x, 0x140);
  return x;
}
__device__ __forceinline__ float max16(float x) {
  x = fmaxf(x, DPPF(x, 0xB1)); x = fmaxf(x, DPPF(x, 0x4E)); x = fmaxf(x, DPPF(x, 0x141)); x = fmaxf(x, DPPF(x, 0x140));
  return x;
}
__device__ __forceinline__ void rope32_8(float (&v)[8], int L, const float* tab) {
  float pr[8];
#pragma unroll
  for (int e = 0; e < 8; ++e) pr[e] = __shfl_xor(v[e], 2);
  if (L < 4) {
    float c[8], s[8];
    load8(tab + (L & 1) * 8, c);
    load8(tab + 16 + (L & 1) * 8, s);
#pragma unroll
    for (int e = 0; e < 8; ++e) v[e] = (L < 2) ? (v[e] * c[e] - pr[e] * s[e]) : (v[e] * c[e] + pr[e] * s[e]);
  }
}
__device__ __forceinline__ void rope16_8(float (&v)[8], int lc0, const float* tab) {
  float pr[8];
#pragma unroll
  for (int e = 0; e < 8; ++e) pr[e] = __shfl_xor(v[e], 1);
  if (lc0 < 16) {
    float c[8], s[8];
    load8(tab + 32, c);
    load8(tab + 40, s);
#pragma unroll
    for (int e = 0; e < 8; ++e) v[e] = (lc0 == 0) ? (v[e] * c[e] - pr[e] * s[e]) : (v[e] * c[e] + pr[e] * s[e]);
  }
}

typedef u32 u32x4 __attribute__((ext_vector_type(4)));
struct Tile4 { u32x4 v0, v1, v2, v3; };
__device__ __forceinline__ void gemm_load_tile(const u16* __restrict__ g, int ld, int k0, Tile4& r) {
  const int tid = threadIdx.x;
  const int row = tid >> 3, kc = tid & 7;
  const u16* base = g + (size_t)row * ld + k0 + kc * 8;
  r.v0 = *reinterpret_cast<const u32x4*>(base);
  r.v1 = *reinterpret_cast<const u32x4*>(base + (size_t)32 * ld);
  r.v2 = *reinterpret_cast<const u32x4*>(base + (size_t)64 * ld);
  r.v3 = *reinterpret_cast<const u32x4*>(base + (size_t)96 * ld);
}
__device__ __forceinline__ void gemm_store_tile(char* buf, const Tile4& r) {
  const int tid = threadIdx.x;
  const int row = tid >> 3, kc = tid & 7;
  char* base = buf + row * 144 + kc * 16;
  *reinterpret_cast<u32x4*>(base) = r.v0;
  *reinterpret_cast<u32x4*>(base + 32 * 144) = r.v1;
  *reinterpret_cast<u32x4*>(base + 64 * 144) = r.v2;
  *reinterpret_cast<u32x4*>(base + 96 * 144) = r.v3;
}
__device__ __forceinline__ void mma_ktile(const char* sa, const char* sb, f32x16 (&acc)[2][2]) {
  const int lane = threadIdx.x & 63, wid = threadIdx.x >> 6;
  const int wr = wid >> 1, wc = wid & 1;
  const int r32 = lane & 31, hf = lane >> 5;
  const char* pa = sa + (wr * 64 + r32) * 144 + hf * 16;
  const char* pb = sb + (wc * 64 + r32) * 144 + hf * 16;
  bf16x8 a0[2], b0[2], a1[2], b1[2];
#pragma unroll
  for (int i = 0; i < 2; ++i) {
    a0[i] = *reinterpret_cast<const bf16x8*>(pa + i * 32 * 144);
    b0[i] = *reinterpret_cast<const bf16x8*>(pb + i * 32 * 144);
  }
#pragma unroll
  for (int s = 0; s < 4; s += 2) {
#pragma unroll
    for (int i = 0; i < 2; ++i) {
      a1[i] = *reinterpret_cast<const bf16x8*>(pa + i * 32 * 144 + (s + 1) * 32);
      b1[i] = *reinterpret_cast<const bf16x8*>(pb + i * 32 * 144 + (s + 1) * 32);
    }
    __builtin_amdgcn_s_setprio(1);
#pragma unroll
    for (int i = 0; i < 2; ++i)
#pragma unroll
      for (int j = 0; j < 2; ++j)
        acc[i][j] = __builtin_amdgcn_mfma_f32_32x32x16_bf16(a0[i], b0[j], acc[i][j], 0, 0, 0);
    __builtin_amdgcn_s_setprio(0);
    if (s + 2 < 4) {
#pragma unroll
      for (int i = 0; i < 2; ++i) {
        a0[i] = *reinterpret_cast<const bf16x8*>(pa + i * 32 * 144 + (s + 2) * 32);
        b0[i] = *reinterpret_cast<const bf16x8*>(pb + i * 32 * 144 + (s + 2) * 32);
      }
    }
    __builtin_amdgcn_s_setprio(1);
#pragma unroll
    for (int i = 0; i < 2; ++i)
#pragma unroll
      for (int j = 0; j < 2; ++j)
        acc[i][j] = __builtin_amdgcn_mfma_f32_32x32x16_bf16(a1[i], b1[j], acc[i][j], 0, 0, 0);
    __builtin_amdgcn_s_setprio(0);
  }
}
#define GEMM_KT(i, nk) ((((i) + ((int)(blockIdx.x >> 3))) & ((nk) - 1)) << 6)
__device__ __forceinline__ void gemm_prefetch(const u16* __restrict__ A, int lda, const u16* __restrict__ B, int ldb, int K, Tile4& ra, Tile4& rb) {
  const int nk = K >> 6;
  gemm_load_tile(A, lda, GEMM_KT(0, nk), ra);
  gemm_load_tile(B, ldb, GEMM_KT(0, nk), rb);
}
__device__ __forceinline__ void gemm_mainloop(const u16* __restrict__ A, int lda, const u16* __restrict__ B, int ldb,
                                              int K, f32x16 (&acc)[2][2], char* smem, Tile4& ra, Tile4& rb) {
  const int nk = K >> 6;
  __syncthreads();
  gemm_store_tile(smem, ra);
  gemm_store_tile(smem + 2 * ABUF, rb);
  __syncthreads();
#pragma unroll 1
  for (int kt = 0; kt < nk; ++kt) {
    const int cur = kt & 1;
    if (kt + 1 < nk) {
      gemm_load_tile(A, lda, GEMM_KT(kt + 1, nk), ra);
      gemm_load_tile(B, ldb, GEMM_KT(kt + 1, nk), rb);
    }
    mma_ktile(smem + cur * ABUF, smem + (2 + cur) * ABUF, acc);
    if (kt + 1 < nk) {
      gemm_store_tile(smem + (cur ^ 1) * ABUF, ra);
      gemm_store_tile(smem + (2 + (cur ^ 1)) * ABUF, rb);
    }
    __syncthreads();
  }
}
__device__ __forceinline__ void zero_acc(f32x16 (&acc)[2][2]) {
#pragma unroll
  for (int i = 0; i < 2; ++i)
#pragma unroll
    for (int j = 0; j < 2; ++j)
#pragma unroll
      for (int r = 0; r < 16; ++r) acc[i][j][r] = 0.f;
}
__device__ __forceinline__ void stage_acc(const f32x16 (&acc)[2][2], float* cs) {
  const int lane = threadIdx.x & 63, wid = threadIdx.x >> 6;
  const int wr = wid >> 1, wc = wid & 1;
#pragma unroll
  for (int i = 0; i < 2; ++i)
#pragma unroll
    for (int j = 0; j < 2; ++j)
#pragma unroll
      for (int r = 0; r < 16; ++r) {
        int row = wr * 64 + i * 32 + (r & 3) + 8 * (r >> 2) + 4 * (lane >> 5);
        int col = wc * 64 + j * 32 + (lane & 31);
        cs[row * CS_LD + col] = acc[i][j][r];
      }
}

__device__ __forceinline__ int win_srccol(int n) {
  if (n < 2116) return n;
  if (n < 2176) return -1;
  return n - 60;
}
__device__ void phase_prep(const Params& p, char* smem) {
  const int tid = threadIdx.x, lane = tid & 63, wid = tid >> 6;
  for (int rb = blockIdx.x; rb < T / 4; rb += gridDim.x) {
    int row = rb * 4 + wid;
    const float* xr = p.x + (size_t)row * DM;
    float4 v[4];
    float ss = 0.f;
#pragma unroll
    for (int i = 0; i < 4; ++i) {
      v[i] = *reinterpret_cast<const float4*>(xr + lane * 4 + 256 * i);
      ss += v[i].x * v[i].x + v[i].y * v[i].y + v[i].z * v[i].z + v[i].w * v[i].w;
    }
    ss = wave_sum(ss);
    float r = rsqrtf(ss * (1.f / DM) + EPS);
#pragma unroll
    for (int i = 0; i < 4; ++i) {
      float4 g = *reinterpret_cast<const float4*>(p.norm1_g + lane * 4 + 256 * i);
      uint2 o;
      o.x = pack_bf16(v[i].x * r * g.x, v[i].y * r * g.y);
      o.y = pack_bf16(v[i].z * r * g.z, v[i].w * r * g.w);
      *reinterpret_cast<uint2*>(p.xn + (size_t)row * DM + lane * 4 + 256 * i) = o;
    }
  }
  float* tile = reinterpret_cast<float*>(smem);
  constexpr int NT_TOTAL = 1056 + 128 + 128 + 256 + 512 + 8 + 8;
  for (int ti = blockIdx.x; ti < NT_TOTAL; ti += gridDim.x) {
    const float* src; const float* scale = nullptr; u16* dst; int ldsrc, K, nn, mode = 0; int t = ti;
    if (t < 1056) { src = p.w_in; ldsrc = 4164; K = 1024; nn = 66; dst = p.WinT; mode = 1; }
    else if ((t -= 1056) < 128) { src = p.w_a_out; ldsrc = 1024; K = 512; nn = 16; dst = p.WaT; }
    else if ((t -= 128) < 128) { src = p.w_b_out; ldsrc = 1024; K = 512; nn = 16; dst = p.WbT; }
    else if ((t -= 128) < 256) { src = p.w_o; ldsrc = 1024; K = 1024; nn = 16; dst = p.WoT; }
    else if ((t -= 256) < 512) { src = p.peer_wq; ldsrc = 2048; K = 1024; nn = 32; dst = p.WqT; scale = p.norm2_g; }
    else if ((t -= 512) < 8) { src = p.w_uk; ldsrc = 128; K = 256; nn = 2; dst = p.WkvT; scale = p.kv_norm_g; }
    else { t -= 8; src = p.w_uv; ldsrc = 128; K = 256; nn = 2; dst = p.WkvT + 128 * 256; scale = p.kv_norm_g; }
    int n0 = (t % nn) * 64, k0 = (t / nn) * 64;
    __syncthreads();
    {
      int n = tid & 63;
      int sc = (mode == 1) ? win_srccol(n0 + n) : (n0 + n);
      for (int kk = tid >> 6; kk < 64; kk += 4) {
        float v = 0.f;
        if (sc >= 0) v = src[(size_t)(k0 + kk) * ldsrc + sc];
        if (scale) v *= scale[k0 + kk];
        tile[kk * 65 + n] = v;
      }
    }
    __syncthreads();
    {
      int k = (tid & 31) * 2;
      for (int n = tid >> 5; n < 64; n += 8) {
        u32 o = pack_bf16(tile[k * 65 + n], tile[(k + 1) * 65 + n]);
        *reinterpret_cast<u32*>(dst + (size_t)(n0 + n) * K + k0 + k) = o;
      }
    }
  }
  constexpr int G_SUB = 262144 / 4, G_SW = 65536 / 4;
  constexpr int G_TOTAL = G_SUB + G_SW;
  for (int gi = blockIdx.x * NTHREADS + tid; gi < G_TOTAL; gi += gridDim.x * NTHREADS) {
    int g = gi;
    if (g < G_SUB) {
      float4 v = *reinterpret_cast<const float4*>(p.peer_subkeys + (size_t)g * 4);
      uint2 o = {pack_bf16(v.x, v.y), pack_bf16(v.z, v.w)};
      *reinterpret_cast<uint2*>(p.SubK + (size_t)g * 4) = o;
    } else {
      g -= G_SUB;
      float4 v = *reinterpret_cast<const float4*>(p.spatial_w + (size_t)g * 4);
      int e = g * 4; int s = e & 127, tt = (e >> 7) & 127;
      if (s > tt) v.x = 0.f;
      if (s + 1 > tt) v.y = 0.f;
      if (s + 2 > tt) v.z = 0.f;
      if (s + 3 > tt) v.w = 0.f;
      uint2 o = {pack_bf16(v.x, v.y), pack_bf16(v.z, v.w)};
      *reinterpret_cast<uint2*>(p.Wtril + (size_t)g * 4) = o;
    }
  }
  if (blockIdx.x == 0) {
    float* red = reinterpret_cast<float*>(smem);
    __syncthreads();
    float vq = 0.f, vk = 0.f, vn = 0.f;
    if (tid < 128) {
      vq = fabsf(p.q_norm_g[tid]); vk = fabsf(p.k_norm_g[tid]);
      float ss = 0.f;
      for (int k = 0; k < 256; ++k) { float w = p.w_uv[k * 128 + tid] * p.kv_norm_g[k]; ss += w * w; }
      vn = sqrtf(ss);
    }
    red[tid] = vq; red[256 + tid] = vk; red[512 + tid] = vn;
    __syncthreads();
    if (tid == 0) {
      float mq = 0.f, mk = 0.f, mn = 0.f;
      for (int k = 0; k < 128; ++k) { mq = fmaxf(mq, red[k]); mk = fmaxf(mk, red[256 + k]); mn = fmaxf(mn, red[512 + k]); }
      int eq = ilogbf(440.f / fmaxf(11.3137085f * mq, 1e-20f));
      int ek = ilogbf(440.f / fmaxf(11.3137085f * mk, 1e-20f));
      int ev = ilogbf(440.f / fmaxf(16.f * mn, 1e-20f));
      eq = eq > 40 ? 40 : (eq < -40 ? -40 : eq); ek = ek > 40 ? 40 : (ek < -40 ? -40 : ek); ev = ev > 40 ? 40 : (ev < -40 ? -40 : ev);
      p.scal[0] = ldexpf(1.f, eq); p.scal[1] = ldexpf(1.f, ek); p.scal[2] = ldexpf(1.f, ev);
      p.scal[3] = ldexpf(1.f, -eq - ek); p.scal[4] = ldexpf(1.f, -ev);
    }
    __syncthreads();
  }
  for (int gi = blockIdx.x * NTHREADS + tid; gi < T * 24; gi += gridDim.x * NTHREADS) {
    int t = gi / 24, j = gi - t * 24;
    float posf = (float)p.pos[t];
    float sn, cn;
    if (j < 16) { sincosf(posf * INV32[j], &sn, &cn); p.rtab[(size_t)t * 48 + j] = cn; p.rtab[(size_t)t * 48 + 16 + j] = sn; }
    else { int jj = j - 16; sincosf(posf * INV16[jj], &sn, &cn); p.rtab[(size_t)t * 48 + 32 + jj] = cn; p.rtab[(size_t)t * 48 + 40 + jj] = sn; }
  }
  for (int rb = blockIdx.x; rb < 8192; rb += gridDim.x) {
    int r = rb * 4 + wid;
    bool isu = r < 16384;
    int rr = isu ? r : r - 16384;
    const float* src = (isu ? p.peer_u : p.peer_v) + (size_t)rr * 1024 + lane * 16;
    float v[16];
#pragma unroll
    for (int i = 0; i < 4; ++i) {
      float4 q = *reinterpret_cast<const float4*>(src + 4 * i);
      v[4 * i] = q.x; v[4 * i + 1] = q.y; v[4 * i + 2] = q.z; v[4 * i + 3] = q.w;
    }
    if (isu) {
#pragma unroll
      for (int i = 0; i < 4; ++i) {
        float4 g = *reinterpret_cast<const float4*>(p.norm2_g + lane * 16 + 4 * i);
        v[4 * i] *= g.x; v[4 * i + 1] *= g.y; v[4 * i + 2] *= g.z; v[4 * i + 3] *= g.w;
      }
    }
    float amax = 0.f;
#pragma unroll
    for (int i = 0; i < 16; ++i) amax = fmaxf(amax, fabsf(v[i]));
#pragma unroll
    for (int m = 32; m >= 1; m >>= 1) amax = fmaxf(amax, __shfl_xor(amax, m));
    int ex = 0;
    if (amax > 0.f) ex = ilogbf(224.f / amax);
    ex = ex > 60 ? 60 : (ex < -60 ? -60 : ex);
    float sc = ldexpf(1.f, ex);
    u32 w[4];
#pragma unroll
    for (int i = 0; i < 4; ++i) {
      int t = __builtin_amdgcn_cvt_pk_fp8_f32(v[4 * i] * sc, v[4 * i + 1] * sc, 0, false);
      t = __builtin_amdgcn_cvt_pk_fp8_f32(v[4 * i + 2] * sc, v[4 * i + 3] * sc, t, true);
      w[i] = (u32)t;
    }
    uint4 o = {w[0], w[1], w[2], w[3]};
    *reinterpret_cast<uint4*>((isu ? p.U8 : p.V8) + (size_t)rr * 1024 + lane * 16) = o;
    if (lane == 0) (isu ? p.su : p.sv)[rr] = ldexpf(1.f, -ex);
  }
}

__device__ __forceinline__ void rope_pair(float& y0, float& y1, int lc, int half, int xm, float posf, const float* inv) {
  float p0 = __shfl_xor(y0, xm), p1 = __shfl_xor(y1, xm);
  if (lc < 2 * half) {
    int j = lc & (half - 1);
    float a0 = posf * inv[j], a1 = posf * inv[j + 1];
    float s0, c0, s1, c1;
    sincosf(a0, &s0, &c0);
    sincosf(a1, &s1, &c1);
    if (lc < half) { y0 = y0 * c0 - p0 * s0; y1 = y1 * c1 - p1 * s1; }
    else { y0 = y0 * c0 + p0 * s0; y1 = y1 * c1 + p1 * s1; }
  }
}

__device__ __forceinline__ bool tile_swizzle(int step, int ntn, int ntiles, int& mt, int& nt) {
  const int x = blockIdx.x & 7, slot = blockIdx.x >> 3;
  const int nslots = gridDim.x >> 3;
  const int lin = (step * 8 + x) * nslots + slot;
  if (lin >= ntiles) return false;
  const int per = ntn * 16;
  const int g = lin / per, rem = lin - g * per;
  nt = rem >> 4;
  mt = g * 16 + (rem & 15);
  return true;
}

__device__ void phase_gemm1(const Params& p, char* smem) {
  const int tid = threadIdx.x, lane = tid & 63, wid = tid >> 6;
  float* cs = reinterpret_cast<float*>(smem);
  constexpr int NTN = NWIN / 128;
  constexpr int NTILES = (T / 128) * NTN;
  int mt, nt;
  bool have = tile_swizzle(0, NTN, NTILES, mt, nt);
  Tile4 ra, rb;
  if (have) gemm_prefetch(p.xn + (size_t)mt * 128 * DM, DM, p.WinT + (size_t)nt * 128 * DM, DM, DM, ra, rb);
  for (int step = 0; have; ++step) {
    int m0 = mt * 128;
    f32x16 acc[2][2];
    zero_acc(acc);
    gemm_mainloop(p.xn + (size_t)m0 * DM, DM, p.WinT + (size_t)nt * 128 * DM, DM, DM, acc, smem, ra, rb);
    stage_acc(acc, cs);
    __syncthreads();
    int mt2 = 0, nt2 = 0;
    const bool nxt = tile_swizzle(step + 1, NTN, NTILES, mt2, nt2);
    if (nxt) gemm_prefetch(p.xn + (size_t)mt2 * 128 * DM, DM, p.WinT + (size_t)nt2 * 128 * DM, DM, DM, ra, rb);
    const int L = lane & 15, rsub = lane >> 4, c0 = L * 8;
#pragma unroll 1
    for (int it = 0; it < 8; ++it) {
      const int row = wid * 32 + it * 4 + rsub;
      const size_t t = (size_t)m0 + row;
      float v[8];
      load8(cs + row * CS_LD + c0, v);
      if (nt < 8) {
#pragma unroll
        for (int e = 0; e < 8; ++e) v[e] = gelu_f(v[e]);
        u16* dst = (nt < 4) ? (p.gu + t * 512 + nt * 128 + c0) : (p.gv + t * 512 + (nt - 4) * 128 + c0);
        *reinterpret_cast<uint4*>(dst) = pack8(v);
      } else if (nt < 12) {
        float ss = 0.f;
#pragma unroll
        for (int e = 0; e < 8; ++e) ss += v[e] * v[e];
        ss = sum16(ss);
        float r = rsqrtf(ss * (1.f / 128.f) + EPS);
        float g[8];
        load8(p.q_norm_g + c0, g);
#pragma unroll
        for (int e = 0; e < 8; ++e) v[e] = v[e] * r * g[e];
        rope32_8(v, L, p.rtab + t * 48);
        *reinterpret_cast<uint4*>(p.qh + t * 512 + (nt - 8) * 128 + c0) = pack8(v);
      } else if (nt < 14) {
        *reinterpret_cast<uint4*>(p.ckv + t * 256 + (nt - 12) * 128 + c0) = pack8(v);
      } else if (nt < 16) {
        rope16_8(v, c0 & 63, p.rtab + t * 48);
        *reinterpret_cast<uint4*>(p.qi + t * 256 + (nt - 14) * 128 + c0) = pack8(v);
      } else if (nt == 16) {
        rope16_8(v, c0 < 64 ? c0 : 64, p.rtab + t * 48);
        if (c0 < 64) *reinterpret_cast<uint4*>(p.ki + ((t >> 4) * 8 + L) * 128 + (t & 15) * 8) = pack8(v);
        else if (c0 == 64) *reinterpret_cast<float4*>(p.wi + t * 4) = make_float4(v[0] * 0.0625f, v[1] * 0.0625f, v[2] * 0.0625f, v[3] * 0.0625f);
      } else {
#pragma unroll
        for (int e = 0; e < 8; ++e) v[e] = sigmoid_f(v[e]);
        *reinterpret_cast<uint4*>(p.sg + t * 2048 + (nt - 17) * 128 + c0) = pack8(v);
      }
    }
    mt = mt2; nt = nt2; have = nxt;
  }
}

__device__ void unit_kv(const Params& p, char* smem, int mt) {
  const int tid = threadIdx.x, lane = tid & 63, wid = tid >> 6;
  float* cs = reinterpret_cast<float*>(smem);
  float* rr_s = reinterpret_cast<float*>(smem + EXTRA_OFF);
  const int m0 = mt * 128;
  __syncthreads();
  {
    int row = tid >> 1, half = tid & 1;
    const u16* src = p.ckv + (size_t)(m0 + row) * 256 + half * 128;
    float ss = 0.f;
#pragma unroll 4
    for (int i = 0; i < 16; ++i) {
      uint4 q = *reinterpret_cast<const uint4*>(src + i * 8);
      u32 w[4] = {q.x, q.y, q.z, q.w};
#pragma unroll
      for (int j = 0; j < 4; ++j) { float a = bf_lo(w[j]), b = bf_hi(w[j]); ss += a * a + b * b; }
    }
    ss += __shfl_xor(ss, 1);
    if (half == 0) rr_s[row] = rsqrtf(ss * (1.f / 256.f) + EPS);
  }
  Tile4 ra, rb;
  gemm_prefetch(p.ckv + (size_t)m0 * 256, 256, p.WkvT, 256, 256, ra, rb);
#pragma unroll 1
  for (int nt = 0; nt < 2; ++nt) {
    f32x16 acc[2][2];
    zero_acc(acc);
    gemm_mainloop(p.ckv + (size_t)m0 * 256, 256, p.WkvT + (size_t)nt * 128 * 256, 256, 256, acc, smem, ra, rb);
    stage_acc(acc, cs);
    __syncthreads();
    if (nt == 0) gemm_prefetch(p.ckv + (size_t)m0 * 256, 256, p.WkvT + (size_t)128 * 256, 256, 256, ra, rb);
    const int L = lane & 15, rsub = lane >> 4, c0 = L * 8;
#pragma unroll 1
    for (int it = 0; it < 8; ++it) {
      const int row = wid * 32 + it * 4 + rsub;
      const size_t t = (size_t)m0 + row;
      float v[8];
      load8(cs + row * CS_LD + c0, v);
      const float rs = rr_s[row];
#pragma unroll
      for (int e = 0; e < 8; ++e) v[e] *= rs;
      if (nt == 0) {
        float ss = 0.f;
#pragma unroll
        for (int e = 0; e < 8; ++e) ss += v[e] * v[e];
        ss = sum16(ss);
        float r = rsqrtf(ss * (1.f / 128.f) + EPS);
        float g[8];
        load8(p.k_norm_g + c0, g);
#pragma unroll
        for (int e = 0; e < 8; ++e) v[e] = v[e] * r * g[e];
        rope32_8(v, L, p.rtab + t * 48);
        {
          const float sk = p.scal[1];
          int w0 = __builtin_amdgcn_cvt_pk_fp8_f32(v[0] * sk, v[1] * sk, 0, false);
          w0 = __builtin_amdgcn_cvt_pk_fp8_f32(v[2] * sk, v[3] * sk, w0, true);
          int w1 = __builtin_amdgcn_cvt_pk_fp8_f32(v[4] * sk, v[5] * sk, 0, false);
          w1 = __builtin_amdgcn_cvt_pk_fp8_f32(v[6] * sk, v[7] * sk, w1, true);
          *reinterpret_cast<uint2*>(p.kv8 + t * 256 + c0) = make_uint2((u32)w0, (u32)w1);
        }
      } else {
        {
          const float sv8 = p.scal[2];
          int w0 = __builtin_amdgcn_cvt_pk_fp8_f32(v[0] * sv8, v[1] * sv8, 0, false);
          w0 = __builtin_amdgcn_cvt_pk_fp8_f32(v[2] * sv8, v[3] * sv8, w0, true);
          int w1 = __builtin_amdgcn_cvt_pk_fp8_f32(v[4] * sv8, v[5] * sv8, 0, false);
          w1 = __builtin_amdgcn_cvt_pk_fp8_f32(v[6] * sv8, v[7] * sv8, w1, true);
          *reinterpret_cast<uint2*>(p.kv8 + t * 256 + 128 + c0) = make_uint2((u32)w0, (u32)w1);
        }
      }
    }
    __syncthreads();
  }
}

__device__ void unit_spatial(const Params& p, char* smem, int unit) {
  const int tid = threadIdx.x, lane = tid & 63, wid = tid >> 6;
  const int chunk = unit >> 2, g = unit & 3;
  const int t0 = chunk * 128;
  float* cs = reinterpret_cast<float*>(smem);
  float* mu_s = reinterpret_cast<float*>(smem + EXTRA_OFF);
  float* rs_s = mu_s + 128;
  __syncthreads();
  {
    int row = tid >> 1, half = tid & 1;
    const u16* src = p.gv + (size_t)(t0 + row) * 512 + half * 256;
    float s = 0.f, ss = 0.f;
#pragma unroll 4
    for (int i = 0; i < 32; ++i) {
      uint4 q = *reinterpret_cast<const uint4*>(src + i * 8);
      u32 w[4] = {q.x, q.y, q.z, q.w};
#pragma unroll
      for (int j = 0; j < 4; ++j) { float a = bf_lo(w[j]), b = bf_hi(w[j]); s += a + b; ss += a * a + b * b; }
    }
    s += __shfl_xor(s, 1);
    ss += __shfl_xor(ss, 1);
    float mean = s * (1.f / 512.f);
    float var = fmaxf(ss * (1.f / 512.f) - mean * mean, 0.f);
    if (half == 0) { mu_s[row] = mean; rs_s[row] = rsqrtf(var + EPS); }
  }
  {
    const u16* wsrc = p.Wtril + (size_t)g * 128 * 128;
#pragma unroll
    for (int i = 0; i < 8; ++i) {
      int c = tid + 256 * i;
      int row = c >> 4, kc = c & 15;
      uint4 q = *reinterpret_cast<const uint4*>(wsrc + row * 128 + kc * 8);
      *reinterpret_cast<uint4*>(smem + (kc >> 3) * ABUF + row * 144 + (kc & 7) * 16) = q;
    }
  }
  __syncthreads();
  {
    int s = tid & 127;
    float mu = mu_s[s], rs = rs_s[s];
    const u16* src = p.gv + (size_t)(t0 + s) * 512 + g * 128;
    char* bbase = smem + (2 + (s >> 6)) * ABUF + (s & 63) * 2;
#pragma unroll
    for (int i = 0; i < 8; ++i) {
      int d0 = ((tid >> 7) + 2 * i) * 8;
      uint4 q = *reinterpret_cast<const uint4*>(src + d0);
      u32 w[4] = {q.x, q.y, q.z, q.w};
#pragma unroll
      for (int j = 0; j < 4; ++j) {
        int d = d0 + 2 * j;
        float a = (bf_lo(w[j]) - mu) * rs * p.v_norm_g[g * 128 + d] + p.v_norm_b[g * 128 + d];
        float b = (bf_hi(w[j]) - mu) * rs * p.v_norm_g[g * 128 + d + 1] + p.v_norm_b[g * 128 + d + 1];
        *reinterpret_cast<u16*>(bbase + d * 144) = f2bf(a);
        *reinterpret_cast<u16*>(bbase + (d + 1) * 144) = f2bf(b);
      }
    }
  }
  __syncthreads();
  f32x16 acc[2][2];
  zero_acc(acc);
  mma_ktile(smem, smem + 2 * ABUF, acc);
  mma_ktile(smem + ABUF, smem + 3 * ABUF, acc);
  __syncthreads();
  stage_acc(acc, cs);
  __syncthreads();
  const int L = lane & 15, rsub = lane >> 4, c0 = L * 8;
#pragma unroll 1
  for (int it = 0; it < 8; ++it) {
    const int row = wid * 32 + it * 4 + rsub;
    const size_t t = (size_t)t0 + row;
    float v[8], u[8];
    load8(cs + row * CS_LD + c0, v);
    const float b = p.spatial_b[g * 128 + row];
    unpack8(*reinterpret_cast<const uint4*>(p.gu + t * 512 + g * 128 + c0), u);
#pragma unroll
    for (int e = 0; e < 8; ++e) v[e] = u[e] * (v[e] + b);
    *reinterpret_cast<uint4*>(p.ya + t * 512 + g * 128 + c0) = pack8(v);
  }
}

__device__ __forceinline__ void radix_partition(const u32 (&key)[12], int n, int rank, int slack, u32& lo, u32& hi, int& limit) {
  u32 vor = 0u, vand = 0xFFFFFFFFu;
#pragma unroll
  for (int k = 0; k < 12; ++k) { vor |= key[k]; vand &= (key[k] != 0u) ? key[k] : 0xFFFFFFFFu; }
#define DPPU(v, ctrl) ((u32)__builtin_amdgcn_update_dpp(0, (int)(v), (ctrl), 0xF, 0xF, true))
  vor |= DPPU(vor, 0xB1); vor |= DPPU(vor, 0x4E); vor |= DPPU(vor, 0x141); vor |= DPPU(vor, 0x140);
  vand &= DPPU(vand, 0xB1); vand &= DPPU(vand, 0x4E); vand &= DPPU(vand, 0x141); vand &= DPPU(vand, 0x140);
  vor = (u32)(__builtin_amdgcn_readlane((int)vor, 0) | __builtin_amdgcn_readlane((int)vor, 16) |
              __builtin_amdgcn_readlane((int)vor, 32) | __builtin_amdgcn_readlane((int)vor, 48));
  vand = (u32)(__builtin_amdgcn_readlane((int)vand, 0) & __builtin_amdgcn_readlane((int)vand, 16) &
               __builtin_amdgcn_readlane((int)vand, 32) & __builtin_amdgcn_readlane((int)vand, 48));
#undef DPPU
  const u32 diff = vor ^ vand;
  int b = diff ? (31 - __clz(diff)) : -1;
  u32 prefix = (b >= 31) ? 0u : (vand & ~((2u << b) - 1u));
  if (b < 0) prefix = vand;
  int krem = rank, ncand = n;
  while (b >= 0 && ncand - krem > slack) {
    u32 cand = prefix | (1u << b);
    u32 himask = ~((1u << b) - 1u);
    int c = 0;
#pragma unroll
    for (int k = 0; k < 12; ++k) c += __popcll(__ballot((key[k] & himask) == cand));
    if (c >= krem) { prefix = cand; ncand = c; } else { krem -= c; ncand -= c; }
    --b;
  }
  lo = prefix;
  hi = (b >= 0) ? (prefix | ((2u << b) - 1u)) : prefix;
  limit = (ncand - krem <= slack) ? ncand : krem;
}

__device__ __forceinline__ void idx_load_keys(const Params& p, int tb, int jc, int kcol, int lane, bf16x8 (&bf)[4][2]) {
  const u16* kb = p.ki + ((size_t)((tb + jc) >> 4) * 8 + (lane >> 4)) * 128 + kcol * 8;
#pragma unroll
  for (int u = 0; u < 4; ++u) {
    bf[u][0] = *reinterpret_cast<const bf16x8*>(kb + u * 1024);
    bf[u][1] = *reinterpret_cast<const bf16x8*>(kb + u * 1024 + 512);
  }
}
__device__ __forceinline__ void idx_compact(u32* cv, u16* ci, int n, int lane, int& newcnt, float& newthr) {
  u32 key[12]; u16 idx[12];
#pragma unroll
  for (int k = 0; k < 12; ++k) {
    int e = lane + 64 * k;
    bool in = e < n;
    key[k] = in ? sortable(cv[e]) : 0u;
    idx[k] = in ? ci[e] : (u16)0;
  }
  u32 lo, hi; int limit;
  radix_partition(key, n, 256, 64, lo, hi, limit);
  int base = 0, tcnt = 0;
#pragma unroll
  for (int k = 0; k < 12; ++k) {
    bool eq = key[k] >= lo && key[k] <= hi;
    unsigned long long meq = __ballot(eq);
    bool keep = (key[k] > hi) || (eq && (tcnt + mbcnt64(meq)) < limit);
    unsigned long long m = __ballot(keep);
    int pos = base + mbcnt64(m);
    if (keep) { cv[pos] = unsortable(key[k]); ci[pos] = idx[k]; }
    base += __popcll(m);
    tcnt += __popcll(meq);
  }
  newcnt = base;
  newthr = (lo <= 0x007FFFFFu) ? -INFINITY : __uint_as_float(unsortable(lo));
}

__device__ void unit_indexer(const Params& p, char* smem, int unit) {
  const int tid = threadIdx.x, lane = tid & 63, wid = tid >> 6;
  const int b = unit >> 10, grp = unit & 1023;
  const int tb = b * SEQ, i0 = grp * 16;
  u32* cval = reinterpret_cast<u32*>(smem);
  u16* cidx = reinterpret_cast<u16*>(smem + 16 * CAP * 4);
  __syncthreads();
  const int qsub = lane >> 4;
  const int ql = wid * 4 + qsub;
  const int iq = i0 + ql;
  const int kcol = lane & 15;
  bf16x8 afr[2];
  {
    const u16* qa = p.qi + ((size_t)(tb + i0 + wid * 4 + (kcol >> 2)) * 4 + (kcol & 3)) * 64 + 8 * (lane >> 4);
    const float wa = p.wi[(size_t)(tb + i0 + wid * 4 + (kcol >> 2)) * 4 + (kcol & 3)];
#pragma unroll
    for (int hh = 0; hh < 2; ++hh) {
      uint4 raw = *reinterpret_cast<const uint4*>(qa + 32 * hh);
      float f[8];
      unpack8(raw, f);
#pragma unroll
      for (int e = 0; e < 8; ++e) f[e] *= wa;
      uint4 pk = pack8(f);
      afr[hh] = __builtin_bit_cast(bf16x8, pk);
    }
  }
  const float4 w4 = *reinterpret_cast<const float4*>(p.wi + (size_t)(tb + iq) * 4);
  const float lim0 = (w4.x > 0.f) ? INFINITY : -INFINITY, lim1 = (w4.y > 0.f) ? INFINITY : -INFINITY;
  const float lim2 = (w4.z > 0.f) ? INFINITY : -INFINITY, lim3 = (w4.w > 0.f) ? INFINITY : -INFINITY;
  float thr = -INFINITY;
  const int kmul = 64;
  int cntr = 0;
  u32* myval = cval + ql * CAP;
  u16* myidx = cidx + ql * CAP;
  const u32 lowmask = (1u << kcol) - 1u;
  const int nchunks = (grp + 1 + 3) >> 2;

  auto process = [&](const bf16x8 (&bf)[4][2], int jc) {
    f32x4 acc[4];
#pragma unroll
    for (int u = 0; u < 4; ++u) {
      f32x4 z = {0.f, 0.f, 0.f, 0.f};
      acc[u] = __builtin_amdgcn_mfma_f32_16x16x32_bf16(afr[0], bf[u][0], z, 0, 0, 0);
    }
#pragma unroll
    for (int u = 0; u < 4; ++u) acc[u] = __builtin_amdgcn_mfma_f32_16x16x32_bf16(afr[1], bf[u][1], acc[u], 0, 0, 0);
    float sc[4];
    bool ps[4];
    bool anyp = false;
#pragma unroll
    for (int u = 0; u < 4; ++u) {
      float r0 = __builtin_amdgcn_fmed3f(acc[u][0], 0.f, lim0), r1 = __builtin_amdgcn_fmed3f(acc[u][1], 0.f, lim1);
      float r2 = __builtin_amdgcn_fmed3f(acc[u][2], 0.f, lim2), r3 = __builtin_amdgcn_fmed3f(acc[u][3], 0.f, lim3);
      float s = (r0 + r1) + (r2 + r3);
      s += 0.0f;
      sc[u] = s;
      ps[u] = ((jc + 16 * u + kcol) <= iq) && (s > thr);
      anyp |= ps[u];
    }
    if (__ballot(anyp)) {
#pragma unroll
      for (int u = 0; u < 4; ++u) {
        unsigned long long m = __ballot(ps[u]);
        u32 g16 = (u32)(m >> (16 * qsub)) & 0xFFFFu;
        int slot = cntr + __popc(g16 & lowmask);
        if (ps[u] && slot < CAP) { myval[slot] = __float_as_uint(sc[u]); myidx[slot] = (u16)(jc + 16 * u + kcol); }
        cntr += __popc(g16);
      }
      unsigned long long need = __ballot(cntr > CAP - 64);
      while (need) {
        int l = __ffsll((long long)need) - 1;
        int qc = l >> 4;
        need &= ~(0xFFFFull << (qc * 16));
        int qlc = wid * 4 + qc;
        int n = __builtin_amdgcn_readlane(cntr, qc * 16);
        if (n > CAP) n = CAP;
        int nc; float nt;
        idx_compact(cval + qlc * CAP, cidx + qlc * CAP, n, lane, nc, nt);
        if (qsub == qc) { thr = nt; cntr = nc; }
      }
    }
  };

  bf16x8 bA[4][2], bB[4][2];
  const int lastc = nchunks - 1;
  idx_load_keys(p, tb, 0, kcol, lane, bA);
  for (int ch = 0; ch < nchunks; ch += 2) {
    idx_load_keys(p, tb, min(ch + 1, lastc) * kmul, kcol, lane, bB);
    process(bA, ch * 64);
    idx_load_keys(p, tb, min(ch + 2, lastc) * kmul, kcol, lane, bA);
    if (ch + 1 < nchunks) process(bB, (ch + 1) * 64);
  }
  for (int qc = 0; qc < 4; ++qc) {
    int qlc = wid * 4 + qc;
    int n = __builtin_amdgcn_readlane(cntr, qc * 16);
    if (n > CAP) n = CAP;
    u32* cv = cval + qlc * CAP; u16* ci = cidx + qlc * CAP;
    u16* out = p.sel + (size_t)(tb + i0 + qlc) * 256;
    if (n <= 256) {
#pragma unroll
      for (int k = 0; k < 4; ++k) {
        int e = lane + 64 * k;
        out[e] = (e < n) ? ci[e] : (u16)0xFFFF;
      }
    } else {
      u32 key[12]; u16 idx[12];
#pragma unroll
      for (int k = 0; k < 12; ++k) {
        int e = lane + 64 * k;
        bool in = e < n;
        key[k] = in ? sortable(cv[e]) : 0u;
        idx[k] = in ? ci[e] : (u16)0;
      }
      u32 lo, hi; int limit;
      radix_partition(key, n, 256, 0, lo, hi, limit);
      int base = 0, tcnt = 0;
#pragma unroll
      for (int k = 0; k < 12; ++k) {
        bool eq = key[k] >= lo && key[k] <= hi;
        unsigned long long meq = __ballot(eq);
        bool keep = (key[k] > hi) || (eq && (tcnt + mbcnt64(meq)) < limit);
        unsigned long long m = __ballot(keep);
        int pos = base + mbcnt64(m);
        if (keep && pos < 256) ci[pos] = idx[k];
        base += __popcll(m);
        tcnt += __popcll(meq);
      }
      __builtin_amdgcn_wave_barrier();
      *reinterpret_cast<uint2*>(out + lane * 4) = *reinterpret_cast<const uint2*>(ci + lane * 4);
      __builtin_amdgcn_wave_barrier();
    }
  }
}

__device__ void phase_attn(const Params& p, char* smem) {
  const int tid = threadIdx.x, lane = tid & 63, wid = tid >> 6;
  constexpr int WSTRIDE = 13312;
  u16* lidx = reinterpret_cast<u16*>(smem + wid * WSTRIDE);
  float* Pt = reinterpret_cast<float*>(smem + wid * WSTRIDE + 512);
  char* tile = smem + wid * WSTRIDE + 1024;
  const float sq = p.scal[0];
  const float lf = 0.08838834764831845f * 1.4426950408889634f * p.scal[3];
  const float ovs = p.scal[4];
  const int xq = blockIdx.x & 7;
  const int b = xq & 1;
  const int rblk = (blockIdx.x >> 3) * 4 + (xq >> 1);
  const int nrb = (gridDim.x >> 3) * 4;
  const int n16 = lane & 15, g4 = lane >> 4;
  for (int i = rblk * 4 + wid; i < SEQ; i += nrb * 4) {
    const int tq = b * SEQ + i;
    const size_t tb = (size_t)b * SEQ;
    __builtin_amdgcn_wave_barrier();
    {
      uint2 v = *reinterpret_cast<const uint2*>(p.sel + (size_t)tq * 256 + lane * 4);
      *reinterpret_cast<uint2*>(lidx + lane * 4) = v;
    }
    __builtin_amdgcn_wave_barrier();
    long qf[4];
#pragma unroll
    for (int s = 0; s < 4; ++s) {
      qf[s] = 0;
      if (n16 < 4) {
        float qv[8];
        unpack8(*reinterpret_cast<const uint4*>(p.qh + (size_t)tq * 512 + n16 * 128 + 32 * s + 8 * g4), qv);
        int w0 = __builtin_amdgcn_cvt_pk_fp8_f32(qv[0] * sq, qv[1] * sq, 0, false);
        w0 = __builtin_amdgcn_cvt_pk_fp8_f32(qv[2] * sq, qv[3] * sq, w0, true);
        int w1 = __builtin_amdgcn_cvt_pk_fp8_f32(qv[4] * sq, qv[5] * sq, 0, false);
        w1 = __builtin_amdgcn_cvt_pk_fp8_f32(qv[6] * sq, qv[7] * sq, w1, true);
        qf[s] = (long)(((unsigned long long)(u32)w1 << 32) | (unsigned long long)(u32)w0);
      }
    }
    float mrun[4] = {-1e30f, -1e30f, -1e30f, -1e30f}, lrun[4] = {0.f, 0.f, 0.f, 0.f};
    float2_t o2[4][4];
#pragma unroll
    for (int h = 0; h < 4; ++h)
#pragma unroll
      for (int j = 0; j < 4; ++j) { o2[h][j].x = 0.f; o2[h][j].y = 0.f; }
    u32x4 kr[8];
#pragma unroll
    for (int r = 0; r < 8; ++r) {
      int id = lidx[r * 4 + g4];
      int idc = (id <= i) ? id : 0;
      kr[r] = *reinterpret_cast<const u32x4*>(p.kv8 + (tb + idc) * 256 + n16 * 16);
    }
#pragma unroll 1
    for (int g2 = 0; g2 < 8; ++g2) {
      __builtin_amdgcn_wave_barrier();
#pragma unroll
      for (int r = 0; r < 8; ++r) *reinterpret_cast<u32x4*>(tile + (r * 4 + g4) * 272 + n16 * 16) = kr[r];
      __builtin_amdgcn_wave_barrier();
      {
        const int gn = (g2 < 7) ? g2 + 1 : 7;
#pragma unroll
        for (int r = 0; r < 8; ++r) {
          int id = lidx[gn * 32 + r * 4 + g4];
          int idc = (id <= i) ? id : 0;
          kr[r] = *reinterpret_cast<const u32x4*>(p.kv8 + (tb + idc) * 256 + n16 * 16);
        }
      }
      float sc[2][4];
#pragma unroll
      for (int tt = 0; tt < 2; ++tt) {
        int id = lidx[g2 * 32 + tt * 16 + n16];
        bool valid = id <= i;
        f32x4 acc = {0.f, 0.f, 0.f, 0.f};
#pragma unroll
        for (int s = 0; s < 4; ++s) {
          long kf = *reinterpret_cast<const long*>(tile + (tt * 16 + n16) * 272 + 32 * s + 8 * g4);
          acc = __builtin_amdgcn_mfma_f32_16x16x32_fp8_fp8(qf[s], kf, acc, 0, 0, 0);
        }
#pragma unroll
        for (int h = 0; h < 4; ++h) sc[tt][h] = valid ? acc[h] * lf : -1e30f;
      }
      float alpha[4], pp[2][4];
#pragma unroll
      for (int h = 0; h < 4; ++h) {
        float mg = max16(fmaxf(sc[0][h], sc[1][h]));
        float mnew = fmaxf(mrun[h], __int_as_float(__builtin_amdgcn_readfirstlane(__float_as_int(mg))));
        alpha[h] = __builtin_amdgcn_exp2f(mrun[h] - mnew);
        mrun[h] = mnew;
        pp[0][h] = __builtin_amdgcn_exp2f(sc[0][h] - mnew);
        pp[1][h] = __builtin_amdgcn_exp2f(sc[1][h] - mnew);
        float ls = sum16(pp[0][h] + pp[1][h]);
        lrun[h] = lrun[h] * alpha[h] + __int_as_float(__builtin_amdgcn_readfirstlane(__float_as_int(ls)));
      }
      if (lane < 16) {
        *reinterpret_cast<float4*>(Pt + lane * 4) = make_float4(pp[0][0], pp[0][1], pp[0][2], pp[0][3]);
        *reinterpret_cast<float4*>(Pt + (16 + lane) * 4) = make_float4(pp[1][0], pp[1][1], pp[1][2], pp[1][3]);
      }
#pragma unroll
      for (int h = 0; h < 4; ++h) {
        float2_t a2 = {alpha[h], alpha[h]};
#pragma unroll
        for (int j = 0; j < 4; ++j) o2[h][j] *= a2;
      }
      __builtin_amdgcn_wave_barrier();
#pragma unroll
      for (int it = 0; it < 8; ++it) {
        const int nk = it * 4 + g4;
        float4 pw = *reinterpret_cast<const float4*>(Pt + nk * 4);
        uint2 q = *reinterpret_cast<const uint2*>(tile + nk * 272 + 128 + n16 * 8);
        float2_t v2[4] = {__builtin_amdgcn_cvt_pk_f32_fp8((int)q.x, false), __builtin_amdgcn_cvt_pk_f32_fp8((int)q.x, true),
                          __builtin_amdgcn_cvt_pk_f32_fp8((int)q.y, false), __builtin_amdgcn_cvt_pk_f32_fp8((int)q.y, true)};
        float pv[4] = {pw.x, pw.y, pw.z, pw.w};
#pragma unroll
        for (int h = 0; h < 4; ++h) {
          float2_t ph = {pv[h], pv[h]};
#pragma unroll
          for (int j = 0; j < 4; ++j) o2[h][j] += ph * v2[j];
        }
      }
      __builtin_amdgcn_wave_barrier();
    }
#pragma unroll
    for (int h = 0; h < 4; ++h) {
      float inv = ovs * __builtin_amdgcn_rcpf(lrun[h]);
      float ov[8];
#pragma unroll
      for (int j = 0; j < 4; ++j) {
        float x0 = o2[h][j].x, x1 = o2[h][j].y;
        x0 += __shfl_xor(x0, 16); x0 += __shfl_xor(x0, 32);
        x1 += __shfl_xor(x1, 16); x1 += __shfl_xor(x1, 32);
        ov[2 * j] = x0 * inv; ov[2 * j + 1] = x1 * inv;
      }
      if (g4 == 0) *reinterpret_cast<uint4*>(p.yb + (size_t)tq * 512 + h * 128 + n16 * 8) = pack8(ov);
    }
  }
}

__device__ void phase_merge(const Params& p, char* smem) {
  const int tid = threadIdx.x, lane = tid & 63, wid = tid >> 6;
  float* cs = reinterpret_cast<float*>(smem);
  constexpr int NTILES = (T / 128) * 8;
  int mt, nt;
  bool have = tile_swizzle(0, 8, NTILES, mt, nt);
  Tile4 ra, rb;
  if (have) gemm_prefetch(p.ya + (size_t)mt * 128 * 512, 512, p.WaT + (size_t)nt * 128 * 512, 512, 512, ra, rb);
  for (int step = 0; have; ++step) {
    int m0 = mt * 128, n0 = nt * 128;
    f32x16 acc[2][2];
    zero_acc(acc);
    gemm_mainloop(p.ya + (size_t)m0 * 512, 512, p.WaT + (size_t)n0 * 512, 512, 512, acc, smem, ra, rb);
    stage_acc(acc, cs);
    __syncthreads();
    gemm_prefetch(p.yb + (size_t)m0 * 512, 512, p.WbT + (size_t)n0 * 512, 512, 512, ra, rb);
#pragma unroll 2
    for (int it = 0; it < 8; ++it) {
      const int row = wid * 32 + it * 4 + (lane >> 4), c0 = (lane & 15) * 8;
      float v[8], g[8];
      load8(cs + row * CS_LD + c0, v);
      unpack8(*reinterpret_cast<const uint4*>(p.sg + (size_t)(m0 + row) * 2048 + n0 + c0), g);
#pragma unroll
      for (int e = 0; e < 8; ++e) v[e] *= g[e];
      *reinterpret_cast<uint4*>(p.merged + (size_t)(m0 + row) * 1024 + n0 + c0) = pack8(v);
    }
    __syncthreads();
    zero_acc(acc);
    gemm_mainloop(p.yb + (size_t)m0 * 512, 512, p.WbT + (size_t)n0 * 512, 512, 512, acc, smem, ra, rb);
    stage_acc(acc, cs);
    __syncthreads();
    int mt2 = 0, nt2 = 0;
    const bool nxt = tile_swizzle(step + 1, 8, NTILES, mt2, nt2);
    if (nxt) gemm_prefetch(p.ya + (size_t)mt2 * 128 * 512, 512, p.WaT + (size_t)nt2 * 128 * 512, 512, 512, ra, rb);
#pragma unroll 2
    for (int it = 0; it < 8; ++it) {
      const int row = wid * 32 + it * 4 + (lane >> 4), c0 = (lane & 15) * 8;
      float v[8], g[8], pa[8];
      load8(cs + row * CS_LD + c0, v);
      unpack8(*reinterpret_cast<const uint4*>(p.sg + (size_t)(m0 + row) * 2048 + 1024 + n0 + c0), g);
      uint4* mp = reinterpret_cast<uint4*>(p.merged + (size_t)(m0 + row) * 1024 + n0 + c0);
      unpack8(*mp, pa);
#pragma unroll
      for (int e = 0; e < 8; ++e) v[e] = pa[e] + v[e] * g[e];
      *mp = pack8(v);
    }
    mt = mt2; nt = nt2; have = nxt;
  }
}

__device__ void phase_wo(const Params& p, char* smem) {
  const int tid = threadIdx.x, lane = tid & 63, wid = tid >> 6;
  float* cs = reinterpret_cast<float*>(smem);
  constexpr int NTILES = (T / 128) * 8;
  int mt, nt;
  bool have = tile_swizzle(0, 8, NTILES, mt, nt);
  Tile4 ra, rb;
  if (have) gemm_prefetch(p.merged + (size_t)mt * 128 * 1024, 1024, p.WoT + (size_t)nt * 128 * 1024, 1024, 1024, ra, rb);
  for (int step = 0; have; ++step) {
    int m0 = mt * 128, n0 = nt * 128;
    f32x16 acc[2][2];
    zero_acc(acc);
    gemm_mainloop(p.merged + (size_t)m0 * 1024, 1024, p.WoT + (size_t)n0 * 1024, 1024, 1024, acc, smem, ra, rb);
    stage_acc(acc, cs);
    __syncthreads();
    int mt2 = 0, nt2 = 0;
    const bool nxt = tile_swizzle(step + 1, 8, NTILES, mt2, nt2);
    if (nxt) gemm_prefetch(p.merged + (size_t)mt2 * 128 * 1024, 1024, p.WoT + (size_t)nt2 * 128 * 1024, 1024, 1024, ra, rb);
#pragma unroll 2
    for (int it = 0; it < 8; ++it) {
      const int row = wid * 32 + it * 4 + (lane >> 4), c0 = (lane & 15) * 8;
      const size_t t = (size_t)m0 + row;
      float v[8], xv[8];
      load8(cs + row * CS_LD + c0, v);
      load8(p.x + t * 1024 + n0 + c0, xv);
      float ss = 0.f;
#pragma unroll
      for (int e = 0; e < 8; ++e) { v[e] += xv[e]; ss += v[e] * v[e]; }
      *reinterpret_cast<uint4*>(p.h1b + t * 1024 + n0 + c0) = pack8(v);
      ss = sum16(ss);
      if ((lane & 15) == 0) p.ssq[(size_t)nt * T + t] = ss;
    }
    mt = mt2; nt = nt2; have = nxt;
  }
}

__device__ __forceinline__ void ins16(float (&l)[16], float v) {
#pragma unroll
  for (int q = 15; q >= 1; --q) l[q] = __builtin_amdgcn_fmed3f(v, l[q - 1], l[q]);
  l[0] = fmaxf(l[0], v);
}
__device__ void phase_peerq(const Params& p, char* smem) {
  const int tid = threadIdx.x, lane = tid & 63, wid = tid >> 6;
  const int wr = wid >> 1, wc = wid & 1;
  float* cs = reinterpret_cast<float*>(smem);
  constexpr int NTILES = (T / 128) * 16;
  int mt, hp;
  bool have = tile_swizzle(0, 16, NTILES, mt, hp);
  Tile4 ra, rb;
  if (have) gemm_prefetch(p.h1b + (size_t)mt * 128 * 1024, 1024, p.WqT + (size_t)hp * 128 * 1024, 1024, 1024, ra, rb);
  for (int step = 0; have; ++step) {
    int m0 = mt * 128;
    f32x16 acc[2][2];
    zero_acc(acc);
    gemm_mainloop(p.h1b + (size_t)m0 * 1024, 1024, p.WqT + (size_t)hp * 128 * 1024, 1024, 1024, acc, smem, ra, rb);
#pragma unroll
    for (int i = 0; i < 2; ++i)
#pragma unroll
      for (int j = 0; j < 2; ++j)
#pragma unroll
        for (int r = 0; r < 16; ++r) {
          int row = wr * 64 + i * 32 + (r & 3) + 8 * (r >> 2) + 4 * (lane >> 5);
          int col = wc * 64 + j * 32 + (lane & 31);
          *reinterpret_cast<u16*>(smem + (col >> 6) * ABUF + row * 144 + (col & 63) * 2) = f2bf(acc[i][j][r]);
        }
    {
      const u16* sk = p.SubK + (size_t)hp * 128 * 128;
#pragma unroll
      for (int i = 0; i < 8; ++i) {
        int c = tid + 256 * i;
        int row = c >> 4, kc = c & 15;
        uint4 q = *reinterpret_cast<const uint4*>(sk + row * 128 + kc * 8);
        *reinterpret_cast<uint4*>(smem + (2 + (kc >> 3)) * ABUF + row * 144 + (kc & 7) * 16) = q;
      }
    }
    __syncthreads();
    zero_acc(acc);
    mma_ktile(smem, smem + 2 * ABUF, acc);
    mma_ktile(smem + ABUF, smem + 3 * ABUF, acc);
    __syncthreads();
    stage_acc(acc, cs);
    __syncthreads();
    int mt2 = 0, hp2 = 0;
    const bool nxt = tile_swizzle(step + 1, 16, NTILES, mt2, hp2);
    if (nxt) gemm_prefetch(p.h1b + (size_t)mt2 * 128 * 1024, 1024, p.WqT + (size_t)hp2 * 128 * 1024, 1024, 1024, ra, rb);
    {
      int row = tid >> 1, half = tid & 1;
      float* rp = cs + row * CS_LD + half * 64;
      float l[16];
#pragma unroll
      for (int q = 0; q < 16; ++q) l[q] = -INFINITY;
      for (int c = 0; c < 64; c += 4) {
        float4 v4 = *reinterpret_cast<const float4*>(rp + c);
        float vv[4] = {v4.x, v4.y, v4.z, v4.w};
#pragma unroll
        for (int e = 0; e < 4; ++e) {
          u32 bits = __float_as_uint(vv[e]);
          u32 n = (u32)(half * 64 + c + e);
          bits = (bits & ~127u) | ((bits >> 31) ? n : (127u - n));
          ins16(l, __uint_as_float(bits));
        }
      }
#pragma unroll
      for (int q = 0; q < 16; ++q) rp[q] = l[q];
    }
    __syncthreads();
    if (tid < 128) {
      int row = tid;
      size_t t = (size_t)m0 + row;
      const float* la = cs + row * CS_LD;
      const float* lb = la + 64;
      float ssum = 0.f;
#pragma unroll
      for (int q = 0; q < 8; ++q) ssum += p.ssq[(size_t)q * T + t];
      float rt = rsqrtf(ssum * (1.f / 1024.f) + EPS);
      int ia = 0, ib = 0;
      float* ov = p.stv + ((size_t)hp * T + t) * 16;
      u8* oi = p.sti + ((size_t)hp * T + t) * 16;
      float ovv[16]; u32 oii[4] = {0u, 0u, 0u, 0u};
#pragma unroll
      for (int q = 0; q < 16; ++q) {
        float va = la[ia], vb = lb[ib];
        bool ta = va >= vb;
        float v = ta ? va : vb;
        ia += ta ? 1 : 0;
        ib += ta ? 0 : 1;
        u32 bits = __float_as_uint(v);
        u32 low = bits & 127u;
        u32 n = (bits >> 31) ? low : (127u - low);
        ovv[q] = __uint_as_float(bits & ~127u) * rt;
        oii[q >> 2] |= n << (8 * (q & 3));
      }
#pragma unroll
      for (int q = 0; q < 4; ++q) *reinterpret_cast<float4*>(ov + 4 * q) = make_float4(ovv[4 * q], ovv[4 * q + 1], ovv[4 * q + 2], ovv[4 * q + 3]);
      *reinterpret_cast<uint4*>(oi) = make_uint4(oii[0], oii[1], oii[2], oii[3]);
    }
    mt = mt2; hp = hp2; have = nxt;
  }
}

__device__ void phase_peer(const Params& p, char* smem) {
  const int tid = threadIdx.x, lane = tid & 63, wid = tid >> 6;
  int* pe_e = reinterpret_cast<int*>(smem + wid * 4096);
  float* pe_su = reinterpret_cast<float*>(smem + wid * 4096 + 512);
  float* pe_gv = reinterpret_cast<float*>(smem + wid * 4096 + 1024);
  float* svl = reinterpret_cast<float*>(smem + wid * 4096 + 1536);
  u8* sil = reinterpret_cast<u8*>(smem + wid * 4096 + 2560);
  const int h = lane >> 3, g = lane & 7;
  u32 prt[7];
#pragma unroll
  for (int c = 0; c < 7; ++c) prt[c] = PAIR_TAB[g * 7 + c];
  float4 nsv = make_float4(0.f, 0.f, 0.f, 0.f); uint4 nsi = make_uint4(0u, 0u, 0u, 0u);
  {
    int tq0 = blockIdx.x * 4 + wid;
    if (tq0 < T) {
      nsv = *reinterpret_cast<const float4*>(p.stv + ((size_t)(lane >> 2) * T + tq0) * 16 + (lane & 3) * 4);
      if (lane < 16) nsi = *reinterpret_cast<const uint4*>(p.sti + ((size_t)lane * T + tq0) * 16);
    }
  }
  for (int tq = blockIdx.x * 4 + wid; tq < T; tq += gridDim.x * 4) {
    const size_t t = tq;
    __builtin_amdgcn_wave_barrier();
    *reinterpret_cast<float4*>(svl + lane * 4) = nsv;
    if (lane < 16) *reinterpret_cast<uint4*>(sil + lane * 16) = nsi;
    __builtin_amdgcn_wave_barrier();
    {
      int tqn = tq + gridDim.x * 4;
      if (tqn < T) {
        nsv = *reinterpret_cast<const float4*>(p.stv + ((size_t)(lane >> 2) * T + tqn) * 16 + (lane & 3) * 4);
        if (lane < 16) nsi = *reinterpret_cast<const uint4*>(p.sti + ((size_t)lane * T + tqn) * 16);
      }
    }
    const float* s1 = svl + (2 * h) * 16;
    const float* s2 = s1 + 16;
    float l[16];
#pragma unroll
    for (int q = 0; q < 16; ++q) l[q] = -INFINITY;
#pragma unroll
    for (int c = 0; c < 7; ++c) {
      u32 pr = prt[c];
      float v = -INFINITY;
      if (pr != 0xffu) {
        float a = s1[pr >> 4] + s2[pr & 15];
        u32 bits = __float_as_uint(a);
        bits = (bits & ~255u) | ((bits >> 31) ? pr : (255u - pr));
        v = __uint_as_float(bits);
      }
      ins16(l, v);
    }
#pragma unroll
    for (int msk = 1; msk <= 4; msk <<= 1) {
      float c[16];
#pragma unroll
      for (int q = 0; q < 16; ++q) c[q] = __shfl_xor(l[15 - q], msk);
#pragma unroll
      for (int q = 0; q < 16; ++q) c[q] = fmaxf(l[q], c[q]);
#pragma unroll
      for (int st = 8; st >= 1; st >>= 1)
#pragma unroll
        for (int q = 0; q < 16; ++q)
          if ((q & st) == 0) {
            float hi = fmaxf(c[q], c[q + st]), lo = fminf(c[q], c[q + st]);
            c[q] = hi; c[q + st] = lo;
          }
#pragma unroll
      for (int q = 0; q < 16; ++q) l[q] = c[q];
    }
    {
      float m = -INFINITY, ssum = 0.f;
      float bvv[16];
#pragma unroll
      for (int q = 0; q < 16; ++q) {
        u32 bits = __float_as_uint(l[q]);
        u32 low = bits & 255u;
        int prq = (int)((bits >> 31) ? low : (255u - low));
        bvv[q] = s1[prq >> 4] + s2[prq & 15];
        m = fmaxf(m, bvv[q]);
      }
#pragma unroll
      for (int q = 0; q < 16; ++q) { bvv[q] = __expf(bvv[q] - m); ssum += bvv[q]; }
      float inv = 1.f / ssum;
      const u8* i1 = sil + (2 * h) * 16;
      const u8* i2 = i1 + 16;
#pragma unroll
      for (int q = 0; q < 16; ++q) {
        if ((q >> 1) == g) {
          u32 bits = __float_as_uint(l[q]);
          u32 low = bits & 255u;
          int prq = (int)((bits >> 31) ? low : (255u - low));
          int exi = (int)i1[prq >> 4] * 128 + (int)i2[prq & 15];
          pe_e[h * 16 + q] = exi;
          pe_su[h * 16 + q] = p.su[exi];
          pe_gv[h * 16 + q] = bvv[q] * inv * p.sv[exi];
        }
      }
      __builtin_amdgcn_wave_barrier();
    }
    float rt;
    {
      float ssum = 0.f;
#pragma unroll
      for (int q = 0; q < 8; ++q) ssum += p.ssq[(size_t)q * T + t];
      rt = rsqrtf(ssum * (1.f / 1024.f) + EPS);
    }
    float2_t h2[8];
    {
      uint4 hx0 = *reinterpret_cast<const uint4*>(p.h1b + t * 1024 + lane * 16);
      uint4 hx1 = *reinterpret_cast<const uint4*>(p.h1b + t * 1024 + lane * 16 + 8);
      u32 hw[8] = {hx0.x, hx0.y, hx0.z, hx0.w, hx1.x, hx1.y, hx1.z, hx1.w};
#pragma unroll
      for (int q = 0; q < 8; ++q) { h2[q].x = bf_lo(hw[q]); h2[q].y = bf_hi(hw[q]); }
    }
    float2_t y2[8];
#pragma unroll
    for (int q = 0; q < 8; ++q) { y2[q].x = 0.f; y2[q].y = 0.f; }
    const int kk = (lane >> 3) & 7;
    for (int e0 = 0; e0 < 128; e0 += 8) {
      uint4 ur[8], vr[8];
#pragma unroll
      for (int k = 0; k < 8; ++k) {
        int ex = pe_e[e0 + k];
        ur[k] = *reinterpret_cast<const uint4*>(p.U8 + (size_t)ex * 1024 + lane * 16);
        vr[k] = *reinterpret_cast<const uint4*>(p.V8 + (size_t)ex * 1024 + lane * 16);
      }
      float d[8];
#pragma unroll
      for (int k = 0; k < 8; ++k) {
        u32 uw[4] = {ur[k].x, ur[k].y, ur[k].z, ur[k].w};
        float2_t acc = {0.f, 0.f};
#pragma unroll
        for (int q = 0; q < 4; ++q) {
          acc += __builtin_amdgcn_cvt_pk_f32_fp8((int)uw[q], false) * h2[2 * q];
          acc += __builtin_amdgcn_cvt_pk_f32_fp8((int)uw[q], true) * h2[2 * q + 1];
        }
        d[k] = acc.x + acc.y;
      }
      float e4[4], f2[2], gsum;
      {
        const bool hi = (lane & 32) != 0;
#pragma unroll
        for (int k = 0; k < 4; ++k) {
          float snd = hi ? d[k] : d[k + 4], kp = hi ? d[k + 4] : d[k];
          e4[k] = kp + __shfl_xor(snd, 32);
        }
        const bool hb = (lane & 16) != 0;
#pragma unroll
        for (int k = 0; k < 2; ++k) {
          float snd = hb ? e4[k] : e4[k + 2], kp = hb ? e4[k + 2] : e4[k];
          f2[k] = kp + __shfl_xor(snd, 16);
        }
        const bool hc = (lane & 8) != 0;
        float snd = hc ? f2[0] : f2[1], kp = hc ? f2[1] : f2[0];
        gsum = kp + __shfl_xor(snd, 8);
        gsum += __shfl_xor(gsum, 4);
        gsum += __shfl_xor(gsum, 2);
        gsum += __shfl_xor(gsum, 1);
      }
      float cme = pe_gv[e0 + kk] * gelu_f(gsum * rt * pe_su[e0 + kk]);
#pragma unroll
      for (int k = 0; k < 8; ++k) {
        float ck = __int_as_float(__builtin_amdgcn_readlane(__float_as_int(cme), k * 8));
        float2_t c2 = {ck, ck};
        u32 vw[4] = {vr[k].x, vr[k].y, vr[k].z, vr[k].w};
#pragma unroll
        for (int q = 0; q < 4; ++q) {
          y2[2 * q] += c2 * __builtin_amdgcn_cvt_pk_f32_fp8((int)vw[q], false);
          y2[2 * q + 1] += c2 * __builtin_amdgcn_cvt_pk_f32_fp8((int)vw[q], true);
        }
      }
    }
    float* op = p.out + t * 1024 + lane * 16;
#pragma unroll
    for (int q = 0; q < 4; ++q) {
      float4 a = make_float4(h2[2 * q].x + y2[2 * q].x, h2[2 * q].y + y2[2 * q].y, h2[2 * q + 1].x + y2[2 * q + 1].x, h2[2 * q + 1].y + y2[2 * q + 1].y);
      *reinterpret_cast<float4*>(op + 4 * q) = a;
    }
    __builtin_amdgcn_wave_barrier();
  }
}

__device__ void phase_mix(const Params& p, char* smem) {
  const int G = gridDim.x;
  {
    int* qslot = reinterpret_cast<int*>(smem + EXTRA_OFF + 1024);
    for (;;) {
      __syncthreads();
      if (threadIdx.x == 0) *qslot = (int)__hip_atomic_fetch_add(p.bar + 16, 1u, __ATOMIC_RELAXED, __HIP_MEMORY_SCOPE_AGENT);
      __syncthreads();
      const int s = *qslot;
      if (s >= 2048) break;
      int grp = 1023 - (s >> 1), b = s & 1;
      unit_indexer(p, smem, (b << 10) | grp);
    }
  }
  for (int u = blockIdx.x; u < 1024; u += G) unit_spatial(p, smem, u);
  for (int u = blockIdx.x; u < 256; u += G) unit_kv(p, smem, u);
}

template <int PH>
__device__ __forceinline__ void run_phase(const Params& p, char* smem) {
  if (PH == 0) phase_prep(p, smem);
  else if (PH == 1) phase_gemm1(p, smem);
  else if (PH == 2) phase_mix(p, smem);
  else if (PH == 3) phase_attn(p, smem);
  else if (PH == 4) phase_merge(p, smem);
  else if (PH == 5) phase_wo(p, smem);
  else if (PH == 6) phase_peerq(p, smem);
  else phase_peer(p, smem);
}

template <int PH>
__global__ void __launch_bounds__(NTHREADS, 2) phase_kernel(Params p) {
  __shared__ __attribute__((aligned(16))) char smem[SMEM_BYTES];
  run_phase<PH>(p, smem);
}

#define XB_CNT(j) (64 + 64 * (j))
#define XB_SUB(j) (1088 + 64 * (j))
#define XB_GEN(j) (2112 + 64 * (j))
#define XB_TOP 3136
#define XB_TOPGEN 3200
#define XB_WORDS 3264
__device__ __forceinline__ unsigned xb_ld(unsigned* q) { return __hip_atomic_load(q, __ATOMIC_RELAXED, __HIP_MEMORY_SCOPE_AGENT); }
__device__ __forceinline__ unsigned xb_add(unsigned* q) { return __hip_atomic_fetch_add(q, 1u, __ATOMIC_RELAXED, __HIP_MEMORY_SCOPE_AGENT); }
__device__ __forceinline__ unsigned xb_xcc_id() { return (unsigned)__builtin_amdgcn_s_getreg((3 << 11) | 20) & 0xFu; }
__device__ __forceinline__ void grid_barrier(unsigned* bar, unsigned x, unsigned nloc, unsigned nx) {
  asm volatile("s_waitcnt vmcnt(0)" ::: "memory");
  __syncthreads();
  if (threadIdx.x == 0) {
    const unsigned old = xb_add(&bar[XB_SUB(x)]);
    const unsigned gen = old / nloc;
    if (old + 1u == (gen + 1u) * nloc) {
      __builtin_amdgcn_fence(__ATOMIC_RELEASE, "agent");
      asm volatile("s_waitcnt vmcnt(0)" ::: "memory");
      const unsigned og = xb_add(&bar[XB_TOP]);
      const unsigned tg = og / nx;
      if (og + 1u == (tg + 1u) * nx) xb_add(&bar[XB_TOPGEN]);
      else { unsigned sp = 0; while (xb_ld(&bar[XB_TOPGEN]) == tg) { __builtin_amdgcn_s_sleep(1); if (++sp > (1u << 24)) break; } }
      __builtin_amdgcn_fence(__ATOMIC_ACQUIRE, "agent");
      xb_add(&bar[XB_GEN(x)]);
      asm volatile("s_waitcnt vmcnt(0)" ::: "memory");
    } else {
      unsigned sp = 0;
      while (xb_ld(&bar[XB_GEN(x)]) == gen) { __builtin_amdgcn_s_sleep(1); if (++sp > (1u << 24)) break; }
      __builtin_amdgcn_fence(__ATOMIC_ACQUIRE, "agent");
      asm volatile("s_waitcnt vmcnt(0)" ::: "memory");
    }
  }
  __syncthreads();
}

__global__ void __launch_bounds__(NTHREADS, 2) mega_kernel(Params p) {
  __shared__ __attribute__((aligned(16))) char smem[SMEM_BYTES];
  cg::grid_group grid = cg::this_grid();
#define GSYNC() grid_barrier(p.bar, xb_x, xb_nloc, xb_nx)
  const unsigned xb_x = xb_xcc_id();
  if (threadIdx.x == 0) xb_add(&p.bar[XB_CNT(xb_x)]);
  asm volatile("s_waitcnt vmcnt(0)" ::: "memory");
  grid.sync();
  unsigned xb_nloc = 1, xb_nx = 0;
  if (threadIdx.x == 0) {
    for (unsigned j = 0; j < 16; ++j) { const unsigned c = xb_ld(&p.bar[XB_CNT(j)]); xb_nx += (c > 0u) ? 1u : 0u; if (j == xb_x) xb_nloc = c; }
    if (xb_nloc == 0u) xb_nloc = 1u;
    if (xb_nx == 0u) xb_nx = 1u;
  }
#define RUNP(X) run_phase<X>(p, smem); GSYNC();
  RUNP(0) RUNP(1) RUNP(2) RUNP(3) RUNP(4) RUNP(5) RUNP(6)
  run_phase<7>(p, smem);
}

extern "C" void kernel_launch(void* const* d_in, const int* in_sizes, int n_in, void* d_out, int out_size,
                              void* d_ws, size_t ws_size, hipStream_t stream) {
  Params p{};
  p.x = (const float*)d_in[0]; p.pos = (const int*)d_in[1];
  p.norm1_g = (const float*)d_in[2]; p.w_in = (const float*)d_in[3]; p.v_norm_g = (const float*)d_in[4];
  p.v_norm_b = (const float*)d_in[5]; p.spatial_w = (const float*)d_in[6]; p.spatial_b = (const float*)d_in[7];
  p.kv_norm_g = (const float*)d_in[8]; p.w_uk = (const float*)d_in[9]; p.w_uv = (const float*)d_in[10];
  p.q_norm_g = (const float*)d_in[11]; p.k_norm_g = (const float*)d_in[12]; p.w_a_out = (const float*)d_in[13];
  p.w_b_out = (const float*)d_in[14]; p.w_o = (const float*)d_in[15]; p.norm2_g = (const float*)d_in[16];
  p.peer_wq = (const float*)d_in[17]; p.peer_subkeys = (const float*)d_in[18]; p.peer_u = (const float*)d_in[19];
  p.peer_v = (const float*)d_in[20];
  p.out = (float*)d_out;
  char* w = (char*)d_ws;
  size_t off = 0;
  auto take = [&](size_t bytes) { char* r = w + off; off += (bytes + 255) & ~(size_t)255; return r; };
  const size_t MB = 1u << 20;
  char* r_xn = take(64 * MB);
  p.xn = (u16*)r_xn; p.ya = (u16*)r_xn; p.yb = (u16*)(r_xn + 32 * MB);
  p.WinT = (u16*)take((size_t)NWIN * 1024 * 2);
  p.WaT = (u16*)take(1024 * 512 * 2); p.WbT = (u16*)take(1024 * 512 * 2);
  p.WoT = (u16*)take(1024 * 1024 * 2); p.WqT = (u16*)take(2048 * 1024 * 2);
  p.WkvT = (u16*)take(256 * 256 * 2); p.SubK = (u16*)take(262144 * 2); p.Wtril = (u16*)take(65536 * 2);
  p.U8 = (u8*)take(16 * MB); p.V8 = (u8*)take(16 * MB);
  p.su = (float*)take(16384 * 4); p.sv = (float*)take(16384 * 4);
  char* r_g = take(96 * MB);
  p.gu = (u16*)r_g; p.gv = (u16*)(r_g + 32 * MB); p.qh = (u16*)(r_g + 64 * MB); p.merged = (u16*)r_g;
  p.ckv = (u16*)take(16 * MB); p.qi = (u16*)take(16 * MB); p.ki = (u16*)take(4 * MB);
  p.wi = (float*)take((size_t)T * 4 * 4);
  char* r_sg = take(128 * MB);
  p.sg = (u16*)r_sg; p.h1b = (u16*)r_sg; p.stv = (float*)(r_sg + 64 * MB); p.sti = (u8*)(r_sg + 96 * MB);
  p.sel = (u16*)take(16 * MB);
  p.kv8 = (u8*)take(8 * MB); p.scal = (float*)take(256);
  p.ssq = (float*)take((size_t)T * 8 * 4);
  p.bar = (unsigned*)take(XB_WORDS * 4);
  p.rtab = (float*)take((size_t)T * 48 * 4);
  if (off > ws_size) { fprintf(stderr, "workspace too small: need %zu have %zu\n", off, ws_size); return; }

  static int grid_blocks = 0;
  if (!grid_blocks) {
    int dev = 0, cus = 0, per_cu = 0;
    hipGetDevice(&dev);
    hipDeviceGetAttribute(&cus, hipDeviceAttributeMultiprocessorCount, dev);
    hipOccupancyMaxActiveBlocksPerMultiprocessor(&per_cu, mega_kernel, NTHREADS, 0);
    if (per_cu > 2) per_cu = 2;
    if (per_cu < 1) per_cu = 1;
    grid_blocks = cus * per_cu;
  }
  hipMemsetAsync(p.bar, 0, XB_WORDS * 4, stream);
#if MULTI_LAUNCH
  dim3 g(grid_blocks), b(NTHREADS);
  phase_kernel<0><<<g, b, 0, stream>>>(p);
  phase_kernel<1><<<g, b, 0, stream>>>(p);
  phase_kernel<2><<<g, b, 0, stream>>>(p);
  phase_kernel<3><<<g, b, 0, stream>>>(p);
  phase_kernel<4><<<g, b, 0, stream>>>(p);
  phase_kernel<5><<<g, b, 0, stream>>>(p);
  phase_kernel<6><<<g, b, 0, stream>>>(p);
  phase_kernel<7><<<g, b, 0, stream>>>(p);
#else
  void* args[] = {&p};
  hipError_t e = hipLaunchCooperativeKernel((void*)mega_kernel, dim3(grid_blocks), dim3(NTHREADS), args, 0, stream);
  if (e != hipSuccess) fprintf(stderr, "cooperative launch failed: %s (grid %d)\n", hipGetErrorString(e), grid_blocks);
#endif
}
```

```cpp
#include <hip/hip_runtime.h>
#include <hip/hip_cooperative_groups.h>
#include <stdint.h>
#include <cstdio>
namespace cg = cooperative_groups;

#ifndef MULTI_LAUNCH
#define MULTI_LAUNCH 0
#endif

typedef unsigned short u16;
typedef unsigned int u32;
typedef unsigned char u8;
using bf16x8 = __attribute__((ext_vector_type(8))) short;
using f32x4 = __attribute__((ext_vector_type(4))) float;
using f32x16 = __attribute__((ext_vector_type(16))) float;
typedef __bf16 bf16x2_t __attribute__((ext_vector_type(2)));
typedef float float2_t __attribute__((ext_vector_type(2)));

constexpr int BATCH = 2, SEQ = 16384, DM = 1024, T = BATCH * SEQ;
constexpr int NWIN = 4224;
constexpr int NTHREADS = 256;
constexpr float EPS = 1e-6f;
constexpr int ABUF = 128 * 144;
constexpr int CS_LD = 132;
constexpr int SMEM_BYTES = 77824;
constexpr int EXTRA_OFF = 4 * ABUF;
constexpr int CAP = 768;

__constant__ float INV32[16] = {1.000000000e+00f, 4.403665960e-01f, 1.939227432e-01f, 8.539710194e-02f, 3.760603070e-02f, 1.656043902e-02f, 7.292664610e-03f, 3.211445874e-03f, 1.414213562e-03f, 6.227723788e-04f, 2.742481884e-04f, 1.207697351e-04f, 5.318296098e-05f, 2.341999971e-05f, 1.031338616e-05f, 4.541670478e-06f};
__constant__ float INV16[8] = {1.000000000e+00f, 1.939227432e-01f, 3.760603070e-02f, 7.292664610e-03f, 1.414213562e-03f, 2.742481884e-04f, 5.318296098e-05f, 1.031338616e-05f};
__constant__ u8 PAIR_TAB[56] = {
  0x00,0x01,0x02,0x03,0x04,0x05,0x06,0x07,0x08,0x09,0x0a,0x0b,0x0c,0x0d,0x0e,0x0f,
  0x10,0x11,0x12,0x13,0x14,0x15,0x16,0x17,
  0x20,0x21,0x22,0x23,0x24,
  0x30,0x31,0x32,0x33,
  0x40,0x41,0x42,
  0x50,0x51,
  0x60,0x61,
  0x70,0x71,
  0x80,0x90,0xa0,0xb0,0xc0,0xd0,0xe0,0xf0,
  0xff,0xff,0xff,0xff,0xff,0xff};

constexpr size_t MBY = (size_t)1 << 20;
constexpr size_t al256(size_t x) { return (x + 255) & ~(size_t)255; }
constexpr size_t O_XN = 0;
constexpr size_t O_WINT = O_XN + 64 * MBY;
constexpr size_t O_WAT = O_WINT + al256((size_t)NWIN * 1024 * 2);
constexpr size_t O_WBT = O_WAT + 1024 * 512 * 2;
constexpr size_t O_WOT = O_WBT + 1024 * 512 * 2;
constexpr size_t O_WQT = O_WOT + 1024 * 1024 * 2;
constexpr size_t O_WKVT = O_WQT + 2048 * 1024 * 2;
constexpr size_t O_SUBK = O_WKVT + 256 * 256 * 2;
constexpr size_t O_WTRIL = O_SUBK + 262144 * 2;
constexpr size_t O_U8 = O_WTRIL + 65536 * 2;
constexpr size_t O_V8 = O_U8 + 16 * MBY;
constexpr size_t O_SU = O_V8 + 16 * MBY;
constexpr size_t O_SV = O_SU + 16384 * 4;
constexpr size_t O_G = O_SV + 16384 * 4;
constexpr size_t O_KI = O_G + 128 * MBY;
constexpr size_t O_WI = O_KI + 4 * MBY;
constexpr size_t O_SG = O_WI + (size_t)T * 4 * 4;
constexpr size_t O_SEL = O_SG + 128 * MBY;
constexpr size_t O_KV8 = O_SEL + 16 * MBY;
constexpr size_t O_SCAL = O_KV8 + 8 * MBY;
constexpr size_t O_SSQ = O_SCAL + 256;
constexpr size_t O_BAR = O_SSQ + (size_t)T * 8 * 4;
constexpr size_t O_RTAB = O_BAR + al256(3264 * 4);
constexpr size_t O_END = O_RTAB + (size_t)T * 48 * 4;

struct Params {
  const float* x; const int* pos;
  const float *norm1_g, *w_in, *v_norm_g, *v_norm_b, *spatial_w, *spatial_b, *kv_norm_g, *w_uk, *w_uv,
      *q_norm_g, *k_norm_g, *w_a_out, *w_b_out, *w_o, *norm2_g, *peer_wq, *peer_subkeys, *peer_u, *peer_v;
  float* out;
  char* ws;
#define WSP(TYPE, NAME, OFF) __device__ __forceinline__ TYPE* NAME() const { return reinterpret_cast<TYPE*>(ws + (OFF)); }
  WSP(u16, xn, O_XN) WSP(u16, ya, O_XN) WSP(u16, yb, O_XN + 32 * MBY)
  WSP(u16, eidT, O_XN) WSP(float, egv, O_XN + 8 * MBY) WSP(float, esu, O_XN + 24 * MBY) WSP(float, coef, O_XN + 40 * MBY)
  WSP(u16, WinT, O_WINT) WSP(u16, WaT, O_WAT) WSP(u16, WbT, O_WBT) WSP(u16, WoT, O_WOT) WSP(u16, WqT, O_WQT)
  WSP(u16, WkvT, O_WKVT) WSP(u16, SubK, O_SUBK) WSP(u16, Wtril, O_WTRIL)
  WSP(u8, U8, O_U8) WSP(u8, V8, O_V8) WSP(u8, sx, O_SU)
  WSP(u16, gu, O_G) WSP(u16, gv, O_G + 32 * MBY) WSP(u16, qh, O_G + 64 * MBY) WSP(u16, merged, O_G)
  WSP(u16, ckv, O_G + 96 * MBY) WSP(u16, qi, O_G + 112 * MBY) WSP(float, part, O_G)
  WSP(u16, ki, O_KI) WSP(float, wi, O_WI)
  WSP(u16, sg, O_SG) WSP(u16, h1b, O_SG) WSP(float, stv, O_SG + 64 * MBY) WSP(u8, sti, O_SG + 96 * MBY)
  WSP(u16, sel, O_SEL) WSP(u8, kv8, O_KV8) WSP(float, scal, O_SCAL) WSP(float, ssq, O_SSQ)
  WSP(unsigned, bar, O_BAR)
  WSP(float, rtab, O_RTAB)
#undef WSP
};

__device__ __forceinline__ u32 pack_bf16(float a, float b) {
  float2_t v = {a, b};
  bf16x2_t r = __builtin_convertvector(v, bf16x2_t);
  return __builtin_bit_cast(u32, r);
}
__device__ __forceinline__ u16 f2bf(float a) { return (u16)(pack_bf16(a, 0.f) & 0xffffu); }
__device__ __forceinline__ float bf_lo(u32 u) { return __uint_as_float(u << 16); }
__device__ __forceinline__ float bf_hi(u32 u) { return __uint_as_float(u & 0xffff0000u); }
__device__ __forceinline__ float bf2f(u16 h) { return __uint_as_float(((u32)h) << 16); }
__device__ __forceinline__ float wave_sum(float v) {
#pragma unroll
  for (int m = 32; m >= 1; m >>= 1) v += __shfl_xor(v, m);
  return v;
}
__device__ __forceinline__ float gelu_f(float x) {
  float z = -2.3022082f * (x + 0.044715f * x * x * x);
  return x * __builtin_amdgcn_rcpf(1.f + __builtin_amdgcn_exp2f(z));
}
__device__ __forceinline__ float sigmoid_f(float x) { return __builtin_amdgcn_rcpf(1.f + __builtin_amdgcn_exp2f(-1.4426950408889634f * x)); }
__device__ __forceinline__ u32 sortable(u32 b) { return b ^ ((u32)((int)b >> 31) | 0x80000000u); }
__device__ __forceinline__ u32 unsortable(u32 k) { return k ^ ((k & 0x80000000u) ? 0x80000000u : 0xffffffffu); }
__device__ __forceinline__ int mbcnt64(unsigned long long m) {
  return __builtin_amdgcn_mbcnt_hi((u32)(m >> 32), __builtin_amdgcn_mbcnt_lo((u32)m, 0));
}

__device__ __forceinline__ void load8(const float* p, float (&v)[8]) {
  float4 a = *reinterpret_cast<const float4*>(p), b = *reinterpret_cast<const float4*>(p + 4);
  v[0] = a.x; v[1] = a.y; v[2] = a.z; v[3] = a.w; v[4] = b.x; v[5] = b.y; v[6] = b.z; v[7] = b.w;
}
__device__ __forceinline__ void unpack8(uint4 q, float (&v)[8]) {
  v[0] = bf_lo(q.x); v[1] = bf_hi(q.x); v[2] = bf_lo(q.y); v[3] = bf_hi(q.y);
  v[4] = bf_lo(q.z); v[5] = bf_hi(q.z); v[6] = bf_lo(q.w); v[7] = bf_hi(q.w);
}
__device__ __forceinline__ uint4 pack8(const float (&v)[8]) {
  uint4 o = {pack_bf16(v[0], v[1]), pack_bf16(v[2], v[3]), pack_bf16(v[4], v[5]), pack_bf16(v[6], v[7])};
  return o;
}
#define DPPF(v, ctrl) __int_as_float(__builtin_amdgcn_update_dpp(0, __float_as_int(v), (ctrl), 0xF, 0xF, true))
__device__ __forceinline__ float sum16(float x) {
  x += DPPF(x, 0xB1); x += DPPF(x, 0x4E); x += DPPF(x, 0x141); x += DPPF(x, 0x140);
  return x;
}
__device__ __forceinline__ float max16(float x) {
  x = fmaxf(x, DPPF(x, 0xB1)); x = fmaxf(x, DPPF(x, 0x4E)); x = fmaxf(x, DPPF(x, 0x141)); x = fmaxf(x, DPPF(x, 0x140));
  return x;
}
__device__ __forceinline__ void rope32_8(float (&v)[8], int L, const float* tab) {
  float pr[8];
#pragma unroll
  for (int e = 0; e < 8; ++e) pr[e] = __shfl_xor(v[e], 2);
  if (L < 4) {
    float c[8], s[8];
    load8(tab + (L & 1) * 8, c);
    load8(tab + 16 + (L & 1) * 8, s);
#pragma unroll
    for (int e = 0; e < 8; ++e) v[e] = (L < 2) ? (v[e] * c[e] - pr[e] * s[e]) : (v[e] * c[e] + pr[e] * s[e]);
  }
}
__device__ __forceinline__ void rope16_8(float (&v)[8], int lc0, const float* tab) {
  float pr[8];
#pragma unroll
  for (int e = 0; e < 8; ++e) pr[e] = __shfl_xor(v[e], 1);
  if (lc0 < 16) {
    float c[8], s[8];
    load8(tab + 32, c);
    load8(tab + 40, s);
#pragma unroll
    for (int e = 0; e < 8; ++e) v[e] = (lc0 == 0) ? (v[e] * c[e] - pr[e] * s[e]) : (v[e] * c[e] + pr[e] * s[e]);
  }
}

typedef u32 u32x4 __attribute__((ext_vector_type(4)));
struct Tile4 { u32x4 v0, v1, v2, v3; };
__device__ __forceinline__ void gemm_load_tile(const u16* __restrict__ g, int ld, int k0, Tile4& r) {
  const int tid = threadIdx.x;
  const int row = tid >> 3, kc = tid & 7;
  const u16* base = g + (size_t)row * ld + k0 + kc * 8;
  r.v0 = *reinterpret_cast<const u32x4*>(base);
  r.v1 = *reinterpret_cast<const u32x4*>(base + (size_t)32 * ld);
  r.v2 = *reinterpret_cast<const u32x4*>(base + (size_t)64 * ld);
  r.v3 = *reinterpret_cast<const u32x4*>(base + (size_t)96 * ld);
}
__device__ __forceinline__ void gemm_store_tile(char* buf, const Tile4& r) {
  const int tid = threadIdx.x;
  const int row = tid >> 3, kc = tid & 7;
  char* base = buf + row * 144 + kc * 16;
  *reinterpret_cast<u32x4*>(base) = r.v0;
  *reinterpret_cast<u32x4*>(base + 32 * 144) = r.v1;
  *reinterpret_cast<u32x4*>(base + 64 * 144) = r.v2;
  *reinterpret_cast<u32x4*>(base + 96 * 144) = r.v3;
}
__device__ __forceinline__ void mma_ktile(const char* sa, const char* sb, f32x16 (&acc)[2][2]) {
  const int lane = threadIdx.x & 63, wid = threadIdx.x >> 6;
  const int wr = wid >> 1, wc = wid & 1;
  const int r32 = lane & 31, hf = lane >> 5;
  const char* pa = sa + (wr * 64 + r32) * 144 + hf * 16;
  const char* pb = sb + (wc * 64 + r32) * 144 + hf * 16;
  bf16x8 a0[2], b0[2], a1[2], b1[2];
#pragma unroll
  for (int i = 0; i < 2; ++i) {
    a0[i] = *reinterpret_cast<const bf16x8*>(pa + i * 32 * 144);
    b0[i] = *reinterpret_cast<const bf16x8*>(pb + i * 32 * 144);
  }
#pragma unroll
  for (int s = 0; s < 4; s += 2) {
#pragma unroll
    for (int i = 0; i < 2; ++i) {
      a1[i] = *reinterpret_cast<const bf16x8*>(pa + i * 32 * 144 + (s + 1) * 32);
      b1[i] = *reinterpret_cast<const bf16x8*>(pb + i * 32 * 144 + (s + 1) * 32);
    }
    __builtin_amdgcn_s_setprio(1);
#pragma unroll
    for (int i = 0; i < 2; ++i)
#pragma unroll
      for (int j = 0; j < 2; ++j)
        acc[i][j] = __builtin_amdgcn_mfma_f32_32x32x16_bf16(a0[i], b0[j], acc[i][j], 0, 0, 0);
    __builtin_amdgcn_s_setprio(0);
    if (s + 2 < 4) {
#pragma unroll
      for (int i = 0; i < 2; ++i) {
        a0[i] = *reinterpret_cast<const bf16x8*>(pa + i * 32 * 144 + (s + 2) * 32);
        b0[i] = *reinterpret_cast<const bf16x8*>(pb + i * 32 * 144 + (s + 2) * 32);
      }
    }
    __builtin_amdgcn_s_setprio(1);
#pragma unroll
    for (int i = 0; i < 2; ++i)
#pragma unroll
      for (int j = 0; j < 2; ++j)
        acc[i][j] = __builtin_amdgcn_mfma_f32_32x32x16_bf16(a1[i], b1[j], acc[i][j], 0, 0, 0);
    __builtin_amdgcn_s_setprio(0);
  }
}
#define GEMM_KT(i, nk) ((((i) + ((int)(blockIdx.x >> 3))) & ((nk) - 1)) << 6)
__device__ __forceinline__ void gemm_prefetch(const u16* __restrict__ A, int lda, const u16* __restrict__ B, int ldb, int K, Tile4& ra, Tile4& rb) {
  const int nk = K >> 6;
  gemm_load_tile(A, lda, GEMM_KT(0, nk), ra);
  gemm_load_tile(B, ldb, GEMM_KT(0, nk), rb);
}
__device__ __forceinline__ void gemm_mainloop(const u16* __restrict__ A, int lda, const u16* __restrict__ B, int ldb,
                                              int K, f32x16 (&acc)[2][2], char* smem, Tile4& ra, Tile4& rb) {
  const int nk = K >> 6;
  __syncthreads();
  gemm_store_tile(smem, ra);
  gemm_store_tile(smem + 2 * ABUF, rb);
  __syncthreads();
#pragma unroll 2
  for (int kt = 0; kt < nk; ++kt) {
    const int cur = kt & 1;
    if (kt + 1 < nk) {
      gemm_load_tile(A, lda, GEMM_KT(kt + 1, nk), ra);
      gemm_load_tile(B, ldb, GEMM_KT(kt + 1, nk), rb);
    }
    mma_ktile(smem + cur * ABUF, smem + (2 + cur) * ABUF, acc);
    if (kt + 1 < nk) {
      gemm_store_tile(smem + (cur ^ 1) * ABUF, ra);
      gemm_store_tile(smem + (2 + (cur ^ 1)) * ABUF, rb);
    }
    __syncthreads();
  }
}
__device__ __forceinline__ void gemm_mainloop_rolled(const u16* __restrict__ A, int lda, const u16* __restrict__ B, int ldb,
                                              int K, f32x16 (&acc)[2][2], char* smem, Tile4& ra, Tile4& rb) {
  const int nk = K >> 6;
  __syncthreads();
  gemm_store_tile(smem, ra);
  gemm_store_tile(smem + 2 * ABUF, rb);
  __syncthreads();
#pragma unroll 1
  for (int kt = 0; kt < nk; ++kt) {
    const int cur = kt & 1;
    if (kt + 1 < nk) {
      gemm_load_tile(A, lda, GEMM_KT(kt + 1, nk), ra);
      gemm_load_tile(B, ldb, GEMM_KT(kt + 1, nk), rb);
    }
    mma_ktile(smem + cur * ABUF, smem + (2 + cur) * ABUF, acc);
    if (kt + 1 < nk) {
      gemm_store_tile(smem + (cur ^ 1) * ABUF, ra);
      gemm_store_tile(smem + (2 + (cur ^ 1)) * ABUF, rb);
    }
    __syncthreads();
  }
}
__device__ __forceinline__ void zero_acc(f32x16 (&acc)[2][2]) {
#pragma unroll
  for (int i = 0; i < 2; ++i)
#pragma unroll
    for (int j = 0; j < 2; ++j)
#pragma unroll
      for (int r = 0; r < 16; ++r) acc[i][j][r] = 0.f;
}
__device__ __forceinline__ void stage_acc(const f32x16 (&acc)[2][2], float* cs) {
  const int lane = threadIdx.x & 63, wid = threadIdx.x >> 6;
  const int wr = wid >> 1, wc = wid & 1;
#pragma unroll
  for (int i = 0; i < 2; ++i)
#pragma unroll
    for (int j = 0; j < 2; ++j)
#pragma unroll
      for (int r = 0; r < 16; ++r) {
        int row = wr * 64 + i * 32 + (r & 3) + 8 * (r >> 2) + 4 * (lane >> 5);
        int col = wc * 64 + j * 32 + (lane & 31);
        cs[row * CS_LD + col] = acc[i][j][r];
      }
}

__device__ __forceinline__ int win_srccol(int n) {
  if (n < 2116) return n;
  if (n < 2176) return -1;
  return n - 60;
}
__device__ void phase_prep(const Params& p, char* smem) {
  const int tid = threadIdx.x, lane = tid & 63, wid = tid >> 6;
  for (int rb = blockIdx.x; rb < T / 4; rb += 2 * gridDim.x) {
    const int rowa = rb * 4 + wid;
    const int rbb = rb + gridDim.x;
    const bool hasb = rbb < T / 4;
    const int rowb = hasb ? rbb * 4 + wid : rowa;
    const float* xa = p.x + (size_t)rowa * DM;
    const float* xb = p.x + (size_t)rowb * DM;
    float4 va[4], vb[4];
#pragma unroll
    for (int i = 0; i < 4; ++i) va[i] = *reinterpret_cast<const float4*>(xa + lane * 4 + 256 * i);
#pragma unroll
    for (int i = 0; i < 4; ++i) vb[i] = *reinterpret_cast<const float4*>(xb + lane * 4 + 256 * i);
    float4 g[4];
#pragma unroll
    for (int i = 0; i < 4; ++i) g[i] = *reinterpret_cast<const float4*>(p.norm1_g + lane * 4 + 256 * i);
    float sa = 0.f, sb = 0.f;
#pragma unroll
    for (int i = 0; i < 4; ++i) {
      sa += va[i].x * va[i].x + va[i].y * va[i].y + va[i].z * va[i].z + va[i].w * va[i].w;
      sb += vb[i].x * vb[i].x + vb[i].y * vb[i].y + vb[i].z * vb[i].z + vb[i].w * vb[i].w;
    }
    sa = wave_sum(sa); sb = wave_sum(sb);
    const float ra = rsqrtf(sa * (1.f / DM) + EPS), rbv = rsqrtf(sb * (1.f / DM) + EPS);
#pragma unroll
    for (int i = 0; i < 4; ++i) {
      uint2 o;
      o.x = pack_bf16(va[i].x * ra * g[i].x, va[i].y * ra * g[i].y);
      o.y = pack_bf16(va[i].z * ra * g[i].z, va[i].w * ra * g[i].w);
      *reinterpret_cast<uint2*>(p.xn() + (size_t)rowa * DM + lane * 4 + 256 * i) = o;
    }
    if (hasb) {
#pragma unroll
      for (int i = 0; i < 4; ++i) {
        uint2 o;
        o.x = pack_bf16(vb[i].x * rbv * g[i].x, vb[i].y * rbv * g[i].y);
        o.y = pack_bf16(vb[i].z * rbv * g[i].z, vb[i].w * rbv * g[i].w);
        *reinterpret_cast<uint2*>(p.xn() + (size_t)rowb * DM + lane * 4 + 256 * i) = o;
      }
    }
  }
  float* tile = reinterpret_cast<float*>(smem);
  constexpr int NT_TOTAL = 1056 + 128 + 128 + 256 + 512 + 8 + 8;
  for (int ti = blockIdx.x; ti < NT_TOTAL; ti += gridDim.x) {
    const float* src; const float* scale = nullptr; u16* dst; int ldsrc, K, nn, mode = 0; int t = ti;
    if (t < 1056) { src = p.w_in; ldsrc = 4164; K = 1024; nn = 66; dst = p.WinT(); mode = 1; }
    else if ((t -= 1056) < 128) { src = p.w_a_out; ldsrc = 1024; K = 512; nn = 16; dst = p.WaT(); }
    else if ((t -= 128) < 128) { src = p.w_b_out; ldsrc = 1024; K = 512; nn = 16; dst = p.WbT(); }
    else if ((t -= 128) < 256) { src = p.w_o; ldsrc = 1024; K = 1024; nn = 16; dst = p.WoT(); }
    else if ((t -= 256) < 512) { src = p.peer_wq; ldsrc = 2048; K = 1024; nn = 32; dst = p.WqT(); scale = p.norm2_g; }
    else if ((t -= 512) < 8) { src = p.w_uk; ldsrc = 128; K = 256; nn = 2; dst = p.WkvT(); scale = p.kv_norm_g; }
    else { t -= 8; src = p.w_uv; ldsrc = 128; K = 256; nn = 2; dst = p.WkvT() + 128 * 256; scale = p.kv_norm_g; }
    int n0 = (t % nn) * 64, k0 = (t / nn) * 64;
    __syncthreads();
    {
      const int n = tid & 63, kb = tid >> 6;
      const int sc = (mode == 1) ? win_srccol(n0 + n) : (n0 + n);
      const float* sp = src + (size_t)(k0 + kb) * ldsrc + (sc >= 0 ? sc : 0);
      float v[16];
#pragma unroll
      for (int i = 0; i < 16; ++i) v[i] = sp[(size_t)(4 * i) * ldsrc];
      if (scale) {
        float s[16];
#pragma unroll
        for (int i = 0; i < 16; ++i) s[i] = scale[k0 + kb + 4 * i];
#pragma unroll
        for (int i = 0; i < 16; ++i) v[i] *= s[i];
      }
#pragma unroll
      for (int i = 0; i < 16; ++i) tile[(kb + 4 * i) * 65 + n] = (sc >= 0) ? v[i] : 0.f;
    }
    __syncthreads();
    {
      int k = (tid & 31) * 2;
      for (int n = tid >> 5; n < 64; n += 8) {
        u32 o = pack_bf16(tile[k * 65 + n], tile[(k + 1) * 65 + n]);
        *reinterpret_cast<u32*>(dst + (size_t)(n0 + n) * K + k0 + k) = o;
      }
    }
  }
  constexpr int G_SUB = 262144 / 4, G_SW = 65536 / 4;
  constexpr int G_TOTAL = G_SUB + G_SW;
  for (int gi = blockIdx.x * NTHREADS + tid; gi < G_TOTAL; gi += gridDim.x * NTHREADS) {
    int g = gi;
    if (g < G_SUB) {
      float4 v = *reinterpret_cast<const float4*>(p.peer_subkeys + (size_t)g * 4);
      uint2 o = {pack_bf16(v.x, v.y), pack_bf16(v.z, v.w)};
      *reinterpret_cast<uint2*>(p.SubK() + (size_t)g * 4) = o;
    } else {
      g -= G_SUB;
      float4 v = *reinterpret_cast<const float4*>(p.spatial_w + (size_t)g * 4);
      int e = g * 4; int s = e & 127, tt = (e >> 7) & 127;
      if (s > tt) v.x = 0.f;
      if (s + 1 > tt) v.y = 0.f;
      if (s + 2 > tt) v.z = 0.f;
      if (s + 3 > tt) v.w = 0.f;
      uint2 o = {pack_bf16(v.x, v.y), pack_bf16(v.z, v.w)};
      *reinterpret_cast<uint2*>(p.Wtril() + (size_t)g * 4) = o;
    }
  }
  if (blockIdx.x == 0) {
    float* red = reinterpret_cast<float*>(smem);
    __syncthreads();
    {
      const int c4 = (tid & 31) * 4, rg = tid >> 5;
      float4 acc = make_float4(0.f, 0.f, 0.f, 0.f);
#pragma unroll 8
      for (int k = rg; k < 256; k += 8) {
        const float4 w = *reinterpret_cast<const float4*>(p.w_uv + k * 128 + c4);
        const float g = p.kv_norm_g[k];
        acc.x += (w.x * g) * (w.x * g); acc.y += (w.y * g) * (w.y * g); acc.z += (w.z * g) * (w.z * g); acc.w += (w.w * g) * (w.w * g);
      }
      *reinterpret_cast<float4*>(red + 1024 + rg * 128 + c4) = acc;
    }
    __syncthreads();
    float vq = 0.f, vk = 0.f, vn = 0.f;
    if (tid < 128) {
      vq = fabsf(p.q_norm_g[tid]); vk = fabsf(p.k_norm_g[tid]);
      float ss = 0.f;
#pragma unroll
      for (int r = 0; r < 8; ++r) ss += red[1024 + r * 128 + tid];
      vn = sqrtf(ss);
    }
#pragma unroll
    for (int m = 32; m >= 1; m >>= 1) {
      vq = fmaxf(vq, __shfl_xor(vq, m)); vk = fmaxf(vk, __shfl_xor(vk, m)); vn = fmaxf(vn, __shfl_xor(vn, m));
    }
    if (lane == 0) { red[wid] = vq; red[4 + wid] = vk; red[8 + wid] = vn; }
    __syncthreads();
    if (tid == 0) {
      float mq = 0.f, mk = 0.f, mn = 0.f;
      for (int k = 0; k < 4; ++k) { mq = fmaxf(mq, red[k]); mk = fmaxf(mk, red[4 + k]); mn = fmaxf(mn, red[8 + k]); }
      int eq = ilogbf(440.f / fmaxf(11.3137085f * mq, 1e-20f));
      int ek = ilogbf(440.f / fmaxf(11.3137085f * mk, 1e-20f));
      int ev = ilogbf(440.f / fmaxf(16.f * mn, 1e-20f));
      eq = eq > 40 ? 40 : (eq < -40 ? -40 : eq); ek = ek > 40 ? 40 : (ek < -40 ? -40 : ek); ev = ev > 40 ? 40 : (ev < -40 ? -40 : ev);
      p.scal()[0] = ldexpf(1.f, eq); p.scal()[1] = ldexpf(1.f, ek); p.scal()[2] = ldexpf(1.f, ev);
      p.scal()[3] = ldexpf(1.f, -eq - ek); p.scal()[4] = ldexpf(1.f, -ev);
    }
    __syncthreads();
  }
  for (int gi = blockIdx.x * NTHREADS + tid; gi < T * 24; gi += gridDim.x * NTHREADS) {
    int t = gi / 24, j = gi - t * 24;
    float posf = (float)p.pos[t];
    float sn, cn;
    if (j < 16) { sincosf(posf * INV32[j], &sn, &cn); p.rtab()[(size_t)t * 48 + j] = cn; p.rtab()[(size_t)t * 48 + 16 + j] = sn; }
    else { int jj = j - 16; sincosf(posf * INV16[jj], &sn, &cn); p.rtab()[(size_t)t * 48 + 32 + jj] = cn; p.rtab()[(size_t)t * 48 + 40 + jj] = sn; }
  }
}

__device__ __forceinline__ void rope_pair(float& y0, float& y1, int lc, int half, int xm, float posf, const float* inv) {
  float p0 = __shfl_xor(y0, xm), p1 = __shfl_xor(y1, xm);
  if (lc < 2 * half) {
    int j = lc & (half - 1);
    float a0 = posf * inv[j], a1 = posf * inv[j + 1];
    float s0, c0, s1, c1;
    sincosf(a0, &s0, &c0);
    sincosf(a1, &s1, &c1);
    if (lc < half) { y0 = y0 * c0 - p0 * s0; y1 = y1 * c1 - p1 * s1; }
    else { y0 = y0 * c0 + p0 * s0; y1 = y1 * c1 + p1 * s1; }
  }
}

__device__ __forceinline__ bool tile_swizzle(int step, int ntn, int ntiles, int& mt, int& nt) {
  const int x = blockIdx.x & 7, slot = blockIdx.x >> 3;
  const int nslots = gridDim.x >> 3;
  const int lin = (step * 8 + x) * nslots + slot;
  if (lin >= ntiles) return false;
  const int per = ntn * 16;
  const int g = lin / per, rem = lin - g * per;
  nt = rem >> 4;
  mt = g * 16 + (rem & 15);
  return true;
}

__device__ void phase_gemm1(const Params& p, char* smem) {
  const int tid = threadIdx.x, lane = tid & 63, wid = tid >> 6;
  float* cs = reinterpret_cast<float*>(smem);
  constexpr int NTN = NWIN / 128;
  constexpr int NTILES = (T / 128) * NTN;
  int mt, nt;
  bool have = tile_swizzle(0, NTN, NTILES, mt, nt);
  Tile4 ra, rb;
  if (have) gemm_prefetch(p.xn() + (size_t)mt * 128 * DM, DM, p.WinT() + (size_t)nt * 128 * DM, DM, DM, ra, rb);
  for (int step = 0; have; ++step) {
    int m0 = mt * 128;
    f32x16 acc[2][2];
    zero_acc(acc);
    gemm_mainloop(p.xn() + (size_t)m0 * DM, DM, p.WinT() + (size_t)nt * 128 * DM, DM, DM, acc, smem, ra, rb);
    stage_acc(acc, cs);
    __syncthreads();
    int mt2 = 0, nt2 = 0;
    const bool nxt = tile_swizzle(step + 1, NTN, NTILES, mt2, nt2);
    if (nxt) gemm_prefetch(p.xn() + (size_t)mt2 * 128 * DM, DM, p.WinT() + (size_t)nt2 * 128 * DM, DM, DM, ra, rb);
    const int L = lane & 15, rsub = lane >> 4, c0 = L * 8;
#pragma unroll 1
    for (int it = 0; it < 8; ++it) {
      const int row = wid * 32 + it * 4 + rsub;
      const size_t t = (size_t)m0 + row;
      float v[8];
      load8(cs + row * CS_LD + c0, v);
      if (nt < 8) {
#pragma unroll
        for (int e = 0; e < 8; ++e) v[e] = gelu_f(v[e]);
        u16* dst = (nt < 4) ? (p.gu() + t * 512 + nt * 128 + c0) : (p.gv() + t * 512 + (nt - 4) * 128 + c0);
        *reinterpret_cast<uint4*>(dst) = pack8(v);
      } else if (nt < 12) {
        float ss = 0.f;
#pragma unroll
        for (int e = 0; e < 8; ++e) ss += v[e] * v[e];
        ss = sum16(ss);
        float r = rsqrtf(ss * (1.f / 128.f) + EPS);
        float g[8];
        load8(p.q_norm_g + c0, g);
#pragma unroll
        for (int e = 0; e < 8; ++e) v[e] = v[e] * r * g[e];
        rope32_8(v, L, p.rtab() + t * 48);
        *reinterpret_cast<uint4*>(p.qh() + t * 512 + (nt - 8) * 128 + c0) = pack8(v);
      } else if (nt < 14) {
        *reinterpret_cast<uint4*>(p.ckv() + t * 256 + (nt - 12) * 128 + c0) = pack8(v);
      } else if (nt < 16) {
        rope16_8(v, c0 & 63, p.rtab() + t * 48);
        *reinterpret_cast<uint4*>(p.qi() + t * 256 + (nt - 14) * 128 + c0) = pack8(v);
      } else if (nt == 16) {
        rope16_8(v, c0 < 64 ? c0 : 64, p.rtab() + t * 48);
        if (c0 < 64) *reinterpret_cast<uint4*>(p.ki() + ((t >> 4) * 8 + L) * 128 + (t & 15) * 8) = pack8(v);
        else if (c0 == 64) *reinterpret_cast<float4*>(p.wi() + t * 4) = make_float4(v[0] * 0.0625f, v[1] * 0.0625f, v[2] * 0.0625f, v[3] * 0.0625f);
      } else {
#pragma unroll
        for (int e = 0; e < 8; ++e) v[e] = sigmoid_f(v[e]);
        *reinterpret_cast<uint4*>(p.sg() + t * 2048 + (nt - 17) * 128 + c0) = pack8(v);
      }
    }
    mt = mt2; nt = nt2; have = nxt;
  }
}

__device__ void unit_kv(const Params& p, char* smem, int mt) {
  const int tid = threadIdx.x, lane = tid & 63, wid = tid >> 6;
  float* cs = reinterpret_cast<float*>(smem);
  float* rr_s = reinterpret_cast<float*>(smem + EXTRA_OFF);
  const int m0 = mt * 128;
  __syncthreads();
  {
    int row = tid >> 1, half = tid & 1;
    const u16* src = p.ckv() + (size_t)(m0 + row) * 256 + half * 128;
    float ss = 0.f;
#pragma unroll 4
    for (int i = 0; i < 16; ++i) {
      uint4 q = *reinterpret_cast<const uint4*>(src + i * 8);
      u32 w[4] = {q.x, q.y, q.z, q.w};
#pragma unroll
      for (int j = 0; j < 4; ++j) { float a = bf_lo(w[j]), b = bf_hi(w[j]); ss += a * a + b * b; }
    }
    ss += __shfl_xor(ss, 1);
    if (half == 0) rr_s[row] = rsqrtf(ss * (1.f / 256.f) + EPS);
  }
  Tile4 ra, rb;
  gemm_prefetch(p.ckv() + (size_t)m0 * 256, 256, p.WkvT(), 256, 256, ra, rb);
#pragma unroll 1
  for (int nt = 0; nt < 2; ++nt) {
    f32x16 acc[2][2];
    zero_acc(acc);
    gemm_mainloop_rolled(p.ckv() + (size_t)m0 * 256, 256, p.WkvT() + (size_t)nt * 128 * 256, 256, 256, acc, smem, ra, rb);
    stage_acc(acc, cs);
    __syncthreads();
    if (nt == 0) gemm_prefetch(p.ckv() + (size_t)m0 * 256, 256, p.WkvT() + (size_t)128 * 256, 256, 256, ra, rb);
    const int L = lane & 15, rsub = lane >> 4, c0 = L * 8;
#pragma unroll 1
    for (int it = 0; it < 8; ++it) {
      const int row = wid * 32 + it * 4 + rsub;
      const size_t t = (size_t)m0 + row;
      float v[8];
      load8(cs + row * CS_LD + c0, v);
      const float rs = rr_s[row];
#pragma unroll
      for (int e = 0; e < 8; ++e) v[e] *= rs;
      if (nt == 0) {
        float ss = 0.f;
#pragma unroll
        for (int e = 0; e < 8; ++e) ss += v[e] * v[e];
        ss = sum16(ss);
        float r = rsqrtf(ss * (1.f / 128.f) + EPS);
        float g[8];
        load8(p.k_norm_g + c0, g);
#pragma unroll
        for (int e = 0; e < 8; ++e) v[e] = v[e] * r * g[e];
        rope32_8(v, L, p.rtab() + t * 48);
        {
          const float sk = p.scal()[1];
          int w0 = __builtin_amdgcn_cvt_pk_fp8_f32(v[0] * sk, v[1] * sk, 0, false);
          w0 = __builtin_amdgcn_cvt_pk_fp8_f32(v[2] * sk, v[3] * sk, w0, true);
          int w1 = __builtin_amdgcn_cvt_pk_fp8_f32(v[4] * sk, v[5] * sk, 0, false);
          w1 = __builtin_amdgcn_cvt_pk_fp8_f32(v[6] * sk, v[7] * sk, w1, true);
          *reinterpret_cast<uint2*>(p.kv8() + t * 256 + c0) = make_uint2((u32)w0, (u32)w1);
        }
      } else {
        {
          const float sv8 = p.scal()[2];
          int w0 = __builtin_amdgcn_cvt_pk_fp8_f32(v[0] * sv8, v[1] * sv8, 0, false);
          w0 = __builtin_amdgcn_cvt_pk_fp8_f32(v[2] * sv8, v[3] * sv8, w0, true);
          int w1 = __builtin_amdgcn_cvt_pk_fp8_f32(v[4] * sv8, v[5] * sv8, 0, false);
          w1 = __builtin_amdgcn_cvt_pk_fp8_f32(v[6] * sv8, v[7] * sv8, w1, true);
          *reinterpret_cast<uint2*>(p.kv8() + t * 256 + 128 + c0) = make_uint2((u32)w0, (u32)w1);
        }
      }
    }
    __syncthreads();
  }
}

__device__ void unit_spatial(const Params& p, char* smem, int unit) {
  const int tid = threadIdx.x, lane = tid & 63, wid = tid >> 6;
  const int chunk = unit >> 2, g = unit & 3;
  const int t0 = chunk * 128;
  float* cs = reinterpret_cast<float*>(smem);
  float* mu_s = reinterpret_cast<float*>(smem + EXTRA_OFF);
  float* rs_s = mu_s + 128;
  __syncthreads();
  {
    int row = tid >> 1, half = tid & 1;
    const u16* src = p.gv() + (size_t)(t0 + row) * 512 + half * 256;
    float s = 0.f, ss = 0.f;
#pragma unroll 4
    for (int i = 0; i < 32; ++i) {
      uint4 q = *reinterpret_cast<const uint4*>(src + i * 8);
      u32 w[4] = {q.x, q.y, q.z, q.w};
#pragma unroll
      for (int j = 0; j < 4; ++j) { float a = bf_lo(w[j]), b = bf_hi(w[j]); s += a + b; ss += a * a + b * b; }
    }
    s += __shfl_xor(s, 1);
    ss += __shfl_xor(ss, 1);
    float mean = s * (1.f / 512.f);
    float var = fmaxf(ss * (1.f / 512.f) - mean * mean, 0.f);
    if (half == 0) { mu_s[row] = mean; rs_s[row] = rsqrtf(var + EPS); }
  }
  {
    const u16* wsrc = p.Wtril() + (size_t)g * 128 * 128;
#pragma unroll
    for (int i = 0; i < 8; ++i) {
      int c = tid + 256 * i;
      int row = c >> 4, kc = c & 15;
      uint4 q = *reinterpret_cast<const uint4*>(wsrc + row * 128 + kc * 8);
      *reinterpret_cast<uint4*>(smem + (kc >> 3) * ABUF + row * 144 + (kc & 7) * 16) = q;
    }
  }
  __syncthreads();
  {
    int s = tid & 127;
    float mu = mu_s[s], rs = rs_s[s];
    const u16* src = p.gv() + (size_t)(t0 + s) * 512 + g * 128;
    char* bbase = smem + (2 + (s >> 6)) * ABUF + (s & 63) * 2;
#pragma unroll
    for (int i = 0; i < 8; ++i) {
      int d0 = ((tid >> 7) + 2 * i) * 8;
      uint4 q = *reinterpret_cast<const uint4*>(src + d0);
      u32 w[4] = {q.x, q.y, q.z, q.w};
#pragma unroll
      for (int j = 0; j < 4; ++j) {
        int d = d0 + 2 * j;
        float a = (bf_lo(w[j]) - mu) * rs * p.v_norm_g[g * 128 + d] + p.v_norm_b[g * 128 + d];
        float b = (bf_hi(w[j]) - mu) * rs * p.v_norm_g[g * 128 + d + 1] + p.v_norm_b[g * 128 + d + 1];
        *reinterpret_cast<u16*>(bbase + d * 144) = f2bf(a);
        *reinterpret_cast<u16*>(bbase + (d + 1) * 144) = f2bf(b);
      }
    }
  }
  __syncthreads();
  f32x16 acc[2][2];
  zero_acc(acc);
  mma_ktile(smem, smem + 2 * ABUF, acc);
  mma_ktile(smem + ABUF, smem + 3 * ABUF, acc);
  __syncthreads();
  stage_acc(acc, cs);
  __syncthreads();
  const int L = lane & 15, rsub = lane >> 4, c0 = L * 8;
#pragma unroll 1
  for (int it = 0; it < 8; ++it) {
    const int row = wid * 32 + it * 4 + rsub;
    const size_t t = (size_t)t0 + row;
    float v[8], u[8];
    load8(cs + row * CS_LD + c0, v);
    const float b = p.spatial_b[g * 128 + row];
    unpack8(*reinterpret_cast<const uint4*>(p.gu() + t * 512 + g * 128 + c0), u);
#pragma unroll
    for (int e = 0; e < 8; ++e) v[e] = u[e] * (v[e] + b);
    *reinterpret_cast<uint4*>(p.ya() + t * 512 + g * 128 + c0) = pack8(v);
  }
}

__device__ __forceinline__ void radix_partition(const u32 (&key)[12], int n, int rank, int slack, u32& lo, u32& hi, int& limit) {
  u32 vor = 0u, vand = 0xFFFFFFFFu;
#pragma unroll
  for (int k = 0; k < 12; ++k) { vor |= key[k]; vand &= (key[k] != 0u) ? key[k] : 0xFFFFFFFFu; }
#define DPPU(v, ctrl) ((u32)__builtin_amdgcn_update_dpp(0, (int)(v), (ctrl), 0xF, 0xF, true))
  vor |= DPPU(vor, 0xB1); vor |= DPPU(vor, 0x4E); vor |= DPPU(vor, 0x141); vor |= DPPU(vor, 0x140);
  vand &= DPPU(vand, 0xB1); vand &= DPPU(vand, 0x4E); vand &= DPPU(vand, 0x141); vand &= DPPU(vand, 0x140);
  vor = (u32)(__builtin_amdgcn_readlane((int)vor, 0) | __builtin_amdgcn_readlane((int)vor, 16) |
              __builtin_amdgcn_readlane((int)vor, 32) | __builtin_amdgcn_readlane((int)vor, 48));
  vand = (u32)(__builtin_amdgcn_readlane((int)vand, 0) & __builtin_amdgcn_readlane((int)vand, 16) &
               __builtin_amdgcn_readlane((int)vand, 32) & __builtin_amdgcn_readlane((int)vand, 48));
#undef DPPU
  const u32 diff = vor ^ vand;
  int b = diff ? (31 - __clz(diff)) : -1;
  u32 prefix = (b >= 31) ? 0u : (vand & ~((2u << b) - 1u));
  if (b < 0) prefix = vand;
  int krem = rank, ncand = n;
  while (b >= 0 && ncand - krem > slack) {
    u32 cand = prefix | (1u << b);
    u32 himask = ~((1u << b) - 1u);
    int c = 0;
#pragma unroll
    for (int k = 0; k < 12; ++k) c += __popcll(__ballot((key[k] & himask) == cand));
    if (c >= krem) { prefix = cand; ncand = c; } else { krem -= c; ncand -= c; }
    --b;
  }
  lo = prefix;
  hi = (b >= 0) ? (prefix | ((2u << b) - 1u)) : prefix;
  limit = (ncand - krem <= slack) ? ncand : krem;
}

__device__ __forceinline__ void idx_load_keys(const Params& p, int tb, int jc, int kcol, int lane, bf16x8 (&bf)[4][2]) {
  const u16* kb = p.ki() + ((size_t)((tb + jc) >> 4) * 8 + (lane >> 4)) * 128 + kcol * 8;
#pragma unroll
  for (int u = 0; u < 4; ++u) {
    bf[u][0] = *reinterpret_cast<const bf16x8*>(kb + u * 1024);
    bf[u][1] = *reinterpret_cast<const bf16x8*>(kb + u * 1024 + 512);
  }
}
__device__ __forceinline__ void idx_compact(u32* cv, u16* ci, int n, int lane, int& newcnt, float& newthr) {
  u32 key[12]; u16 idx[12];
#pragma unroll
  for (int k = 0; k < 12; ++k) {
    int e = lane + 64 * k;
    bool in = e < n;
    key[k] = in ? sortable(cv[e]) : 0u;
    idx[k] = in ? ci[e] : (u16)0;
  }
  u32 lo, hi; int limit;
  radix_partition(key, n, 256, 64, lo, hi, limit);
  int base = 0, tcnt = 0;
#pragma unroll
  for (int k = 0; k < 12; ++k) {
    bool eq = key[k] >= lo && key[k] <= hi;
    unsigned long long meq = __ballot(eq);
    bool keep = (key[k] > hi) || (eq && (tcnt + mbcnt64(meq)) < limit);
    unsigned long long m = __ballot(keep);
    int pos = base + mbcnt64(m);
    if (keep) { cv[pos] = unsortable(key[k]); ci[pos] = idx[k]; }
    base += __popcll(m);
    tcnt += __popcll(meq);
  }
  newcnt = base;
  newthr = (lo <= 0x007FFFFFu) ? -INFINITY : __uint_as_float(unsortable(lo));
}

__device__ void unit_indexer(const Params& p, char* smem, int unit) {
  const int tid = threadIdx.x, lane = tid & 63, wid = tid >> 6;
  const int b = unit >> 10, grp = unit & 1023;
  const int tb = b * SEQ, i0 = grp * 16;
  u32* cval = reinterpret_cast<u32*>(smem);
  u16* cidx = reinterpret_cast<u16*>(smem + 16 * CAP * 4);
  __syncthreads();
  const int qsub = lane >> 4;
  const int ql = wid * 4 + qsub;
  const int iq = i0 + ql;
  const int kcol = lane & 15;
  bf16x8 afr[2];
  {
    const u16* qa = p.qi() + ((size_t)(tb + i0 + wid * 4 + (kcol >> 2)) * 4 + (kcol & 3)) * 64 + 8 * (lane >> 4);
    const float wa = p.wi()[(size_t)(tb + i0 + wid * 4 + (kcol >> 2)) * 4 + (kcol & 3)];
#pragma unroll
    for (int hh = 0; hh < 2; ++hh) {
      uint4 raw = *reinterpret_cast<const uint4*>(qa + 32 * hh);
      float f[8];
      unpack8(raw, f);
#pragma unroll
      for (int e = 0; e < 8; ++e) f[e] *= wa;
      uint4 pk = pack8(f);
      afr[hh] = __builtin_bit_cast(bf16x8, pk);
    }
  }
  const float4 w4 = *reinterpret_cast<const float4*>(p.wi() + (size_t)(tb + iq) * 4);
  const float lim0 = (w4.x > 0.f) ? INFINITY : -INFINITY, lim1 = (w4.y > 0.f) ? INFINITY : -INFINITY;
  const float lim2 = (w4.z > 0.f) ? INFINITY : -INFINITY, lim3 = (w4.w > 0.f) ? INFINITY : -INFINITY;
  float thr = -INFINITY;
  const int kmul = 64;
  int cntr = 0;
  u32* myval = cval + ql * CAP;
  u16* myidx = cidx + ql * CAP;
  const u32 lowmask = (1u << kcol) - 1u;
  const int nchunks = (grp + 1 + 3) >> 2;

  auto process = [&](const bf16x8 (&bf)[4][2], int jc) {
    f32x4 acc[4];
#pragma unroll
    for (int u = 0; u < 4; ++u) {
      f32x4 z = {0.f, 0.f, 0.f, 0.f};
      acc[u] = __builtin_amdgcn_mfma_f32_16x16x32_bf16(afr[0], bf[u][0], z, 0, 0, 0);
    }
#pragma unroll
    for (int u = 0; u < 4; ++u) acc[u] = __builtin_amdgcn_mfma_f32_16x16x32_bf16(afr[1], bf[u][1], acc[u], 0, 0, 0);
    float sc[4];
    bool ps[4];
    bool anyp = false;
#pragma unroll
    for (int u = 0; u < 4; ++u) {
      float r0 = __builtin_amdgcn_fmed3f(acc[u][0], 0.f, lim0), r1 = __builtin_amdgcn_fmed3f(acc[u][1], 0.f, lim1);
      float r2 = __builtin_amdgcn_fmed3f(acc[u][2], 0.f, lim2), r3 = __builtin_amdgcn_fmed3f(acc[u][3], 0.f, lim3);
      float s = (r0 + r1) + (r2 + r3);
      s += 0.0f;
      sc[u] = s;
      ps[u] = ((jc + 16 * u + kcol) <= iq) && (s > thr);
      anyp |= ps[u];
    }
    if (__ballot(anyp)) {
#pragma unroll
      for (int u = 0; u < 4; ++u) {
        unsigned long long m = __ballot(ps[u]);
        u32 g16 = (u32)(m >> (16 * qsub)) & 0xFFFFu;
        int slot = cntr + __popc(g16 & lowmask);
        if (ps[u] && slot < CAP) { myval[slot] = __float_as_uint(sc[u]); myidx[slot] = (u16)(jc + 16 * u + kcol); }
        cntr += __popc(g16);
      }
      unsigned long long need = __ballot(cntr > CAP - 64);
      while (need) {
        int l = __ffsll((long long)need) - 1;
        int qc = l >> 4;
        need &= ~(0xFFFFull << (qc * 16));
        int qlc = wid * 4 + qc;
        int n = __builtin_amdgcn_readlane(cntr, qc * 16);
        if (n > CAP) n = CAP;
        int nc; float nt;
        idx_compact(cval + qlc * CAP, cidx + qlc * CAP, n, lane, nc, nt);
        if (qsub == qc) { thr = nt; cntr = nc; }
      }
    }
  };

  bf16x8 bA[4][2], bB[4][2];
  const int lastc = nchunks - 1;
  idx_load_keys(p, tb, 0, kcol, lane, bA);
  for (int ch = 0; ch < nchunks; ch += 2) {
    idx_load_keys(p, tb, min(ch + 1, lastc) * kmul, kcol, lane, bB);
    process(bA, ch * 64);
    idx_load_keys(p, tb, min(ch + 2, lastc) * kmul, kcol, lane, bA);
    if (ch + 1 < nchunks) process(bB, (ch + 1) * 64);
  }
  for (int qc = 0; qc < 4; ++qc) {
    int qlc = wid * 4 + qc;
    int n = __builtin_amdgcn_readlane(cntr, qc * 16);
    if (n > CAP) n = CAP;
    u32* cv = cval + qlc * CAP; u16* ci = cidx + qlc * CAP;
    u16* out = p.sel() + (size_t)(tb + i0 + qlc) * 256;
    if (n <= 256) {
#pragma unroll
      for (int k = 0; k < 4; ++k) {
        int e = lane + 64 * k;
        out[e] = (e < n) ? ci[e] : (u16)0xFFFF;
      }
    } else {
      u32 key[12]; u16 idx[12];
#pragma unroll
      for (int k = 0; k < 12; ++k) {
        int e = lane + 64 * k;
        bool in = e < n;
        key[k] = in ? sortable(cv[e]) : 0u;
        idx[k] = in ? ci[e] : (u16)0;
      }
      u32 lo, hi; int limit;
      radix_partition(key, n, 256, 0, lo, hi, limit);
      int base = 0, tcnt = 0;
#pragma unroll
      for (int k = 0; k < 12; ++k) {
        bool eq = key[k] >= lo && key[k] <= hi;
        unsigned long long meq = __ballot(eq);
        bool keep = (key[k] > hi) || (eq && (tcnt + mbcnt64(meq)) < limit);
        unsigned long long m = __ballot(keep);
        int pos = base + mbcnt64(m);
        if (keep && pos < 256) ci[pos] = idx[k];
        base += __popcll(m);
        tcnt += __popcll(meq);
      }
      __builtin_amdgcn_wave_barrier();
      *reinterpret_cast<uint2*>(out + lane * 4) = *reinterpret_cast<const uint2*>(ci + lane * 4);
      __builtin_amdgcn_wave_barrier();
    }
  }
}

__device__ void convert_expert_tables(const Params& p) {
  const int tid = threadIdx.x, lane = tid & 63, wid = tid >> 6;
  for (int rb = blockIdx.x; rb < 8192; rb += gridDim.x) {
    int r = rb * 4 + wid;
    bool isu = r < 16384;
    int rr = isu ? r : r - 16384;
    const float* src = (isu ? p.peer_u : p.peer_v) + (size_t)rr * 1024 + lane * 16;
    float v[16];
#pragma unroll
    for (int i = 0; i < 4; ++i) {
      float4 q = *reinterpret_cast<const float4*>(src + 4 * i);
      v[4 * i] = q.x; v[4 * i + 1] = q.y; v[4 * i + 2] = q.z; v[4 * i + 3] = q.w;
    }
    if (isu) {
#pragma unroll
      for (int i = 0; i < 4; ++i) {
        float4 g = *reinterpret_cast<const float4*>(p.norm2_g + lane * 16 + 4 * i);
        v[4 * i] *= g.x; v[4 * i + 1] *= g.y; v[4 * i + 2] *= g.z; v[4 * i + 3] *= g.w;
      }
    }
    float amax = 0.f;
#pragma unroll
    for (int i = 0; i < 16; ++i) amax = fmaxf(amax, fabsf(v[i]));
#pragma unroll
    for (int m = 32; m >= 1; m >>= 1) amax = fmaxf(amax, __shfl_xor(amax, m));
    int ex = 0;
    if (amax > 0.f) ex = ilogbf(224.f / amax);
    ex = ex > 60 ? 60 : (ex < -60 ? -60 : ex);
    float sc = ldexpf(1.f, ex);
    u32 w[4];
#pragma unroll
    for (int i = 0; i < 4; ++i) {
      int t = __builtin_amdgcn_cvt_pk_fp8_f32(v[4 * i] * sc, v[4 * i + 1] * sc, 0, false);
      t = __builtin_amdgcn_cvt_pk_fp8_f32(v[4 * i + 2] * sc, v[4 * i + 3] * sc, t, true);
      w[i] = (u32)t;
    }
    uint4 o = {w[0], w[1], w[2], w[3]};
    *reinterpret_cast<uint4*>((isu ? p.U8() : p.V8()) + (size_t)(lane >> 3) * 2097152 + (size_t)rr * 128 + (lane & 7) * 16) = o;
    if (lane == 0) p.sx()[rr * 2 + (isu ? 0 : 1)] = (u8)(signed char)(-ex);
  }
}

__device__ void phase_attn(const Params& p, char* smem) {
  const int tid = threadIdx.x, lane = tid & 63, wid = tid >> 6;
  constexpr int WSTRIDE = 13312;
  u16* lidx = reinterpret_cast<u16*>(smem + wid * WSTRIDE);
  float* Pt = reinterpret_cast<float*>(smem + wid * WSTRIDE + 512);
  char* tile = smem + wid * WSTRIDE + 1024;
  const float sq = p.scal()[0];
  const float lf = 0.08838834764831845f * 1.4426950408889634f * p.scal()[3];
  const float ovs = p.scal()[4];
  const int xq = blockIdx.x & 7;
  const int b = xq & 1;
  const int rblk = (blockIdx.x >> 3) * 4 + (xq >> 1);
  const int nrb = (gridDim.x >> 3) * 4;
  const int n16 = lane & 15, g4 = lane >> 4;
  for (int i = rblk * 4 + wid; i < SEQ; i += nrb * 4) {
    const int tq = b * SEQ + i;
    const size_t tb = (size_t)b * SEQ;
    __builtin_amdgcn_wave_barrier();
    {
      uint2 v = *reinterpret_cast<const uint2*>(p.sel() + (size_t)tq * 256 + lane * 4);
      *reinterpret_cast<uint2*>(lidx + lane * 4) = v;
    }
    __builtin_amdgcn_wave_barrier();
    long qf[4];
#pragma unroll
    for (int s = 0; s < 4; ++s) {
      qf[s] = 0;
      if (n16 < 4) {
        float qv[8];
        unpack8(*reinterpret_cast<const uint4*>(p.qh() + (size_t)tq * 512 + n16 * 128 + 32 * s + 8 * g4), qv);
        int w0 = __builtin_amdgcn_cvt_pk_fp8_f32(qv[0] * sq, qv[1] * sq, 0, false);
        w0 = __builtin_amdgcn_cvt_pk_fp8_f32(qv[2] * sq, qv[3] * sq, w0, true);
        int w1 = __builtin_amdgcn_cvt_pk_fp8_f32(qv[4] * sq, qv[5] * sq, 0, false);
        w1 = __builtin_amdgcn_cvt_pk_fp8_f32(qv[6] * sq, qv[7] * sq, w1, true);
        qf[s] = (long)(((unsigned long long)(u32)w1 << 32) | (unsigned long long)(u32)w0);
      }
    }
    float mrun[4] = {-1e30f, -1e30f, -1e30f, -1e30f}, lrun[4] = {0.f, 0.f, 0.f, 0.f};
    float2_t o2[4][4];
#pragma unroll
    for (int h = 0; h < 4; ++h)
#pragma unroll
      for (int j = 0; j < 4; ++j) { o2[h][j].x = 0.f; o2[h][j].y = 0.f; }
    u32x4 kr[8];
#pragma unroll
    for (int r = 0; r < 8; ++r) {
      int id = lidx[r * 4 + g4];
      int idc = (id <= i) ? id : 0;
      kr[r] = *reinterpret_cast<const u32x4*>(p.kv8() + (tb + idc) * 256 + n16 * 16);
    }
#pragma unroll 1
    for (int g2 = 0; g2 < 8; ++g2) {
      __builtin_amdgcn_wave_barrier();
#pragma unroll
      for (int r = 0; r < 8; ++r) *reinterpret_cast<u32x4*>(tile + (r * 4 + g4) * 272 + n16 * 16) = kr[r];
      __builtin_amdgcn_wave_barrier();
      {
        const int gn = (g2 < 7) ? g2 + 1 : 7;
#pragma unroll
        for (int r = 0; r < 8; ++r) {
          int id = lidx[gn * 32 + r * 4 + g4];
          int idc = (id <= i) ? id : 0;
          kr[r] = *reinterpret_cast<const u32x4*>(p.kv8() + (tb + idc) * 256 + n16 * 16);
        }
      }
      float sc[2][4];
#pragma unroll
      for (int tt = 0; tt < 2; ++tt) {
        int id = lidx[g2 * 32 + tt * 16 + n16];
        bool valid = id <= i;
        f32x4 acc = {0.f, 0.f, 0.f, 0.f};
#pragma unroll
        for (int s = 0; s < 4; ++s) {
          long kf = *reinterpret_cast<const long*>(tile + (tt * 16 + n16) * 272 + 32 * s + 8 * g4);
          acc = __builtin_amdgcn_mfma_f32_16x16x32_fp8_fp8(qf[s], kf, acc, 0, 0, 0);
        }
#pragma unroll
        for (int h = 0; h < 4; ++h) sc[tt][h] = valid ? acc[h] * lf : -1e30f;
      }
      float alpha[4], pp[2][4];
#pragma unroll
      for (int h = 0; h < 4; ++h) {
        float mg = max16(fmaxf(sc[0][h], sc[1][h]));
        float mnew = fmaxf(mrun[h], __int_as_float(__builtin_amdgcn_readfirstlane(__float_as_int(mg))));
        alpha[h] = __builtin_amdgcn_exp2f(mrun[h] - mnew);
        mrun[h] = mnew;
        pp[0][h] = __builtin_amdgcn_exp2f(sc[0][h] - mnew);
        pp[1][h] = __builtin_amdgcn_exp2f(sc[1][h] - mnew);
        float ls = sum16(pp[0][h] + pp[1][h]);
        lrun[h] = lrun[h] * alpha[h] + __int_as_float(__builtin_amdgcn_readfirstlane(__float_as_int(ls)));
      }
      if (lane < 16) {
        *reinterpret_cast<float4*>(Pt + lane * 4) = make_float4(pp[0][0], pp[0][1], pp[0][2], pp[0][3]);
        *reinterpret_cast<float4*>(Pt + (16 + lane) * 4) = make_float4(pp[1][0], pp[1][1], pp[1][2], pp[1][3]);
      }
#pragma unroll
      for (int h = 0; h < 4; ++h) {
        float2_t a2 = {alpha[h], alpha[h]};
#pragma unroll
        for (int j = 0; j < 4; ++j) o2[h][j] *= a2;
      }
      __builtin_amdgcn_wave_barrier();
#pragma unroll
      for (int it = 0; it < 8; ++it) {
        const int nk = it * 4 + g4;
        float4 pw = *reinterpret_cast<const float4*>(Pt + nk * 4);
        uint2 q = *reinterpret_cast<const uint2*>(tile + nk * 272 + 128 + n16 * 8);
        float2_t v2[4] = {__builtin_amdgcn_cvt_pk_f32_fp8((int)q.x, false), __builtin_amdgcn_cvt_pk_f32_fp8((int)q.x, true),
                          __builtin_amdgcn_cvt_pk_f32_fp8((int)q.y, false), __builtin_amdgcn_cvt_pk_f32_fp8((int)q.y, true)};
        float pv[4] = {pw.x, pw.y, pw.z, pw.w};
#pragma unroll
        for (int h = 0; h < 4; ++h) {
          float2_t ph = {pv[h], pv[h]};
#pragma unroll
          for (int j = 0; j < 4; ++j) o2[h][j] += ph * v2[j];
        }
      }
      __builtin_amdgcn_wave_barrier();
    }
#pragma unroll
    for (int h = 0; h < 4; ++h) {
      float inv = ovs * __builtin_amdgcn_rcpf(lrun[h]);
      float ov[8];
#pragma unroll
      for (int j = 0; j < 4; ++j) {
        float x0 = o2[h][j].x, x1 = o2[h][j].y;
        x0 += __shfl_xor(x0, 16); x0 += __shfl_xor(x0, 32);
        x1 += __shfl_xor(x1, 16); x1 += __shfl_xor(x1, 32);
        ov[2 * j] = x0 * inv; ov[2 * j + 1] = x1 * inv;
      }
      if (g4 == 0) *reinterpret_cast<uint4*>(p.yb() + (size_t)tq * 512 + h * 128 + n16 * 8) = pack8(ov);
    }
  }
  convert_expert_tables(p);
}

__device__ void phase_merge(const Params& p, char* smem) {
  const int tid = threadIdx.x, lane = tid & 63, wid = tid >> 6;
  float* cs = reinterpret_cast<float*>(smem);
  constexpr int NTILES = (T / 128) * 8;
  int mt, nt;
  bool have = tile_swizzle(0, 8, NTILES, mt, nt);
  Tile4 ra, rb;
  if (have) gemm_prefetch(p.ya() + (size_t)mt * 128 * 512, 512, p.WaT() + (size_t)nt * 128 * 512, 512, 512, ra, rb);
  for (int step = 0; have; ++step) {
    int m0 = mt * 128, n0 = nt * 128;
    f32x16 acc[2][2];
    zero_acc(acc);
    gemm_mainloop(p.ya() + (size_t)m0 * 512, 512, p.WaT() + (size_t)n0 * 512, 512, 512, acc, smem, ra, rb);
    stage_acc(acc, cs);
    __syncthreads();
    gemm_prefetch(p.yb() + (size_t)m0 * 512, 512, p.WbT() + (size_t)n0 * 512, 512, 512, ra, rb);
#pragma unroll 2
    for (int it = 0; it < 8; ++it) {
      const int row = wid * 32 + it * 4 + (lane >> 4), c0 = (lane & 15) * 8;
      float v[8], g[8];
      load8(cs + row * CS_LD + c0, v);
      unpack8(*reinterpret_cast<const uint4*>(p.sg() + (size_t)(m0 + row) * 2048 + n0 + c0), g);
#pragma unroll
      for (int e = 0; e < 8; ++e) v[e] *= g[e];
      *reinterpret_cast<uint4*>(p.merged() + (size_t)(m0 + row) * 1024 + n0 + c0) = pack8(v);
    }
    __syncthreads();
    zero_acc(acc);
    gemm_mainloop(p.yb() + (size_t)m0 * 512, 512, p.WbT() + (size_t)n0 * 512, 512, 512, acc, smem, ra, rb);
    stage_acc(acc, cs);
    __syncthreads();
    int mt2 = 0, nt2 = 0;
    const bool nxt = tile_swizzle(step + 1, 8, NTILES, mt2, nt2);
    if (nxt) gemm_prefetch(p.ya() + (size_t)mt2 * 128 * 512, 512, p.WaT() + (size_t)nt2 * 128 * 512, 512, 512, ra, rb);
#pragma unroll 2
    for (int it = 0; it < 8; ++it) {
      const int row = wid * 32 + it * 4 + (lane >> 4), c0 = (lane & 15) * 8;
      float v[8], g[8], pa[8];
      load8(cs + row * CS_LD + c0, v);
      unpack8(*reinterpret_cast<const uint4*>(p.sg() + (size_t)(m0 + row) * 2048 + 1024 + n0 + c0), g);
      uint4* mp = reinterpret_cast<uint4*>(p.merged() + (size_t)(m0 + row) * 1024 + n0 + c0);
      unpack8(*mp, pa);
#pragma unroll
      for (int e = 0; e < 8; ++e) v[e] = pa[e] + v[e] * g[e];
      *mp = pack8(v);
    }
    mt = mt2; nt = nt2; have = nxt;
  }
}

__device__ void phase_wo(const Params& p, char* smem) {
  const int tid = threadIdx.x, lane = tid & 63, wid = tid >> 6;
  float* cs = reinterpret_cast<float*>(smem);
  constexpr int NTILES = (T / 128) * 8;
  int mt, nt;
  bool have = tile_swizzle(0, 8, NTILES, mt, nt);
  Tile4 ra, rb;
  if (have) gemm_prefetch(p.merged() + (size_t)mt * 128 * 1024, 1024, p.WoT() + (size_t)nt * 128 * 1024, 1024, 1024, ra, rb);
  for (int step = 0; have; ++step) {
    int m0 = mt * 128, n0 = nt * 128;
    f32x16 acc[2][2];
    zero_acc(acc);
    gemm_mainloop(p.merged() + (size_t)m0 * 1024, 1024, p.WoT() + (size_t)n0 * 1024, 1024, 1024, acc, smem, ra, rb);
    stage_acc(acc, cs);
    __syncthreads();
    int mt2 = 0, nt2 = 0;
    const bool nxt = tile_swizzle(step + 1, 8, NTILES, mt2, nt2);
    if (nxt) gemm_prefetch(p.merged() + (size_t)mt2 * 128 * 1024, 1024, p.WoT() + (size_t)nt2 * 128 * 1024, 1024, 1024, ra, rb);
#pragma unroll 2
    for (int it = 0; it < 8; ++it) {
      const int row = wid * 32 + it * 4 + (lane >> 4), c0 = (lane & 15) * 8;
      const size_t t = (size_t)m0 + row;
      float v[8], xv[8];
      load8(cs + row * CS_LD + c0, v);
      load8(p.x + t * 1024 + n0 + c0, xv);
      float ss = 0.f;
#pragma unroll
      for (int e = 0; e < 8; ++e) { v[e] += xv[e]; ss += v[e] * v[e]; }
      *reinterpret_cast<uint4*>(p.h1b() + t * 1024 + n0 + c0) = pack8(v);
      ss = sum16(ss);
      if ((lane & 15) == 0) p.ssq()[(size_t)nt * T + t] = ss;
    }
    mt = mt2; nt = nt2; have = nxt;
  }
}

__device__ __forceinline__ void ins16(float (&l)[16], float v) {
#pragma unroll
  for (int q = 15; q >= 1; --q) l[q] = __builtin_amdgcn_fmed3f(v, l[q - 1], l[q]);
  l[0] = fmaxf(l[0], v);
}
__device__ void phase_peerq(const Params& p, char* smem) {
  const int tid = threadIdx.x, lane = tid & 63, wid = tid >> 6;
  const int wr = wid >> 1, wc = wid & 1;
  float* cs = reinterpret_cast<float*>(smem);
  constexpr int NTILES = (T / 128) * 16;
  int mt, hp;
  bool have = tile_swizzle(0, 16, NTILES, mt, hp);
  Tile4 ra, rb;
  if (have) gemm_prefetch(p.h1b() + (size_t)mt * 128 * 1024, 1024, p.WqT() + (size_t)hp * 128 * 1024, 1024, 1024, ra, rb);
  for (int step = 0; have; ++step) {
    int m0 = mt * 128;
    f32x16 acc[2][2];
    zero_acc(acc);
    gemm_mainloop(p.h1b() + (size_t)m0 * 1024, 1024, p.WqT() + (size_t)hp * 128 * 1024, 1024, 1024, acc, smem, ra, rb);
#pragma unroll
    for (int i = 0; i < 2; ++i)
#pragma unroll
      for (int j = 0; j < 2; ++j)
#pragma unroll
        for (int r = 0; r < 16; ++r) {
          int row = wr * 64 + i * 32 + (r & 3) + 8 * (r >> 2) + 4 * (lane >> 5);
          int col = wc * 64 + j * 32 + (lane & 31);
          *reinterpret_cast<u16*>(smem + (col >> 6) * ABUF + row * 144 + (col & 63) * 2) = f2bf(acc[i][j][r]);
        }
    {
      const u16* sk = p.SubK() + (size_t)hp * 128 * 128;
#pragma unroll
      for (int i = 0; i < 8; ++i) {
        int c = tid + 256 * i;
        int row = c >> 4, kc = c & 15;
        uint4 q = *reinterpret_cast<const uint4*>(sk + row * 128 + kc * 8);
        *reinterpret_cast<uint4*>(smem + (2 + (kc >> 3)) * ABUF + row * 144 + (kc & 7) * 16) = q;
      }
    }
    __syncthreads();
    zero_acc(acc);
    mma_ktile(smem, smem + 2 * ABUF, acc);
    mma_ktile(smem + ABUF, smem + 3 * ABUF, acc);
    __syncthreads();
    stage_acc(acc, cs);
    __syncthreads();
    int mt2 = 0, hp2 = 0;
    const bool nxt = tile_swizzle(step + 1, 16, NTILES, mt2, hp2);
    if (nxt) gemm_prefetch(p.h1b() + (size_t)mt2 * 128 * 1024, 1024, p.WqT() + (size_t)hp2 * 128 * 1024, 1024, 1024, ra, rb);
    {
      int row = tid >> 1, half = tid & 1;
      float* rp = cs + row * CS_LD + half * 64;
      float l[16];
#pragma unroll
      for (int q = 0; q < 16; ++q) l[q] = -INFINITY;
      for (int c = 0; c < 64; c += 4) {
        float4 v4 = *reinterpret_cast<const float4*>(rp + c);
        float vv[4] = {v4.x, v4.y, v4.z, v4.w};
#pragma unroll
        for (int e = 0; e < 4; ++e) {
          u32 bits = __float_as_uint(vv[e]);
          u32 n = (u32)(half * 64 + c + e);
          bits = (bits & ~127u) | ((bits >> 31) ? n : (127u - n));
          ins16(l, __uint_as_float(bits));
        }
      }
#pragma unroll
      for (int q = 0; q < 16; ++q) rp[q] = l[q];
    }
    __syncthreads();
    if (tid < 128) {
      int row = tid;
      size_t t = (size_t)m0 + row;
      const float* la = cs + row * CS_LD;
      const float* lb = la + 64;
      float ssum = 0.f;
#pragma unroll
      for (int q = 0; q < 8; ++q) ssum += p.ssq()[(size_t)q * T + t];
      float rt = rsqrtf(ssum * (1.f / 1024.f) + EPS);
      int ia = 0, ib = 0;
      float* ov = p.stv() + ((size_t)hp * T + t) * 16;
      u8* oi = p.sti() + ((size_t)hp * T + t) * 16;
      float ovv[16]; u32 oii[4] = {0u, 0u, 0u, 0u};
#pragma unroll
      for (int q = 0; q < 16; ++q) {
        float va = la[ia], vb = lb[ib];
        bool ta = va >= vb;
        float v = ta ? va : vb;
        ia += ta ? 1 : 0;
        ib += ta ? 0 : 1;
        u32 bits = __float_as_uint(v);
        u32 low = bits & 127u;
        u32 n = (bits >> 31) ? low : (127u - low);
        ovv[q] = __uint_as_float(bits & ~127u) * rt;
        oii[q >> 2] |= n << (8 * (q & 3));
      }
#pragma unroll
      for (int q = 0; q < 4; ++q) *reinterpret_cast<float4*>(ov + 4 * q) = make_float4(ovv[4 * q], ovv[4 * q + 1], ovv[4 * q + 2], ovv[4 * q + 3]);
      *reinterpret_cast<uint4*>(oi) = make_uint4(oii[0], oii[1], oii[2], oii[3]);
    }
    mt = mt2; hp = hp2; have = nxt;
  }
}

__device__ void phase_peer_lists(const Params& p, char* smem) {
  const int nthr = gridDim.x * NTHREADS;
  int tid = threadIdx.x;
  asm volatile("" : "+v"(tid));
  u16* sxl = reinterpret_cast<u16*>(smem);
  float* vls = reinterpret_cast<float*>(smem + 32768) + tid;
  u8* xls = reinterpret_cast<u8*>(smem + 65536) + tid * 4;
  __syncthreads();
#pragma unroll
  for (int i = 0; i < 8; ++i)
    reinterpret_cast<u32x4*>(smem)[tid + 256 * i] = reinterpret_cast<const u32x4*>(p.sx())[tid + 256 * i];
  __syncthreads();
  for (int it = blockIdx.x * NTHREADS + tid; it < T * 8; it += nthr) {
    const size_t t = (size_t)(it >> 3);
    const int h = it & 7;
    const float* v1 = p.stv() + ((size_t)(2 * h) * T + t) * 16;
    const float* v2 = v1 + (size_t)T * 16;
    const u8* x1 = p.sti() + ((size_t)(2 * h) * T + t) * 16;
    const u8* x2 = x1 + (size_t)T * 16;
    float s1[16], s2[16];
#pragma unroll
    for (int c = 0; c < 4; ++c) {
      const f32x4 a = *reinterpret_cast<const f32x4*>(v1 + 4 * c), b = *reinterpret_cast<const f32x4*>(v2 + 4 * c);
#pragma unroll
      for (int e = 0; e < 4; ++e) { s1[4 * c + e] = a[e]; s2[4 * c + e] = b[e]; }
    }
    {
      const u32x4 xa = *reinterpret_cast<const u32x4*>(x1), xb = *reinterpret_cast<const u32x4*>(x2);
#pragma unroll
      for (int e = 0; e < 4; ++e) {
        *reinterpret_cast<u32*>(xls + e * 1024) = xa[e];
        *reinterpret_cast<u32*>(xls + (4 + e) * 1024) = xb[e];
      }
    }
#pragma unroll
    for (int e = 0; e < 16; ++e) { vls[e * 256] = s1[e]; vls[(16 + e) * 256] = s2[e]; }
    float l[16];
#pragma unroll
    for (int i = 0; i < 16; ++i)
#pragma unroll
      for (int j = 0; j < 16 / (i + 1); ++j) {
        const u32 pr = (u32)(i * 16 + j);
        u32 bits = __float_as_uint(s1[i] + s2[j]);
        bits = (bits & ~255u) | ((bits >> 31) ? pr : (255u - pr));
        const float v = __uint_as_float(bits);
        if (i == 0) l[j] = v;
        else {
          const int r0 = (i + 1) * (j + 1) - 1;
#pragma unroll
          for (int q = 15; q > r0; --q) l[q] = __builtin_amdgcn_fmed3f(v, l[q - 1], l[q]);
          l[r0] = fmaxf(l[r0], v);
        }
      }
    float bv[16], m = -INFINITY;
    u32 ex[16];
#pragma unroll
    for (int q = 0; q < 16; ++q) {
      const u32 bits = __float_as_uint(l[q]);
      const u32 low = bits & 255u;
      const u32 prq = (bits >> 31) ? low : (255u - low);
      const u32 i = prq >> 4, j = prq & 15u;
      bv[q] = vls[i * 256] + vls[(16 + j) * 256];
      ex[q] = (u32)xls[(i >> 2) * 1024 + (i & 3)] * 128u + (u32)xls[(4 + (j >> 2)) * 1024 + (j & 3)];
      m = fmaxf(m, bv[q]);
    }
    float ssum = 0.f;
#pragma unroll
    for (int q = 0; q < 16; ++q) { bv[q] = __expf(bv[q] - m); ssum += bv[q]; }
    const float inv = 1.f / ssum;
    float gvq[16], suq[16];
#pragma unroll
    for (int q = 0; q < 16; ++q) {
      const int sxe = (int)sxl[ex[q]];
      const int eu = (int)(signed char)(sxe & 0xff), ev = (int)(signed char)(sxe >> 8);
      suq[q] = __uint_as_float((u32)(127 + eu) << 23);
      gvq[q] = bv[q] * inv * __uint_as_float((u32)(127 + ev) << 23);
    }
    u16* oe = p.eidT() + t * 128 + h * 16;
    float* og = p.egv() + t * 128 + h * 16;
    float* os = p.esu() + t * 128 + h * 16;
#pragma unroll
    for (int c = 0; c < 2; ++c) {
      u32x4 w;
#pragma unroll
      for (int e = 0; e < 4; ++e) w[e] = ex[8 * c + 2 * e] | (ex[8 * c + 2 * e + 1] << 16);
      *reinterpret_cast<u32x4*>(oe + 8 * c) = w;
    }
#pragma unroll
    for (int c = 0; c < 4; ++c) {
      const f32x4 a = {gvq[4 * c], gvq[4 * c + 1], gvq[4 * c + 2], gvq[4 * c + 3]};
      const f32x4 b = {suq[4 * c], suq[4 * c + 1], suq[4 * c + 2], suq[4 * c + 3]};
      *reinterpret_cast<f32x4*>(og + 4 * c) = a;
      *reinterpret_cast<f32x4*>(os + 4 * c) = b;
    }
  }
}

__device__ __forceinline__ u32 eid_at(const u32x4& a, const u32x4& b, int j) {
  const u32 w = (j < 8) ? a[(j >> 1) & 3] : b[(j >> 1) & 3];
  return (j & 1) ? (w >> 16) : (w & 0xffffu);
}
__device__ __forceinline__ float dot16_fp8(const u32x4& u, const float2_t (&h2)[8]) {
  float2_t acc = __builtin_amdgcn_cvt_pk_f32_fp8((int)u[0], false) * h2[0];
  acc += __builtin_amdgcn_cvt_pk_f32_fp8((int)u[0], true) * h2[1];
#pragma unroll
  for (int q = 1; q < 4; ++q) {
    acc += __builtin_amdgcn_cvt_pk_f32_fp8((int)u[q], false) * h2[2 * q];
    acc += __builtin_amdgcn_cvt_pk_f32_fp8((int)u[q], true) * h2[2 * q + 1];
  }
  return acc.x + acc.y;
}
__device__ __forceinline__ void axpy16_fp8(float c, const u32x4& v, float2_t (&y2)[8]) {
  const float2_t c2 = {c, c};
#pragma unroll
  for (int q = 0; q < 4; ++q) {
    y2[2 * q] += c2 * __builtin_amdgcn_cvt_pk_f32_fp8((int)v[q], false);
    y2[2 * q + 1] += c2 * __builtin_amdgcn_cvt_pk_f32_fp8((int)v[q], true);
  }
}
#define PEER_CLAMP(x) ((x) < T ? (x) : T - 1)

__device__ void phase_peer_u(const Params& p) {
  int tid = threadIdx.x;
  asm volatile("" : "+v"(tid));
  const int lane = tid & 63, wid = tid >> 6;
  const int k = lane >> 3, g = lane & 7;
  const int slice = blockIdx.x & 7;
  const int nw = ((int)(gridDim.x + 7 - slice) >> 3) * 4;
  const u8* ub = p.U8() + (size_t)slice * 2097152;
  const u32 g16 = g * 16;
  const u16* ep = p.eidT() + k * 16;
  const u16* hp = p.h1b() + slice * 128 + g * 16;
  int t = (blockIdx.x >> 3) * 4 + wid;
  u32x4 ch0, ch1, ne0, ne1, nh0, nh1;
  u32x4 ua[8], uc[8];
  {
    const size_t tc = PEER_CLAMP(t);
    const u32x4 ce0 = *reinterpret_cast<const u32x4*>(ep + tc * 128), ce1 = *reinterpret_cast<const u32x4*>(ep + tc * 128 + 8);
    ch0 = *reinterpret_cast<const u32x4*>(hp + tc * 1024); ch1 = *reinterpret_cast<const u32x4*>(hp + tc * 1024 + 8);
    const size_t tn = PEER_CLAMP(t + nw);
    ne0 = *reinterpret_cast<const u32x4*>(ep + tn * 128); ne1 = *reinterpret_cast<const u32x4*>(ep + tn * 128 + 8);
    nh0 = *reinterpret_cast<const u32x4*>(hp + tn * 1024); nh1 = *reinterpret_cast<const u32x4*>(hp + tn * 1024 + 8);
#pragma unroll
    for (int j = 0; j < 8; ++j) ua[j] = *reinterpret_cast<const u32x4*>(ub + (eid_at(ce0, ce1, j) * 128u + g16));
#pragma unroll
    for (int j = 0; j < 8; ++j) uc[j] = *reinterpret_cast<const u32x4*>(ub + (eid_at(ce0, ce1, 8 + j) * 128u + g16));
  }
  __builtin_amdgcn_s_waitcnt(0x0F70);
  for (; t < T; t += nw) {
    const size_t t2 = PEER_CLAMP(t + 2 * nw);
    const u32x4 pe0 = *reinterpret_cast<const u32x4*>(ep + t2 * 128), pe1 = *reinterpret_cast<const u32x4*>(ep + t2 * 128 + 8);
    const u32x4 ph0 = *reinterpret_cast<const u32x4*>(hp + t2 * 1024), ph1 = *reinterpret_cast<const u32x4*>(hp + t2 * 1024 + 8);
    float2_t h2[8];
#pragma unroll
    for (int q = 0; q < 4; ++q) {
      h2[q].x = bf_lo(ch0[q]); h2[q].y = bf_hi(ch0[q]);
      h2[4 + q].x = bf_lo(ch1[q]); h2[4 + q].y = bf_hi(ch1[q]);
    }
    float d[16];
#pragma unroll
    for (int j = 0; j < 8; ++j) d[j] = dot16_fp8(ua[j], h2);
#pragma unroll
    for (int j = 0; j < 8; ++j) ua[j] = *reinterpret_cast<const u32x4*>(ub + (eid_at(ne0, ne1, j) * 128u + g16));
#pragma unroll
    for (int j = 0; j < 8; ++j) d[8 + j] = dot16_fp8(uc[j], h2);
#pragma unroll
    for (int j = 0; j < 8; ++j) uc[j] = *reinterpret_cast<const u32x4*>(ub + (eid_at(ne0, ne1, 8 + j) * 128u + g16));
    float e8[8], f4[4], r2[2];
    {
      const bool b2 = (g & 4) != 0, b1 = (g & 2) != 0, b0 = (g & 1) != 0;
#pragma unroll
      for (int i = 0; i < 8; ++i) { const float kp = b2 ? d[i + 8] : d[i], snd = b2 ? d[i] : d[i + 8]; e8[i] = kp + DPPF(snd, 0x141); }
#pragma unroll
      for (int i = 0; i < 4; ++i) { const float kp = b1 ? e8[i + 4] : e8[i], snd = b1 ? e8[i] : e8[i + 4]; f4[i] = kp + DPPF(snd, 0x4E); }
#pragma unroll
      for (int i = 0; i < 2; ++i) { const float kp = b0 ? f4[i + 2] : f4[i], snd = b0 ? f4[i] : f4[i + 2]; r2[i] = kp + DPPF(snd, 0xB1); }
    }
    const float2_t o = {r2[0], r2[1]};
    *reinterpret_cast<float2_t*>(p.part() + ((size_t)t * 8 + slice) * 128 + lane * 2) = o;
    ch0 = nh0; ch1 = nh1; nh0 = ph0; nh1 = ph1; ne0 = pe0; ne1 = pe1;
  }
}

__device__ void phase_peer_coef(const Params& p) {
  int tid = threadIdx.x;
  asm volatile("" : "+v"(tid));
  const int lane = tid & 63, wid = tid >> 6;
#pragma unroll 4
  for (int tq = blockIdx.x * 4 + wid; tq < T; tq += gridDim.x * 4) {
    const size_t t = tq;
    float2_t s = {0.f, 0.f};
#pragma unroll
    for (int sl = 0; sl < 8; ++sl) s += *reinterpret_cast<const float2_t*>(p.part() + (t * 8 + sl) * 128 + lane * 2);
    float ssum = 0.f;
#pragma unroll
    for (int q = 0; q < 8; ++q) ssum += p.ssq()[(size_t)q * T + t];
    const float rt = rsqrtf(ssum * (1.f / 1024.f) + EPS);
    const float2_t su = *reinterpret_cast<const float2_t*>(p.esu() + t * 128 + lane * 2);
    const float2_t gv = *reinterpret_cast<const float2_t*>(p.egv() + t * 128 + lane * 2);
    float2_t c;
    c.x = gv.x * gelu_f(s.x * rt * su.x);
    c.y = gv.y * gelu_f(s.y * rt * su.y);
    *reinterpret_cast<float2_t*>(p.coef() + t * 128 + lane * 2) = c;
  }
}

__device__ void phase_peer_v(const Params& p, char* smem) {
  int tid = threadIdx.x;
  asm volatile("" : "+v"(tid));
  const int lane = tid & 63, wid = tid >> 6;
  const int k = lane >> 3, g = lane & 7;
  const int slice = blockIdx.x & 7;
  const int nw = ((int)(gridDim.x + 7 - slice) >> 3) * 4;
  const u8* vb = p.V8() + (size_t)slice * 2097152;
  const u32 g16 = g * 16;
  const u16* ep = p.eidT() + k * 16;
  const float* cp = p.coef() + k * 16;
  float* xs = reinterpret_cast<float*>(smem + wid * 512);
  const int wofs = g * 16 + ((k & 1) << 3) + ((k & 2) << 1) + ((k & 4) >> 1);
  int t = (blockIdx.x >> 3) * 4 + wid;
  u32x4 ne0, ne1;
  f32x4 cc0, cc1, cc2, cc3;
  u32x4 va[8], vc[8];
  {
    const size_t tc = PEER_CLAMP(t);
    const u32x4 ce0 = *reinterpret_cast<const u32x4*>(ep + tc * 128), ce1 = *reinterpret_cast<const u32x4*>(ep + tc * 128 + 8);
    cc0 = *reinterpret_cast<const f32x4*>(cp + tc * 128); cc1 = *reinterpret_cast<const f32x4*>(cp + tc * 128 + 4);
    cc2 = *reinterpret_cast<const f32x4*>(cp + tc * 128 + 8); cc3 = *reinterpret_cast<const f32x4*>(cp + tc * 128 + 12);
    const size_t tn = PEER_CLAMP(t + nw);
    ne0 = *reinterpret_cast<const u32x4*>(ep + tn * 128); ne1 = *reinterpret_cast<const u32x4*>(ep + tn * 128 + 8);
#pragma unroll
    for (int j = 0; j < 8; ++j) va[j] = *reinterpret_cast<const u32x4*>(vb + (eid_at(ce0, ce1, j) * 128u + g16));
#pragma unroll
    for (int j = 0; j < 8; ++j) vc[j] = *reinterpret_cast<const u32x4*>(vb + (eid_at(ce0, ce1, 8 + j) * 128u + g16));
  }
  __builtin_amdgcn_s_waitcnt(0x0F70);
  for (; t < T; t += nw) {
    const size_t t1 = PEER_CLAMP(t + nw), t2 = PEER_CLAMP(t + 2 * nw);
    const u32x4 pe0 = *reinterpret_cast<const u32x4*>(ep + t2 * 128), pe1 = *reinterpret_cast<const u32x4*>(ep + t2 * 128 + 8);
    const f32x4 pc0 = *reinterpret_cast<const f32x4*>(cp + t1 * 128), pc1 = *reinterpret_cast<const f32x4*>(cp + t1 * 128 + 4);
    const f32x4 pc2 = *reinterpret_cast<const f32x4*>(cp + t1 * 128 + 8), pc3 = *reinterpret_cast<const f32x4*>(cp + t1 * 128 + 12);
    const u32 hw = *reinterpret_cast<const u32*>(p.h1b() + (size_t)t * 1024 + slice * 128 + lane * 2);
    float2_t y2[8];
#pragma unroll
    for (int q = 0; q < 8; ++q) { y2[q].x = 0.f; y2[q].y = 0.f; }
#pragma unroll
    for (int j = 0; j < 4; ++j) axpy16_fp8(cc0[j], va[j], y2);
#pragma unroll
    for (int j = 0; j < 4; ++j) axpy16_fp8(cc1[j], va[4 + j], y2);
#pragma unroll
    for (int j = 0; j < 8; ++j) va[j] = *reinterpret_cast<const u32x4*>(vb + (eid_at(ne0, ne1, j) * 128u + g16));
#pragma unroll
    for (int j = 0; j < 4; ++j) axpy16_fp8(cc2[j], vc[j], y2);
#pragma unroll
    for (int j = 0; j < 4; ++j) axpy16_fp8(cc3[j], vc[4 + j], y2);
#pragma unroll
    for (int j = 0; j < 8; ++j) vc[j] = *reinterpret_cast<const u32x4*>(vb + (eid_at(ne0, ne1, 8 + j) * 128u + g16));
    float a8[8], b4[4];
    {
      const bool k0 = (k & 1) != 0, k1 = (k & 2) != 0;
#pragma unroll
      for (int i = 0; i < 8; ++i) {
        const float lo = (i & 1) ? y2[i >> 1].y : y2[i >> 1].x, hi = (i & 1) ? y2[4 + (i >> 1)].y : y2[4 + (i >> 1)].x;
        const float kp = k0 ? hi : lo, snd = k0 ? lo : hi;
        a8[i] = kp + DPPF(snd, 0x128);
      }
#pragma unroll
      for (int i = 0; i < 4; ++i) { const float kp = k1 ? a8[i + 4] : a8[i], snd = k1 ? a8[i] : a8[i + 4]; b4[i] = kp + __shfl_xor(snd, 16); }
    }
    float2_t c2;
    {
      auto r0 = __builtin_amdgcn_permlane32_swap(__float_as_uint(b4[0]), __float_as_uint(b4[2]), false, false);
      auto r1 = __builtin_amdgcn_permlane32_swap(__float_as_uint(b4[1]), __float_as_uint(b4[3]), false, false);
      c2.x = __uint_as_float(r0[0]) + __uint_as_float(r0[1]);
      c2.y = __uint_as_float(r1[0]) + __uint_as_float(r1[1]);
    }
    __builtin_amdgcn_wave_barrier();
    *reinterpret_cast<float2_t*>(xs + wofs) = c2;
    __builtin_amdgcn_wave_barrier();
    const float2_t yv = *reinterpret_cast<const float2_t*>(xs + lane * 2);
    const float2_t o = {bf_lo(hw) + yv.x, bf_hi(hw) + yv.y};
    *reinterpret_cast<float2_t*>(p.out + (size_t)t * 1024 + slice * 128 + lane * 2) = o;
    cc0 = pc0; cc1 = pc1; cc2 = pc2; cc3 = pc3; ne0 = pe0; ne1 = pe1;
  }
}

__device__ void phase_mix(const Params& p, char* smem) {
  const int G = gridDim.x;
  {
    int* qslot = reinterpret_cast<int*>(smem + EXTRA_OFF + 1024);
    for (;;) {
      __syncthreads();
      if (threadIdx.x == 0) *qslot = (int)__hip_atomic_fetch_add(p.bar() + 16, 1u, __ATOMIC_RELAXED, __HIP_MEMORY_SCOPE_AGENT);
      __syncthreads();
      const int s = *qslot;
      if (s >= 2048) break;
      int grp = 1023 - (s >> 1), b = s & 1;
      unit_indexer(p, smem, (b << 10) | grp);
    }
  }
  for (int u = blockIdx.x; u < 1024; u += G) unit_spatial(p, smem, u);
  for (int u = blockIdx.x; u < 256; u += G) unit_kv(p, smem, u);
}

template <int PH>
__device__ __forceinline__ void run_phase(const Params& p, char* smem) {
  if (PH == 0) phase_prep(p, smem);
  else if (PH == 1) phase_gemm1(p, smem);
  else if (PH == 2) phase_mix(p, smem);
  else if (PH == 3) phase_attn(p, smem);
  else if (PH == 4) phase_merge(p, smem);
  else if (PH == 5) phase_wo(p, smem);
  else if (PH == 6) phase_peerq(p, smem);
  else if (PH == 7) phase_peer_lists(p, smem);
  else if (PH == 8) phase_peer_u(p);
  else if (PH == 9) phase_peer_coef(p);
  else phase_peer_v(p, smem);
}

template <int PH>
__global__ void __launch_bounds__(NTHREADS, 2) phase_kernel(Params p) {
  __shared__ __attribute__((aligned(16))) char smem[SMEM_BYTES];
  run_phase<PH>(p, smem);
}

#define XB_CNT(j) (64 + 64 * (j))
#define XB_SUB(j) (1088 + 64 * (j))
#define XB_GEN(j) (2112 + 64 * (j))
#define XB_TOP 3136
#define XB_TOPGEN 3200
#define XB_WORDS 3264
__device__ __forceinline__ unsigned xb_ld(unsigned* q) { return __hip_atomic_load(q, __ATOMIC_RELAXED, __HIP_MEMORY_SCOPE_AGENT); }
__device__ __forceinline__ unsigned xb_add(unsigned* q) { return __hip_atomic_fetch_add(q, 1u, __ATOMIC_RELAXED, __HIP_MEMORY_SCOPE_AGENT); }
__device__ __forceinline__ unsigned xb_xcc_id() { return (unsigned)__builtin_amdgcn_s_getreg((3 << 11) | 20) & 0xFu; }
__device__ __forceinline__ void grid_barrier(unsigned* bar, unsigned x, unsigned nloc, unsigned nx) {
  asm volatile("s_waitcnt vmcnt(0)" ::: "memory");
  __syncthreads();
  if (threadIdx.x == 0) {
    const unsigned old = xb_add(&bar[XB_SUB(x)]);
    const unsigned gen = old / nloc;
    if (old + 1u == (gen + 1u) * nloc) {
      __builtin_amdgcn_fence(__ATOMIC_RELEASE, "agent");
      asm volatile("s_waitcnt vmcnt(0)" ::: "memory");
      const unsigned og = xb_add(&bar[XB_TOP]);
      const unsigned tg = og / nx;
      if (og + 1u == (tg + 1u) * nx) xb_add(&bar[XB_TOPGEN]);
      else { unsigned sp = 0; while (xb_ld(&bar[XB_TOPGEN]) == tg) { __builtin_amdgcn_s_sleep(1); if (++sp > (1u << 24)) break; } }
      __builtin_amdgcn_fence(__ATOMIC_ACQUIRE, "agent");
      xb_add(&bar[XB_GEN(x)]);
      asm volatile("s_waitcnt vmcnt(0)" ::: "memory");
    } else {
      unsigned sp = 0;
      while (xb_ld(&bar[XB_GEN(x)]) == gen) { __builtin_amdgcn_s_sleep(1); if (++sp > (1u << 24)) break; }
      __builtin_amdgcn_fence(__ATOMIC_ACQUIRE, "agent");
      asm volatile("s_waitcnt vmcnt(0)" ::: "memory");
    }
  }
  __syncthreads();
}

__global__ void __launch_bounds__(NTHREADS, 2) mega_kernel(Params p) {
  __shared__ __attribute__((aligned(16))) char smem[SMEM_BYTES];
  cg::grid_group grid = cg::this_grid();
#define GSYNC() grid_barrier(p.bar(), xb_x, xb_nloc, xb_nx)
  const unsigned xb_x = xb_xcc_id();
  if (threadIdx.x == 0) xb_add(&p.bar()[XB_CNT(xb_x)]);
  asm volatile("s_waitcnt vmcnt(0)" ::: "memory");
  grid.sync();
  unsigned xb_nloc = 1, xb_nx = 0;
  if (threadIdx.x == 0) {
    for (unsigned j = 0; j < 16; ++j) { const unsigned c = xb_ld(&p.bar()[XB_CNT(j)]); xb_nx += (c > 0u) ? 1u : 0u; if (j == xb_x) xb_nloc = c; }
    if (xb_nloc == 0u) xb_nloc = 1u;
    if (xb_nx == 0u) xb_nx = 1u;
  }
#define RUNP(X) run_phase<X>(p, smem); GSYNC();
#ifndef PROBE_DUP
#define PROBE_DUP 0
#endif
#define DUPP(X) if (PROBE_DUP == (X)) { RUNP(X) }
  RUNP(0) RUNP(1) RUNP(2) RUNP(3) RUNP(4) RUNP(5) RUNP(6) DUPP(7) RUNP(7) DUPP(8) RUNP(8) DUPP(9) RUNP(9) DUPP(10)
  run_phase<10>(p, smem);
}

extern "C" void kernel_launch(void* const* d_in, const int* in_sizes, int n_in, void* d_out, int out_size,
                              void* d_ws, size_t ws_size, hipStream_t stream) {
  Params p{};
  p.x = (const float*)d_in[0]; p.pos = (const int*)d_in[1];
  p.norm1_g = (const float*)d_in[2]; p.w_in = (const float*)d_in[3]; p.v_norm_g = (const float*)d_in[4];
  p.v_norm_b = (const float*)d_in[5]; p.spatial_w = (const float*)d_in[6]; p.spatial_b = (const float*)d_in[7];
  p.kv_norm_g = (const float*)d_in[8]; p.w_uk = (const float*)d_in[9]; p.w_uv = (const float*)d_in[10];
  p.q_norm_g = (const float*)d_in[11]; p.k_norm_g = (const float*)d_in[12]; p.w_a_out = (const float*)d_in[13];
  p.w_b_out = (const float*)d_in[14]; p.w_o = (const float*)d_in[15]; p.norm2_g = (const float*)d_in[16];
  p.peer_wq = (const float*)d_in[17]; p.peer_subkeys = (const float*)d_in[18]; p.peer_u = (const float*)d_in[19];
  p.peer_v = (const float*)d_in[20];
  p.out = (float*)d_out;
  p.ws = (char*)d_ws;
  if (O_END > ws_size) { fprintf(stderr, "workspace too small: need %zu have %zu\n", (size_t)O_END, ws_size); return; }

  static int grid_blocks = 0;
  if (!grid_blocks) {
    int dev = 0, cus = 0, per_cu = 0;
    hipGetDevice(&dev);
    hipDeviceGetAttribute(&cus, hipDeviceAttributeMultiprocessorCount, dev);
    hipOccupancyMaxActiveBlocksPerMultiprocessor(&per_cu, mega_kernel, NTHREADS, 0);
    if (per_cu > 2) per_cu = 2;
    if (per_cu < 1) per_cu = 1;
    grid_blocks = cus * per_cu;
    if (grid_blocks > 8) grid_blocks &= ~7;
  }
  hipMemsetAsync(p.ws + O_BAR, 0, XB_WORDS * 4, stream);
#if MULTI_LAUNCH
  dim3 g(grid_blocks), b(NTHREADS);
  phase_kernel<0><<<g, b, 0, stream>>>(p);
  phase_kernel<1><<<g, b, 0, stream>>>(p);
  phase_kernel<2><<<g, b, 0, stream>>>(p);
  phase_kernel<3><<<g, b, 0, stream>>>(p);
  phase_kernel<4><<<g, b, 0, stream>>>(p);
  phase_kernel<5><<<g, b, 0, stream>>>(p);
  phase_kernel<6><<<g, b, 0, stream>>>(p);
  phase_kernel<7><<<g, b, 0, stream>>>(p);
  phase_kernel<8><<<g, b, 0, stream>>>(p);
  phase_kernel<9><<<g, b, 0, stream>>>(p);
  phase_kernel<10><<<g, b, 0, stream>>>(p);
#else
  void* args[] = {&p};
  hipError_t e = hipLaunchCooperativeKernel((void*)mega_kernel, dim3(grid_blocks), dim3(NTHREADS), args, 0, stream);
  if (e != hipSuccess) fprintf(stderr, "cooperative launch failed: %s (grid %d)\n", hipGetErrorString(e), grid_blocks);
#endif
}
```

```cpp
#include <hip/hip_runtime.h>
#include <hip/hip_cooperative_groups.h>
#include <stdint.h>
#include <cstdio>
namespace cg = cooperative_groups;

#ifndef MULTI_LAUNCH
#define MULTI_LAUNCH 0
#endif

typedef unsigned short u16;
typedef unsigned int u32;
typedef unsigned char u8;
using bf16x8 = __attribute__((ext_vector_type(8))) short;
using f32x4 = __attribute__((ext_vector_type(4))) float;
using f32x16 = __attribute__((ext_vector_type(16))) float;
typedef __bf16 bf16x2_t __attribute__((ext_vector_type(2)));
typedef float float2_t __attribute__((ext_vector_type(2)));

constexpr int BATCH = 2, SEQ = 16384, DM = 1024, T = BATCH * SEQ;
constexpr int NWIN = 4224;
constexpr int NTHREADS = 256;
constexpr float EPS = 1e-6f;
constexpr int ABUF = 128 * 144;
constexpr int CS_LD = 132;
constexpr int SMEM_BYTES = 77824;
constexpr int EXTRA_OFF = 4 * ABUF;
constexpr int CAP = 768;

__constant__ float INV32[16] = {1.000000000e+00f, 4.403665960e-01f, 1.939227432e-01f, 8.539710194e-02f, 3.760603070e-02f, 1.656043902e-02f, 7.292664610e-03f, 3.211445874e-03f, 1.414213562e-03f, 6.227723788e-04f, 2.742481884e-04f, 1.207697351e-04f, 5.318296098e-05f, 2.341999971e-05f, 1.031338616e-05f, 4.541670478e-06f};
__constant__ float INV16[8] = {1.000000000e+00f, 1.939227432e-01f, 3.760603070e-02f, 7.292664610e-03f, 1.414213562e-03f, 2.742481884e-04f, 5.318296098e-05f, 1.031338616e-05f};
__constant__ u8 PAIR_TAB[56] = {
  0x00,0x01,0x02,0x03,0x04,0x05,0x06,0x07,0x08,0x09,0x0a,0x0b,0x0c,0x0d,0x0e,0x0f,
  0x10,0x11,0x12,0x13,0x14,0x15,0x16,0x17,
  0x20,0x21,0x22,0x23,0x24,
  0x30,0x31,0x32,0x33,
  0x40,0x41,0x42,
  0x50,0x51,
  0x60,0x61,
  0x70,0x71,
  0x80,0x90,0xa0,0xb0,0xc0,0xd0,0xe0,0xf0,
  0xff,0xff,0xff,0xff,0xff,0xff};

constexpr size_t MBY = (size_t)1 << 20;
constexpr size_t al256(size_t x) { return (x + 255) & ~(size_t)255; }
constexpr size_t O_XN = 0;
constexpr size_t O_WINT = O_XN + 64 * MBY;
constexpr size_t O_WAT = O_WINT + al256((size_t)NWIN * 1024 * 2);
constexpr size_t O_WBT = O_WAT + 1024 * 512 * 2;
constexpr size_t O_WOT = O_WBT + 1024 * 512 * 2;
constexpr size_t O_WQT = O_WOT + 1024 * 1024 * 2;
constexpr size_t O_WKVT = O_WQT + 2048 * 1024 * 2;
constexpr size_t O_SUBK = O_WKVT + 256 * 256 * 2;
constexpr size_t O_WTRIL = O_SUBK + 262144 * 2;
constexpr size_t O_U8 = O_WTRIL + 65536 * 2;
constexpr size_t O_V8 = O_U8 + 16 * MBY;
constexpr size_t O_SU = O_V8 + 16 * MBY;
constexpr size_t O_SV = O_SU + 16384 * 4;
constexpr size_t O_G = O_SV + 16384 * 4;
constexpr size_t O_KI = O_G + 128 * MBY;
constexpr size_t O_WI = O_KI + 4 * MBY;
constexpr size_t O_SG = O_WI + (size_t)T * 4 * 4;
constexpr size_t O_SEL = O_SG + 128 * MBY;
constexpr size_t O_KV8 = O_SEL + 16 * MBY;
constexpr size_t O_SCAL = O_KV8 + 8 * MBY;
constexpr size_t O_SSQ = O_SCAL + 256;
constexpr size_t O_BAR = O_SSQ + (size_t)T * 8 * 4;
constexpr size_t O_RTAB = O_BAR + al256(3264 * 4);
constexpr size_t O_WQN = O_RTAB + (size_t)T * 48 * 4;
constexpr size_t O_END = O_WQN + 1024 * 2048 * 2;

struct Params {
  const float* x; const int* pos;
  const float *norm1_g, *w_in, *v_norm_g, *v_norm_b, *spatial_w, *spatial_b, *kv_norm_g, *w_uk, *w_uv,
      *q_norm_g, *k_norm_g, *w_a_out, *w_b_out, *w_o, *norm2_g, *peer_wq, *peer_subkeys, *peer_u, *peer_v;
  float* out;
  char* ws;
#define WSP(TYPE, NAME, OFF) __device__ __forceinline__ TYPE* NAME() const { return reinterpret_cast<TYPE*>(ws + (OFF)); }
  WSP(u16, xn, O_XN) WSP(u16, ya, O_XN) WSP(u16, yb, O_XN + 32 * MBY)
  WSP(u16, eidT, O_XN) WSP(float, egv, O_XN + 8 * MBY) WSP(float, esu, O_XN + 24 * MBY) WSP(float, coef, O_XN + 40 * MBY)
  WSP(u8, chi, O_XN + 40 * MBY) WSP(u8, clo, O_XN + 44 * MBY) WSP(float, csc, O_XN + 48 * MBY)
  WSP(u16, WinT, O_WINT) WSP(u16, WaT, O_WAT) WSP(u16, WbT, O_WBT) WSP(u16, WoT, O_WOT) WSP(u16, WqT, O_WQT)
  WSP(u16, WkvT, O_WKVT) WSP(u16, SubK, O_SUBK) WSP(u16, Wtril, O_WTRIL)
  WSP(u8, U8, O_U8) WSP(u8, V8, O_V8) WSP(u8, sx, O_SU)
  WSP(u16, gu, O_G) WSP(u16, gv, O_G + 32 * MBY) WSP(u16, qh, O_G + 64 * MBY) WSP(u16, merged, O_G)
  WSP(u16, ckv, O_G + 96 * MBY) WSP(u16, qi, O_G + 112 * MBY) WSP(u32, part, O_G)
  WSP(u8, hhi, O_G + 64 * MBY) WSP(u8, hlo, O_G + 96 * MBY)
  WSP(u16, ki, O_KI) WSP(float, wi, O_WI)
  WSP(u16, sg, O_SG) WSP(u16, h1b, O_SG) WSP(float, stv, O_SG + 64 * MBY) WSP(u8, sti, O_SG + 96 * MBY)
  WSP(u16, sel, O_SEL) WSP(u8, kv8, O_KV8) WSP(float, scal, O_SCAL) WSP(float, ssq, O_SSQ)
  WSP(unsigned, bar, O_BAR)
  WSP(float, rtab, O_RTAB) WSP(u16, WqN, O_WQN)
#undef WSP
};

__device__ __forceinline__ u32 pack_bf16(float a, float b) {
  float2_t v = {a, b};
  bf16x2_t r = __builtin_convertvector(v, bf16x2_t);
  return __builtin_bit_cast(u32, r);
}
__device__ __forceinline__ u16 f2bf(float a) { return (u16)(pack_bf16(a, 0.f) & 0xffffu); }
__device__ __forceinline__ float bf_lo(u32 u) { return __uint_as_float(u << 16); }
__device__ __forceinline__ float bf_hi(u32 u) { return __uint_as_float(u & 0xffff0000u); }
__device__ __forceinline__ float bf2f(u16 h) { return __uint_as_float(((u32)h) << 16); }
__device__ __forceinline__ float wave_sum(float v) {
#pragma unroll
  for (int m = 32; m >= 1; m >>= 1) v += __shfl_xor(v, m);
  return v;
}
__device__ __forceinline__ float gelu_f(float x) {
  float z = -2.3022082f * (x + 0.044715f * x * x * x);
  return x * __builtin_amdgcn_rcpf(1.f + __builtin_amdgcn_exp2f(z));
}
__device__ __forceinline__ float sigmoid_f(float x) { return __builtin_amdgcn_rcpf(1.f + __builtin_amdgcn_exp2f(-1.4426950408889634f * x)); }
__device__ __forceinline__ u32 sortable(u32 b) { return b ^ ((u32)((int)b >> 31) | 0x80000000u); }
__device__ __forceinline__ u32 unsortable(u32 k) { return k ^ ((k & 0x80000000u) ? 0x80000000u : 0xffffffffu); }
__device__ __forceinline__ int mbcnt64(unsigned long long m) {
  return __builtin_amdgcn_mbcnt_hi((u32)(m >> 32), __builtin_amdgcn_mbcnt_lo((u32)m, 0));
}

__device__ __forceinline__ void load8(const float* p, float (&v)[8]) {
  float4 a = *reinterpret_cast<const float4*>(p), b = *reinterpret_cast<const float4*>(p + 4);
  v[0] = a.x; v[1] = a.y; v[2] = a.z; v[3] = a.w; v[4] = b.x; v[5] = b.y; v[6] = b.z; v[7] = b.w;
}
__device__ __forceinline__ void unpack8(uint4 q, float (&v)[8]) {
  v[0] = bf_lo(q.x); v[1] = bf_hi(q.x); v[2] = bf_lo(q.y); v[3] = bf_hi(q.y);
  v[4] = bf_lo(q.z); v[5] = bf_hi(q.z); v[6] = bf_lo(q.w); v[7] = bf_hi(q.w);
}
__device__ __forceinline__ uint4 pack8(const float (&v)[8]) {
  uint4 o = {pack_bf16(v[0], v[1]), pack_bf16(v[2], v[3]), pack_bf16(v[4], v[5]), pack_bf16(v[6], v[7])};
  return o;
}
#define DPPF(v, ctrl) __int_as_float(__builtin_amdgcn_update_dpp(0, __float_as_int(v), (ctrl), 0xF, 0xF, true))
__device__ __forceinline__ float sum16(float x) {
  x += DPPF(x, 0xB1); x += DPPF(x, 0x4E); x += DPPF(x, 0x141); x += DPPF(x, 0x140);
  return x;
}
__device__ __forceinline__ float max16(float x) {
  x = fmaxf(x, DPPF(x, 0xB1)); x = fmaxf(x, DPPF(x, 0x4E)); x = fmaxf(x, DPPF(x, 0x141)); x = fmaxf(x, DPPF(x, 0x140));
  return x;
}
__device__ __forceinline__ void rope32_8(float (&v)[8], int L, const float* tab) {
  float pr[8];
#pragma unroll
  for (int e = 0; e < 8; ++e) pr[e] = __shfl_xor(v[e], 2);
  if (L < 4) {
    float c[8], s[8];
    load8(tab + (L & 1) * 8, c);
    load8(tab + 16 + (L & 1) * 8, s);
#pragma unroll
    for (int e = 0; e < 8; ++e) v[e] = (L < 2) ? (v[e] * c[e] - pr[e] * s[e]) : (v[e] * c[e] + pr[e] * s[e]);
  }
}
__device__ __forceinline__ void rope16_8(float (&v)[8], int lc0, const float* tab) {
  float pr[8];
#pragma unroll
  for (int e = 0; e < 8; ++e) pr[e] = __shfl_xor(v[e], 1);
  if (lc0 < 16) {
    float c[8], s[8];
    load8(tab + 32, c);
    load8(tab + 40, s);
#pragma unroll
    for (int e = 0; e < 8; ++e) v[e] = (lc0 == 0) ? (v[e] * c[e] - pr[e] * s[e]) : (v[e] * c[e] + pr[e] * s[e]);
  }
}

typedef u32 u32x4 __attribute__((ext_vector_type(4)));
struct Tile4 { u32x4 v0, v1, v2, v3; };
__device__ __forceinline__ void gemm_load_tile(const u16* __restrict__ g, int ld, int k0, Tile4& r) {
  const int tid = threadIdx.x;
  const int row = tid >> 3, kc = tid & 7;
  const u16* base = g + (size_t)row * ld + k0 + kc * 8;
  r.v0 = *reinterpret_cast<const u32x4*>(base);
  r.v1 = *reinterpret_cast<const u32x4*>(base + (size_t)32 * ld);
  r.v2 = *reinterpret_cast<const u32x4*>(base + (size_t)64 * ld);
  r.v3 = *reinterpret_cast<const u32x4*>(base + (size_t)96 * ld);
}
__device__ __forceinline__ void gemm_store_tile(char* buf, const Tile4& r) {
  const int tid = threadIdx.x;
  const int row = tid >> 3, kc = tid & 7;
  char* base = buf + row * 144 + kc * 16;
  *reinterpret_cast<u32x4*>(base) = r.v0;
  *reinterpret_cast<u32x4*>(base + 32 * 144) = r.v1;
  *reinterpret_cast<u32x4*>(base + 64 * 144) = r.v2;
  *reinterpret_cast<u32x4*>(base + 96 * 144) = r.v3;
}
__device__ __forceinline__ void mma_ktile(const char* sa, const char* sb, f32x16 (&acc)[2][2]) {
  const int lane = threadIdx.x & 63, wid = threadIdx.x >> 6;
  const int wr = wid >> 1, wc = wid & 1;
  const int r32 = lane & 31, hf = lane >> 5;
  const char* pa = sa + (wr * 64 + r32) * 144 + hf * 16;
  const char* pb = sb + (wc * 64 + r32) * 144 + hf * 16;
  bf16x8 a0[2], b0[2], a1[2], b1[2];
#pragma unroll
  for (int i = 0; i < 2; ++i) {
    a0[i] = *reinterpret_cast<const bf16x8*>(pa + i * 32 * 144);
    b0[i] = *reinterpret_cast<const bf16x8*>(pb + i * 32 * 144);
  }
#pragma unroll
  for (int s = 0; s < 4; s += 2) {
#pragma unroll
    for (int i = 0; i < 2; ++i) {
      a1[i] = *reinterpret_cast<const bf16x8*>(pa + i * 32 * 144 + (s + 1) * 32);
      b1[i] = *reinterpret_cast<const bf16x8*>(pb + i * 32 * 144 + (s + 1) * 32);
    }
#pragma unroll
    for (int i = 0; i < 2; ++i)
#pragma unroll
      for (int j = 0; j < 2; ++j)
        acc[i][j] = __builtin_amdgcn_mfma_f32_32x32x16_bf16(a0[i], b0[j], acc[i][j], 0, 0, 0);
    if (s + 2 < 4) {
#pragma unroll
      for (int i = 0; i < 2; ++i) {
        a0[i] = *reinterpret_cast<const bf16x8*>(pa + i * 32 * 144 + (s + 2) * 32);
        b0[i] = *reinterpret_cast<const bf16x8*>(pb + i * 32 * 144 + (s + 2) * 32);
      }
    }
#pragma unroll
    for (int i = 0; i < 2; ++i)
#pragma unroll
      for (int j = 0; j < 2; ++j)
        acc[i][j] = __builtin_amdgcn_mfma_f32_32x32x16_bf16(a1[i], b1[j], acc[i][j], 0, 0, 0);
  }
}
#define GEMM_KT(i, nk) ((((i) + ((int)(blockIdx.x >> 3))) & ((nk) - 1)) << 6)
__device__ __forceinline__ void gemm_prefetch(const u16* __restrict__ A, int lda, const u16* __restrict__ B, int ldb, int K, Tile4& ra, Tile4& rb) {
  const int nk = K >> 6;
  gemm_load_tile(A, lda, GEMM_KT(0, nk), ra);
  gemm_load_tile(B, ldb, GEMM_KT(0, nk), rb);
}
constexpr int GBUF = 128 * 128;
__device__ __forceinline__ void gemm_store_tile_sw(char* buf, const Tile4& r) {
  const int tid = threadIdx.x;
  const int row = tid >> 3, kc = tid & 7;
  char* base = buf + row * 128 + ((kc ^ ((row >> 1) & 7)) << 4);
  *reinterpret_cast<u32x4*>(base) = r.v0;
  *reinterpret_cast<u32x4*>(base + 32 * 128) = r.v1;
  *reinterpret_cast<u32x4*>(base + 64 * 128) = r.v2;
  *reinterpret_cast<u32x4*>(base + 96 * 128) = r.v3;
}
__device__ __forceinline__ void gemm_glds_tile(const u16* __restrict__ g, int ld, int k0, char* buf) {
  const int tid = threadIdx.x;
  const int row = tid >> 3, pc = tid & 7;
  const u16* src = g + (size_t)row * ld + k0 + ((pc ^ ((row >> 1) & 7)) << 3);
  char* d = buf + __builtin_amdgcn_readfirstlane((tid >> 6) * 1024);
  __builtin_amdgcn_global_load_lds(reinterpret_cast<const unsigned*>(src), reinterpret_cast<unsigned*>(d), 16, 0, 0);
  __builtin_amdgcn_global_load_lds(reinterpret_cast<const unsigned*>(src + (size_t)32 * ld), reinterpret_cast<unsigned*>(d + 4096), 16, 0, 0);
  __builtin_amdgcn_global_load_lds(reinterpret_cast<const unsigned*>(src + (size_t)64 * ld), reinterpret_cast<unsigned*>(d + 8192), 16, 0, 0);
  __builtin_amdgcn_global_load_lds(reinterpret_cast<const unsigned*>(src + (size_t)96 * ld), reinterpret_cast<unsigned*>(d + 12288), 16, 0, 0);
}
template <class F>
__device__ __forceinline__ void mma_ktile_sw(const char* sa, const char* sb, f32x16 (&acc)[2][2], F&& issue) {
  const int lane = threadIdx.x & 63, wid = threadIdx.x >> 6;
  const int wr = wid >> 1, wc = wid & 1;
  const int r32 = lane & 31, hf = lane >> 5;
  const int x0 = (hf ^ ((r32 >> 1) & 7)) << 4;
  const char* pa = sa + (wr * 64 + r32) * 128;
  const char* pb = sb + (wc * 64 + r32) * 128;
  bf16x8 a0[2], b0[2], a1[2], b1[2];
#pragma unroll
  for (int i = 0; i < 2; ++i) {
    a0[i] = *reinterpret_cast<const bf16x8*>(pa + i * 4096 + x0);
    b0[i] = *reinterpret_cast<const bf16x8*>(pb + i * 4096 + x0);
  }
  issue();
#pragma unroll
  for (int s = 0; s < 4; s += 2) {
#pragma unroll
    for (int i = 0; i < 2; ++i) {
      a1[i] = *reinterpret_cast<const bf16x8*>(pa + i * 4096 + (x0 ^ ((s + 1) << 5)));
      b1[i] = *reinterpret_cast<const bf16x8*>(pb + i * 4096 + (x0 ^ ((s + 1) << 5)));
    }
#pragma unroll
    for (int i = 0; i < 2; ++i)
#pragma unroll
      for (int j = 0; j < 2; ++j)
        acc[i][j] = __builtin_amdgcn_mfma_f32_32x32x16_bf16(a0[i], b0[j], acc[i][j], 0, 0, 0);
    if (s + 2 < 4) {
#pragma unroll
      for (int i = 0; i < 2; ++i) {
        a0[i] = *reinterpret_cast<const bf16x8*>(pa + i * 4096 + (x0 ^ ((s + 2) << 5)));
        b0[i] = *reinterpret_cast<const bf16x8*>(pb + i * 4096 + (x0 ^ ((s + 2) << 5)));
      }
    }
#pragma unroll
    for (int i = 0; i < 2; ++i)
#pragma unroll
      for (int j = 0; j < 2; ++j)
        acc[i][j] = __builtin_amdgcn_mfma_f32_32x32x16_bf16(a1[i], b1[j], acc[i][j], 0, 0, 0);
  }
}
__device__ __forceinline__ void gemm_mainloop(const u16* __restrict__ A, int lda, const u16* __restrict__ B, int ldb,
                                              int K, f32x16 (&acc)[2][2], char* smem, Tile4& ra, Tile4& rb) {
  const int nk = K >> 6;
  __syncthreads();
  __builtin_amdgcn_s_setprio(0);
  gemm_store_tile_sw(smem, ra);
  gemm_store_tile_sw(smem + 2 * GBUF, rb);
  __syncthreads();
#pragma unroll 2
  for (int kt = 0; kt < nk; ++kt) {
    const int cur = kt & 1;
    mma_ktile_sw(smem + cur * GBUF, smem + (2 + cur) * GBUF, acc, [&] {
      if (kt + 1 < nk) {
        __builtin_amdgcn_s_setprio(2);
        gemm_glds_tile(A, lda, GEMM_KT(kt + 1, nk), smem + (cur ^ 1) * GBUF);
        gemm_glds_tile(B, ldb, GEMM_KT(kt + 1, nk), smem + (2 + (cur ^ 1)) * GBUF);
        __builtin_amdgcn_s_setprio(0);
      }
    });
    asm volatile("s_waitcnt vmcnt(0)" ::: "memory");
    __syncthreads();
  }
  __builtin_amdgcn_s_setprio(1);
}
__device__ __forceinline__ void gemm_mainloop_rolled(const u16* __restrict__ A, int lda, const u16* __restrict__ B, int ldb,
                                              int K, f32x16 (&acc)[2][2], char* smem, Tile4& ra, Tile4& rb) {
  const int nk = K >> 6;
  __syncthreads();
  gemm_store_tile(smem, ra);
  gemm_store_tile(smem + 2 * ABUF, rb);
  __syncthreads();
#pragma unroll 1
  for (int kt = 0; kt < nk; ++kt) {
    const int cur = kt & 1;
    if (kt + 1 < nk) {
      gemm_load_tile(A, lda, GEMM_KT(kt + 1, nk), ra);
      gemm_load_tile(B, ldb, GEMM_KT(kt + 1, nk), rb);
    }
    mma_ktile(smem + cur * ABUF, smem + (2 + cur) * ABUF, acc);
    if (kt + 1 < nk) {
      gemm_store_tile(smem + (cur ^ 1) * ABUF, ra);
      gemm_store_tile(smem + (2 + (cur ^ 1)) * ABUF, rb);
    }
    __syncthreads();
  }
}
__device__ __forceinline__ void zero_acc(f32x16 (&acc)[2][2]) {
#pragma unroll
  for (int i = 0; i < 2; ++i)
#pragma unroll
    for (int j = 0; j < 2; ++j)
#pragma unroll
      for (int r = 0; r < 16; ++r) acc[i][j][r] = 0.f;
}
__device__ __forceinline__ void stage_acc(const f32x16 (&acc)[2][2], float* cs) {
  const int lane = threadIdx.x & 63, wid = threadIdx.x >> 6;
  const int wr = wid >> 1, wc = wid & 1;
#pragma unroll
  for (int i = 0; i < 2; ++i)
#pragma unroll
    for (int j = 0; j < 2; ++j)
#pragma unroll
      for (int r = 0; r < 16; ++r) {
        int row = wr * 64 + i * 32 + (r & 3) + 8 * (r >> 2) + 4 * (lane >> 5);
        int col = wc * 64 + j * 32 + (lane & 31);
        cs[row * CS_LD + col] = acc[i][j][r];
      }
}

__device__ __forceinline__ int win_srccol(int n) {
  if (n < 2116) return n;
  if (n < 2176) return -1;
  return n - 60;
}
__device__ void phase_prep(const Params& p, char* smem) {
  const int tid = threadIdx.x, lane = tid & 63, wid = tid >> 6;
  for (int rb = blockIdx.x; rb < T / 4; rb += 2 * gridDim.x) {
    const int rowa = rb * 4 + wid;
    const int rbb = rb + gridDim.x;
    const bool hasb = rbb < T / 4;
    const int rowb = hasb ? rbb * 4 + wid : rowa;
    const float* xa = p.x + (size_t)rowa * DM;
    const float* xb = p.x + (size_t)rowb * DM;
    float4 va[4], vb[4];
#pragma unroll
    for (int i = 0; i < 4; ++i) va[i] = *reinterpret_cast<const float4*>(xa + lane * 4 + 256 * i);
#pragma unroll
    for (int i = 0; i < 4; ++i) vb[i] = *reinterpret_cast<const float4*>(xb + lane * 4 + 256 * i);
    float4 g[4];
#pragma unroll
    for (int i = 0; i < 4; ++i) g[i] = *reinterpret_cast<const float4*>(p.norm1_g + lane * 4 + 256 * i);
    float sa = 0.f, sb = 0.f;
#pragma unroll
    for (int i = 0; i < 4; ++i) {
      sa += va[i].x * va[i].x + va[i].y * va[i].y + va[i].z * va[i].z + va[i].w * va[i].w;
      sb += vb[i].x * vb[i].x + vb[i].y * vb[i].y + vb[i].z * vb[i].z + vb[i].w * vb[i].w;
    }
    sa = wave_sum(sa); sb = wave_sum(sb);
    const float ra = rsqrtf(sa * (1.f / DM) + EPS), rbv = rsqrtf(sb * (1.f / DM) + EPS);
#pragma unroll
    for (int i = 0; i < 4; ++i) {
      uint2 o;
      o.x = pack_bf16(va[i].x * ra * g[i].x, va[i].y * ra * g[i].y);
      o.y = pack_bf16(va[i].z * ra * g[i].z, va[i].w * ra * g[i].w);
      *reinterpret_cast<uint2*>(p.xn() + (size_t)rowa * DM + lane * 4 + 256 * i) = o;
    }
    if (hasb) {
#pragma unroll
      for (int i = 0; i < 4; ++i) {
        uint2 o;
        o.x = pack_bf16(vb[i].x * rbv * g[i].x, vb[i].y * rbv * g[i].y);
        o.y = pack_bf16(vb[i].z * rbv * g[i].z, vb[i].w * rbv * g[i].w);
        *reinterpret_cast<uint2*>(p.xn() + (size_t)rowb * DM + lane * 4 + 256 * i) = o;
      }
    }
  }
  float* tile = reinterpret_cast<float*>(smem);
  constexpr int NT_TOTAL = 1056 + 128 + 128 + 256 + 8 + 8;
  for (int ti = blockIdx.x; ti < NT_TOTAL; ti += gridDim.x) {
    const float* src; const float* scale = nullptr; u16* dst; int ldsrc, K, nn, mode = 0; int t = ti;
    if (t < 1056) { src = p.w_in; ldsrc = 4164; K = 1024; nn = 66; dst = p.WinT(); mode = 1; }
    else if ((t -= 1056) < 128) { src = p.w_a_out; ldsrc = 1024; K = 512; nn = 16; dst = p.WaT(); }
    else if ((t -= 128) < 128) { src = p.w_b_out; ldsrc = 1024; K = 512; nn = 16; dst = p.WbT(); }
    else if ((t -= 128) < 256) { src = p.w_o; ldsrc = 1024; K = 1024; nn = 16; dst = p.WoT(); }
    else if ((t -= 256) < 8) { src = p.w_uk; ldsrc = 128; K = 256; nn = 2; dst = p.WkvT(); scale = p.kv_norm_g; }
    else { t -= 8; src = p.w_uv; ldsrc = 128; K = 256; nn = 2; dst = p.WkvT() + 128 * 256; scale = p.kv_norm_g; }
    int n0 = (t % nn) * 64, k0 = (t / nn) * 64;
    __syncthreads();
    {
      const int n = tid & 63, kb = tid >> 6;
      const int sc = (mode == 1) ? win_srccol(n0 + n) : (n0 + n);
      const float* sp = src + (size_t)(k0 + kb) * ldsrc + (sc >= 0 ? sc : 0);
      float v[16];
#pragma unroll
      for (int i = 0; i < 16; ++i) v[i] = sp[(size_t)(4 * i) * ldsrc];
      if (scale) {
        float s[16];
#pragma unroll
        for (int i = 0; i < 16; ++i) s[i] = scale[k0 + kb + 4 * i];
#pragma unroll
        for (int i = 0; i < 16; ++i) v[i] *= s[i];
      }
#pragma unroll
      for (int i = 0; i < 16; ++i) tile[(kb + 4 * i) * 65 + n] = (sc >= 0) ? v[i] : 0.f;
    }
    __syncthreads();
    {
      int k = (tid & 31) * 2;
      for (int n = tid >> 5; n < 64; n += 8) {
        u32 o = pack_bf16(tile[k * 65 + n], tile[(k + 1) * 65 + n]);
        *reinterpret_cast<u32*>(dst + (size_t)(n0 + n) * K + k0 + k) = o;
      }
    }
  }
  constexpr int G_SUB = 262144 / 4, G_SW = 65536 / 4, G_WQ = 1024 * 2048 / 4;
  constexpr int G_TOTAL = G_SUB + G_SW + G_WQ;
  for (int gi = blockIdx.x * NTHREADS + tid; gi < G_TOTAL; gi += gridDim.x * NTHREADS) {
    int g = gi;
    if (g >= G_SUB + G_SW) {
      g -= G_SUB + G_SW;
      float4 v = *reinterpret_cast<const float4*>(p.peer_wq + (size_t)g * 4);
      const float gs = p.norm2_g[g >> 9];
      uint2 o = {pack_bf16(v.x * gs, v.y * gs), pack_bf16(v.z * gs, v.w * gs)};
      *reinterpret_cast<uint2*>(p.WqN() + (size_t)g * 4) = o;
    } else if (g < G_SUB) {
      float4 v = *reinterpret_cast<const float4*>(p.peer_subkeys + (size_t)g * 4);
      uint2 o = {pack_bf16(v.x, v.y), pack_bf16(v.z, v.w)};
      *reinterpret_cast<uint2*>(p.SubK() + (size_t)g * 4) = o;
    } else {
      g -= G_SUB;
      float4 v = *reinterpret_cast<const float4*>(p.spatial_w + (size_t)g * 4);
      int e = g * 4; int s = e & 127, tt = (e >> 7) & 127;
      if (s > tt) v.x = 0.f;
      if (s + 1 > tt) v.y = 0.f;
      if (s + 2 > tt) v.z = 0.f;
      if (s + 3 > tt) v.w = 0.f;
      uint2 o = {pack_bf16(v.x, v.y), pack_bf16(v.z, v.w)};
      *reinterpret_cast<uint2*>(p.Wtril() + (size_t)g * 4) = o;
    }
  }
  if (blockIdx.x == 0) {
    float* red = reinterpret_cast<float*>(smem);
    __syncthreads();
    {
      const int c4 = (tid & 31) * 4, rg = tid >> 5;
      float4 acc = make_float4(0.f, 0.f, 0.f, 0.f);
#pragma unroll 8
      for (int k = rg; k < 256; k += 8) {
        const float4 w = *reinterpret_cast<const float4*>(p.w_uv + k * 128 + c4);
        const float g = p.kv_norm_g[k];
        acc.x += (w.x * g) * (w.x * g); acc.y += (w.y * g) * (w.y * g); acc.z += (w.z * g) * (w.z * g); acc.w += (w.w * g) * (w.w * g);
      }
      *reinterpret_cast<float4*>(red + 1024 + rg * 128 + c4) = acc;
    }
    __syncthreads();
    float vq = 0.f, vk = 0.f, vn = 0.f;
    if (tid < 128) {
      vq = fabsf(p.q_norm_g[tid]); vk = fabsf(p.k_norm_g[tid]);
      float ss = 0.f;
#pragma unroll
      for (int r = 0; r < 8; ++r) ss += red[1024 + r * 128 + tid];
      vn = sqrtf(ss);
    }
#pragma unroll
    for (int m = 32; m >= 1; m >>= 1) {
      vq = fmaxf(vq, __shfl_xor(vq, m)); vk = fmaxf(vk, __shfl_xor(vk, m)); vn = fmaxf(vn, __shfl_xor(vn, m));
    }
    if (lane == 0) { red[wid] = vq; red[4 + wid] = vk; red[8 + wid] = vn; }
    __syncthreads();
    if (tid == 0) {
      float mq = 0.f, mk = 0.f, mn = 0.f;
      for (int k = 0; k < 4; ++k) { mq = fmaxf(mq, red[k]); mk = fmaxf(mk, red[4 + k]); mn = fmaxf(mn, red[8 + k]); }
      int eq = ilogbf(440.f / fmaxf(11.3137085f * mq, 1e-20f));
      int ek = ilogbf(440.f / fmaxf(11.3137085f * mk, 1e-20f));
      int ev = ilogbf(440.f / fmaxf(16.f * mn, 1e-20f));
      eq = eq > 40 ? 40 : (eq < -40 ? -40 : eq); ek = ek > 40 ? 40 : (ek < -40 ? -40 : ek); ev = ev > 40 ? 40 : (ev < -40 ? -40 : ev);
      p.scal()[0] = ldexpf(1.f, eq); p.scal()[1] = ldexpf(1.f, ek); p.scal()[2] = ldexpf(1.f, ev);
      p.scal()[3] = ldexpf(1.f, -eq - ek); p.scal()[4] = ldexpf(1.f, -ev);
    }
    __syncthreads();
  }
  for (int gi = blockIdx.x * NTHREADS + tid; gi < T * 24; gi += gridDim.x * NTHREADS) {
    int t = gi / 24, j = gi - t * 24;
    float posf = (float)p.pos[t];
    float sn, cn;
    if (j < 16) { sincosf(posf * INV32[j], &sn, &cn); p.rtab()[(size_t)t * 48 + j] = cn; p.rtab()[(size_t)t * 48 + 16 + j] = sn; }
    else { int jj = j - 16; sincosf(posf * INV16[jj], &sn, &cn); p.rtab()[(size_t)t * 48 + 32 + jj] = cn; p.rtab()[(size_t)t * 48 + 40 + jj] = sn; }
  }
}

__device__ __forceinline__ void rope_pair(float& y0, float& y1, int lc, int half, int xm, float posf, const float* inv) {
  float p0 = __shfl_xor(y0, xm), p1 = __shfl_xor(y1, xm);
  if (lc < 2 * half) {
    int j = lc & (half - 1);
    float a0 = posf * inv[j], a1 = posf * inv[j + 1];
    float s0, c0, s1, c1;
    sincosf(a0, &s0, &c0);
    sincosf(a1, &s1, &c1);
    if (lc < half) { y0 = y0 * c0 - p0 * s0; y1 = y1 * c1 - p1 * s1; }
    else { y0 = y0 * c0 + p0 * s0; y1 = y1 * c1 + p1 * s1; }
  }
}

__device__ __forceinline__ bool tile_swizzle(int step, int ntn, int ntiles, int& mt, int& nt) {
  const int x = blockIdx.x & 7, slot = blockIdx.x >> 3;
  const int nslots = gridDim.x >> 3;
  int lin = (step * 8 + x) * nslots + slot;
  const int left = ntiles - step * 8 * nslots;
  if (left <= 0) return false;
  if (left < 8 * nslots && (left & 7) == 0) {
    const int rx = left >> 3;
    if (slot >= rx) return false;
    lin = step * 8 * nslots + x * rx + slot;
  }
  if (lin >= ntiles) return false;
  const int per = ntn * 16;
  const int g = lin / per, rem = lin - g * per;
  nt = rem >> 4;
  mt = g * 16 + (rem & 15);
  return true;
}

__device__ void phase_gemm1(const Params& p, char* smem) {
  const int tid = threadIdx.x, lane = tid & 63, wid = tid >> 6;
  float* cs = reinterpret_cast<float*>(smem);
  constexpr int NTN = NWIN / 128;
  constexpr int NTILES = (T / 128) * NTN;
  int mt, nt;
  bool have = tile_swizzle(0, NTN, NTILES, mt, nt);
  Tile4 ra, rb;
  if (have) gemm_prefetch(p.xn() + (size_t)mt * 128 * DM, DM, p.WinT() + (size_t)nt * 128 * DM, DM, DM, ra, rb);
  for (int step = 0; have; ++step) {
    int m0 = mt * 128;
    f32x16 acc[2][2];
    zero_acc(acc);
    gemm_mainloop(p.xn() + (size_t)m0 * DM, DM, p.WinT() + (size_t)nt * 128 * DM, DM, DM, acc, smem, ra, rb);
    stage_acc(acc, cs);
    __syncthreads();
    int mt2 = 0, nt2 = 0;
    const bool nxt = tile_swizzle(step + 1, NTN, NTILES, mt2, nt2);
    if (nxt) gemm_prefetch(p.xn() + (size_t)mt2 * 128 * DM, DM, p.WinT() + (size_t)nt2 * 128 * DM, DM, DM, ra, rb);
    const int L = lane & 15, rsub = lane >> 4, c0 = L * 8;
#pragma unroll 2
    for (int it = 0; it < 8; ++it) {
      const int row = wid * 32 + it * 4 + rsub;
      const size_t t = (size_t)m0 + row;
      float v[8];
      load8(cs + row * CS_LD + c0, v);
      if (nt < 8) {
#pragma unroll
        for (int e = 0; e < 8; ++e) v[e] = gelu_f(v[e]);
        u16* dst = (nt < 4) ? (p.gu() + t * 512 + nt * 128 + c0) : (p.gv() + t * 512 + (nt - 4) * 128 + c0);
        *reinterpret_cast<uint4*>(dst) = pack8(v);
      } else if (nt < 12) {
        float ss = 0.f;
#pragma unroll
        for (int e = 0; e < 8; ++e) ss += v[e] * v[e];
        ss = sum16(ss);
        float r = rsqrtf(ss * (1.f / 128.f) + EPS);
        float g[8];
        load8(p.q_norm_g + c0, g);
#pragma unroll
        for (int e = 0; e < 8; ++e) v[e] = v[e] * r * g[e];
        rope32_8(v, L, p.rtab() + t * 48);
        *reinterpret_cast<uint4*>(p.qh() + t * 512 + (nt - 8) * 128 + c0) = pack8(v);
      } else if (nt < 14) {
        *reinterpret_cast<uint4*>(p.ckv() + t * 256 + (nt - 12) * 128 + c0) = pack8(v);
      } else if (nt < 16) {
        rope16_8(v, c0 & 63, p.rtab() + t * 48);
        *reinterpret_cast<uint4*>(p.qi() + t * 256 + (nt - 14) * 128 + c0) = pack8(v);
      } else if (nt == 16) {
        rope16_8(v, c0 < 64 ? c0 : 64, p.rtab() + t * 48);
        if (c0 < 64) *reinterpret_cast<uint4*>(p.ki() + ((t >> 4) * 8 + L) * 128 + (t & 15) * 8) = pack8(v);
        else if (c0 == 64) *reinterpret_cast<float4*>(p.wi() + t * 4) = make_float4(v[0] * 0.0625f, v[1] * 0.0625f, v[2] * 0.0625f, v[3] * 0.0625f);
      } else {
#pragma unroll
        for (int e = 0; e < 8; ++e) v[e] = sigmoid_f(v[e]);
        *reinterpret_cast<uint4*>(p.sg() + t * 2048 + (nt - 17) * 128 + c0) = pack8(v);
      }
    }
    mt = mt2; nt = nt2; have = nxt;
  }
}

__device__ void unit_kv(const Params& p, char* smem, int mt) {
  const int tid = threadIdx.x, lane = tid & 63, wid = tid >> 6;
  float* cs = reinterpret_cast<float*>(smem);
  float* rr_s = reinterpret_cast<float*>(smem + EXTRA_OFF);
  const int m0 = mt * 128;
  __syncthreads();
  {
    int row = tid >> 1, half = tid & 1;
    const u16* src = p.ckv() + (size_t)(m0 + row) * 256 + half * 128;
    float ss = 0.f;
#pragma unroll 16
    for (int i = 0; i < 16; ++i) {
      uint4 q = *reinterpret_cast<const uint4*>(src + i * 8);
      u32 w[4] = {q.x, q.y, q.z, q.w};
#pragma unroll
      for (int j = 0; j < 4; ++j) { float a = bf_lo(w[j]), b = bf_hi(w[j]); ss += a * a + b * b; }
    }
    ss += __shfl_xor(ss, 1);
    if (half == 0) rr_s[row] = rsqrtf(ss * (1.f / 256.f) + EPS);
  }
  Tile4 ra, rb;
  gemm_prefetch(p.ckv() + (size_t)m0 * 256, 256, p.WkvT(), 256, 256, ra, rb);
#pragma unroll 1
  for (int nt = 0; nt < 2; ++nt) {
    f32x16 acc[2][2];
    zero_acc(acc);
    gemm_mainloop_rolled(p.ckv() + (size_t)m0 * 256, 256, p.WkvT() + (size_t)nt * 128 * 256, 256, 256, acc, smem, ra, rb);
    stage_acc(acc, cs);
    __syncthreads();
    if (nt == 0) gemm_prefetch(p.ckv() + (size_t)m0 * 256, 256, p.WkvT() + (size_t)128 * 256, 256, 256, ra, rb);
    const int L = lane & 15, rsub = lane >> 4, c0 = L * 8;
#pragma unroll 2
    for (int it = 0; it < 8; ++it) {
      const int row = wid * 32 + it * 4 + rsub;
      const size_t t = (size_t)m0 + row;
      float v[8];
      load8(cs + row * CS_LD + c0, v);
      const float rs = rr_s[row];
#pragma unroll
      for (int e = 0; e < 8; ++e) v[e] *= rs;
      if (nt == 0) {
        float ss = 0.f;
#pragma unroll
        for (int e = 0; e < 8; ++e) ss += v[e] * v[e];
        ss = sum16(ss);
        float r = rsqrtf(ss * (1.f / 128.f) + EPS);
        float g[8];
        load8(p.k_norm_g + c0, g);
#pragma unroll
        for (int e = 0; e < 8; ++e) v[e] = v[e] * r * g[e];
        rope32_8(v, L, p.rtab() + t * 48);
        {
          const float sk = p.scal()[1];
          int w0 = __builtin_amdgcn_cvt_pk_fp8_f32(v[0] * sk, v[1] * sk, 0, false);
          w0 = __builtin_amdgcn_cvt_pk_fp8_f32(v[2] * sk, v[3] * sk, w0, true);
          int w1 = __builtin_amdgcn_cvt_pk_fp8_f32(v[4] * sk, v[5] * sk, 0, false);
          w1 = __builtin_amdgcn_cvt_pk_fp8_f32(v[6] * sk, v[7] * sk, w1, true);
          *reinterpret_cast<uint2*>(p.kv8() + t * 256 + c0) = make_uint2((u32)w0, (u32)w1);
        }
      } else {
        {
          const float sv8 = p.scal()[2];
          int w0 = __builtin_amdgcn_cvt_pk_fp8_f32(v[0] * sv8, v[1] * sv8, 0, false);
          w0 = __builtin_amdgcn_cvt_pk_fp8_f32(v[2] * sv8, v[3] * sv8, w0, true);
          int w1 = __builtin_amdgcn_cvt_pk_fp8_f32(v[4] * sv8, v[5] * sv8, 0, false);
          w1 = __builtin_amdgcn_cvt_pk_fp8_f32(v[6] * sv8, v[7] * sv8, w1, true);
          *reinterpret_cast<uint2*>(p.kv8() + t * 256 + 128 + c0) = make_uint2((u32)w0, (u32)w1);
        }
      }
    }
    __syncthreads();
  }
}

__device__ void unit_spatial(const Params& p, char* smem, int unit) {
  const int tid = threadIdx.x, lane = tid & 63, wid = tid >> 6;
  const int chunk = unit >> 2, g = unit & 3;
  const int t0 = chunk * 128;
  float* cs = reinterpret_cast<float*>(smem);
  float* mu_s = reinterpret_cast<float*>(smem + EXTRA_OFF);
  float* rs_s = mu_s + 128;
  __syncthreads();
  {
    int row = tid >> 1, half = tid & 1;
    const u16* src = p.gv() + (size_t)(t0 + row) * 512 + half * 256;
    float s = 0.f, ss = 0.f;
#pragma unroll 16
    for (int i = 0; i < 32; ++i) {
      uint4 q = *reinterpret_cast<const uint4*>(src + i * 8);
      u32 w[4] = {q.x, q.y, q.z, q.w};
#pragma unroll
      for (int j = 0; j < 4; ++j) { float a = bf_lo(w[j]), b = bf_hi(w[j]); s += a + b; ss += a * a + b * b; }
    }
    s += __shfl_xor(s, 1);
    ss += __shfl_xor(ss, 1);
    float mean = s * (1.f / 512.f);
    float var = fmaxf(ss * (1.f / 512.f) - mean * mean, 0.f);
    if (half == 0) { mu_s[row] = mean; rs_s[row] = rsqrtf(var + EPS); }
  }
  const int L = lane & 15, rsub = lane >> 4, c0 = L * 8;
  u32x4 gq[8];
  float sbq[8];
#pragma unroll
  for (int it = 0; it < 8; ++it) {
    const int row = wid * 32 + it * 4 + rsub;
    gq[it] = *reinterpret_cast<const u32x4*>(p.gu() + ((size_t)t0 + row) * 512 + g * 128 + c0);
    sbq[it] = p.spatial_b[g * 128 + row];
  }
  {
    const u16* wsrc = p.Wtril() + (size_t)g * 128 * 128;
#pragma unroll
    for (int i = 0; i < 8; ++i) {
      int c = tid + 256 * i;
      int row = c >> 4, kc = c & 15;
      uint4 q = *reinterpret_cast<const uint4*>(wsrc + row * 128 + kc * 8);
      *reinterpret_cast<uint4*>(smem + (kc >> 3) * ABUF + row * 144 + (kc & 7) * 16) = q;
    }
  }
  __syncthreads();
  {
    int s = tid & 127;
    float mu = mu_s[s], rs = rs_s[s];
    const u16* src = p.gv() + (size_t)(t0 + s) * 512 + g * 128;
    char* bbase = smem + (2 + (s >> 6)) * ABUF + (s & 63) * 2;
#pragma unroll
    for (int i = 0; i < 8; ++i) {
      int d0 = ((tid >> 7) + 2 * i) * 8;
      uint4 q = *reinterpret_cast<const uint4*>(src + d0);
      u32 w[4] = {q.x, q.y, q.z, q.w};
#pragma unroll
      for (int j = 0; j < 4; ++j) {
        int d = d0 + 2 * j;
        float a = (bf_lo(w[j]) - mu) * rs * p.v_norm_g[g * 128 + d] + p.v_norm_b[g * 128 + d];
        float b = (bf_hi(w[j]) - mu) * rs * p.v_norm_g[g * 128 + d + 1] + p.v_norm_b[g * 128 + d + 1];
        *reinterpret_cast<u16*>(bbase + d * 144) = f2bf(a);
        *reinterpret_cast<u16*>(bbase + (d + 1) * 144) = f2bf(b);
      }
    }
  }
  __syncthreads();
  f32x16 acc[2][2];
  zero_acc(acc);
  mma_ktile(smem, smem + 2 * ABUF, acc);
  mma_ktile(smem + ABUF, smem + 3 * ABUF, acc);
  __syncthreads();
  stage_acc(acc, cs);
  __syncthreads();
#pragma unroll
  for (int it = 0; it < 8; ++it) {
    const int row = wid * 32 + it * 4 + rsub;
    const size_t t = (size_t)t0 + row;
    float v[8], u[8];
    load8(cs + row * CS_LD + c0, v);
    const float b = sbq[it];
    unpack8(make_uint4(gq[it][0], gq[it][1], gq[it][2], gq[it][3]), u);
#pragma unroll
    for (int e = 0; e < 8; ++e) v[e] = u[e] * (v[e] + b);
    *reinterpret_cast<uint4*>(p.ya() + t * 512 + g * 128 + c0) = pack8(v);
  }
}

template <int NK>
__device__ __forceinline__ void radix_partition(const u32 (&key)[NK], int n, int rank, int slack, u32& lo, u32& hi, int& limit) {
  u32 vor = 0u, vand = 0xFFFFFFFFu;
#pragma unroll
  for (int k = 0; k < NK; ++k) { vor |= key[k]; vand &= (key[k] != 0u) ? key[k] : 0xFFFFFFFFu; }
#define DPPU(v, ctrl) ((u32)__builtin_amdgcn_update_dpp(0, (int)(v), (ctrl), 0xF, 0xF, true))
  vor |= DPPU(vor, 0xB1); vor |= DPPU(vor, 0x4E); vor |= DPPU(vor, 0x141); vor |= DPPU(vor, 0x140);
  vand &= DPPU(vand, 0xB1); vand &= DPPU(vand, 0x4E); vand &= DPPU(vand, 0x141); vand &= DPPU(vand, 0x140);
  vor = (u32)(__builtin_amdgcn_readlane((int)vor, 0) | __builtin_amdgcn_readlane((int)vor, 16) |
              __builtin_amdgcn_readlane((int)vor, 32) | __builtin_amdgcn_readlane((int)vor, 48));
  vand = (u32)(__builtin_amdgcn_readlane((int)vand, 0) & __builtin_amdgcn_readlane((int)vand, 16) &
               __builtin_amdgcn_readlane((int)vand, 32) & __builtin_amdgcn_readlane((int)vand, 48));
#undef DPPU
  const u32 diff = vor ^ vand;
  int b = diff ? (31 - __clz(diff)) : -1;
  u32 prefix = (b >= 31) ? 0u : (vand & ~((2u << b) - 1u));
  if (b < 0) prefix = vand;
  int krem = rank, ncand = n;
  while (b >= 0 && ncand - krem > slack) {
    u32 cand = prefix | (1u << b);
    u32 himask = ~((1u << b) - 1u);
    int c = 0;
#pragma unroll
    for (int k = 0; k < NK; ++k) c += __popcll(__ballot((key[k] & himask) == cand));
    if (c >= krem) { prefix = cand; ncand = c; } else { krem -= c; ncand -= c; }
    --b;
  }
  lo = prefix;
  hi = (b >= 0) ? (prefix | ((2u << b) - 1u)) : prefix;
  limit = (ncand - krem <= slack) ? ncand : krem;
}

__device__ __forceinline__ void idx_load_keys(const Params& p, int tb, int jc, int kcol, int lane, bf16x8 (&bf)[4][2]) {
  const u16* kb = p.ki() + ((size_t)((tb + jc) >> 4) * 8 + (lane >> 4)) * 128 + kcol * 8;
#pragma unroll
  for (int u = 0; u < 4; ++u) {
    bf[u][0] = *reinterpret_cast<const bf16x8*>(kb + u * 1024);
    bf[u][1] = *reinterpret_cast<const bf16x8*>(kb + u * 1024 + 512);
  }
}
__device__ __forceinline__ void idx_compact(u32* cv, u16* ci, int n, int lane, int& newcnt, float& newthr) {
  u32 key[12]; u16 idx[12];
#pragma unroll
  for (int k = 0; k < 12; ++k) {
    int e = lane + 64 * k;
    bool in = e < n;
    key[k] = in ? sortable(cv[e]) : 0u;
    idx[k] = in ? ci[e] : (u16)0;
  }
  u32 lo, hi; int limit;
  if (n > 576) {
    const u32 skey[3] = {key[0], key[4], key[8]};
    int slimit;
    radix_partition<3>(skey, 192, (330 * 192) / n, 8, lo, hi, slimit);
    int base = 0;
#pragma unroll
    for (int k = 0; k < 12; ++k) {
      const bool keep = key[k] >= lo;
      const unsigned long long m = __ballot(keep);
      const int pos = base + mbcnt64(m);
      if (keep) { cv[pos] = unsortable(key[k]); ci[pos] = idx[k]; }
      base += __popcll(m);
    }
    if (base >= 256 && base <= 480 && lo > 0x007FFFFFu) {
      newcnt = base;
      newthr = __uint_as_float(unsortable(lo));
      return;
    }
  }
  radix_partition<12>(key, n, 256, 64, lo, hi, limit);
  int base = 0, tcnt = 0;
#pragma unroll
  for (int k = 0; k < 12; ++k) {
    bool eq = key[k] >= lo && key[k] <= hi;
    unsigned long long meq = __ballot(eq);
    bool keep = (key[k] > hi) || (eq && (tcnt + mbcnt64(meq)) < limit);
    unsigned long long m = __ballot(keep);
    int pos = base + mbcnt64(m);
    if (keep) { cv[pos] = unsortable(key[k]); ci[pos] = idx[k]; }
    base += __popcll(m);
    tcnt += __popcll(meq);
  }
  newcnt = base;
  newthr = (lo <= 0x007FFFFFu) ? -INFINITY : __uint_as_float(unsortable(lo));
}

template <int NK>
__device__ __forceinline__ void idx_final_select(const u32* cv, u16* ci, int n, int lane, u16* out) {
  u32 key[NK]; u16 idx[NK];
#pragma unroll
  for (int k = 0; k < NK; ++k) {
    int e = lane + 64 * k;
    bool in = e < n;
    key[k] = in ? sortable(cv[e]) : 0u;
    idx[k] = in ? ci[e] : (u16)0;
  }
  u32 lo, hi; int limit;
  radix_partition<NK>(key, n, 256, 0, lo, hi, limit);
  int base = 0, tcnt = 0;
#pragma unroll
  for (int k = 0; k < NK; ++k) {
    bool eq = key[k] >= lo && key[k] <= hi;
    unsigned long long meq = __ballot(eq);
    bool keep = (key[k] > hi) || (eq && (tcnt + mbcnt64(meq)) < limit);
    unsigned long long m = __ballot(keep);
    int pos = base + mbcnt64(m);
    if (keep && pos < 256) ci[pos] = idx[k];
    base += __popcll(m);
    tcnt += __popcll(meq);
  }
  __builtin_amdgcn_wave_barrier();
  *reinterpret_cast<uint2*>(out + lane * 4) = *reinterpret_cast<const uint2*>(ci + lane * 4);
  __builtin_amdgcn_wave_barrier();
}

__device__ void unit_indexer(const Params& p, char* smem, int unit) {
  const int tid = threadIdx.x, lane = tid & 63, wid = tid >> 6;
  const int b = unit >> 10, grp = unit & 1023;
  const int tb = b * SEQ, i0 = grp * 16;
  u32* cval = reinterpret_cast<u32*>(smem);
  u16* cidx = reinterpret_cast<u16*>(smem + 16 * CAP * 4);
  __syncthreads();
  const int qsub = lane >> 4;
  const int ql = wid * 4 + qsub;
  const int iq = i0 + ql;
  const int kcol = lane & 15;
  bf16x8 afr[2];
  {
    const u16* qa = p.qi() + ((size_t)(tb + i0 + wid * 4 + (kcol >> 2)) * 4 + (kcol & 3)) * 64 + 8 * (lane >> 4);
    const float wa = p.wi()[(size_t)(tb + i0 + wid * 4 + (kcol >> 2)) * 4 + (kcol & 3)];
#pragma unroll
    for (int hh = 0; hh < 2; ++hh) {
      uint4 raw = *reinterpret_cast<const uint4*>(qa + 32 * hh);
      float f[8];
      unpack8(raw, f);
#pragma unroll
      for (int e = 0; e < 8; ++e) f[e] *= wa;
      uint4 pk = pack8(f);
      afr[hh] = __builtin_bit_cast(bf16x8, pk);
    }
  }
  const float4 w4 = *reinterpret_cast<const float4*>(p.wi() + (size_t)(tb + iq) * 4);
  const float lim0 = (w4.x > 0.f) ? INFINITY : -INFINITY, lim1 = (w4.y > 0.f) ? INFINITY : -INFINITY;
  const float lim2 = (w4.z > 0.f) ? INFINITY : -INFINITY, lim3 = (w4.w > 0.f) ? INFINITY : -INFINITY;
  float thr = -INFINITY;
  float thrv[4] = {-INFINITY, -INFINITY, -INFINITY, -INFINITY};
  const int kmul = 64;
  int cntr = 0;
  u32* myval = cval + ql * CAP;
  u16* myidx = cidx + ql * CAP;
  const u32 lowmask = (1u << kcol) - 1u;
  const u32 lowmask16 = (lowmask << 16) | 0xFFFFu;
  const int sh16 = 16 * qsub;
  const int nchunks = (grp + 1 + 3) >> 2;

  auto process = [&](const bf16x8 (&bf)[4][2], int jc) {
    f32x4 acc[4];
#pragma unroll
    for (int u = 0; u < 4; ++u) {
      f32x4 z = {0.f, 0.f, 0.f, 0.f};
      acc[u] = __builtin_amdgcn_mfma_f32_16x16x32_bf16(afr[0], bf[u][0], z, 0, 0, 0);
    }
#pragma unroll
    for (int u = 0; u < 4; ++u) acc[u] = __builtin_amdgcn_mfma_f32_16x16x32_bf16(afr[1], bf[u][1], acc[u], 0, 0, 0);
    float sc[4];
    bool ps[4];
    bool anyp = false;
#pragma unroll
    for (int u = 0; u < 4; ++u) {
      float r0 = __builtin_amdgcn_fmed3f(acc[u][0], 0.f, lim0), r1 = __builtin_amdgcn_fmed3f(acc[u][1], 0.f, lim1);
      float r2 = __builtin_amdgcn_fmed3f(acc[u][2], 0.f, lim2), r3 = __builtin_amdgcn_fmed3f(acc[u][3], 0.f, lim3);
      float s = (r0 + r1) + (r2 + r3);
      s += 0.0f;
      sc[u] = s;
      ps[u] = s > thrv[u];
      anyp |= ps[u];
    }
    if (__ballot(anyp)) {
      u32 g[4];
#pragma unroll
      for (int u = 0; u < 4; ++u) g[u] = (u32)(__ballot(ps[u]) >> sh16) & 0xFFFFu;
      const u32 mlo = g[0] | (g[1] << 16), mhi = g[2] | (g[3] << 16);
      const int clo = cntr + __popc(mlo);
      const int s0 = cntr + __popc(mlo & lowmask), s1 = cntr + __popc(mlo & lowmask16);
      const int s2 = clo + __popc(mhi & lowmask), s3 = clo + __popc(mhi & lowmask16);
      if (ps[0]) { myval[s0] = __float_as_uint(sc[0]); myidx[s0] = (u16)(jc + kcol); }
      if (ps[1]) { myval[s1] = __float_as_uint(sc[1]); myidx[s1] = (u16)(jc + 16 + kcol); }
      if (ps[2]) { myval[s2] = __float_as_uint(sc[2]); myidx[s2] = (u16)(jc + 32 + kcol); }
      if (ps[3]) { myval[s3] = __float_as_uint(sc[3]); myidx[s3] = (u16)(jc + 48 + kcol); }
      cntr = clo + __popc(mhi);
      unsigned long long need = __ballot(cntr > CAP - 64);
      while (need) {
        int l = __ffsll((long long)need) - 1;
        int qc = l >> 4;
        need &= ~(0xFFFFull << (qc * 16));
        int qlc = wid * 4 + qc;
        int n = __builtin_amdgcn_readlane(cntr, qc * 16);
        if (n > CAP) n = CAP;
        int nc; float nt;
        idx_compact(cval + qlc * CAP, cidx + qlc * CAP, n, lane, nc, nt);
        if (qsub == qc) { thr = nt; cntr = nc; thrv[0] = nt; thrv[1] = nt; thrv[2] = nt; thrv[3] = nt; }
      }
    }
  };

  bf16x8 bA[4][2], bB[4][2];
  const int lastc = nchunks - 1;
  idx_load_keys(p, tb, 0, kcol, lane, bA);
  for (int ch = 0; ch < nchunks; ch += 2) {
    idx_load_keys(p, tb, min(ch + 1, lastc) * kmul, kcol, lane, bB);
    if (ch == lastc) {
#pragma unroll
      for (int u = 0; u < 4; ++u) thrv[u] = ((ch * 64 + 16 * u + kcol) <= iq) ? thr : INFINITY;
    }
    process(bA, ch * 64);
    idx_load_keys(p, tb, min(ch + 2, lastc) * kmul, kcol, lane, bA);
    if (ch + 1 < nchunks) {
      if (ch + 1 == lastc) {
#pragma unroll
        for (int u = 0; u < 4; ++u) thrv[u] = (((ch + 1) * 64 + 16 * u + kcol) <= iq) ? thr : INFINITY;
      }
      process(bB, (ch + 1) * 64);
    }
  }
  for (int qc = 0; qc < 4; ++qc) {
    int qlc = wid * 4 + qc;
    int n = __builtin_amdgcn_readlane(cntr, qc * 16);
    if (n > CAP) n = CAP;
    u32* cv = cval + qlc * CAP; u16* ci = cidx + qlc * CAP;
    u16* out = p.sel() + (size_t)(tb + i0 + qlc) * 256;
    if (n <= 256) {
#pragma unroll
      for (int k = 0; k < 4; ++k) {
        int e = lane + 64 * k;
        out[e] = (e < n) ? ci[e] : (u16)0xFFFF;
      }
    } else if (n <= 384) idx_final_select<6>(cv, ci, n, lane, out);
    else if (n <= 512) idx_final_select<8>(cv, ci, n, lane, out);
    else idx_final_select<12>(cv, ci, n, lane, out);
  }
}

__device__ __forceinline__ void conv_load(const Params& p, int r, int lane, f32x4 (&v)[4]) {
  const bool isu = r < 16384;
  const int rr = isu ? r : r - 16384;
  const float* src = (isu ? p.peer_u : p.peer_v) + (size_t)rr * 1024 + lane * 16;
#pragma unroll
  for (int i = 0; i < 4; ++i) v[i] = *reinterpret_cast<const f32x4*>(src + 4 * i);
}
__device__ __forceinline__ void conv_finish(const Params& p, int r, int lane, const f32x4 (&vin)[4]) {
  const bool isu = r < 16384;
  const int rr = isu ? r : r - 16384;
  float v[16];
#pragma unroll
  for (int i = 0; i < 4; ++i) { v[4 * i] = vin[i][0]; v[4 * i + 1] = vin[i][1]; v[4 * i + 2] = vin[i][2]; v[4 * i + 3] = vin[i][3]; }
  if (isu) {
#pragma unroll
    for (int i = 0; i < 4; ++i) {
      float4 g = *reinterpret_cast<const float4*>(p.norm2_g + lane * 16 + 4 * i);
      v[4 * i] *= g.x; v[4 * i + 1] *= g.y; v[4 * i + 2] *= g.z; v[4 * i + 3] *= g.w;
    }
  }
  float amax = 0.f;
#pragma unroll
  for (int i = 0; i < 16; ++i) amax = fmaxf(amax, fabsf(v[i]));
#pragma unroll
  for (int m = 32; m >= 1; m >>= 1) amax = fmaxf(amax, __shfl_xor(amax, m));
  int ex = 0;
  if (amax > 0.f) ex = ilogbf(6.f / amax);
  ex = ex > 60 ? 60 : (ex < -60 ? -60 : ex);
  float sc = ldexpf(1.f, ex);
  u32 w0 = 0u, w1 = 0u;
  w0 = __builtin_amdgcn_cvt_scalef32_pk_fp4_f32(w0, v[0] * sc, v[1] * sc, 1.0f, 0);
  w0 = __builtin_amdgcn_cvt_scalef32_pk_fp4_f32(w0, v[2] * sc, v[3] * sc, 1.0f, 1);
  w0 = __builtin_amdgcn_cvt_scalef32_pk_fp4_f32(w0, v[4] * sc, v[5] * sc, 1.0f, 2);
  w0 = __builtin_amdgcn_cvt_scalef32_pk_fp4_f32(w0, v[6] * sc, v[7] * sc, 1.0f, 3);
  w1 = __builtin_amdgcn_cvt_scalef32_pk_fp4_f32(w1, v[8] * sc, v[9] * sc, 1.0f, 0);
  w1 = __builtin_amdgcn_cvt_scalef32_pk_fp4_f32(w1, v[10] * sc, v[11] * sc, 1.0f, 1);
  w1 = __builtin_amdgcn_cvt_scalef32_pk_fp4_f32(w1, v[12] * sc, v[13] * sc, 1.0f, 2);
  w1 = __builtin_amdgcn_cvt_scalef32_pk_fp4_f32(w1, v[14] * sc, v[15] * sc, 1.0f, 3);
  *reinterpret_cast<uint2*>((isu ? p.U8() : p.V8()) + (size_t)(lane >> 4) * 2097152 + (size_t)rr * 128 + (lane & 15) * 8) = make_uint2(w0, w1);
  if (lane == 0) p.sx()[rr * 2 + (isu ? 0 : 1)] = (u8)(signed char)(-ex);
}
__device__ void convert_rows_of_slot(const Params& p, int s) {
  int tid = threadIdx.x;
  asm volatile("" : "+v"(tid));
  const int lane = tid & 63, wid = tid >> 6;
  f32x4 v[4][4];
#pragma unroll
  for (int k = 0; k < 4; ++k) conv_load(p, (4 * s + k) * 4 + wid, lane, v[k]);
#pragma unroll
  for (int k = 0; k < 4; ++k) conv_finish(p, (4 * s + k) * 4 + wid, lane, v[k]);
}

typedef int i32x2t __attribute__((ext_vector_type(2)));
__device__ void phase_attn(const Params& p, char* smem) {
  const int tid = threadIdx.x, lane = tid & 63, wid = tid >> 6;
  constexpr int WSTRIDE = 13312;
  u16* lidx0 = reinterpret_cast<u16*>(smem + wid * WSTRIDE);
  u16* lidx1 = reinterpret_cast<u16*>(smem + wid * WSTRIDE + 9728);
  u8* Pb = reinterpret_cast<u8*>(smem + wid * WSTRIDE + 512);
  char* tile = smem + wid * WSTRIDE + 1024;
  const float sq = p.scal()[0];
  const float lf = 0.08838834764831845f * 1.4426950408889634f * p.scal()[3];
  const float ovs = p.scal()[4];
  const int xq = blockIdx.x & 7;
  const int b = xq & 1;
  const int rblk = (blockIdx.x >> 3) * 4 + (xq >> 1);
  const int nrb = (gridDim.x >> 3) * 4;
  const int n16 = lane & 15, g4 = lane >> 4;
  const int istep = nrb * 4;
  const size_t tb = (size_t)b * SEQ;
  uint2 selr = make_uint2(0u, 0u);
  u32x4 qraw[4];
  u32x4 kr[8];
  {
    const int i0q = rblk * 4 + wid;
    const size_t tq0 = tb + i0q;
    selr = *reinterpret_cast<const uint2*>(p.sel() + tq0 * 256 + lane * 4);
    __builtin_amdgcn_wave_barrier();
    *reinterpret_cast<uint2*>(lidx0 + lane * 4) = selr;
    __builtin_amdgcn_wave_barrier();
#pragma unroll
    for (int s = 0; s < 4; ++s) qraw[s] = *reinterpret_cast<const u32x4*>(p.qh() + tq0 * 512 + (n16 >> 2) * 128 + 32 * s + 8 * g4);
#pragma unroll
    for (int r = 0; r < 8; ++r) {
      int id = lidx0[r * 4 + g4];
      int idc = (id <= i0q) ? id : 0;
      kr[r] = *reinterpret_cast<const u32x4*>(p.kv8() + (tb + idc) * 256 + n16 * 16);
    }
  }
  int cur = 0;
  for (int i = rblk * 4 + wid; i < SEQ; i += istep, cur ^= 1) {
    const int tq = b * SEQ + i;
    u16* lidx = cur ? lidx1 : lidx0;
    u16* lnx = cur ? lidx0 : lidx1;
    const int inx = (i + istep < SEQ) ? i + istep : i;
    long qf[4];
#pragma unroll
    for (int s = 0; s < 4; ++s) {
      qf[s] = 0;
      if ((n16 & 3) == 0) {
        float qv[8];
        unpack8(make_uint4(qraw[s][0], qraw[s][1], qraw[s][2], qraw[s][3]), qv);
        int w0 = __builtin_amdgcn_cvt_pk_fp8_f32(qv[0] * sq, qv[1] * sq, 0, false);
        w0 = __builtin_amdgcn_cvt_pk_fp8_f32(qv[2] * sq, qv[3] * sq, w0, true);
        int w1 = __builtin_amdgcn_cvt_pk_fp8_f32(qv[4] * sq, qv[5] * sq, 0, false);
        w1 = __builtin_amdgcn_cvt_pk_fp8_f32(qv[6] * sq, qv[7] * sq, w1, true);
        qf[s] = (long)(((unsigned long long)(u32)w1 << 32) | (unsigned long long)(u32)w0);
      }
    }
    {
      const size_t tqn = tb + inx;
      selr = *reinterpret_cast<const uint2*>(p.sel() + tqn * 256 + lane * 4);
#pragma unroll
      for (int s = 0; s < 4; ++s) qraw[s] = *reinterpret_cast<const u32x4*>(p.qh() + tqn * 512 + (n16 >> 2) * 128 + 32 * s + 8 * g4);
    }
    float mrun = -1e30f, lrun = 0.f;
    f32x4 ohi[8], olo[8];
#pragma unroll
    for (int tl = 0; tl < 8; ++tl) { ohi[tl] = f32x4{0.f, 0.f, 0.f, 0.f}; olo[tl] = f32x4{0.f, 0.f, 0.f, 0.f}; }
#pragma unroll 2
    for (int g2 = 0; g2 < 8; ++g2) {
      __builtin_amdgcn_wave_barrier();
#pragma unroll
      for (int r = 0; r < 8; ++r) *reinterpret_cast<u32x4*>(tile + (r * 4 + g4) * 272 + n16 * 16) = kr[r];
      if (g2 == 1) *reinterpret_cast<uint2*>(lnx + lane * 4) = selr;
      __builtin_amdgcn_wave_barrier();
      {
        const u16* lsrc = (g2 < 7) ? lidx + (g2 + 1) * 32 : lnx;
        const int bound = (g2 < 7) ? i : inx;
#pragma unroll
        for (int r = 0; r < 8; ++r) {
          int id = lsrc[r * 4 + g4];
          int idc = (id <= bound) ? id : 0;
          kr[r] = *reinterpret_cast<const u32x4*>(p.kv8() + (tb + idc) * 256 + n16 * 16);
        }
      }
      float sc[2];
#pragma unroll
      for (int tt = 0; tt < 2; ++tt) {
        int id = lidx[g2 * 32 + tt * 16 + n16];
        bool valid = id <= i;
        f32x4 acc = {0.f, 0.f, 0.f, 0.f};
#pragma unroll
        for (int s = 0; s < 4; ++s) {
          long kf = *reinterpret_cast<const long*>(tile + (tt * 16 + n16) * 272 + 32 * s + 8 * g4);
          acc = __builtin_amdgcn_mfma_f32_16x16x32_fp8_fp8(qf[s], kf, acc, 0, 0, 0);
        }
        sc[tt] = valid ? acc[0] * lf : -1e30f;
      }
      {
        const float mg = max16(fmaxf(sc[0], sc[1]));
        const bool up = mg > mrun + 8.f;
        const float mnew = up ? mg : mrun;
        const float al = __builtin_amdgcn_exp2f(mrun - mnew);
        mrun = mnew;
        const float p0 = __builtin_amdgcn_exp2f(sc[0] - mnew), p1 = __builtin_amdgcn_exp2f(sc[1] - mnew);
        lrun = lrun * al + sum16(p0 + p1);
        const int ph = __builtin_amdgcn_cvt_pk_fp8_f32(p0, p1, 0, false);
        const float2_t pb = __builtin_amdgcn_cvt_pk_f32_fp8(ph, false);
        const int pl = __builtin_amdgcn_cvt_pk_fp8_f32((p0 - pb.x) * 16.f, (p1 - pb.y) * 16.f, 0, false);
        Pb[g4 * 32 + n16] = (u8)ph; Pb[g4 * 32 + 16 + n16] = (u8)(ph >> 8);
        Pb[128 + g4 * 32 + n16] = (u8)pl; Pb[128 + g4 * 32 + 16 + n16] = (u8)(pl >> 8);
        if (__ballot(up)) {
          f32x4 av;
#pragma unroll
          for (int h = 0; h < 4; ++h) av[h] = __int_as_float(__builtin_amdgcn_readlane(__float_as_int(al), 16 * h));
#pragma unroll
          for (int tl = 0; tl < 8; ++tl) { ohi[tl] *= av; olo[tl] *= av; }
        }
      }
      __builtin_amdgcn_wave_barrier();
      {
        long ah = 0, alw = 0;
        if (n16 < 4) {
          ah = *reinterpret_cast<const long*>(Pb + n16 * 32 + 8 * g4);
          alw = *reinterpret_cast<const long*>(Pb + 128 + n16 * 32 + 8 * g4);
        }
        const char* vrow = tile + (8 * g4 + (n16 >> 1)) * 272 + 128 + 8 * (n16 & 1);
#pragma unroll
        for (int tl = 0; tl < 8; ++tl) {
          const i32x2t vt = __builtin_amdgcn_ds_read_tr8_b64_v2i32((__attribute__((address_space(3))) i32x2t*)(vrow + 16 * tl));
          const long vb8 = (long)(((unsigned long long)(u32)vt[1] << 32) | (unsigned long long)(u32)vt[0]);
          ohi[tl] = __builtin_amdgcn_mfma_f32_16x16x32_fp8_fp8(ah, vb8, ohi[tl], 0, 0, 0);
          olo[tl] = __builtin_amdgcn_mfma_f32_16x16x32_fp8_fp8(alw, vb8, olo[tl], 0, 0, 0);
        }
      }
      __builtin_amdgcn_wave_barrier();
    }
    {
      float* ot = reinterpret_cast<float*>(tile);
#pragma unroll
      for (int tl = 0; tl < 8; ++tl) {
        f32x4 o = ohi[tl] + olo[tl] * 0.0625f;
        asm volatile("" : "+v"(o));
        if (lane < 16) {
#pragma unroll
          for (int h = 0; h < 4; ++h) ot[h * 128 + 16 * tl + n16] = o[h];
        }
      }
      __builtin_amdgcn_wave_barrier();
      const float inv = ovs * __builtin_amdgcn_rcpf(lrun);
      float ov[8];
      load8(ot + g4 * 128 + n16 * 8, ov);
#pragma unroll
      for (int e = 0; e < 8; ++e) ov[e] *= inv;
      *reinterpret_cast<uint4*>(p.yb() + (size_t)tq * 512 + g4 * 128 + n16 * 8) = pack8(ov);
      __builtin_amdgcn_wave_barrier();
    }
  }
  for (int tix = blockIdx.x; tix < 128; tix += gridDim.x) {
    const int hp = tix >> 3, ct = tix & 7;
    float* cs = reinterpret_cast<float*>(smem);
    Tile4 ra, rb;
    f32x16 acc[2][2];
    zero_acc(acc);
    gemm_prefetch(p.SubK() + (size_t)hp * 128 * 128, 128, p.WqN() + (size_t)ct * 128 * 2048 + hp * 128, 2048, 128, ra, rb);
    gemm_mainloop_rolled(p.SubK() + (size_t)hp * 128 * 128, 128, p.WqN() + (size_t)ct * 128 * 2048 + hp * 128, 2048, 128, acc, smem, ra, rb);
    stage_acc(acc, cs);
    __syncthreads();
#pragma unroll 2
    for (int it = 0; it < 8; ++it) {
      const int row = wid * 32 + it * 4 + (lane >> 4), c0 = (lane & 15) * 8;
      float v[8];
      load8(cs + row * CS_LD + c0, v);
      *reinterpret_cast<uint4*>(p.WqT() + ((size_t)hp * 128 + row) * 1024 + ct * 128 + c0) = pack8(v);
    }
    __syncthreads();
  }
}

__device__ void phase_merge(const Params& p, char* smem) {
  const int tid = threadIdx.x, lane = tid & 63, wid = tid >> 6;
  float* cs = reinterpret_cast<float*>(smem);
  constexpr int NTILES = (T / 128) * 8;
  int mt, nt;
  bool have = tile_swizzle(0, 8, NTILES, mt, nt);
  Tile4 ra, rb;
  if (have) gemm_prefetch(p.ya() + (size_t)mt * 128 * 512, 512, p.WaT() + (size_t)nt * 128 * 512, 512, 512, ra, rb);
  const int erow = wid * 32 + (lane >> 4), ec0 = (lane & 15) * 8;
  u32x4 ga0, ga1, ga2, ga3, ga4, ga5, ga6, ga7, gb0, gb1, gb2, gb3, gb4, gb5, gb6, gb7;
#define GLD(R, PTR) R = *reinterpret_cast<const u32x4*>(PTR);
#define GU4(R) make_uint4(R[0], R[1], R[2], R[3])
  {
    const u16* sga = p.sg() + ((size_t)(have ? mt : 0) * 128 + erow) * 2048 + (have ? nt : 0) * 128 + ec0;
    GLD(ga0, sga) GLD(ga1, sga + 4 * 2048) GLD(ga2, sga + 8 * 2048) GLD(ga3, sga + 12 * 2048)
    GLD(ga4, sga + 16 * 2048) GLD(ga5, sga + 20 * 2048) GLD(ga6, sga + 24 * 2048) GLD(ga7, sga + 28 * 2048)
  }
  for (int step = 0; have; ++step) {
    int m0 = mt * 128, n0 = nt * 128;
    f32x16 acc[2][2];
    zero_acc(acc);
    gemm_mainloop(p.ya() + (size_t)m0 * 512, 512, p.WaT() + (size_t)n0 * 512, 512, 512, acc, smem, ra, rb);
    stage_acc(acc, cs);
    __syncthreads();
    gemm_prefetch(p.yb() + (size_t)m0 * 512, 512, p.WbT() + (size_t)n0 * 512, 512, 512, ra, rb);
    const u16* sgb = p.sg() + ((size_t)m0 + erow) * 2048 + 1024 + n0 + ec0;
#define EP1(IT, GA, GB) { \
      const int row = erow + 4 * (IT); \
      float v[8], g[8]; \
      load8(cs + row * CS_LD + ec0, v); \
      unpack8(GU4(GA), g); \
      GLD(GB, sgb + (size_t)(4 * (IT)) * 2048) \
      _Pragma("unroll") for (int e = 0; e < 8; ++e) v[e] *= g[e]; \
      *reinterpret_cast<uint4*>(p.merged() + (size_t)(m0 + row) * 1024 + n0 + ec0) = pack8(v); }
    EP1(0, ga0, gb0) EP1(1, ga1, gb1) EP1(2, ga2, gb2) EP1(3, ga3, gb3) EP1(4, ga4, gb4) EP1(5, ga5, gb5) EP1(6, ga6, gb6) EP1(7, ga7, gb7)
#undef EP1
    __syncthreads();
    zero_acc(acc);
    gemm_mainloop(p.yb() + (size_t)m0 * 512, 512, p.WbT() + (size_t)n0 * 512, 512, 512, acc, smem, ra, rb);
    stage_acc(acc, cs);
    __syncthreads();
    int mt2 = 0, nt2 = 0;
    const bool nxt = tile_swizzle(step + 1, 8, NTILES, mt2, nt2);
    if (nxt) gemm_prefetch(p.ya() + (size_t)mt2 * 128 * 512, 512, p.WaT() + (size_t)nt2 * 128 * 512, 512, 512, ra, rb);
    const u16* sgn = p.sg() + ((size_t)(nxt ? mt2 : mt) * 128 + erow) * 2048 + (nxt ? nt2 : nt) * 128 + ec0;
    u16* mp0 = p.merged() + (size_t)(m0 + erow) * 1024 + n0 + ec0;
    u32x4 pa0, pa1, pa2, pa3;
    GLD(pa0, mp0) GLD(pa1, mp0 + 4 * 1024) GLD(pa2, mp0 + 8 * 1024) GLD(pa3, mp0 + 12 * 1024)
#define EP2(IT, GB, PA, GA) { \
      const int row = erow + 4 * (IT); \
      float v[8], g[8], pa[8]; \
      load8(cs + row * CS_LD + ec0, v); \
      unpack8(GU4(GB), g); \
      unpack8(GU4(PA), pa); \
      if ((IT) < 4) { GLD(PA, mp0 + (size_t)(4 * ((IT) + 4)) * 1024) } \
      GLD(GA, sgn + (size_t)(4 * (IT)) * 2048) \
      _Pragma("unroll") for (int e = 0; e < 8; ++e) v[e] = pa[e] + v[e] * g[e]; \
      *reinterpret_cast<uint4*>(mp0 + (size_t)(4 * (IT)) * 1024) = pack8(v); }
    EP2(0, gb0, pa0, ga0) EP2(1, gb1, pa1, ga1) EP2(2, gb2, pa2, ga2) EP2(3, gb3, pa3, ga3)
    EP2(4, gb4, pa0, ga4) EP2(5, gb5, pa1, ga5) EP2(6, gb6, pa2, ga6) EP2(7, gb7, pa3, ga7)
#undef EP2
    mt = mt2; nt = nt2; have = nxt;
  }
#undef GLD
#undef GU4
}

__device__ void phase_wo(const Params& p, char* smem) {
  const int tid = threadIdx.x, lane = tid & 63, wid = tid >> 6;
  float* cs = reinterpret_cast<float*>(smem);
  constexpr int NTILES = (T / 128) * 8;
  int mt, nt;
  bool have = tile_swizzle(0, 8, NTILES, mt, nt);
  Tile4 ra, rb;
  if (have) gemm_prefetch(p.merged() + (size_t)mt * 128 * 1024, 1024, p.WoT() + (size_t)nt * 128 * 1024, 1024, 1024, ra, rb);
  const int erow = wid * 32 + (lane >> 4), ec0 = (lane & 15) * 8;
  f32x4 xa0, xa1, xa2, xa3, xa4, xa5, xa6, xa7;
#define XLD(A, B, PTR) { const float* xp_ = (PTR); A = *reinterpret_cast<const f32x4*>(xp_); B = *reinterpret_cast<const f32x4*>(xp_ + 4); }
  {
    const float* xq = p.x + ((size_t)(have ? mt : 0) * 128 + erow) * 1024 + (have ? nt : 0) * 128 + ec0;
    XLD(xa0, xa1, xq) XLD(xa2, xa3, xq + 4 * 1024) XLD(xa4, xa5, xq + 8 * 1024) XLD(xa6, xa7, xq + 12 * 1024)
  }
  for (int step = 0; have; ++step) {
    int m0 = mt * 128, n0 = nt * 128;
    f32x16 acc[2][2];
    zero_acc(acc);
    gemm_mainloop(p.merged() + (size_t)m0 * 1024, 1024, p.WoT() + (size_t)n0 * 1024, 1024, 1024, acc, smem, ra, rb);
    f32x4 xb0, xb1, xb2, xb3, xb4, xb5, xb6, xb7;
    {
      const float* xq = p.x + ((size_t)m0 + erow + 16) * 1024 + n0 + ec0;
      XLD(xb0, xb1, xq) XLD(xb2, xb3, xq + 4 * 1024) XLD(xb4, xb5, xq + 8 * 1024) XLD(xb6, xb7, xq + 12 * 1024)
    }
    stage_acc(acc, cs);
    __syncthreads();
    int mt2 = 0, nt2 = 0;
    const bool nxt = tile_swizzle(step + 1, 8, NTILES, mt2, nt2);
    if (nxt) gemm_prefetch(p.merged() + (size_t)mt2 * 128 * 1024, 1024, p.WoT() + (size_t)nt2 * 128 * 1024, 1024, 1024, ra, rb);
    const float* xn_ = p.x + ((size_t)(nxt ? mt2 : mt) * 128 + erow) * 1024 + (nxt ? nt2 : nt) * 128 + ec0;
#define EPI(IT, X0, X1, RELOAD) { \
      const int row = erow + (IT) * 4; \
      const size_t t = (size_t)m0 + row; \
      float v[8]; \
      load8(cs + row * CS_LD + ec0, v); \
      const f32x4 x0_ = X0, x1_ = X1; \
      RELOAD \
      v[0] += x0_[0]; v[1] += x0_[1]; v[2] += x0_[2]; v[3] += x0_[3]; v[4] += x1_[0]; v[5] += x1_[1]; v[6] += x1_[2]; v[7] += x1_[3]; \
      float ss = 0.f; \
      _Pragma("unroll") for (int e = 0; e < 8; ++e) ss += v[e] * v[e]; \
      *reinterpret_cast<uint4*>(p.h1b() + t * 1024 + n0 + ec0) = pack8(v);     \
      ss = sum16(ss); \
      if ((lane & 15) == 0) p.ssq()[(size_t)nt * T + t] = ss; }
    EPI(0, xa0, xa1, XLD(xa0, xa1, xn_))
    EPI(1, xa2, xa3, XLD(xa2, xa3, xn_ + 4 * 1024))
    EPI(2, xa4, xa5, XLD(xa4, xa5, xn_ + 8 * 1024))
    EPI(3, xa6, xa7, XLD(xa6, xa7, xn_ + 12 * 1024))
    EPI(4, xb0, xb1, )
    EPI(5, xb2, xb3, )
    EPI(6, xb4, xb5, )
    EPI(7, xb6, xb7, )
#undef EPI
    mt = mt2; nt = nt2; have = nxt;
  }
#undef XLD
}

__device__ __forceinline__ void ins16(float (&l)[16], float v) {
#pragma unroll
  for (int q = 15; q >= 1; --q) l[q] = __builtin_amdgcn_fmed3f(v, l[q - 1], l[q]);
  l[0] = fmaxf(l[0], v);
}
__device__ void phase_peerq(const Params& p, char* smem) {
  const int tid = threadIdx.x, lane = tid & 63, wid = tid >> 6;
  const int wr = wid >> 1, wc = wid & 1;
  float* cs = reinterpret_cast<float*>(smem);
  constexpr int NTILES = (T / 128) * 16;
  int mt, hp;
  bool have = tile_swizzle(0, 16, NTILES, mt, hp);
  Tile4 ra, rb;
  if (have) gemm_prefetch(p.h1b() + (size_t)mt * 128 * 1024, 1024, p.WqT() + (size_t)hp * 128 * 1024, 1024, 1024, ra, rb);
  for (int step = 0; have; ++step) {
    int m0 = mt * 128;
    f32x16 acc[2][2];
    zero_acc(acc);
    gemm_mainloop(p.h1b() + (size_t)m0 * 1024, 1024, p.WqT() + (size_t)hp * 128 * 1024, 1024, 1024, acc, smem, ra, rb);
    float rt = 0.f;
    if (tid < 128) {
      float ssum = 0.f;
#pragma unroll
      for (int q = 0; q < 8; ++q) ssum += p.ssq()[(size_t)q * T + m0 + tid];
      rt = rsqrtf(ssum * (1.f / 1024.f) + EPS);
    }
    stage_acc(acc, cs);
    __syncthreads();
    int mt2 = 0, hp2 = 0;
    const bool nxt = tile_swizzle(step + 1, 16, NTILES, mt2, hp2);
    if (nxt) gemm_prefetch(p.h1b() + (size_t)mt2 * 128 * 1024, 1024, p.WqT() + (size_t)hp2 * 128 * 1024, 1024, 1024, ra, rb);
    {
      int row = tid >> 1, half = tid & 1;
      float* rp = cs + row * CS_LD + half * 64;
      float l[16];
#pragma unroll
      for (int q = 0; q < 16; ++q) l[q] = -INFINITY;
      for (int c = 0; c < 64; c += 4) {
        float4 v4 = *reinterpret_cast<const float4*>(rp + c);
        float vv[4] = {v4.x, v4.y, v4.z, v4.w};
#pragma unroll
        for (int e = 0; e < 4; ++e) {
          u32 bits = __float_as_uint(vv[e]);
          u32 n = (u32)(half * 64 + c + e);
          bits = (bits & ~127u) | ((bits >> 31) ? n : (127u - n));
          ins16(l, __uint_as_float(bits));
        }
      }
#pragma unroll
      for (int q = 0; q < 16; ++q) rp[q] = l[q];
    }
    __syncthreads();
    if (tid < 128) {
      int row = tid;
      size_t t = (size_t)m0 + row;
      const float* la = cs + row * CS_LD;
      const float* lb = la + 64;
      int ia = 0, ib = 0;
      float* ov = p.stv() + ((size_t)hp * T + t) * 16;
      u8* oi = p.sti() + ((size_t)hp * T + t) * 16;
      float ovv[16]; u32 oii[4] = {0u, 0u, 0u, 0u};
#pragma unroll
      for (int q = 0; q < 16; ++q) {
        float va = la[ia], vb = lb[ib];
        bool ta = va >= vb;
        float v = ta ? va : vb;
        ia += ta ? 1 : 0;
        ib += ta ? 0 : 1;
        u32 bits = __float_as_uint(v);
        u32 low = bits & 127u;
        u32 n = (bits >> 31) ? low : (127u - low);
        ovv[q] = __uint_as_float(bits & ~127u) * rt;
        oii[q >> 2] |= n << (8 * (q & 3));
      }
#pragma unroll
      for (int q = 0; q < 4; ++q) *reinterpret_cast<float4*>(ov + 4 * q) = make_float4(ovv[4 * q], ovv[4 * q + 1], ovv[4 * q + 2], ovv[4 * q + 3]);
      *reinterpret_cast<uint4*>(oi) = make_uint4(oii[0], oii[1], oii[2], oii[3]);
    }
    mt = mt2; hp = hp2; have = nxt;
  }
}

__device__ void phase_peer_lists(const Params& p, char* smem) {
  const int nthr = gridDim.x * NTHREADS;
  int tid = threadIdx.x;
  asm volatile("" : "+v"(tid));
  u16* sxl = reinterpret_cast<u16*>(smem);
  float* vls = reinterpret_cast<float*>(smem + 32768) + tid;
  u8* xls = reinterpret_cast<u8*>(smem + 65536) + tid * 4;
  __syncthreads();
#pragma unroll
  for (int i = 0; i < 8; ++i)
    reinterpret_cast<u32x4*>(smem)[tid + 256 * i] = reinterpret_cast<const u32x4*>(p.sx())[tid + 256 * i];
  __syncthreads();
  f32x4 na0, na1, na2, na3, nb0, nb1, nb2, nb3;
  u32x4 nxa, nxb;
#define LISTS_LOAD(IT) { \
    const int itc_ = (IT) < T * 8 ? (IT) : T * 8 - 1; \
    const size_t t_ = (size_t)(itc_ >> 3); const int h_ = itc_ & 7; \
    const float* v1_ = p.stv() + ((size_t)(2 * h_) * T + t_) * 16; const float* v2_ = v1_ + (size_t)T * 16; \
    const u8* x1_ = p.sti() + ((size_t)(2 * h_) * T + t_) * 16; \
    na0 = *reinterpret_cast<const f32x4*>(v1_); na1 = *reinterpret_cast<const f32x4*>(v1_ + 4); \
    na2 = *reinterpret_cast<const f32x4*>(v1_ + 8); na3 = *reinterpret_cast<const f32x4*>(v1_ + 12); \
    nb0 = *reinterpret_cast<const f32x4*>(v2_); nb1 = *reinterpret_cast<const f32x4*>(v2_ + 4); \
    nb2 = *reinterpret_cast<const f32x4*>(v2_ + 8); nb3 = *reinterpret_cast<const f32x4*>(v2_ + 12); \
    nxa = *reinterpret_cast<const u32x4*>(x1_); nxb = *reinterpret_cast<const u32x4*>(x1_ + (size_t)T * 16); }
  LISTS_LOAD(blockIdx.x * NTHREADS + tid)
  for (int it = blockIdx.x * NTHREADS + tid; it < T * 8; it += nthr) {
    const size_t t = (size_t)(it >> 3);
    const int h = it & 7;
    float s1[16], s2[16];
    {
      const f32x4 a4[4] = {na0, na1, na2, na3}, b4[4] = {nb0, nb1, nb2, nb3};
#pragma unroll
      for (int c = 0; c < 4; ++c)
#pragma unroll
        for (int e = 0; e < 4; ++e) { s1[4 * c + e] = a4[c][e]; s2[4 * c + e] = b4[c][e]; }
    }
    {
      const u32x4 xa = nxa, xb = nxb;
      LISTS_LOAD(it + nthr)
#pragma unroll
      for (int e = 0; e < 4; ++e) {
        *reinterpret_cast<u32*>(xls + e * 1024) = xa[e];
        *reinterpret_cast<u32*>(xls + (4 + e) * 1024) = xb[e];
      }
    }
#pragma unroll
    for (int e = 0; e < 16; ++e) { vls[e * 256] = s1[e]; vls[(16 + e) * 256] = s2[e]; }
    float l[16];
#pragma unroll
    for (int i = 0; i < 16; ++i)
#pragma unroll
      for (int j = 0; j < 16 / (i + 1); ++j) {
        const u32 pr = (u32)(i * 16 + j);
        u32 bits = __float_as_uint(s1[i] + s2[j]);
        bits = (bits & ~255u) | ((bits >> 31) ? pr : (255u - pr));
        const float v = __uint_as_float(bits);
        if (i == 0) l[j] = v;
        else {
          const int r0 = (i + 1) * (j + 1) - 1;
#pragma unroll
          for (int q = 15; q > r0; --q) l[q] = __builtin_amdgcn_fmed3f(v, l[q - 1], l[q]);
          l[r0] = fmaxf(l[r0], v);
        }
      }
    float bv[16], m = -INFINITY;
    u32 ex[16];
#pragma unroll
    for (int q = 0; q < 16; ++q) {
      const u32 bits = __float_as_uint(l[q]);
      const u32 low = bits & 255u;
      const u32 prq = (bits >> 31) ? low : (255u - low);
      const u32 i = prq >> 4, j = prq & 15u;
      bv[q] = vls[i * 256] + vls[(16 + j) * 256];
      ex[q] = (u32)xls[(i >> 2) * 1024 + (i & 3)] * 128u + (u32)xls[(4 + (j >> 2)) * 1024 + (j & 3)];
      m = fmaxf(m, bv[q]);
    }
    float ssum = 0.f;
#pragma unroll
    for (int q = 0; q < 16; ++q) { bv[q] = __expf(bv[q] - m); ssum += bv[q]; }
    const float inv = 1.f / ssum;
    float gvq[16], suq[16];
#pragma unroll
    for (int q = 0; q < 16; ++q) {
      const int sxe = (int)sxl[ex[q]];
      const int eu = (int)(signed char)(sxe & 0xff), ev = (int)(signed char)(sxe >> 8);
      suq[q] = __uint_as_float((u32)(127 + eu) << 23);
      gvq[q] = bv[q] * inv * __uint_as_float((u32)(127 + ev) << 23);
    }
    u16* oe = p.eidT() + t * 128 + h * 16;
    float* og = p.egv() + t * 128 + h * 16;
    float* os = p.esu() + t * 128 + h * 16;
#pragma unroll
    for (int c = 0; c < 2; ++c) {
      u32x4 w;
#pragma unroll
      for (int e = 0; e < 4; ++e) w[e] = ex[8 * c + 2 * e] | (ex[8 * c + 2 * e + 1] << 16);
      *reinterpret_cast<u32x4*>(oe + 8 * c) = w;
    }
#pragma unroll
    for (int c = 0; c < 4; ++c) {
      const f32x4 a = {gvq[4 * c], gvq[4 * c + 1], gvq[4 * c + 2], gvq[4 * c + 3]};
      const f32x4 b = {suq[4 * c], suq[4 * c + 1], suq[4 * c + 2], suq[4 * c + 3]};
      *reinterpret_cast<f32x4*>(og + 4 * c) = a;
      *reinterpret_cast<f32x4*>(os + 4 * c) = b;
    }
  }
#undef LISTS_LOAD
  {
    const int lane = tid & 63, wid = tid >> 6;
    const int tstep = gridDim.x * 4;
    for (int tq0 = blockIdx.x * 4 + wid; tq0 < T; tq0 += 4 * tstep) {
      float sq[4][8];
      u32x4 hh0[4], hh1[4];
#pragma unroll
      for (int k = 0; k < 4; ++k) {
        const int tk = tq0 + k * tstep;
        const size_t t = tk < T ? tk : T - 1;
#pragma unroll
        for (int q = 0; q < 8; ++q) sq[k][q] = p.ssq()[(size_t)q * T + t];
        hh0[k] = *reinterpret_cast<const u32x4*>(p.h1b() + t * 1024 + lane * 16);
        hh1[k] = *reinterpret_cast<const u32x4*>(p.h1b() + t * 1024 + lane * 16 + 8);
      }
#pragma unroll
      for (int k = 0; k < 4; ++k) {
        const int tk = tq0 + k * tstep;
        if (tk < T) {
          const size_t t = tk;
          float ssum = 0.f;
#pragma unroll
          for (int q = 0; q < 8; ++q) ssum += sq[k][q];
          const float sc8 = 8.f * rsqrtf(ssum * (1.f / 1024.f) + EPS);
          const u32x4 h0 = hh0[k], h1 = hh1[k];
          u32x4 whi, wlo;
#pragma unroll
          for (int q = 0; q < 4; ++q) {
            const u32 wa = (q < 2) ? h0[2 * q] : h1[2 * q - 4], wb = (q < 2) ? h0[2 * q + 1] : h1[2 * q - 3];
            const float v0 = bf_lo(wa) * sc8, v1 = bf_hi(wa) * sc8, v2 = bf_lo(wb) * sc8, v3 = bf_hi(wb) * sc8;
            int hi = __builtin_amdgcn_cvt_pk_fp8_f32(v0, v1, 0, false);
            hi = __builtin_amdgcn_cvt_pk_fp8_f32(v2, v3, hi, true);
            const float2_t b01 = __builtin_amdgcn_cvt_pk_f32_fp8(hi, false), b23 = __builtin_amdgcn_cvt_pk_f32_fp8(hi, true);
            int lo = __builtin_amdgcn_cvt_pk_fp8_f32((v0 - b01.x) * 16.f, (v1 - b01.y) * 16.f, 0, false);
            lo = __builtin_amdgcn_cvt_pk_fp8_f32((v2 - b23.x) * 16.f, (v3 - b23.y) * 16.f, lo, true);
            whi[q] = (u32)hi; wlo[q] = (u32)lo;
          }
          *reinterpret_cast<u32x4*>(p.hhi() + t * 1024 + lane * 16) = whi;
          *reinterpret_cast<u32x4*>(p.hlo() + t * 1024 + lane * 16) = wlo;
        }
      }
    }
  }
}

__device__ __forceinline__ u32 eid_at(const u32x4& a, const u32x4& b, int j) {
  const u32 w = (j < 8) ? a[(j >> 1) & 3] : b[(j >> 1) & 3];
  return (j & 1) ? (w >> 16) : (w & 0xffffu);
}
__device__ __forceinline__ float dot16_fp8(const u32x4& u, const float2_t (&h2)[8]) {
  float2_t acc = __builtin_amdgcn_cvt_pk_f32_fp8((int)u[0], false) * h2[0];
  acc += __builtin_amdgcn_cvt_pk_f32_fp8((int)u[0], true) * h2[1];
#pragma unroll
  for (int q = 1; q < 4; ++q) {
    acc += __builtin_amdgcn_cvt_pk_f32_fp8((int)u[q], false) * h2[2 * q];
    acc += __builtin_amdgcn_cvt_pk_f32_fp8((int)u[q], true) * h2[2 * q + 1];
  }
  return acc.x + acc.y;
}
__device__ __forceinline__ void axpy16_fp8(float c, const u32x4& v, float2_t (&y2)[8]) {
  const float2_t c2 = {c, c};
#pragma unroll
  for (int q = 0; q < 4; ++q) {
    y2[2 * q] += c2 * __builtin_amdgcn_cvt_pk_f32_fp8((int)v[q], false);
    y2[2 * q + 1] += c2 * __builtin_amdgcn_cvt_pk_f32_fp8((int)v[q], true);
  }
}
#define PEER_CLAMP(x) ((x) < T ? (x) : T - 1)

typedef int i32x8 __attribute__((ext_vector_type(8)));
__device__ void phase_peer_u(const Params& p, char* smem) {
  int tid = threadIdx.x;
  asm volatile("" : "+v"(tid));
  const int lane = tid & 63, wid = tid >> 6;
  const int k = lane >> 3, g = lane & 7;
  const int n16 = lane & 15, g4 = lane >> 4;
  const int slice = (blockIdx.x & 7) >> 1;
  const int nw = (int)(gridDim.x >> 3) * 8;
  const u8* ub = p.U8() + (size_t)slice * 2097152;
  const u32 g16 = g * 16;
  const u16* ep = p.eidT() + k * 16;
  char* img = smem + wid * 16384;
  float* xs = reinterpret_cast<float*>(smem + 65536 + wid * 512);
  char* wrow = img + k * 2048;
  int rb[2];
#pragma unroll
  for (int ks = 0; ks < 2; ++ks) rb[ks] = n16 * 128 + (((4 * ks + g4) ^ ((n16 >> 1) & 7)) << 4);
  const u8* ap = ((n16 & 1) ? p.hlo() : p.hhi()) + slice * 256 + 16 * g4;
  const bool arow = n16 < 2;
  int t = ((blockIdx.x >> 3) * 4 + wid) * 2 + (blockIdx.x & 1);
  u32x4 ne0, ne1;
  u32x4 ua[8], uc[8];
  u32x4 af[4];
  {
    const size_t tc = PEER_CLAMP(t);
    const u32x4 ce0 = *reinterpret_cast<const u32x4*>(ep + tc * 128), ce1 = *reinterpret_cast<const u32x4*>(ep + tc * 128 + 8);
#pragma unroll
    for (int q = 0; q < 4; ++q) af[q] = *reinterpret_cast<const u32x4*>(ap + tc * 1024 + 128 * (q >> 1) + 64 * (q & 1));
    const size_t tn = PEER_CLAMP(t + nw);
    ne0 = *reinterpret_cast<const u32x4*>(ep + tn * 128); ne1 = *reinterpret_cast<const u32x4*>(ep + tn * 128 + 8);
#pragma unroll
    for (int j = 0; j < 8; ++j) ua[j] = *reinterpret_cast<const u32x4*>(ub + (eid_at(ce0, ce1, j) * 128u + g16));
#pragma unroll
    for (int j = 0; j < 8; ++j) uc[j] = *reinterpret_cast<const u32x4*>(ub + (eid_at(ce0, ce1, 8 + j) * 128u + g16));
  }
  __builtin_amdgcn_s_waitcnt(0x0F70);
  for (; t < T; t += nw) {
#pragma unroll
    for (int j = 0; j < 8; ++j) *reinterpret_cast<u32x4*>(wrow + j * 128 + ((g ^ ((j >> 1) & 7)) << 4)) = ua[j];
#pragma unroll
    for (int j = 0; j < 8; ++j) ua[j] = *reinterpret_cast<const u32x4*>(ub + (eid_at(ne0, ne1, j) * 128u + g16));
#pragma unroll
    for (int j = 0; j < 8; ++j) *reinterpret_cast<u32x4*>(wrow + (8 + j) * 128 + ((g ^ (((8 + j) >> 1) & 7)) << 4)) = uc[j];
#pragma unroll
    for (int j = 0; j < 8; ++j) uc[j] = *reinterpret_cast<const u32x4*>(ub + (eid_at(ne0, ne1, 8 + j) * 128u + g16));
    const size_t t1 = PEER_CLAMP(t + nw), t2 = PEER_CLAMP(t + 2 * nw);
    const u32x4 pe0 = *reinterpret_cast<const u32x4*>(ep + t2 * 128), pe1 = *reinterpret_cast<const u32x4*>(ep + t2 * 128 + 8);
    u32x4 naf[4];
#pragma unroll
    for (int q = 0; q < 4; ++q) naf[q] = *reinterpret_cast<const u32x4*>(ap + t1 * 1024 + 128 * (q >> 1) + 64 * (q & 1));
    i32x8 am[2];
#pragma unroll
    for (int ks = 0; ks < 2; ++ks)
#pragma unroll
      for (int e = 0; e < 8; ++e) am[ks][e] = arow ? (int)af[2 * ks + (e >> 2)][e & 3] : 0;
    float d[8];
#pragma unroll
    for (int blk = 0; blk < 8; ++blk) {
      f32x4 acc = {0.f, 0.f, 0.f, 0.f};
#pragma unroll
      for (int ks = 0; ks < 2; ++ks) {
        const u32x4 bq = *reinterpret_cast<const u32x4*>(img + blk * 2048 + rb[ks]);
        const i32x8 bm = {(int)bq[0], (int)bq[1], (int)bq[2], (int)bq[3], 0, 0, 0, 0};
        acc = __builtin_amdgcn_mfma_scale_f32_16x16x128_f8f6f4(am[ks], bm, acc, 0, 4, 0, 0x7f7f7f7f, 0, 0x7f7f7f7f);
      }
      d[blk] = acc[0] + acc[1] * 0.0625f;
      asm volatile("" : "+v"(d[blk]));
    }
    if (lane < 16) {
#pragma unroll
      for (int blk = 0; blk < 8; ++blk) xs[blk * 16 + n16] = d[blk];
    }
    const float2_t pr = *reinterpret_cast<const float2_t*>(xs + lane * 2);
    p.part()[((size_t)t * 4 + slice) * 64 + lane] = pack_bf16(pr.x, pr.y);
#pragma unroll
    for (int q = 0; q < 4; ++q) af[q] = naf[q];
    ne0 = pe0; ne1 = pe1;
  }
}

__device__ void phase_peer_coef(const Params& p) {
  int tid = threadIdx.x;
  asm volatile("" : "+v"(tid));
  const int lane = tid & 63, wid = tid >> 6;
  const int tstep = gridDim.x * 4;
  for (int tq0 = blockIdx.x * 4 + wid; tq0 < T; tq0 += 8 * tstep) {
    u32 pw[8][4];
    float2_t suv[8], gvv[8];
#pragma unroll
    for (int k = 0; k < 8; ++k) {
      const int tk = tq0 + k * tstep;
      const size_t t = tk < T ? tk : T - 1;
#pragma unroll
      for (int sl = 0; sl < 4; ++sl) pw[k][sl] = p.part()[(t * 4 + sl) * 64 + lane];
      suv[k] = *reinterpret_cast<const float2_t*>(p.esu() + t * 128 + lane * 2);
      gvv[k] = *reinterpret_cast<const float2_t*>(p.egv() + t * 128 + lane * 2);
    }
#pragma unroll
    for (int k = 0; k < 8; ++k) {
      const int tk = tq0 + k * tstep;
      if (tk >= T) continue;
      const size_t t = tk;
      float2_t s = {0.f, 0.f};
#pragma unroll
      for (int sl = 0; sl < 4; ++sl) { const u32 w = pw[k][sl]; s.x += bf_lo(w); s.y += bf_hi(w); }
      const float2_t su = suv[k];
      const float2_t gv = gvv[k];
      float2_t c;
      c.x = gv.x * gelu_f(s.x * 0.125f * su.x);
      c.y = gv.y * gelu_f(s.y * 0.125f * su.y);
      float cm = fmaxf(fabsf(c.x), fabsf(c.y));
#pragma unroll
      for (int m = 32; m >= 1; m >>= 1) cm = fmaxf(cm, __shfl_xor(cm, m));
      int ce = 0;
      if (cm > 0.f) ce = ilogbf(240.f / cm);
      ce = ce > 100 ? 100 : (ce < -100 ? -100 : ce);
      const float csf = ldexpf(1.f, ce);
      const float a0 = c.x * csf, a1 = c.y * csf;
      const int hi = __builtin_amdgcn_cvt_pk_fp8_f32(a0, a1, 0, false);
      const float2_t bk = __builtin_amdgcn_cvt_pk_f32_fp8(hi, false);
      const int lo = __builtin_amdgcn_cvt_pk_fp8_f32((a0 - bk.x) * 16.f, (a1 - bk.y) * 16.f, 0, false);
      *reinterpret_cast<u16*>(p.chi() + t * 128 + lane * 2) = (u16)(hi & 0xffff);
      *reinterpret_cast<u16*>(p.clo() + t * 128 + lane * 2) = (u16)(lo & 0xffff);
      if (lane == 0) p.csc()[t] = ldexpf(1.f, -ce);
    }
  }
}

typedef int i32x2 __attribute__((ext_vector_type(2)));
__device__ void phase_peer_v(const Params& p, char* smem) {
  int tid = threadIdx.x;
  asm volatile("" : "+v"(tid));
  const int lane = tid & 63, wid = tid >> 6;
  const int k = lane >> 3, g = lane & 7;
  const int n16 = lane & 15, g4 = lane >> 4;
  const int slice = (blockIdx.x & 7) >> 1;
  const int nw = (int)(gridDim.x >> 3) * 8;
  const u8* vb = p.V8() + (size_t)slice * 2097152;
  const u32 g16 = g * 16;
  const u16* ep = p.eidT() + k * 16;
  char* img = smem + wid * 16384;
  float* xs = reinterpret_cast<float*>(smem + 65536 + wid * 1024);
  char* wrow = img + k * 2048;
  const int kn = (n16 >> 1) & 7;
  const char* trow = img + (32 * g4 + n16) * 128;
  const u8* ap = ((n16 & 1) ? p.clo() : p.chi()) + 16 * g4;
  const bool arow = n16 < 2;
  int t = ((blockIdx.x >> 3) * 4 + wid) * 2 + (blockIdx.x & 1);
  u32x4 ne0, ne1;
  u32x4 va[8], vc[8];
  u32x4 af0, af1;
  float cs;
  {
    const size_t tc = PEER_CLAMP(t);
    const u32x4 ce0 = *reinterpret_cast<const u32x4*>(ep + tc * 128), ce1 = *reinterpret_cast<const u32x4*>(ep + tc * 128 + 8);
    af0 = *reinterpret_cast<const u32x4*>(ap + tc * 128); af1 = *reinterpret_cast<const u32x4*>(ap + tc * 128 + 64);
    cs = p.csc()[tc];
    const size_t tn = PEER_CLAMP(t + nw);
    ne0 = *reinterpret_cast<const u32x4*>(ep + tn * 128); ne1 = *reinterpret_cast<const u32x4*>(ep + tn * 128 + 8);
#pragma unroll
    for (int j = 0; j < 8; ++j) va[j] = *reinterpret_cast<const u32x4*>(vb + (eid_at(ce0, ce1, j) * 128u + g16));
#pragma unroll
    for (int j = 0; j < 8; ++j) vc[j] = *reinterpret_cast<const u32x4*>(vb + (eid_at(ce0, ce1, 8 + j) * 128u + g16));
  }
  __builtin_amdgcn_s_waitcnt(0x0F70);
  for (; t < T; t += nw) {
#pragma unroll
    for (int j = 0; j < 8; ++j) *reinterpret_cast<u32x4*>(wrow + j * 128 + ((g ^ ((j >> 1) & 7)) << 4)) = va[j];
#pragma unroll
    for (int j = 0; j < 8; ++j) va[j] = *reinterpret_cast<const u32x4*>(vb + (eid_at(ne0, ne1, j) * 128u + g16));
#pragma unroll
    for (int j = 0; j < 8; ++j) *reinterpret_cast<u32x4*>(wrow + (8 + j) * 128 + ((g ^ (((8 + j) >> 1) & 7)) << 4)) = vc[j];
#pragma unroll
    for (int j = 0; j < 8; ++j) vc[j] = *reinterpret_cast<const u32x4*>(vb + (eid_at(ne0, ne1, 8 + j) * 128u + g16));
    const size_t t1 = PEER_CLAMP(t + nw), t2 = PEER_CLAMP(t + 2 * nw);
    const u32x4 pe0 = *reinterpret_cast<const u32x4*>(ep + t2 * 128), pe1 = *reinterpret_cast<const u32x4*>(ep + t2 * 128 + 8);
    const u32x4 naf0 = *reinterpret_cast<const u32x4*>(ap + t1 * 128), naf1 = *reinterpret_cast<const u32x4*>(ap + t1 * 128 + 64);
    const float ncs = p.csc()[t1];
    const uint2 hw = *reinterpret_cast<const uint2*>(p.h1b() + (size_t)t * 1024 + slice * 256 + lane * 4);
    i32x8 am;
#pragma unroll
    for (int e = 0; e < 4; ++e) { am[e] = arow ? (int)af0[e] : 0; am[4 + e] = arow ? (int)af1[e] : 0; }
    float yv[16];
#pragma unroll
    for (int tile = 0; tile < 16; ++tile) {
      const char* ta = trow + (((tile >> 1) ^ kn) << 4) + (tile & 1) * 8;
      const i32x2 r0 = __builtin_amdgcn_ds_read_tr4_b64_v2i32((__attribute__((address_space(3))) i32x2*)(ta));
      const i32x2 r1 = __builtin_amdgcn_ds_read_tr4_b64_v2i32((__attribute__((address_space(3))) i32x2*)(ta + 2048));
      const i32x8 bm = {r0[0], r0[1], r1[0], r1[1], 0, 0, 0, 0};
      f32x4 acc = {0.f, 0.f, 0.f, 0.f};
      acc = __builtin_amdgcn_mfma_scale_f32_16x16x128_f8f6f4(am, bm, acc, 0, 4, 0, 0x7f7f7f7f, 0, 0x7f7f7f7f);
      yv[tile] = (acc[0] + acc[1] * 0.0625f) * cs;
      asm volatile("" : "+v"(yv[tile]));
    }
    __builtin_amdgcn_wave_barrier();
    if (lane < 16) {
#pragma unroll
      for (int tile = 0; tile < 16; ++tile) xs[tile * 16 + n16] = yv[tile];
    }
    __builtin_amdgcn_wave_barrier();
    const f32x4 y4 = *reinterpret_cast<const f32x4*>(xs + lane * 4);
    const f32x4 o = {bf_lo(hw.x) + y4[0], bf_hi(hw.x) + y4[1], bf_lo(hw.y) + y4[2], bf_hi(hw.y) + y4[3]};
    *reinterpret_cast<f32x4*>(p.out + (size_t)t * 1024 + slice * 256 + lane * 4) = o;
    af0 = naf0; af1 = naf1; cs = ncs; ne0 = pe0; ne1 = pe1;
  }
}

__device__ void phase_mix(const Params& p, char* smem) {
  const int G = gridDim.x;
  {
    int* qslot = reinterpret_cast<int*>(smem + EXTRA_OFF + 1024);
    for (;;) {
      __syncthreads();
      if (threadIdx.x == 0) *qslot = (int)__hip_atomic_fetch_add(p.bar() + 16, 1u, __ATOMIC_RELAXED, __HIP_MEMORY_SCOPE_AGENT);
      __syncthreads();
      const int s = *qslot;
      if (s >= 2048) break;
      int grp = 1023 - (s >> 1), b = s & 1;
      unit_indexer(p, smem, (b << 10) | grp);
      convert_rows_of_slot(p, s);
    }
  }
  for (int u = blockIdx.x; u < 1024; u += G) unit_spatial(p, smem, u);
  for (int u = blockIdx.x; u < 256; u += G) unit_kv(p, smem, u);
}

template <int PH>
__device__ __forceinline__ void run_phase(const Params& p, char* smem) {
  if (PH == 0) phase_prep(p, smem);
  else if (PH == 1) phase_gemm1(p, smem);
  else if (PH == 2) phase_mix(p, smem);
  else if (PH == 3) phase_attn(p, smem);
  else if (PH == 4) phase_merge(p, smem);
  else if (PH == 5) phase_wo(p, smem);
  else if (PH == 6) phase_peerq(p, smem);
  else if (PH == 7) phase_peer_lists(p, smem);
  else if (PH == 8) phase_peer_u(p, smem);
  else if (PH == 9) phase_peer_coef(p);
  else phase_peer_v(p, smem);
}

template <int PH>
__global__ void __launch_bounds__(NTHREADS, 2) phase_kernel(Params p) {
  __shared__ __attribute__((aligned(16))) char smem[SMEM_BYTES];
  run_phase<PH>(p, smem);
}

#define XB_CNT(j) (64 + 64 * (j))
#define XB_SUB(j) (1088 + 64 * (j))
#define XB_GEN(j) (2112 + 64 * (j))
#define XB_TOP 3136
#define XB_TOPGEN 3200
#define XB_WORDS 3264
__device__ __forceinline__ unsigned xb_ld(unsigned* q) { return __hip_atomic_load(q, __ATOMIC_RELAXED, __HIP_MEMORY_SCOPE_AGENT); }
__device__ __forceinline__ unsigned xb_add(unsigned* q) { return __hip_atomic_fetch_add(q, 1u, __ATOMIC_RELAXED, __HIP_MEMORY_SCOPE_AGENT); }
__device__ __forceinline__ unsigned xb_xcc_id() { return (unsigned)__builtin_amdgcn_s_getreg((3 << 11) | 20) & 0xFu; }
__device__ __forceinline__ void grid_barrier(unsigned* bar, unsigned x, unsigned nloc, unsigned nx, unsigned xmask) {
  asm volatile("s_waitcnt vmcnt(0)" ::: "memory");
  __syncthreads();
  if (threadIdx.x == 0) {
    const unsigned old = xb_add(&bar[XB_SUB(x)]);
    const unsigned gen = old / nloc;
    if (old + 1u == (gen + 1u) * nloc) {
      __builtin_amdgcn_fence(__ATOMIC_RELEASE, "agent");
      asm volatile("s_waitcnt vmcnt(0)" ::: "memory");
      const unsigned og = xb_add(&bar[XB_TOP]);
      const unsigned tg = og / nx;
      if (og + 1u == (tg + 1u) * nx) {
        for (unsigned j = 0; j < 16; ++j)
          if ((xmask >> j) & 1u) __hip_atomic_fetch_add(&bar[XB_GEN(j)], 1u, __ATOMIC_RELAXED, __HIP_MEMORY_SCOPE_AGENT);
      }
    }
    unsigned sp = 0;
    while (xb_ld(&bar[XB_GEN(x)]) == gen) { __builtin_amdgcn_s_sleep(1); if (++sp > (1u << 24)) break; }
    __builtin_amdgcn_fence(__ATOMIC_ACQUIRE, "agent");
    asm volatile("s_waitcnt vmcnt(0)" ::: "memory");
  }
  __syncthreads();
}

__global__ void __launch_bounds__(NTHREADS, 2) mega_kernel(Params p) {
  __shared__ __attribute__((aligned(16))) char smem[SMEM_BYTES];
  cg::grid_group grid = cg::this_grid();
#define GSYNC() grid_barrier(p.bar(), xb_x, xb_nloc, xb_nx, xb_mask)
  const unsigned xb_x = xb_xcc_id();
  if (threadIdx.x == 0) xb_add(&p.bar()[XB_CNT(xb_x)]);
  asm volatile("s_waitcnt vmcnt(0)" ::: "memory");
  grid.sync();
  unsigned xb_nloc = 1, xb_nx = 0, xb_mask = 0;
  if (threadIdx.x == 0) {
    for (unsigned j = 0; j < 16; ++j) { const unsigned c = xb_ld(&p.bar()[XB_CNT(j)]); xb_nx += (c > 0u) ? 1u : 0u; xb_mask |= (c > 0u) ? (1u << j) : 0u; if (j == xb_x) xb_nloc = c; }
    if (xb_nloc == 0u) xb_nloc = 1u;
    if (xb_nx == 0u) xb_nx = 1u;
  }
#define RUNP(X) run_phase<X>(p, smem); GSYNC();
#ifndef PROBE_DUP
#define PROBE_DUP 0
#endif
#define DUPP(X) if (PROBE_DUP == (X)) { RUNP(X) }
  DUPP(0) RUNP(0) DUPP(1) RUNP(1) RUNP(2) DUPP(3) RUNP(3) DUPP(4) RUNP(4) DUPP(5) RUNP(5) DUPP(6) RUNP(6) DUPP(7) RUNP(7) DUPP(8) RUNP(8) DUPP(9) RUNP(9) DUPP(10)
  run_phase<10>(p, smem);
}

extern "C" void kernel_launch(void* const* d_in, const int* in_sizes, int n_in, void* d_out, int out_size,
                              void* d_ws, size_t ws_size, hipStream_t stream) {
  Params p{};
  p.x = (const float*)d_in[0]; p.pos = (const int*)d_in[1];
  p.norm1_g = (const float*)d_in[2]; p.w_in = (const float*)d_in[3]; p.v_norm_g = (const float*)d_in[4];
  p.v_norm_b = (const float*)d_in[5]; p.spatial_w = (const float*)d_in[6]; p.spatial_b = (const float*)d_in[7];
  p.kv_norm_g = (const float*)d_in[8]; p.w_uk = (const float*)d_in[9]; p.w_uv = (const float*)d_in[10];
  p.q_norm_g = (const float*)d_in[11]; p.k_norm_g = (const float*)d_in[12]; p.w_a_out = (const float*)d_in[13];
  p.w_b_out = (const float*)d_in[14]; p.w_o = (const float*)d_in[15]; p.norm2_g = (const float*)d_in[16];
  p.peer_wq = (const float*)d_in[17]; p.peer_subkeys = (const float*)d_in[18]; p.peer_u = (const float*)d_in[19];
  p.peer_v = (const float*)d_in[20];
  p.out = (float*)d_out;
  p.ws = (char*)d_ws;
  if (O_END > ws_size) { fprintf(stderr, "workspace too small: need %zu have %zu\n", (size_t)O_END, ws_size); return; }

  static int grid_blocks = 0;
  if (!grid_blocks) {
    int dev = 0, cus = 0, per_cu = 0;
    hipGetDevice(&dev);
    hipDeviceGetAttribute(&cus, hipDeviceAttributeMultiprocessorCount, dev);
    hipOccupancyMaxActiveBlocksPerMultiprocessor(&per_cu, mega_kernel, NTHREADS, 0);
    if (per_cu > 2) per_cu = 2;
    if (per_cu < 1) per_cu = 1;
    grid_blocks = cus * per_cu;
    if (grid_blocks > 8) grid_blocks &= ~7;
  }
  hipMemsetAsync(p.ws + O_BAR, 0, XB_WORDS * 4, stream);
#if MULTI_LAUNCH
  dim3 g(grid_blocks), b(NTHREADS);
  phase_kernel<0><<<g, b, 0, stream>>>(p);
  phase_kernel<1><<<g, b, 0, stream>>>(p);
  phase_kernel<2><<<g, b, 0, stream>>>(p);
  phase_kernel<3><<<g, b, 0, stream>>>(p);
  phase_kernel<4><<<g, b, 0, stream>>>(p);
  phase_kernel<5><<<g, b, 0, stream>>>(p);
  phase_kernel<6><<<g, b, 0, stream>>>(p);
  phase_kernel<7><<<g, b, 0, stream>>>(p);
  phase_kernel<8><<<g, b, 0, stream>>>(p);
  phase_kernel<9><<<g, b, 0, stream>>>(p);
  phase_kernel<10><<<g, b, 0, stream>>>(p);
#else
  void* args[] = {&p};
  hipError_t e = hipLaunchCooperativeKernel((void*)mega_kernel, dim3(grid_blocks), dim3(NTHREADS), args, 0, stream);
  if (e != hipSuccess) fprintf(stderr, "cooperative launch failed: %s (grid %d)\n", hipGetErrorString(e), grid_blocks);
#endif
}
```
